# Optimizing an MI355X kernel written in HIP

```python
import math
import jax, jax.numpy as jnp
from jax import lax
import numpy as np

D_MODEL = 1024
BATCH = 8
SEQ = 2048
DEPTH = 2

BRANCH_WIDTH = D_MODEL // 2
GLA_HEADS = 4
GLA_DV = BRANCH_WIDTH // GLA_HEADS
GLA_DK = GLA_DV // 2
GLA_LOW_RANK = 16
GLA_GATE_NORMALIZER = 16.0
GLA_CHUNK = 16
POOL_WINDOWS = (2, 4, 8, 16)
POOL_GROUPS = 4
POOL_GROUP_DIM = BRANCH_WIDTH // POOL_GROUPS
MOBA_HEADS = 4
MOBA_HEAD_DIM = BRANCH_WIDTH // MOBA_HEADS
MOBA_BLOCK = 256
MOBA_TOPK = 3
MOBA_Q_CHUNK = 16
REL_BUCKETS = 32
REL_MAX_EXACT = REL_BUCKETS // 2
REL_MAX_DIST = 128
D_FF = ((8 * D_MODEL + 767) // 768) * 256
NORM_EPS = 1e-6
NEG_INF = -1e30
IN_SPLITS = (GLA_HEADS * GLA_DK, GLA_HEADS * GLA_DK, GLA_HEADS * GLA_DV, GLA_LOW_RANK, GLA_HEADS * GLA_DV,
             BRANCH_WIDTH, MOBA_HEADS * MOBA_HEAD_DIM, MOBA_HEADS * MOBA_HEAD_DIM, MOBA_HEADS * MOBA_HEAD_DIM,
             D_MODEL, D_MODEL, D_MODEL)
IN_COLS = sum(IN_SPLITS)

kernel_name = "hybrid_gla_pool_moba_gated_block"


def rms_norm(x, w):
    x32 = x.astype(jnp.float32)
    y = x32 * lax.rsqrt(jnp.mean(x32 * x32, axis=-1, keepdims=True) + NORM_EPS)
    return (y * w.astype(jnp.float32)).astype(x.dtype)


def split_columns(proj):
    parts, off = [], 0
    for size in IN_SPLITS:
        parts.append(proj[..., off:off + size])
        off += size
    return parts


def t5_bucket(dist):
    n = jnp.maximum(dist, 0)
    large = REL_MAX_EXACT + (jnp.log(jnp.maximum(n, 1).astype(jnp.float32) / REL_MAX_EXACT)
                             / math.log(REL_MAX_DIST / REL_MAX_EXACT)
                             * (REL_BUCKETS - REL_MAX_EXACT)).astype(jnp.int32)
    large = jnp.minimum(large, REL_BUCKETS - 1)
    return jnp.where(n < REL_MAX_EXACT, n, large)


def gla_mix(q, k, v, g_lr, r, wg2, bg, norm_w):
    B_, S_ = q.shape[0], q.shape[1]
    f32 = jnp.float32
    glog = jax.nn.log_sigmoid((g_lr @ wg2).astype(f32) + bg.astype(f32)) / GLA_GATE_NORMALIZER
    N = S_ // GLA_CHUNK

    def chunks(t, d):
        return t.astype(f32).reshape(B_, N, GLA_CHUNK, GLA_HEADS, d).transpose(0, 3, 1, 2, 4)

    qc = chunks(q, GLA_DK) * (GLA_DK ** -0.5)
    kc = chunks(k, GLA_DK)
    vc = chunks(v, GLA_DV)
    b = jnp.cumsum(chunks(glog, GLA_DK), axis=3)
    causal = jnp.tril(jnp.ones((GLA_CHUNK, GLA_CHUNK), dtype=bool))
    diff = b[:, :, :, :, None, :] - b[:, :, :, None, :, :]
    decay = jnp.exp(jnp.where(causal[:, :, None], diff, -jnp.inf))
    attn = jnp.einsum('bhnid,bhnjd,bhnijd->bhnij', qc, kc, decay)
    o_intra = jnp.einsum('bhnij,bhnje->bhnie', attn, vc)
    b_last = b[:, :, :, -1]
    k_tail = kc * jnp.exp(b_last[:, :, :, None, :] - b)
    chunk_state = jnp.einsum('bhncd,bhnce->nbhde', k_tail, vc)
    chunk_decay = jnp.exp(b_last).transpose(2, 0, 1, 3)

    def step(state, inp):
        dec, cs = inp
        return dec[..., None] * state + cs, state

    init = jnp.zeros((B_, GLA_HEADS, GLA_DK, GLA_DV), f32)
    _, s_prev = lax.scan(step, init, (chunk_decay, chunk_state))
    o_inter = jnp.einsum('bhncd,nbhde->bhnce', qc * jnp.exp(b), s_prev)
    o = (o_intra + o_inter).reshape(B_, GLA_HEADS, S_, GLA_DV)
    o = rms_norm(o, norm_w)
    o = o.transpose(0, 2, 1, 3).reshape(B_, S_, GLA_HEADS * GLA_DV)
    return (o * jax.nn.silu(r.astype(f32))).astype(q.dtype)


def pool_mix(u, pool_w, pool_scale):
    B_, S_ = u.shape[0], u.shape[1]
    ug = u.astype(jnp.float32).reshape(B_, S_, POOL_GROUPS, POOL_GROUP_DIM)
    cs = jnp.cumsum(ug, axis=1)
    t = jnp.arange(S_)
    outs = []
    for gi, w in enumerate(POOL_WINDOWS):
        cg = cs[:, :, gi]
        prev = jnp.pad(cg, ((0, 0), (w, 0), (0, 0)))[:, :S_]
        cnt = jnp.minimum(t + 1, w).astype(jnp.float32)[None, :, None]
        outs.append((cg - prev) / cnt - ug[:, :, gi])
    p = jnp.stack(outs, axis=2)
    y = jnp.einsum('bsgc,gce->bsge', p, pool_w.astype(jnp.float32)).reshape(B_, S_, BRANCH_WIDTH)
    return (y * pool_scale.astype(jnp.float32)).astype(u.dtype)


def moba_mix(q, k, v, qn_w, kn_w, rel_bias):
    B_, S_ = q.shape[0], q.shape[1]
    f32 = jnp.float32

    def heads(t):
        return t.astype(f32).reshape(B_, S_, MOBA_HEADS, MOBA_HEAD_DIM).transpose(0, 2, 1, 3)

    qh = rms_norm(heads(q), qn_w)
    kh = rms_norm(heads(k), kn_w)
    vh = heads(v)
    nb = -(-S_ // MOBA_BLOCK)
    pad = nb * MOBA_BLOCK - S_
    kb = jnp.pad(kh, ((0, 0), (0, 0), (0, pad), (0, 0))).reshape(B_, MOBA_HEADS, nb, MOBA_BLOCK, MOBA_HEAD_DIM)
    vb = jnp.pad(vh, ((0, 0), (0, 0), (0, pad), (0, 0))).reshape(B_, MOBA_HEADS, nb, MOBA_BLOCK, MOBA_HEAD_DIM)
    kmean = jnp.mean(kb, axis=3)
    topk = min(MOBA_TOPK, nb)
    scale = MOBA_HEAD_DIM ** -0.5
    bias_hb = rel_bias.astype(f32).T
    bidx = jnp.arange(B_)[:, None, None, None]
    hidx = jnp.arange(MOBA_HEADS)[None, :, None, None]
    n_qc = S_ // MOBA_Q_CHUNK
    qc = qh.reshape(B_, MOBA_HEADS, n_qc, MOBA_Q_CHUNK, MOBA_HEAD_DIM).transpose(2, 0, 1, 3, 4)
    blk_ar = jnp.arange(MOBA_BLOCK)

    def chunk(args):
        ci, qq = args
        start = ci * MOBA_Q_CHUNK
        pos = start + jnp.arange(MOBA_Q_CHUNK)
        qblk = start // MOBA_BLOCK
        scores = jnp.einsum('bhqd,bhnd->bhqn', qq, kmean)
        scores = jnp.where(jnp.arange(nb) < qblk, scores, -jnp.inf)
        _, sel = lax.top_k(scores, topk)
        valid = sel < qblk
        kg = kb[bidx, hidx, sel]
        vg = vb[bidx, hidx, sel]
        kpos = sel[..., None] * MOBA_BLOCK + blk_ar
        bias_sel = bias_hb[hidx[..., None], t5_bucket(pos[None, None, :, None, None] - kpos)]
        lg_sel = jnp.einsum('bhqd,bhqkjd->bhqkj', qq, kg) * scale + bias_sel
        lg_sel = jnp.where(valid[..., None], lg_sel, NEG_INF)
        k_own = lax.dynamic_index_in_dim(kb, qblk, axis=2, keepdims=False)
        v_own = lax.dynamic_index_in_dim(vb, qblk, axis=2, keepdims=False)
        dist = pos[:, None] - (qblk * MOBA_BLOCK + blk_ar)[None, :]
        bias_own = bias_hb[:, t5_bucket(dist)]
        lg_own = jnp.einsum('bhqd,bhjd->bhqj', qq, k_own) * scale + bias_own
        lg_own = jnp.where(dist >= 0, lg_own, NEG_INF)
        lg = jnp.concatenate([lg_sel.reshape(B_, MOBA_HEADS, MOBA_Q_CHUNK, topk * MOBA_BLOCK), lg_own], axis=-1)
        p = jax.nn.softmax(lg, axis=-1)
        p_sel = p[..., :topk * MOBA_BLOCK].reshape(B_, MOBA_HEADS, MOBA_Q_CHUNK, topk, MOBA_BLOCK)
        p_own = p[..., topk * MOBA_BLOCK:]
        return (jnp.einsum('bhqkj,bhqkjd->bhqd', p_sel, vg)
                + jnp.einsum('bhqj,bhjd->bhqd', p_own, v_own))

    out = lax.map(chunk, (jnp.arange(n_qc, dtype=jnp.int32), qc))
    out = out.transpose(1, 0, 3, 2, 4).reshape(B_, S_, MOBA_HEADS * MOBA_HEAD_DIM)
    return out.astype(q.dtype)


def setup_inputs(seed: int = 0) -> dict:
    key = jax.random.key(seed)
    ks = jax.random.split(key, 20)
    nrm = jax.random.normal
    res_scale = (2 * DEPTH) ** -0.5
    return {
        "x": nrm(ks[0], (BATCH, SEQ, D_MODEL), jnp.float32),
        "norm1_w": 1.0 + 0.02 * nrm(ks[1], (DEPTH, D_MODEL), jnp.float32),
        "w_in": nrm(ks[2], (DEPTH, D_MODEL, IN_COLS), jnp.float32) * D_MODEL ** -0.5,
        "gla_wg2": nrm(ks[3], (DEPTH, GLA_LOW_RANK, GLA_HEADS * GLA_DK), jnp.float32) * GLA_LOW_RANK ** -0.5,
        "gla_bg": 0.1 * nrm(ks[4], (DEPTH, GLA_HEADS * GLA_DK), jnp.float32),
        "gla_norm_w": 1.0 + 0.02 * nrm(ks[5], (DEPTH, GLA_DV), jnp.float32),
        "pool_w": nrm(ks[6], (DEPTH, POOL_GROUPS, POOL_GROUP_DIM, POOL_GROUP_DIM), jnp.float32) * POOL_GROUP_DIM ** -0.5,
        "pool_scale": 1.0 + 0.02 * nrm(ks[7], (DEPTH, BRANCH_WIDTH), jnp.float32),
        "moba_qn_w": 1.0 + 0.02 * nrm(ks[8], (DEPTH, MOBA_HEAD_DIM), jnp.float32),
        "moba_kn_w": 1.0 + 0.02 * nrm(ks[9], (DEPTH, MOBA_HEAD_DIM), jnp.float32),
        "rel_bias": 0.5 * nrm(ks[10], (REL_BUCKETS, MOBA_HEADS), jnp.float32),
        "w_up_a": nrm(ks[11], (DEPTH, GLA_HEADS * GLA_DV, D_MODEL), jnp.float32) * (GLA_HEADS * GLA_DV) ** -0.5,
        "w_up_b": nrm(ks[12], (DEPTH, BRANCH_WIDTH, D_MODEL), jnp.float32) * BRANCH_WIDTH ** -0.5,
        "w_up_c": nrm(ks[13], (DEPTH, MOBA_HEADS * MOBA_HEAD_DIM, D_MODEL), jnp.float32) * (MOBA_HEADS * MOBA_HEAD_DIM) ** -0.5,
        "w_out": nrm(ks[14], (DEPTH, D_MODEL, D_MODEL), jnp.float32) * D_MODEL ** -0.5 * res_scale,
        "norm2_w": 1.0 + 0.02 * nrm(ks[15], (DEPTH, D_MODEL), jnp.float32),
        "ffn_w_gate": nrm(ks[16], (DEPTH, D_MODEL, D_FF), jnp.float32) * D_MODEL ** -0.5,
        "ffn_w_up": nrm(ks[17], (DEPTH, D_MODEL, D_FF), jnp.float32) * D_MODEL ** -0.5,
        "ffn_w_down": nrm(ks[18], (DEPTH, D_FF, D_MODEL), jnp.float32) * D_FF ** -0.5 * res_scale,
    }


def reference(x, norm1_w, w_in, gla_wg2, gla_bg, gla_norm_w, pool_w, pool_scale, moba_qn_w, moba_kn_w,
              rel_bias, w_up_a, w_up_b, w_up_c, w_out, norm2_w, ffn_w_gate, ffn_w_up, ffn_w_down):
    for l in range(DEPTH):
        h = rms_norm(x, norm1_w[l])
        (gq, gk, gv, g_lr, gr, pu, mq, mk, mv, gate_a, gate_b, gate_c) = split_columns(h @ w_in[l])
        ya = gla_mix(gq, gk, gv, g_lr, gr, gla_wg2[l], gla_bg[l], gla_norm_w[l])
        yb = pool_mix(pu, pool_w[l], pool_scale[l])
        yc = moba_mix(mq, mk, mv, moba_qn_w[l], moba_kn_w[l], rel_bias)
        merged = (jax.nn.sigmoid(gate_a) * (ya @ w_up_a[l])
                  + jax.nn.sigmoid(gate_b) * (yb @ w_up_b[l])
                  + jax.nn.sigmoid(gate_c) * (yc @ w_up_c[l]))
        x = x + merged @ w_out[l]
        h2 = rms_norm(x, norm2_w[l])
        x = x + (jax.nn.silu(h2 @ ffn_w_gate[l]) * (h2 @ ffn_w_up[l])) @ ffn_w_down[l]
    return x
```

```cpp
#include <hip/hip_runtime.h>
#include <cstdint>
#include <cstdio>

typedef unsigned short bf16_t;
typedef short bf16x8 __attribute__((ext_vector_type(8)));
typedef float f32x4 __attribute__((ext_vector_type(4)));

constexpr int BATCH = 8, SEQ = 2048, D = 1024, M = BATCH * SEQ, DEPTH = 2;
constexpr int IN_COLS = 6672, NIN1 = 3840, NGATE = 3072, NIN = NIN1 + NGATE;
constexpr int FF = 2816, NGU = 2 * FF;
constexpr int C_GLR = 1024;
constexpr float EPS = 1e-6f;
constexpr float LOG2E = 1.4426950408889634f;
constexpr float QSCALE = 0.08838834764831845f * LOG2E;

constexpr size_t MiB = 1u << 20;
constexpr size_t WS_CTL = 0, CTL_BYTES = 1 * MiB;
constexpr size_t WS_RSS = 1 * MiB;
constexpr size_t WS_KMEAN = 230 * MiB;
constexpr size_t WS_W = 2 * MiB;
constexpr size_t W_IN = 0, W_UP = 13 * MiB + 512 * 1024, W_OUT = W_UP + 3 * MiB, W_GU = W_OUT + 2 * MiB, W_DN = W_GU + 11 * MiB, W_PW = W_DN + 5 * MiB + 512 * 1024;
constexpr size_t WS_XB = 38 * MiB;
constexpr size_t WS_GQ = 70 * MiB, WS_GK = 78 * MiB, WS_GG = 86 * MiB;
constexpr size_t WS_GV = 102 * MiB, WS_PU = 118 * MiB;
constexpr size_t WS_MK = 134 * MiB, WS_MV = 150 * MiB;
constexpr size_t WS_SR = 166 * MiB, WS_MQ = 182 * MiB;
constexpr size_t WS_YB = 198 * MiB, WS_US = 214 * MiB;
constexpr size_t WS_SGA = 70 * MiB, WS_SGB = 102 * MiB, WS_SGC = 134 * MiB;
constexpr size_t WS_MERGED = WS_XB, WS_X1B = 70 * MiB, WS_H = 102 * MiB;
constexpr size_t WS_END = 231 * MiB;

__device__ __forceinline__ float bf2f(bf16_t h) { return __uint_as_float(((unsigned)h) << 16); }
__device__ __forceinline__ bf16_t f2bf(float f) { unsigned u = __float_as_uint(f); return (bf16_t)((u + 0x7fffu + ((u >> 16) & 1u)) >> 16); }
__device__ __forceinline__ unsigned pk2(float lo, float hi) { return (unsigned)f2bf(lo) | ((unsigned)f2bf(hi) << 16); }
__device__ __forceinline__ float wave_sum(float v) {
#pragma unroll
    for (int o = 1; o < 64; o <<= 1) v += __shfl_xor(v, o);
    return v;
}
__device__ __forceinline__ float wave_max(float v) {
#pragma unroll
    for (int o = 1; o < 64; o <<= 1) v = fmaxf(v, __shfl_xor(v, o));
    return v;
}
__device__ __forceinline__ float sigmoidf_(float x) { return 1.f / (1.f + __expf(-x)); }
__device__ __forceinline__ float siluf_(float x) { return x / (1.f + __expf(-x)); }
__device__ __forceinline__ float logsigmoidf_(float x) { return fminf(x, 0.f) - log1pf(__expf(-fabsf(x))); }

struct Inputs {
    const float *x, *norm1_w, *w_in, *wg2, *bg, *gla_nw, *pool_w, *pool_scale, *qn_w, *kn_w, *rel_bias, *w_up_a, *w_up_b, *w_up_c, *w_out, *norm2_w, *w_gate, *w_up, *w_down;
};

template <class F>
__device__ __forceinline__ void transpose_item(F src, int K, bf16_t* dst, int k0, int n0, float* scr, int lane) {
    float tv[32];
#pragma unroll
    for (int i = 0; i < 32; ++i) tv[i] = src(k0 + i, n0 + lane);
#pragma unroll
    for (int i = 0; i < 32; ++i) scr[i * 65 + lane] = tv[i];
    __builtin_amdgcn_s_waitcnt(0xc07f); asm volatile("" ::: "memory");
    const int c = lane & 3;
#pragma unroll
    for (int j = 0; j < 4; ++j) {
        const int n = (lane >> 2) + 16 * j; const float* s = scr + (8 * c) * 65 + n;
        uint4 o; o.x = pk2(s[0], s[65]); o.y = pk2(s[130], s[195]); o.z = pk2(s[260], s[325]); o.w = pk2(s[390], s[455]);
        *(uint4*)(dst + (size_t)(n0 + n) * K + k0 + 8 * c) = o;
    }
    __builtin_amdgcn_s_waitcnt(0xc07f); asm volatile("" ::: "memory");
}
constexpr int PI_IN = 32 * (NIN / 64), PI_UP = 16 * 16, PI_OUT = 32 * 16, PI_GU = 32 * (NGU / 64), PI_DN = 88 * 16, PI_PW = 4 * 2;
constexpr int PREP_ITEMS = PI_IN + 3 * PI_UP + PI_OUT + PI_GU + PI_DN + 4 * PI_PW;
template <class InP>
__device__ __forceinline__ void prep_item(InP inp, int l, unsigned char* wsw, int it, float* scr, int lane) {
    if (it < PI_IN) {
        const int nb = NIN / 64, kb = it / nb, n0 = 64 * (it % nb), k0 = 32 * kb;
        const float* w = inp->w_in + (size_t)l * D * IN_COLS; const float* nw = inp->norm1_w + l * D; bf16_t* dst = (bf16_t*)(wsw + W_IN);
        if (n0 >= 512 && n0 < 768) {
            const float* g2 = inp->wg2 + (size_t)l * 16 * 256 + (n0 - 512) + lane; float g2v[16];
#pragma unroll
            for (int r = 0; r < 16; ++r) g2v[r] = g2[r * 256];
            transpose_item([&](int k, int n) { const f32x4* wr = (const f32x4*)(w + (size_t)k * IN_COLS + C_GLR); float s = 0.f;
#pragma unroll
                for (int r4 = 0; r4 < 4; ++r4) { const f32x4 v = wr[r4]; s += v[0] * g2v[4 * r4] + v[1] * g2v[4 * r4 + 1] + v[2] * g2v[4 * r4 + 2] + v[3] * g2v[4 * r4 + 3]; }
                return s * nw[k]; }, D, dst, k0, n0, scr, lane);
        } else {
            const int off = n0 < 512 ? 0 : (n0 < 1280 ? -256 : -240);
            transpose_item([&](int k, int n) { return w[(size_t)k * IN_COLS + n + off] * nw[k]; }, D, dst, k0, n0, scr, lane);
        }
        return;
    }
    it -= PI_IN;
    if (it < 3 * PI_UP) {
        const int br = it / PI_UP; it %= PI_UP; const int kb = it / 16, n0 = 64 * (it % 16), k0 = 32 * kb;
        const float* w = (br == 0 ? inp->w_up_a : br == 1 ? inp->w_up_b : inp->w_up_c) + (size_t)l * 512 * D;
        transpose_item([&](int k, int n) { return w[(size_t)k * D + n]; }, 512, (bf16_t*)(wsw + W_UP + br * MiB), k0, n0, scr, lane);
        return;
    }
    it -= 3 * PI_UP;
    if (it < PI_OUT) {
        const int kb = it / 16, n0 = 64 * (it % 16), k0 = 32 * kb; const float* w = inp->w_out + (size_t)l * D * D;
        transpose_item([&](int k, int n) { return w[(size_t)k * D + n]; }, D, (bf16_t*)(wsw + W_OUT), k0, n0, scr, lane);
        return;
    }
    it -= PI_OUT;
    if (it < PI_GU) {
        const int nb = NGU / 64, kb = it / nb, n0 = 64 * (it % nb), k0 = 32 * kb;
        const int pn = n0 >> 8, i0 = n0 & 255; const float* w = ((i0 < 128) ? inp->w_gate : inp->w_up) + (size_t)l * D * FF; const float* nw = inp->norm2_w + l * D;
        const int coff = 128 * pn + (i0 & 127) - n0;
        transpose_item([&](int k, int n) { return w[(size_t)k * FF + n + coff] * nw[k]; }, D, (bf16_t*)(wsw + W_GU), k0, n0, scr, lane);
        return;
    }
    it -= PI_GU;
    if (it < PI_DN) {
        const int kb = it / 16, n0 = 64 * (it % 16), k0 = 32 * kb; const float* w = inp->w_down + (size_t)l * FF * D;
        transpose_item([&](int k, int n) { return w[(size_t)k * D + n]; }, FF, (bf16_t*)(wsw + W_DN), k0, n0, scr, lane);
        return;
    }
    it -= PI_DN;
    { const int g = it / PI_PW; it %= PI_PW; const int kb = it / 2, n0 = 64 * (it % 2), k0 = 32 * kb; const float* w = inp->pool_w + ((size_t)l * 4 + g) * 128 * 128;
      transpose_item([&](int k, int n) { return w[(size_t)k * 128 + n]; }, 128, (bf16_t*)(wsw + W_PW) + g * 128 * 128, k0, n0, scr, lane); }
}
__global__ void __launch_bounds__(256) k_prep(Inputs in, int l, unsigned char* ws) {
    __shared__ float scr[4][32 * 65];
    const int lane = threadIdx.x & 63, wave = threadIdx.x >> 6;
    for (int it = blockIdx.x * 4 + wave; it < PREP_ITEMS; it += gridDim.x * 4) prep_item(&in, l, ws + WS_W, it, scr[wave], lane);
}

__global__ void __launch_bounds__(256) k_rows(const float* src, bf16_t* dst, float* rss) {
    const int lane = threadIdx.x & 63, row = blockIdx.x * 4 + (threadIdx.x >> 6);
    const f32x4* xr = (const f32x4*)(src + (size_t)row * D) + lane; float s = 0.f;
    unsigned long long* o8 = (unsigned long long*)(dst + (size_t)row * D) + lane;
#pragma unroll
    for (int j = 0; j < 4; ++j) { const f32x4 v = xr[64 * j]; s += (v.x * v.x + v.y * v.y) + (v.z * v.z + v.w * v.w);
        o8[64 * j] = (unsigned long long)pk2(v.x, v.y) | ((unsigned long long)pk2(v.z, v.w) << 32); }
    s = wave_sum(s); if (lane == 0) rss[row] = s;
}

__device__ __forceinline__ void ngemm32(const bf16_t* A, int lda, const bf16_t* Bt, int ldb, int K, f32x4 (&acc)[2][2], int lane) {
    const int r = lane & 15, q = lane >> 4;
    for (int k0 = 0; k0 < K; k0 += 32) {
        bf16x8 a[2], b[2];
#pragma unroll
        for (int i = 0; i < 2; ++i) { a[i] = *(const bf16x8*)(A + (size_t)(i * 16 + r) * lda + k0 + 8 * q); b[i] = *(const bf16x8*)(Bt + (size_t)(i * 16 + r) * ldb + k0 + 8 * q); }
#pragma unroll
        for (int i = 0; i < 2; ++i)
#pragma unroll
            for (int j = 0; j < 2; ++j) acc[i][j] = __builtin_amdgcn_mfma_f32_16x16x32_bf16(a[i], b[j], acc[i][j], 0, 0, 0);
    }
}
#define NG_PRE const int lane = threadIdx.x & 63, wave = threadIdx.x >> 6; const int row0 = blockIdx.y * 64 + (wave >> 1) * 32, col0 = blockIdx.x * 64 + (wave & 1) * 32; \
    f32x4 acc[2][2]; for (int i = 0; i < 2; ++i) for (int j = 0; j < 2; ++j) acc[i][j] = (f32x4){0.f, 0.f, 0.f, 0.f};
#define NG_FOR for (int i = 0; i < 2; ++i) for (int j = 0; j < 2; ++j) for (int rg = 0; rg < 4; ++rg) { const int row = row0 + i * 16 + (lane >> 4) * 4 + rg, col = col0 + j * 16 + (lane & 15);

__global__ void __launch_bounds__(256) k_inproj1(unsigned char* ws, const float* bg) {
    NG_PRE
    ngemm32((const bf16_t*)(ws + WS_XB) + (size_t)row0 * D, D, (const bf16_t*)(ws + WS_W + W_IN) + (size_t)col0 * D, D, D, acc, lane);
    const float* rss = (const float*)(ws + WS_RSS);
    NG_FOR
        const float v = acc[i][j][rg] * rsqrtf(rss[row] * (1.f / D) + EPS);
        const int t = col >> 8, c = col & 255;
        if (t == 0) ((bf16_t*)(ws + WS_GQ))[(size_t)row * 256 + c] = f2bf(v * 0.125f);
        else if (t == 1) ((bf16_t*)(ws + WS_GK))[(size_t)row * 256 + c] = f2bf(v);
        else if (t == 2) ((float*)(ws + WS_GG))[(size_t)row * 256 + c] = logsigmoidf_(v + bg[c]) * (1.f / 16.f);
        else if (t < 5) ((bf16_t*)(ws + WS_GV))[(size_t)row * 512 + (col - 768)] = f2bf(v);
        else if (t < 7) ((bf16_t*)(ws + WS_SR))[(size_t)row * 512 + (col - 1280)] = f2bf(siluf_(v));
        else if (t < 9) ((bf16_t*)(ws + WS_PU))[(size_t)row * 512 + (col - 1792)] = f2bf(v);
        else if (t < 11) ((bf16_t*)(ws + WS_MQ))[(size_t)row * 512 + (col - 2304)] = f2bf(v);
        else if (t < 13) ((bf16_t*)(ws + WS_MK))[(size_t)row * 512 + (col - 2816)] = f2bf(v);
        else ((bf16_t*)(ws + WS_MV))[(size_t)row * 512 + (col - 3328)] = f2bf(v);
    }
}
__global__ void __launch_bounds__(256) k_gates(unsigned char* ws) {
    NG_PRE
    ngemm32((const bf16_t*)(ws + WS_XB) + (size_t)row0 * D, D, (const bf16_t*)(ws + WS_W + W_IN) + (size_t)(NIN1 + col0) * D, D, D, acc, lane);
    const float* rss = (const float*)(ws + WS_RSS);
    NG_FOR
        const float v = acc[i][j][rg] * rsqrtf(rss[row] * (1.f / D) + EPS);
        const int br = col >> 10, c = col & 1023;
        ((bf16_t*)(ws + (br == 0 ? WS_SGA : br == 1 ? WS_SGB : WS_SGC)))[(size_t)row * D + c] = f2bf(sigmoidf_(v));
    }
}
__global__ void __launch_bounds__(256) k_upmerge(unsigned char* ws) {
    NG_PRE
    f32x4 tot[2][2]; for (int i = 0; i < 2; ++i) for (int j = 0; j < 2; ++j) tot[i][j] = (f32x4){0.f, 0.f, 0.f, 0.f};
    for (int br = 0; br < 3; ++br) {
        const bf16_t* Y = (const bf16_t*)(ws + (br == 0 ? WS_SR : br == 1 ? WS_YB : WS_MQ)); const bf16_t* G = (const bf16_t*)(ws + (br == 0 ? WS_SGA : br == 1 ? WS_SGB : WS_SGC));
        for (int i = 0; i < 2; ++i) for (int j = 0; j < 2; ++j) acc[i][j] = (f32x4){0.f, 0.f, 0.f, 0.f};
        ngemm32(Y + (size_t)row0 * 512, 512, (const bf16_t*)(ws + WS_W + W_UP + br * MiB) + (size_t)col0 * 512, 512, 512, acc, lane);
        NG_FOR tot[i][j][rg] += bf2f(G[(size_t)row * D + col]) * acc[i][j][rg]; }
    }
    NG_FOR ((bf16_t*)(ws + WS_MERGED))[(size_t)row * D + col] = f2bf(tot[i][j][rg]); }
}
__global__ void __launch_bounds__(256) k_resgemm(const bf16_t* A, const bf16_t* Bt, int K, const float* resid, float* xout) {
    NG_PRE
    ngemm32(A + (size_t)row0 * K, K, Bt + (size_t)col0 * K, K, K, acc, lane);
    NG_FOR xout[(size_t)row * D + col] = resid[(size_t)row * D + col] + acc[i][j][rg]; }
}
__global__ void __launch_bounds__(256) k_ffn(unsigned char* ws) {
    const int lane = threadIdx.x & 63, wave = threadIdx.x >> 6; const int row0 = blockIdx.y * 64 + (wave >> 1) * 32, j0 = blockIdx.x * 64 + (wave & 1) * 32;
    f32x4 ag[2][2], au[2][2]; for (int i = 0; i < 2; ++i) for (int j = 0; j < 2; ++j) { ag[i][j] = (f32x4){0.f, 0.f, 0.f, 0.f}; au[i][j] = ag[i][j]; }
    const int ng = 256 * (j0 >> 7) + (j0 & 127);
    const bf16_t* A = (const bf16_t*)(ws + WS_X1B) + (size_t)row0 * D; const bf16_t* W = (const bf16_t*)(ws + WS_W + W_GU);
    ngemm32(A, D, W + (size_t)ng * D, D, D, ag, lane);
    ngemm32(A, D, W + (size_t)(ng + 128) * D, D, D, au, lane);
    const float* rss = (const float*)(ws + WS_RSS);
    for (int i = 0; i < 2; ++i) for (int j = 0; j < 2; ++j) for (int rg = 0; rg < 4; ++rg) { const int row = row0 + i * 16 + (lane >> 4) * 4 + rg, col = j0 + j * 16 + (lane & 15);
        const float rs = rsqrtf(rss[row] * (1.f / D) + EPS);
        ((bf16_t*)(ws + WS_H))[(size_t)row * FF + col] = f2bf(siluf_(ag[i][j][rg] * rs) * (au[i][j][rg] * rs)); }
}

__global__ void __launch_bounds__(128) k_gla(unsigned char* ws, const float* nw) {
    const int e = threadIdx.x, b = blockIdx.x >> 2, h = blockIdx.x & 3, lane = e & 63, wave = e >> 6;
    const bf16_t* GQ = (const bf16_t*)(ws + WS_GQ); const bf16_t* GK = (const bf16_t*)(ws + WS_GK); const float* GG = (const float*)(ws + WS_GG);
    const bf16_t* GV = (const bf16_t*)(ws + WS_GV); bf16_t* YA = (bf16_t*)(ws + WS_SR);
    __shared__ float red[2][16]; __shared__ float osh[16][128];
    float S[64];
#pragma unroll
    for (int d = 0; d < 64; ++d) S[d] = 0.f;
    const float nwe = nw[e];
    for (int t0 = 0; t0 < SEQ; t0 += 16) {
#pragma unroll 1
        for (int tt = 0; tt < 16; ++tt) {
            const size_t row = (size_t)b * SEQ + t0 + tt;
            const bf16_t* q = GQ + row * 256 + h * 64; const bf16_t* k = GK + row * 256 + h * 64; const float* g = GG + row * 256 + h * 64;
            const float v = bf2f(GV[row * 512 + h * 128 + e]); float a = 0.f;
#pragma unroll
            for (int d = 0; d < 64; ++d) { S[d] = __expf(g[d]) * S[d] + bf2f(k[d]) * v; a += bf2f(q[d]) * S[d]; }
            osh[tt][e] = a;
            const float s = wave_sum(a * a); if (lane == 0) red[wave][tt] = s;
        }
        __syncthreads();
#pragma unroll 1
        for (int tt = 0; tt < 16; ++tt) { const float rstd = rsqrtf((red[0][tt] + red[1][tt]) * (1.f / 128.f) + EPS);
            const size_t idx = ((size_t)b * SEQ + t0 + tt) * 512 + h * 128 + e; YA[idx] = f2bf(osh[tt][e] * rstd * nwe * bf2f(YA[idx])); }
        __syncthreads();
    }
}

__global__ void __launch_bounds__(256) k_pool(unsigned char* ws, const float* pw, const float* pscale) {
    __shared__ float u[31][128]; __shared__ float p[16][128];
    const int g = blockIdx.x & 3, r0 = (blockIdx.x >> 2) * 16, t0 = r0 & (SEQ - 1), tid = threadIdx.x;
    const bf16_t* PU = (const bf16_t*)(ws + WS_PU);
    for (int x = tid; x < 31 * 128; x += 256) { const int i = x >> 7, c = x & 127, t = t0 - 15 + i; u[i][c] = t >= 0 ? bf2f(PU[(size_t)(r0 - 15 + i) * 512 + g * 128 + c]) : 0.f; }
    __syncthreads();
    const int w = 2 << g;
    for (int x = tid; x < 16 * 128; x += 256) { const int i = x >> 7, c = x & 127, t = t0 + i, cnt = min(t + 1, w); float s = 0.f;
        for (int j = 0; j < cnt; ++j) s += u[15 + i - j][c];
        p[i][c] = s / (float)cnt - u[15 + i][c]; }
    __syncthreads();
    for (int x = tid; x < 16 * 128; x += 256) { const int i = x >> 7, e = x & 127; float y = 0.f;
        for (int c = 0; c < 128; ++c) y += p[i][c] * pw[((size_t)g * 128 + c) * 128 + e];
        ((bf16_t*)(ws + WS_YB))[(size_t)(r0 + i) * 512 + g * 128 + e] = f2bf(y * pscale[g * 128 + e]); }
}

__global__ void __launch_bounds__(256) k_prepass(unsigned char* ws, const float* qw, const float* kw) {
    __shared__ float part[4][128];
    const int lane = threadIdx.x & 63, wave = threadIdx.x >> 6; const int h = blockIdx.x & 3, blk = (blockIdx.x >> 2) & 7, b = blockIdx.x >> 5;
    unsigned* MQ = (unsigned*)(ws + WS_MQ); unsigned* MK = (unsigned*)(ws + WS_MK);
    const float qw0 = qw[2 * lane] * QSCALE, qw1 = qw[2 * lane + 1] * QSCALE, kw0 = kw[2 * lane], kw1 = kw[2 * lane + 1];
    float c0 = 0.f, c1 = 0.f;
    for (int r = 0; r < 64; ++r) {
        const size_t idx = ((size_t)b * SEQ + blk * 256 + wave * 64 + r) * 256 + h * 64 + lane;
        { const unsigned v = MQ[idx]; const float a = __uint_as_float(v << 16), c = __uint_as_float(v & 0xffff0000u); const float rs = rsqrtf(wave_sum(a * a + c * c) * (1.f / 128.f) + EPS); MQ[idx] = pk2(a * rs * qw0, c * rs * qw1); }
        { const unsigned v = MK[idx]; const float a = __uint_as_float(v << 16), c = __uint_as_float(v & 0xffff0000u); const float rs = rsqrtf(wave_sum(a * a + c * c) * (1.f / 128.f) + EPS);
          const float k0 = a * rs * kw0, k1 = c * rs * kw1; c0 += k0; c1 += k1; MK[idx] = pk2(k0, k1); }
    }
    part[wave][2 * lane] = c0; part[wave][2 * lane + 1] = c1;
    __syncthreads();
    if (threadIdx.x < 128) ((float*)(ws + WS_KMEAN))[(((size_t)b * 4 + h) * 8 + blk) * 128 + threadIdx.x] = ((part[0][threadIdx.x] + part[1][threadIdx.x]) + (part[2][threadIdx.x] + part[3][threadIdx.x])) * (1.f / 256.f);
}

__global__ void __launch_bounds__(256) k_moba(unsigned char* ws, const float* rel_bias) {
    __shared__ float tab[4][132]; __shared__ float qs[4][128]; __shared__ float ps[4][1024];
    const int lane = threadIdx.x & 63, wave = threadIdx.x >> 6;
    const int gw = blockIdx.x * 4 + wave; const int t = gw & (SEQ - 1), h = (gw >> 11) & 3, b = gw >> 13;
    for (int x = threadIdx.x; x < 129; x += 256) { int bk = x; if (x >= 16) { bk = 16 + (int)(logf((float)x / 16.f) / 2.0794415416798357f * 16.f); if (bk > 31) bk = 31; } tab[0][x] = rel_bias[bk * 4 + h] * LOG2E; }
    __syncthreads();
    const size_t row = (size_t)b * SEQ + t; const int qblk = t >> 8;
    unsigned* QN = (unsigned*)(ws + WS_MQ); const bf16_t* KN = (const bf16_t*)(ws + WS_MK); const unsigned* MV = (const unsigned*)(ws + WS_MV);
    const unsigned qv = QN[row * 256 + h * 64 + lane]; const float q0 = __uint_as_float(qv << 16), q1 = __uint_as_float(qv & 0xffff0000u);
    qs[wave][2 * lane] = q0; qs[wave][2 * lane + 1] = q1;
    const float* km = (const float*)(ws + WS_KMEAN) + ((size_t)b * 4 + h) * 8 * 128;
    float sc[8];
#pragma unroll
    for (int n = 0; n < 8; ++n) sc[n] = (n < qblk) ? wave_sum(q0 * km[n * 128 + 2 * lane] + q1 * km[n * 128 + 2 * lane + 1]) : -INFINITY;
    int blks[4]; int nvalid = 0;
#pragma unroll
    for (int s = 0; s < 3; ++s) { float best = -INFINITY; int bi = -1;
#pragma unroll
        for (int n = 0; n < 8; ++n) if (sc[n] > best) { best = sc[n]; bi = n; }
        blks[s] = bi;
#pragma unroll
        for (int n = 0; n < 8; ++n) if (n == bi) sc[n] = -INFINITY; }
    blks[3] = qblk;
    __builtin_amdgcn_s_waitcnt(0xc07f);
    float lg[4][4]; float mx = -INFINITY;
#pragma unroll
    for (int s = 0; s < 4; ++s) {
        const int blk = blks[s];
#pragma unroll
        for (int i = 0; i < 4; ++i) {
            lg[s][i] = -INFINITY;
            if (blk >= 0) { const int j = lane + 64 * i, tk = blk * 256 + j, dist = t - tk;
                if (dist >= 0) { const bf16_t* kr = KN + ((size_t)b * SEQ + tk) * 512 + h * 128; float dsum = 0.f;
                    for (int c = 0; c < 16; ++c) { const bf16x8 kk = *(const bf16x8*)(kr + c * 8);
#pragma unroll
                        for (int x = 0; x < 8; ++x) dsum += bf2f((bf16_t)kk[x]) * qs[wave][c * 8 + x]; }
                    lg[s][i] = dsum + tab[0][dist > 128 ? 128 : dist]; mx = fmaxf(mx, lg[s][i]); } }
        }
    }
    mx = wave_max(mx); float sum = 0.f;
#pragma unroll
    for (int s = 0; s < 4; ++s)
#pragma unroll
        for (int i = 0; i < 4; ++i) { const float pp = exp2f(lg[s][i] - mx); sum += pp; ps[wave][s * 256 + lane + 64 * i] = pp; }
    sum = wave_sum(sum);
    __builtin_amdgcn_s_waitcnt(0xc07f);
    float o0 = 0.f, o1 = 0.f;
#pragma unroll
    for (int s = 0; s < 4; ++s) { const int blk = blks[s]; if (blk < 0) continue; const int jn = (s == 3) ? (t & 255) + 1 : 256;
        const unsigned* vr = MV + ((size_t)b * SEQ + blk * 256) * 256 + h * 64 + lane;
        for (int j = 0; j < jn; ++j) { const float pp = ps[wave][s * 256 + j]; const unsigned v = vr[(size_t)j * 256]; o0 += pp * __uint_as_float(v << 16); o1 += pp * __uint_as_float(v & 0xffff0000u); } }
    const float inv = 1.f / sum;
    QN[row * 256 + h * 64 + lane] = pk2(o0 * inv, o1 * inv);
}


namespace pg8 {
#define PG8_LAS __attribute__((address_space(3)))
typedef unsigned u32x4 __attribute__((ext_vector_type(4)));
constexpr int BM = 256, BK = 64, HALF = 128, HTB = HALF * BK * 2, STAGE_BYTES = 8 * HTB, NXCD = 8, WGM = 8;
__host__ __device__ __forceinline__ int lds_byte(int r, int c) { const int st = (r >> 4) * 2 + (c >> 5), rr = r & 15, cc = c & 31, ob = rr * 64 + cc * 2; return st * 1024 + (ob ^ (((ob >> 9) & 1) << 5)); }
__host__ __device__ __forceinline__ void stage_rc(int b, int& R, int& C) { const int st = b / 1024, sb = b % 1024, swz = sb ^ (((sb >> 9) & 1) << 5); R = (st >> 1) * 16 + swz / 64; C = (st & 1) * 32 + (swz % 64) / 2; }
__host__ __device__ __forceinline__ int perm32(int rho) { const int n = rho >> 4, i = rho & 15; return 8 * (i >> 2) + 4 * n + (i & 3); }
struct Unit { int pm, pn, br; };
struct Gemm { const bf16_t* A; const bf16_t* Bt; int M, N, K; };
struct StaticOrder {
    int nM, nN, nwg, G, c;
    __device__ void init(int M_, int N_, int G_, int c_) { nM = M_ / BM; nN = N_ / BM; nwg = nM * nN; G = G_; c = c_; }
    __device__ bool next(int i, Unit& u) const {
        const long L = (long)i * G + c; if (L >= nwg) return false;
        int wgid = (int)L; { const int q = nwg / NXCD, r = nwg % NXCD, xcd = wgid % NXCD, off = wgid / NXCD; wgid = (xcd < r ? xcd * (q + 1) : r * (q + 1) + (xcd - r) * q) + off; }
        const int nig = WGM * nN, gid = wgid / nig, fm = gid * WGM, gsz = (nM - fm) < WGM ? (nM - fm) : WGM;
        u.pm = fm + ((wgid % nig) % gsz); u.pn = (wgid % nig) / gsz; u.br = 0; return true;
    }
    __device__ __forceinline__ const char* pa(const Unit& u, const Gemm& g) const { return (const char*)g.A + (size_t)u.pm * (size_t)(BM * 2) * g.K; }
    __device__ __forceinline__ const char* pb(const Unit& u, const Gemm& g) const { return (const char*)g.Bt + (size_t)u.pn * (size_t)(BM * 2) * g.K; }
    __device__ __forceinline__ void a_ready(const Unit&) const {}
    __device__ __forceinline__ void done(const Unit&) const {}
};
struct UpmOrder {
    StaticOrder so; const bf16_t *Y0, *Y1, *Y2, *W0, *W1, *W2;
    __device__ bool next(int i, Unit& u) const { if (i >= 3) return false; if (!so.next(0, u)) return false; u.br = i; return true; }
    __device__ __forceinline__ const char* pa(const Unit& u, const Gemm& g) const { const bf16_t* y = u.br == 0 ? Y0 : (u.br == 1 ? Y1 : Y2); return (const char*)y + (size_t)u.pm * (size_t)(BM * 2) * g.K; }
    __device__ __forceinline__ const char* pb(const Unit& u, const Gemm& g) const { const bf16_t* w = u.br == 0 ? W0 : (u.br == 1 ? W1 : W2); return (const char*)w + (size_t)u.pn * (size_t)(BM * 2) * g.K; }
    __device__ __forceinline__ void a_ready(const Unit&) const {}
    __device__ __forceinline__ void done(const Unit&) const {}
};
typedef float f32x2_t __attribute__((ext_vector_type(2))); typedef __bf16 bf16x2_t __attribute__((ext_vector_type(2)));
__device__ __forceinline__ unsigned cvt_pk_bf16(float lo, float hi) { const f32x2_t v = {lo, hi}; const bf16x2_t b = __builtin_convertvector(v, bf16x2_t); return __builtin_bit_cast(unsigned, b); }
__device__ __forceinline__ u32x4 pack8(const f32x4& a, const f32x4& b) { u32x4 w; w.x = cvt_pk_bf16(a[0], a[1]); w.y = cvt_pk_bf16(a[2], a[3]); w.z = cvt_pk_bf16(b[0], b[1]); w.w = cvt_pk_bf16(b[2], b[3]); return w; }
__device__ __forceinline__ void unpack8(const u32x4& w, f32x4& a, f32x4& b) {
    a[0] = __uint_as_float(w.x << 16); a[1] = __uint_as_float(w.x & 0xffff0000u); a[2] = __uint_as_float(w.y << 16); a[3] = __uint_as_float(w.y & 0xffff0000u);
    b[0] = __uint_as_float(w.z << 16); b[1] = __uint_as_float(w.z & 0xffff0000u); b[2] = __uint_as_float(w.w << 16); b[3] = __uint_as_float(w.w & 0xffff0000u);
}
__device__ __forceinline__ void row_rstd(const PG8_LAS float* tab, const Unit& u, int wr, int fr, float (&rs)[2][4]) {
#pragma unroll
    for (int ai = 0; ai < 2; ++ai)
#pragma unroll
        for (int m = 0; m < 4; ++m) rs[ai][m] = tab[(u.pm & 7) * BM + ai * HALF + wr * 64 + m * 16 + fr];
}
struct EpiIn1 {
    static constexpr bool PERM = true, AFTER_DRAIN = false;
    unsigned char* ws; const PG8_LAS float* rstab; const float* bg;
    __device__ __forceinline__ void operator()(const f32x4 (&acc)[2][2][4][2], const Unit& u, int wr, int wc, int fr, int fq) const {
        asm volatile("" : "+v"(fr), "+v"(fq));
        const int row0 = u.pm * BM + wr * 64 + fr, cw = wc * 32 + 8 * fq; const int pn = u.pn;
        float rs[2][4]; row_rstd(rstab, u, wr, fr, rs);
        if (pn == 2) {
            float* G = (float*)(ws + WS_GG); size_t zb = 0; asm volatile("" : "+s"(zb)); const float* bgl = bg + zb;
#pragma unroll
            for (int bj = 0; bj < 2; ++bj) { const int c = bj * HALF + cw; const f32x4 b0 = *(const f32x4*)(bgl + c), b1 = *(const f32x4*)(bgl + c + 4);
#pragma unroll
                for (int ai = 0; ai < 2; ++ai)
#pragma unroll
                    for (int m = 0; m < 4; ++m) { const float r = rs[ai][m]; f32x4 v0 = acc[ai][bj][m][0] * r + b0, v1 = acc[ai][bj][m][1] * r + b1;
#pragma unroll
                        for (int x = 0; x < 4; ++x) { v0[x] = (fminf(v0[x], 0.f) - __logf(1.f + __expf(-fabsf(v0[x])))) * 0.0625f; v1[x] = (fminf(v1[x], 0.f) - __logf(1.f + __expf(-fabsf(v1[x])))) * 0.0625f; }
                        float* p = G + (size_t)(row0 + ai * HALF + m * 16) * 256 + c; *(f32x4*)p = v0; *(f32x4*)(p + 4) = v1; asm volatile("" ::: "memory"); } }
            return;
        }
        bf16_t* base; int ldc, coff; float sc = 1.f; bool silu = false;
        if (pn == 0) { base = (bf16_t*)(ws + WS_GQ); ldc = 256; coff = 0; sc = 0.125f; }
        else if (pn == 1) { base = (bf16_t*)(ws + WS_GK); ldc = 256; coff = 0; }
        else { ldc = 512; const int k = (pn - 3) >> 1; coff = ((pn - 3) & 1) * 256; silu = (k == 1);
            base = (bf16_t*)(ws + (k == 0 ? WS_GV : k == 1 ? WS_SR : k == 2 ? WS_PU : k == 3 ? WS_MQ : k == 4 ? WS_MK : WS_MV)); }
#pragma unroll
        for (int ai = 0; ai < 2; ++ai)
#pragma unroll
            for (int m = 0; m < 4; ++m) { const float r = rs[ai][m] * sc; bf16_t* rowp = base + (size_t)(row0 + ai * HALF + m * 16) * ldc + coff + cw;
#pragma unroll
                for (int bj = 0; bj < 2; ++bj) { f32x4 v0 = acc[ai][bj][m][0] * r, v1 = acc[ai][bj][m][1] * r;
                    if (silu) {
#pragma unroll
                        for (int x = 0; x < 4; ++x) { v0[x] = siluf_(v0[x]); v1[x] = siluf_(v1[x]); } }
                    *(u32x4*)(rowp + bj * HALF) = pack8(v0, v1); } asm volatile("" ::: "memory"); }
    }
};
struct EpiGates {
    static constexpr bool PERM = true, AFTER_DRAIN = false;
    unsigned char* ws; const PG8_LAS float* rstab;
    __device__ __forceinline__ void operator()(const f32x4 (&acc)[2][2][4][2], const Unit& u, int wr, int wc, int fr, int fq) const {
        asm volatile("" : "+v"(fr), "+v"(fq));
        const int row0 = u.pm * BM + wr * 64 + fr, cw = wc * 32 + 8 * fq; const int br = u.pn >> 2;
        float rs[2][4]; row_rstd(rstab, u, wr, fr, rs);
        bf16_t* base = (bf16_t*)(ws + (br == 0 ? WS_SGA : br == 1 ? WS_SGB : WS_SGC)) + (u.pn & 3) * 256 + cw;
#pragma unroll
        for (int ai = 0; ai < 2; ++ai)
#pragma unroll
            for (int m = 0; m < 4; ++m) { const float r = rs[ai][m]; bf16_t* rowp = base + (size_t)(row0 + ai * HALF + m * 16) * D;
#pragma unroll
                for (int bj = 0; bj < 2; ++bj) { f32x4 v0 = acc[ai][bj][m][0] * r, v1 = acc[ai][bj][m][1] * r;
#pragma unroll
                    for (int x = 0; x < 4; ++x) { v0[x] = sigmoidf_(v0[x]); v1[x] = sigmoidf_(v1[x]); }
                    *(u32x4*)(rowp + bj * HALF) = pack8(v0, v1); } asm volatile("" ::: "memory"); }
    }
};
struct EpiUpm {
    static constexpr bool PERM = true, AFTER_DRAIN = false;
    unsigned char* ws;
    __device__ __forceinline__ void operator()(const f32x4 (&acc)[2][2][4][2], const Unit& u, int wr, int wc, int fr, int fq) const {
        asm volatile("" : "+v"(fr), "+v"(fq));
        const int row0 = u.pm * BM + wr * 64 + fr, col0 = u.pn * BM + wc * 32 + 8 * fq; const int br = u.br;
        const bf16_t* G = (const bf16_t*)(ws + (br == 0 ? WS_SGA : br == 1 ? WS_SGB : WS_SGC)); bf16_t* O = (bf16_t*)(ws + WS_MERGED);
#pragma unroll
        for (int ai = 0; ai < 2; ++ai)
#pragma unroll
            for (int m = 0; m < 4; ++m) { const size_t off = (size_t)(row0 + ai * HALF + m * 16) * D + col0;
#pragma unroll
                for (int bj = 0; bj < 2; ++bj) { f32x4 g0, g1; unpack8(*(const u32x4*)(G + off + bj * HALF), g0, g1);
                    f32x4 v0 = acc[ai][bj][m][0] * g0, v1 = acc[ai][bj][m][1] * g1;
                    if (br != 0) { f32x4 p0, p1; unpack8(*(const u32x4*)(O + off + bj * HALF), p0, p1); v0 += p0; v1 += p1; }
                    *(u32x4*)(O + off + bj * HALF) = pack8(v0, v1); } }
    }
};
struct EpiRes {
    static constexpr bool PERM = true, AFTER_DRAIN = false;
    const float* resid; float* xout; bf16_t* xb; float* rssp; bool st;
    __device__ __forceinline__ void operator()(const f32x4 (&acc)[2][2][4][2], const Unit& u, int wr, int wc, int fr, int fq) const {
        asm volatile("" : "+v"(fr), "+v"(fq));
        const int row0 = u.pm * BM + wr * 64 + fr, col0 = u.pn * BM + wc * 32 + 8 * fq;
#pragma unroll
        for (int ai = 0; ai < 2; ++ai)
#pragma unroll
            for (int m = 0; m < 4; ++m) { const int row = row0 + ai * HALF + m * 16; const size_t off = (size_t)row * D + col0; float s = 0.f;
#pragma unroll
                for (int bj = 0; bj < 2; ++bj) { const f32x4 r0 = *(const f32x4*)(resid + off + bj * HALF), r1 = *(const f32x4*)(resid + off + bj * HALF + 4);
                    const f32x4 v0 = acc[ai][bj][m][0] + r0, v1 = acc[ai][bj][m][1] + r1;
                    if (st) { *(f32x4*)(xout + off + bj * HALF) = v0; *(f32x4*)(xout + off + bj * HALF + 4) = v1; }
                    if (xb && st) *(u32x4*)(xb + off + bj * HALF) = pack8(v0, v1);
                    s += ((v0[0] * v0[0] + v0[1] * v0[1]) + (v0[2] * v0[2] + v0[3] * v0[3])) + ((v1[0] * v1[0] + v1[1] * v1[1]) + (v1[2] * v1[2] + v1[3] * v1[3])); }
                s += __shfl_xor(s, 16); s += __shfl_xor(s, 32);
                if (fq == 0 && rssp && st) rssp[(size_t)row * 16 + u.pn * 4 + wc] = s; }
    }
};
struct EpiFfn {
    static constexpr bool PERM = true, AFTER_DRAIN = false;
    bf16_t* H; const PG8_LAS float* rstab;
    __device__ __forceinline__ void operator()(const f32x4 (&acc)[2][2][4][2], const Unit& u, int wr, int wc, int fr, int fq) const {
        asm volatile("" : "+v"(fr), "+v"(fq));
        const int row0 = u.pm * BM + wr * 64 + fr, col0 = u.pn * HALF + wc * 32 + 8 * fq;
        float rs[2][4]; row_rstd(rstab, u, wr, fr, rs);
#pragma unroll
        for (int ai = 0; ai < 2; ++ai)
#pragma unroll
            for (int m = 0; m < 4; ++m) { const float r = rs[ai][m]; f32x4 g0 = acc[ai][0][m][0] * r, g1 = acc[ai][0][m][1] * r; const f32x4 u0 = acc[ai][1][m][0] * r, u1 = acc[ai][1][m][1] * r;
#pragma unroll
                for (int x = 0; x < 4; ++x) { g0[x] = siluf_(g0[x]) * u0[x]; g1[x] = siluf_(g1[x]) * u1[x]; }
                *(u32x4*)(H + (size_t)(row0 + ai * HALF + m * 16) * FF + col0) = pack8(g0, g1); asm volatile("" ::: "memory"); }
    }
};
template <class Epi, class Sched, bool ALIGN_EPI = false, bool SP2 = false>
__device__ __forceinline__ void gemm_phase(PG8_LAS unsigned char* lds, const Gemm g, const Sched& S, const Epi& E, const int tid) {
    const int wid = __builtin_amdgcn_readfirstlane(tid >> 6), lane = tid & 63, wr = wid >> 2, wc = wid & 3, fr = lane & 15, fq = lane >> 4;
    const int K = g.K, nt = K / BK;
    unsigned voffA[2], voffB[2];
#pragma unroll
    for (int i = 0; i < 2; ++i) { int R, C; stage_rc(tid * 16 + i * 8192, R, C); const int Rb = Epi::PERM ? ((R & ~31) + perm32(R & 31)) : R;
        voffA[i] = (unsigned)(R * K + C) * 2u; voffB[i] = (unsigned)(Rb * K + C) * 2u; }
    const size_t kstep = (size_t)(BK * 2);
    const size_t hstep = (size_t)HALF * K * 2;
    const unsigned ldsw = (unsigned)wid * 1024u;
    const int aoff = lds_byte(wr * 64 + fr, fq * 8), boff = lds_byte(wc * 32 + fr, fq * 8);
#define PG8_SA(b, h) (((b) * 2 + (h)) * HTB)
#define PG8_SB(b, h) ((4 + (b) * 2 + (h)) * HTB)
#define PG8_STAGE(bufoff, gbase, voff) do { _Pragma("unroll") for (int _i = 0; _i < 2; ++_i) \
        __builtin_amdgcn_global_load_lds((const unsigned*)((const char*)(gbase) + (voff)[_i]), (PG8_LAS unsigned*)(lds + (bufoff) + ldsw + _i * 8192), 16, 0, 0); } while (0)
#define PG8_LDA(dst, b, h) do { _Pragma("unroll") for (int m = 0; m < 4; ++m) _Pragma("unroll") for (int k = 0; k < 2; ++k) dst[m][k] = *(const PG8_LAS bf16x8*)(lds + PG8_SA(b, h) + aoff + m * 2048 + k * 1024); } while (0)
#define PG8_LDB(dst, b, h) do { _Pragma("unroll") for (int n = 0; n < 2; ++n) _Pragma("unroll") for (int k = 0; k < 2; ++k) dst[n][k] = *(const PG8_LAS bf16x8*)(lds + PG8_SB(b, h) + boff + n * 2048 + k * 1024); } while (0)
#define PG8_MMA(ai, bj, At, Bt) do { __builtin_amdgcn_s_setprio(1); _Pragma("unroll") for (int m = 0; m < 4; ++m) _Pragma("unroll") for (int n = 0; n < 2; ++n) _Pragma("unroll") for (int k = 0; k < 2; ++k) \
        acc[ai][bj][m][n] = __builtin_amdgcn_mfma_f32_16x16x32_bf16(Bt[n][k], At[m][k], acc[ai][bj][m][n], 0, 0, 0); __builtin_amdgcn_s_setprio(0); } while (0)
#define PG8_WAIT_V(n) asm volatile("s_waitcnt vmcnt(" #n ")" ::: "memory")
#define PG8_WAIT_L(n) asm volatile("s_waitcnt lgkmcnt(" #n ")" ::: "memory")
#define PG8_BAR __builtin_amdgcn_s_barrier()
#define PG8_SCHED __builtin_amdgcn_sched_barrier(0)
    Unit cur, nxt; int ui = 0;
    if (!S.next(0, cur)) return;
    f32x4 acc[2][2][4][2];
#pragma unroll
    for (int a = 0; a < 2; ++a)
#pragma unroll
        for (int b = 0; b < 2; ++b)
#pragma unroll
            for (int m = 0; m < 4; ++m)
#pragma unroll
                for (int n = 0; n < 2; ++n) acc[a][b][m][n] = (f32x4){0.f, 0.f, 0.f, 0.f};
    bf16x8 At[4][2], B0[2][2], B1[2][2];
    const char* cA = S.pa(cur, g); const char* cB = S.pb(cur, g);
    S.a_ready(cur);
    if constexpr (SP2) {
        PG8_STAGE(PG8_SB(0, 0), cB, voffB); PG8_STAGE(PG8_SB(0, 1), cB + hstep, voffB); PG8_STAGE(PG8_SA(0, 0), cA, voffA); PG8_STAGE(PG8_SA(0, 1), cA + hstep, voffA);
        if (wr == 1) PG8_BAR;
        PG8_WAIT_V(2); PG8_BAR;
        PG8_STAGE(PG8_SB(1, 0), cB + kstep, voffB); PG8_STAGE(PG8_SA(1, 0), cA + kstep, voffA); PG8_STAGE(PG8_SB(1, 1), cB + hstep + kstep, voffB);
        PG8_WAIT_V(6); PG8_BAR;
    } else {
        PG8_STAGE(PG8_SB(0, 0), cB, voffB); PG8_STAGE(PG8_SA(0, 0), cA, voffA); PG8_STAGE(PG8_SB(0, 1), cB + hstep, voffB); PG8_STAGE(PG8_SA(0, 1), cA + hstep, voffA);
        if (wr == 1) PG8_BAR;
        PG8_WAIT_V(4); PG8_BAR;
        PG8_STAGE(PG8_SB(1, 0), cB + kstep, voffB); PG8_STAGE(PG8_SA(1, 0), cA + kstep, voffA); PG8_STAGE(PG8_SB(1, 1), cB + hstep + kstep, voffB);
        PG8_WAIT_V(6); PG8_BAR;
    }
    for (;;) {
        const bool has_next = S.next(ui + 1, nxt);
        const char* nA = has_next ? S.pa(nxt, g) : cA; const char* nB = has_next ? S.pb(nxt, g) : cB;
        for (int t = 0; t < nt; t += 2) {
            const bool last = (t == nt - 2);
            const char* a1 = cA + (size_t)(t + 1) * kstep;
            const char* a2 = last ? nA : cA + (size_t)(t + 2) * kstep; const char* b2 = last ? nB : cB + (size_t)(t + 2) * kstep;
            const char* a3 = a2 + kstep; const char* b3 = b2 + kstep;
            if (last && has_next) S.a_ready(nxt);
            if constexpr (SP2) {
            PG8_LDB(B0, 0, 0); PG8_LDB(B1, 0, 1); PG8_SCHED; PG8_LDA(At, 0, 0); PG8_STAGE(PG8_SA(1, 1), a1 + hstep, voffA);
            PG8_WAIT_V(8); PG8_WAIT_L(0); PG8_BAR; PG8_MMA(0, 0, At, B0); PG8_MMA(0, 1, At, B1); PG8_BAR; PG8_SCHED;
            PG8_LDA(At, 0, 1); PG8_STAGE(PG8_SB(0, 0), b2, voffB); PG8_STAGE(PG8_SB(0, 1), b2 + hstep, voffB); PG8_STAGE(PG8_SA(0, 0), a2, voffA);
            PG8_WAIT_V(8); PG8_WAIT_L(0); PG8_BAR; PG8_MMA(1, 0, At, B0); PG8_MMA(1, 1, At, B1); PG8_BAR; PG8_SCHED;
            PG8_LDB(B0, 1, 0); PG8_LDB(B1, 1, 1); PG8_SCHED; PG8_LDA(At, 1, 0); PG8_STAGE(PG8_SA(0, 1), a2 + hstep, voffA);
            PG8_WAIT_V(8); PG8_WAIT_L(0); PG8_BAR; PG8_MMA(0, 0, At, B0); PG8_MMA(0, 1, At, B1); PG8_BAR; PG8_SCHED;
            PG8_LDA(At, 1, 1); PG8_STAGE(PG8_SB(1, 0), b3, voffB); PG8_STAGE(PG8_SB(1, 1), b3 + hstep, voffB); PG8_STAGE(PG8_SA(1, 0), a3, voffA);
            PG8_WAIT_V(8); PG8_WAIT_L(0); PG8_BAR; PG8_MMA(1, 0, At, B0); PG8_MMA(1, 1, At, B1); PG8_BAR; PG8_SCHED;
            } else {
            PG8_LDB(B0, 0, 0); PG8_SCHED; PG8_LDA(At, 0, 0); PG8_STAGE(PG8_SA(1, 1), a1 + hstep, voffA);
            PG8_WAIT_L(8); PG8_BAR; PG8_WAIT_L(0); PG8_MMA(0, 0, At, B0); PG8_BAR; PG8_SCHED;
            PG8_LDB(B1, 0, 1); PG8_STAGE(PG8_SB(0, 0), b2, voffB);
            PG8_BAR; PG8_WAIT_L(0); PG8_MMA(0, 1, At, B1); PG8_BAR;
            PG8_LDA(At, 0, 1); PG8_STAGE(PG8_SA(0, 0), a2, voffA);
            PG8_BAR; PG8_WAIT_L(0); PG8_MMA(1, 0, At, B0); PG8_BAR; PG8_SCHED;
            PG8_STAGE(PG8_SB(0, 1), b2 + hstep, voffB);
            PG8_WAIT_V(6); PG8_BAR; PG8_MMA(1, 1, At, B1); PG8_BAR;
            PG8_LDB(B0, 1, 0); PG8_SCHED; PG8_LDA(At, 1, 0); PG8_STAGE(PG8_SA(0, 1), a2 + hstep, voffA);
            PG8_WAIT_L(8); PG8_BAR; PG8_WAIT_L(0); PG8_MMA(0, 0, At, B0); PG8_BAR; PG8_SCHED;
            PG8_LDB(B1, 1, 1); PG8_STAGE(PG8_SB(1, 0), b3, voffB);
            PG8_BAR; PG8_WAIT_L(0); PG8_MMA(0, 1, At, B1); PG8_BAR;
            PG8_LDA(At, 1, 1); PG8_STAGE(PG8_SA(1, 0), a3, voffA);
            PG8_BAR; PG8_WAIT_L(0); PG8_MMA(1, 0, At, B0); PG8_BAR; PG8_SCHED;
            PG8_STAGE(PG8_SB(1, 1), b3 + hstep, voffB);
            PG8_WAIT_V(6); PG8_BAR; PG8_MMA(1, 1, At, B1); PG8_BAR;
            }
        }
        if constexpr (ALIGN_EPI) { if (wr == 0) PG8_BAR; }
        if constexpr (!Epi::AFTER_DRAIN) { E(acc, cur, wr, wc, fr, fq); S.done(cur); }
        if (!has_next) break;
#pragma unroll
        for (int a = 0; a < 2; ++a)
#pragma unroll
            for (int b = 0; b < 2; ++b)
#pragma unroll
                for (int m = 0; m < 4; ++m)
#pragma unroll
                    for (int n = 0; n < 2; ++n) acc[a][b][m][n] = (f32x4){0.f, 0.f, 0.f, 0.f};
        cur = nxt; cA = nA; cB = nB; ++ui;
        if constexpr (ALIGN_EPI) { if (wr == 1) PG8_BAR; }
    }
    PG8_WAIT_V(0);
    if constexpr (!ALIGN_EPI) { if (wr == 0) PG8_BAR; }
    PG8_BAR;
    if constexpr (Epi::AFTER_DRAIN) { E.fused(acc, cur, wr, wc, fr, fq, lds, wid, lane); S.done(cur); }
#undef PG8_SA
#undef PG8_SB
#undef PG8_STAGE
#undef PG8_LDA
#undef PG8_LDB
#undef PG8_MMA
#undef PG8_WAIT_V
#undef PG8_WAIT_L
#undef PG8_BAR
#undef PG8_SCHED
}
}

constexpr int NWAVES = 8;
constexpr int RING_BYTES = 131072, LDSCTL_OFF = RING_BYTES, MISC_OFF = LDSCTL_OFF + 320, RSTD_OFF = RING_BYTES + 1024, LDS_BYTES = 147456;
constexpr int CW_BAR = 4096;
#define GAS __attribute__((address_space(1)))
#define LAS __attribute__((address_space(3)))
typedef GAS unsigned gu32;
#define RLX_AGENT __ATOMIC_RELAXED, __HIP_MEMORY_SCOPE_AGENT
#define XB_TMO      128
#define XB_XCNT(j)  (256  + 64 * (j))
#define XB_XSUB(j)  (1280 + 64 * (j))
#define XB_XGEN(j)  (2304 + 64 * (j))
#define XB_TOP      3328
#define XB_TOPGEN   3392
#define XCD_BAR_WORDS 3456
#define XB_SPIN_CAP (1u << 18)

__device__ __forceinline__ unsigned xb_ld(unsigned* p)              { return __hip_atomic_load(p, __ATOMIC_RELAXED, __HIP_MEMORY_SCOPE_AGENT); }
__device__ __forceinline__ unsigned xb_add(unsigned* p, unsigned v) { return __hip_atomic_fetch_add(p, v, __ATOMIC_RELAXED, __HIP_MEMORY_SCOPE_AGENT); }
__device__ __forceinline__ unsigned xb_xcc_id() { return (unsigned)__builtin_amdgcn_s_getreg((3 << 11) | 20) & 0xFu; }
#define XB_SPIN(cond, bar) do { unsigned _sp = 0; while (cond) { __builtin_amdgcn_s_sleep(1); \
    if ((++_sp & 255u) == 0u) { if (xb_ld(&(bar)[XB_TMO])) break; if (_sp > XB_SPIN_CAP) { atomicAdd(&(bar)[XB_TMO], 1u); break; } } } } while (0)

struct XcdBarrier {
    unsigned* bar; unsigned x;
    volatile LAS unsigned* st;
};

__device__ __forceinline__ XcdBarrier xcd_barrier_post(unsigned* bar, volatile LAS unsigned* st) {
    XcdBarrier b; b.bar = bar; b.x = xb_xcc_id(); b.st = st;
    if (threadIdx.x == 0) (void)xb_add(&bar[XB_XCNT(b.x)], 1u);
    return b;
}
__device__ __forceinline__ void xcd_barrier_complete(unsigned* bar, unsigned x, unsigned& nloc, unsigned& nx) {
    const unsigned G = gridDim.x * gridDim.y * gridDim.z;
    unsigned sum, cnt, mine, sp = 0u;
    for (;;) {
        sum = 0u; cnt = 0u; mine = 0u;
#pragma unroll
        for (unsigned j = 0; j < 16; ++j) { const unsigned c = xb_ld(&bar[XB_XCNT(j)]); sum += c; cnt += (c > 0u) ? 1u : 0u; mine = (j == x) ? c : mine; }
        if (sum == G) break;
        __builtin_amdgcn_s_sleep(1);
        if ((++sp & 255u) == 0u) { if (xb_ld(&bar[XB_TMO])) break; if (sp > XB_SPIN_CAP) { atomicAdd(&bar[XB_TMO], 1u); break; } }
    }
    nloc = mine > 0u ? mine : 1u; nx = cnt > 0u ? cnt : 1u;
}

__device__ __forceinline__ void xcd_barrier(const XcdBarrier& b) {
    asm volatile("s_waitcnt vmcnt(0)" ::: "memory");
    __syncthreads();
    if (threadIdx.x == 0) {
        unsigned* bar = b.bar;
        __builtin_amdgcn_s_waitcnt(0);
        unsigned nloc = b.st[0], nx = b.st[1];
        if (nloc == 0u) { xcd_barrier_complete(bar, b.x, nloc, nx); b.st[0] = nloc; b.st[1] = nx; }
        const unsigned old = xb_add(&bar[XB_XSUB(b.x)], 1u);
        const unsigned gen = old / nloc;
        if (old + 1u == (gen + 1u) * nloc) {
            __builtin_amdgcn_fence(__ATOMIC_RELEASE, "agent");
            asm volatile("s_waitcnt vmcnt(0)" ::: "memory");
            const unsigned og = xb_add(&bar[XB_TOP], 1u);
            const unsigned tg = og / nx;
            if (og + 1u == (tg + 1u) * nx) xb_add(&bar[XB_TOPGEN], 1u);
            else XB_SPIN(xb_ld(&bar[XB_TOPGEN]) == tg, bar);
            __builtin_amdgcn_fence(__ATOMIC_ACQUIRE, "agent");
            xb_add(&bar[XB_XGEN(b.x)], 1u);
            asm volatile("s_waitcnt vmcnt(0)" ::: "memory");
        } else {
            XB_SPIN(xb_ld(&bar[XB_XGEN(b.x)]) == gen, bar);
            __builtin_amdgcn_fence(__ATOMIC_ACQUIRE, "agent");
            asm volatile("s_waitcnt vmcnt(0)" ::: "memory");
        }
    }
    __syncthreads();
}

constexpr size_t WS_RSSP = WS_RSS;
constexpr size_t WS_KMEAN2 = 230 * MiB;
constexpr size_t WS_DL = 230 * MiB + 256 * 1024;
constexpr size_t WS_YC = WS_MQ;
constexpr size_t WS_YA = WS_SR;
constexpr size_t WS_S2 = 232 * MiB;
constexpr size_t WS_END2 = 248 * MiB;


namespace mix {
typedef unsigned u32x4 __attribute__((ext_vector_type(4)));
typedef unsigned u32x2 __attribute__((ext_vector_type(2)));
#define MIX_LAS __attribute__((address_space(3)))
using pg8::pack8; using pg8::unpack8; using pg8::cvt_pk_bf16;
#define MIX_BAR() do { asm volatile("s_waitcnt vmcnt(0) lgkmcnt(0)" ::: "memory"); __builtin_amdgcn_s_barrier(); asm volatile("" ::: "memory"); } while (0)

__device__ __forceinline__ void prepass_item(unsigned char* ws, const float* qw, const float* kw, int b, int blk, int h, MIX_LAS float* part, int tid, int lane, int wave) {
    const int sub = lane >> 4, c8 = (lane & 15) * 8;
    f32x4 qw0 = *(const f32x4*)(qw + c8) * QSCALE, qw1 = *(const f32x4*)(qw + c8 + 4) * QSCALE; const f32x4 kw0 = *(const f32x4*)(kw + c8), kw1 = *(const f32x4*)(kw + c8 + 4);
    f32x4 cs0 = {0.f, 0.f, 0.f, 0.f}, cs1 = cs0;
    bf16_t* MQ = (bf16_t*)(ws + WS_MQ); bf16_t* MK = (bf16_t*)(ws + WS_MK);
#pragma unroll 4
    for (int it = 0; it < 8; ++it) {
        const size_t off = ((size_t)b * SEQ + blk * 256 + wave * 32 + it * 4 + sub) * 512 + h * 128 + c8;
        { f32x4 a, c; unpack8(*(const u32x4*)(MQ + off), a, c); float ss = ((a[0] * a[0] + a[1] * a[1]) + (a[2] * a[2] + a[3] * a[3])) + ((c[0] * c[0] + c[1] * c[1]) + (c[2] * c[2] + c[3] * c[3]));
          ss += __shfl_xor(ss, 1); ss += __shfl_xor(ss, 2); ss += __shfl_xor(ss, 4); ss += __shfl_xor(ss, 8); const float rs = rsqrtf(ss * (1.f / 128.f) + EPS);
          *(u32x4*)(MQ + off) = pack8(a * rs * qw0, c * rs * qw1); }
        { f32x4 a, c; unpack8(*(const u32x4*)(MK + off), a, c); float ss = ((a[0] * a[0] + a[1] * a[1]) + (a[2] * a[2] + a[3] * a[3])) + ((c[0] * c[0] + c[1] * c[1]) + (c[2] * c[2] + c[3] * c[3]));
          ss += __shfl_xor(ss, 1); ss += __shfl_xor(ss, 2); ss += __shfl_xor(ss, 4); ss += __shfl_xor(ss, 8); const float rs = rsqrtf(ss * (1.f / 128.f) + EPS);
          a = a * rs * kw0; c = c * rs * kw1; cs0 += a; cs1 += c; *(u32x4*)(MK + off) = pack8(a, c); }
    }
#pragma unroll
    for (int j = 0; j < 4; ++j) { cs0[j] += __shfl_xor(cs0[j], 16); cs0[j] += __shfl_xor(cs0[j], 32); cs1[j] += __shfl_xor(cs1[j], 16); cs1[j] += __shfl_xor(cs1[j], 32); }
    if (sub == 0) { *(MIX_LAS f32x4*)(part + wave * 128 + c8) = cs0; *(MIX_LAS f32x4*)(part + wave * 128 + c8 + 4) = cs1; }
    MIX_BAR();
    if (tid < 128) { float s = 0.f;
#pragma unroll
        for (int w = 0; w < 8; ++w) s += part[w * 128 + tid];
        ((float*)(ws + WS_KMEAN))[(((size_t)b * 4 + h) * 8 + blk) * 128 + tid] = s * (1.f / 256.f); }
    MIX_BAR();
}

constexpr int PSTR = 272;
__device__ __forceinline__ void pool_item(unsigned char* ws, const float* pscale, int pm, int g, MIX_LAS unsigned char* lds, int tid, int lane, int wave) {
    MIX_LAS unsigned char* P = lds; MIX_LAS unsigned char* W = lds + 256 * PSTR;
    const bf16_t* PW = (const bf16_t*)(ws + WS_W + W_PW) + g * 128 * 128;
#pragma unroll
    for (int j = 0; j < 4; ++j) { const int id = tid + 512 * j, e = id >> 4, cc = id & 15; *(MIX_LAS u32x4*)(W + e * PSTR + cc * 16) = *(const u32x4*)(PW + e * 128 + cc * 8); }
    {
        const int cp = tid & 63, seg = tid >> 6, w = 2 << g; const int row0 = pm * 256 + seg * 32, t0 = row0 & (SEQ - 1);
        const unsigned* PU = (const unsigned*)(ws + WS_PU) + g * 64 + cp;
        float s0 = 0.f, s1 = 0.f;
        for (int j = 1; j < w; ++j) if (t0 - j >= 0) { const unsigned v = PU[(size_t)(row0 - j) * 256]; s0 += __uint_as_float(v << 16); s1 += __uint_as_float(v & 0xffff0000u); }
#pragma unroll 8
        for (int r = 0; r < 32; ++r) {
            const int t = t0 + r; const unsigned v = PU[(size_t)(row0 + r) * 256]; const float u0 = __uint_as_float(v << 16), u1 = __uint_as_float(v & 0xffff0000u);
            s0 += u0; s1 += u1; const float ic = 1.f / (float)min(t + 1, w);
            *(MIX_LAS unsigned*)(P + (seg * 32 + r) * PSTR + cp * 4) = cvt_pk_bf16(s0 * ic - u0, s1 * ic - u1);
            if (t - w + 1 >= 0) { const unsigned o = PU[(size_t)(row0 + r - w + 1) * 256]; s0 -= __uint_as_float(o << 16); s1 -= __uint_as_float(o & 0xffff0000u); }
        }
    }
    MIX_BAR();
    f32x4 acc[8][2];
#pragma unroll
    for (int n = 0; n < 8; ++n) { acc[n][0] = (f32x4){0.f, 0.f, 0.f, 0.f}; acc[n][1] = acc[n][0]; }
    const int r = lane & 15, q = lane >> 4;
#pragma unroll
    for (int kk = 0; kk < 4; ++kk) {
        bf16x8 pf[2];
#pragma unroll
        for (int m = 0; m < 2; ++m) pf[m] = *(const MIX_LAS bf16x8*)(P + (wave * 32 + m * 16 + r) * PSTR + (kk * 32 + 8 * q) * 2);
#pragma unroll
        for (int n = 0; n < 8; ++n) { const bf16x8 wf = *(const MIX_LAS bf16x8*)(W + (n * 16 + r) * PSTR + (kk * 32 + 8 * q) * 2);
#pragma unroll
            for (int m = 0; m < 2; ++m) acc[n][m] = __builtin_amdgcn_mfma_f32_16x16x32_bf16(wf, pf[m], acc[n][m], 0, 0, 0); }
    }
    bf16_t* YB = (bf16_t*)(ws + WS_YB);
#pragma unroll
    for (int n = 0; n < 8; ++n) { const f32x4 sc = *(const f32x4*)(pscale + g * 128 + n * 16 + 4 * q);
#pragma unroll
        for (int m = 0; m < 2; ++m) { const f32x4 y = acc[n][m] * sc; u32x2 o; o.x = cvt_pk_bf16(y[0], y[1]); o.y = cvt_pk_bf16(y[2], y[3]);
            *(u32x2*)(YB + (size_t)(pm * 256 + wave * 32 + m * 16 + r) * 512 + g * 128 + n * 16 + 4 * q) = o; } }
    MIX_BAR();
}

constexpr int GSTR = 144;
constexpr int GL_SEG = 0, GL_QE = 2048, GL_KE = GL_QE + 64 * GSTR, GL_VT = GL_KE + 64 * GSTR, GL_P = GL_VT + 128 * GSTR, GL_RED = GL_P + 64 * GSTR;
__device__ __forceinline__ void gla_cumsum(const float* GG, size_t row0, int h, MIX_LAS unsigned char* lds, int d, int seg, float (&bc)[8], float& bL) {
    const float* g = GG + (row0 + seg * 8) * 256 + h * 64 + d; float c = 0.f;
#pragma unroll
    for (int j = 0; j < 8; ++j) { c += g[j * 256]; bc[j] = c; }
    MIX_LAS float* SEG = (MIX_LAS float*)(lds + GL_SEG); SEG[seg * 64 + d] = c;
    MIX_BAR();
    float off = 0.f, tot = 0.f;
#pragma unroll
    for (int s = 0; s < 8; ++s) { const float v = SEG[s * 64 + d]; tot += v; off += (s < seg) ? v : 0.f; }
#pragma unroll
    for (int j = 0; j < 8; ++j) bc[j] += off;
    bL = tot;
}
__device__ __forceinline__ void gla_vt(const bf16_t* GV, size_t row0, int h, MIX_LAS unsigned char* lds, int tid) {
    const int e = tid & 127, tq = tid >> 7; const bf16_t* v = GV + (row0 + tq * 16) * 512 + h * 128 + e; unsigned w[8];
#pragma unroll
    for (int j = 0; j < 8; ++j) w[j] = (unsigned)v[(2 * j) * 512] | ((unsigned)v[(2 * j + 1) * 512] << 16);
    MIX_LAS u32x4* p = (MIX_LAS u32x4*)(lds + GL_VT + e * GSTR + tq * 32); p[0] = (u32x4){w[0], w[1], w[2], w[3]}; p[1] = (u32x4){w[4], w[5], w[6], w[7]};
}
__device__ __forceinline__ void gla_passA_item(unsigned char* ws, int cid, MIX_LAS unsigned char* lds, int tid, int lane, int wave) {
    const int d = tid & 63, seg = tid >> 6, bh = cid >> 5, n = cid & 31, b = bh >> 2, h = bh & 3; const size_t row0 = (size_t)b * SEQ + n * 64;
    float bc[8], bL;
    const bf16_t* gk = (const bf16_t*)(ws + WS_GK) + (row0 + seg * 8) * 256 + h * 64 + d; float kv[8];
#pragma unroll
    for (int j = 0; j < 8; ++j) kv[j] = bf2f(gk[j * 256]);
    gla_vt((const bf16_t*)(ws + WS_GV), row0, h, lds, tid);
    gla_cumsum((const float*)(ws + WS_GG), row0, h, lds, d, seg, bc, bL);
    { f32x4 a, c;
#pragma unroll
      for (int j = 0; j < 4; ++j) { a[j] = kv[j] * __expf(bL - bc[j]); c[j] = kv[4 + j] * __expf(bL - bc[4 + j]); }
      *(MIX_LAS u32x4*)(lds + GL_KE + d * GSTR + seg * 16) = pack8(a, c); }
    if (seg == 0) ((float*)(ws + WS_DL))[(size_t)cid * 64 + d] = __expf(bL);
    MIX_BAR();
    const int r = lane & 15, q = lane >> 4; f32x4 acc[4];
#pragma unroll
    for (int dt = 0; dt < 4; ++dt) acc[dt] = (f32x4){0.f, 0.f, 0.f, 0.f};
#pragma unroll
    for (int kk = 0; kk < 2; ++kk) { const bf16x8 vf = *(const MIX_LAS bf16x8*)(lds + GL_VT + (wave * 16 + r) * GSTR + (kk * 32 + 8 * q) * 2);
#pragma unroll
        for (int dt = 0; dt < 4; ++dt) { const bf16x8 kf = *(const MIX_LAS bf16x8*)(lds + GL_KE + (dt * 16 + r) * GSTR + (kk * 32 + 8 * q) * 2);
            acc[dt] = __builtin_amdgcn_mfma_f32_16x16x32_bf16(kf, vf, acc[dt], 0, 0, 0); } }
    bf16_t* US = (bf16_t*)(ws + WS_US) + ((size_t)cid * 128 + wave * 16 + r) * 64;
#pragma unroll
    for (int dt = 0; dt < 4; ++dt) { u32x2 o; o.x = cvt_pk_bf16(acc[dt][0], acc[dt][1]); o.y = cvt_pk_bf16(acc[dt][2], acc[dt][3]); *(u32x2*)(US + dt * 16 + 4 * q) = o; }
    MIX_BAR();
}
__device__ __forceinline__ void gla_scan(unsigned char* ws, int gtid) {
    const int bh = gtid >> 12, e = (gtid >> 5) & 127, dp = gtid & 31;
    const size_t uoff = (((size_t)bh * 32) * 128 + e) * 32 + dp; const unsigned* US = (const unsigned*)(ws + WS_US) + uoff; unsigned* S2 = (unsigned*)(ws + WS_S2) + uoff; const float* DLp = (const float*)(ws + WS_DL) + (size_t)bh * 32 * 64 + 2 * dp;
    float s0 = 0.f, s1 = 0.f;
#pragma unroll 8
    for (int n = 0; n < 32; ++n) { const unsigned u = US[(size_t)n * 128 * 32]; const float d0 = DLp[n * 64], d1 = DLp[n * 64 + 1];
        S2[(size_t)n * 128 * 32] = cvt_pk_bf16(s0, s1);
        s0 = d0 * s0 + __uint_as_float(u << 16); s1 = d1 * s1 + __uint_as_float(u & 0xffff0000u); }
}
__device__ __forceinline__ void gla_passC_item(unsigned char* ws, const float* nw, int cid, MIX_LAS unsigned char* lds, int tid, int lane, int wave, size_t ya_off) {
    const int d = tid & 63, seg = tid >> 6, bh = cid >> 5, n = cid & 31, b = bh >> 2, h = bh & 3; const size_t row0 = (size_t)b * SEQ + n * 64;
    float bc[8], bL;
    const bf16_t* gk = (const bf16_t*)(ws + WS_GK) + (row0 + seg * 8) * 256 + h * 64 + d; const bf16_t* gq = (const bf16_t*)(ws + WS_GQ) + (row0 + seg * 8) * 256 + h * 64 + d; float kv[8], qv[8];
#pragma unroll
    for (int j = 0; j < 8; ++j) { kv[j] = bf2f(gk[j * 256]); qv[j] = bf2f(gq[j * 256]); }
    const int r = lane & 15, q = lane >> 4, it2 = wave & 3, eh = wave >> 2;
    bf16x8 sfr[4][2]; { const bf16_t* ST = (const bf16_t*)(ws + WS_S2) + (size_t)cid * 128 * 64;
#pragma unroll
        for (int nn = 0; nn < 4; ++nn)
#pragma unroll
            for (int kk = 0; kk < 2; ++kk) sfr[nn][kk] = *(const bf16x8*)(ST + ((eh * 4 + nn) * 16 + r) * 64 + kk * 32 + 8 * q); }
    const size_t yoff = (row0 + it2 * 16 + r) * 512 + h * 128 + eh * 64 + 4 * q; u32x2 srv[4];
#pragma unroll
    for (int nn = 0; nn < 4; ++nn) srv[nn] = *(const u32x2*)((const bf16_t*)(ws + WS_SR) + yoff + nn * 16);
    gla_vt((const bf16_t*)(ws + WS_GV), row0, h, lds, tid);
    gla_cumsum((const float*)(ws + WS_GG), row0, h, lds, d, seg, bc, bL);
#pragma unroll
    for (int j = 0; j < 8; ++j) { const float ex = __expf(bc[j]);
        *(MIX_LAS bf16_t*)(lds + GL_QE + (seg * 8 + j) * GSTR + 2 * d) = f2bf(qv[j] * ex);
        *(MIX_LAS bf16_t*)(lds + GL_KE + (seg * 8 + j) * GSTR + 2 * d) = f2bf(kv[j] * __expf(-bc[j])); }
    MIX_BAR();
    {
        const int it = wave >> 1;
#pragma unroll
        for (int jj = 0; jj < 2; ++jj) { const int jt = 2 * (wave & 1) + jj; f32x4 acc = {0.f, 0.f, 0.f, 0.f};
            if (jt <= it) {
#pragma unroll
                for (int kk = 0; kk < 2; ++kk) { const bf16x8 qf = *(const MIX_LAS bf16x8*)(lds + GL_QE + (it * 16 + r) * GSTR + (kk * 32 + 8 * q) * 2);
                    const bf16x8 kf = *(const MIX_LAS bf16x8*)(lds + GL_KE + (jt * 16 + r) * GSTR + (kk * 32 + 8 * q) * 2);
                    acc = __builtin_amdgcn_mfma_f32_16x16x32_bf16(qf, kf, acc, 0, 0, 0); }
                if (jt == it) {
#pragma unroll
                    for (int x = 0; x < 4; ++x) if (r > 4 * q + x) acc[x] = 0.f; } }
#pragma unroll
            for (int x = 0; x < 4; ++x) *(MIX_LAS bf16_t*)(lds + GL_P + (it * 16 + 4 * q + x) * GSTR + (jt * 16 + r) * 2) = f2bf(acc[x]); }
    }
    MIX_BAR();
    const int it = it2; f32x4 acc[4];
    {
        bf16x8 pf[2], qf[2];
#pragma unroll
        for (int kk = 0; kk < 2; ++kk) { pf[kk] = *(const MIX_LAS bf16x8*)(lds + GL_P + (it * 16 + r) * GSTR + (kk * 32 + 8 * q) * 2); qf[kk] = *(const MIX_LAS bf16x8*)(lds + GL_QE + (it * 16 + r) * GSTR + (kk * 32 + 8 * q) * 2); }
#pragma unroll
        for (int nn = 0; nn < 4; ++nn) { const int et = eh * 4 + nn; acc[nn] = (f32x4){0.f, 0.f, 0.f, 0.f};
#pragma unroll
            for (int kk = 0; kk < 2; ++kk) { const bf16x8 vf = *(const MIX_LAS bf16x8*)(lds + GL_VT + (et * 16 + r) * GSTR + (kk * 32 + 8 * q) * 2);
                const bf16x8 sf = sfr[nn][kk];
                acc[nn] = __builtin_amdgcn_mfma_f32_16x16x32_bf16(vf, pf[kk], acc[nn], 0, 0, 0);
                acc[nn] = __builtin_amdgcn_mfma_f32_16x16x32_bf16(sf, qf[kk], acc[nn], 0, 0, 0); } }
    }
    float ss = 0.f;
#pragma unroll
    for (int nn = 0; nn < 4; ++nn) ss += (acc[nn][0] * acc[nn][0] + acc[nn][1] * acc[nn][1]) + (acc[nn][2] * acc[nn][2] + acc[nn][3] * acc[nn][3]);
    ss += __shfl_xor(ss, 16); ss += __shfl_xor(ss, 32);
    MIX_LAS float* RED = (MIX_LAS float*)(lds + GL_RED);
    if (q == 0) RED[eh * 64 + it * 16 + r] = ss;
    MIX_BAR();
    const float rstd = rsqrtf((RED[it * 16 + r] + RED[64 + it * 16 + r]) * (1.f / 128.f) + EPS);
    bf16_t* YA = (bf16_t*)(ws + ya_off) + yoff;
#pragma unroll
    for (int nn = 0; nn < 4; ++nn) { const u32x2 sr = srv[nn]; const f32x4 w4 = *(const f32x4*)(nw + eh * 64 + nn * 16 + 4 * q);
        const float y0 = acc[nn][0] * rstd * w4[0] * __uint_as_float(sr.x << 16), y1 = acc[nn][1] * rstd * w4[1] * __uint_as_float(sr.x & 0xffff0000u);
        const float y2 = acc[nn][2] * rstd * w4[2] * __uint_as_float(sr.y << 16), y3 = acc[nn][3] * rstd * w4[3] * __uint_as_float(sr.y & 0xffff0000u);
        u32x2 o; o.x = cvt_pk_bf16(y0, y1); o.y = cvt_pk_bf16(y2, y3); *(u32x2*)(YA + nn * 16) = o; }
    MIX_BAR();
}
}

namespace moba {
typedef short s16x4 __attribute__((ext_vector_type(4)));
typedef float f32x16 __attribute__((ext_vector_type(16)));
typedef unsigned u32x4 __attribute__((ext_vector_type(4)));
using pg8::cvt_pk_bf16;
constexpr int D = 128, LD = 512, NW = 8, QBLK = 32, KVBLK = 64, QB = 256;
constexpr int SHM_V = KVBLK * D * 2, SHM_K = KVBLK * D * 2;
constexpr int LDS_WS = 2 * SHM_V + 2 * SHM_K, LDS_TAB = LDS_WS + NW * 64 * 4, LDS_BYTES = LDS_TAB + 512;
constexpr float THR2 = 11.5f;
#define KSWZ(row, colB) ((row) * 256 + ((colB) ^ (((row) & 7) << 4)))
#define SBAR() __builtin_amdgcn_sched_barrier(0)
__device__ __forceinline__ int v_st(int k, int c) { const int kk = (k & ~0xC) | ((k & 4) << 1) | ((k & 8) >> 1); return ((kk >> 3) * 4 + (c >> 5)) * 512 + ((kk & 7) * 32 + (c & 31)) * 2; }
__device__ __forceinline__ int v_rd_base(int lane) { return ((lane & 3) << 3) | (((lane >> 2) & 3) << 6) | (((lane >> 4) & 1) << 5) | (((lane >> 5) & 1) << 8); }
constexpr int v_rd_off(int d0, int ks, int half) { return d0 * 512 + ks * 4096 + half * 2048; }
__device__ __forceinline__ int crow(int r, int hi) { return (r & 3) + 8 * (r >> 2) + 4 * hi; }
__device__ __forceinline__ bf16x8 load8(const bf16_t* p) { return *reinterpret_cast<const bf16x8*>(p); }

__device__ __forceinline__ void partialSM(f32x16& p0, f32x16& p1, float& m_reg, float& mn, float& alpha) {
    float pmax = p0[0];
#pragma unroll
    for (int r = 1; r < 16; ++r) pmax = fmaxf(pmax, p0[r]);
#pragma unroll
    for (int r = 0; r < 16; ++r) pmax = fmaxf(pmax, p1[r]);
    { auto rr = __builtin_amdgcn_permlane32_swap(__float_as_uint(pmax), __float_as_uint(pmax), false, false); pmax = fmaxf(__uint_as_float(rr[0]), __uint_as_float(rr[1])); }
    if (__builtin_expect(__all((pmax - m_reg) <= THR2), 1)) { mn = m_reg; alpha = 1.f; }
    else { mn = fmaxf(m_reg, pmax); alpha = __builtin_amdgcn_exp2f(m_reg - mn); m_reg = mn; }
#pragma unroll
    for (int r = 0; r < 16; ++r) p0[r] = p0[r] - mn;
#pragma unroll
    for (int r = 0; r < 16; ++r) p1[r] = p1[r] - mn;
#pragma unroll
    for (int r = 0; r < 16; ++r) p0[r] = __builtin_amdgcn_exp2f(p0[r]);
}
__device__ __forceinline__ void finishSM(f32x16& p0, f32x16& p1, float alpha, float& l_reg, bf16x8& pa0, bf16x8& pa1, bf16x8& pa2, bf16x8& pa3) {
#pragma unroll
    for (int r = 0; r < 16; ++r) p1[r] = __builtin_amdgcn_exp2f(p1[r]);
    float ps = 0;
#pragma unroll
    for (int r = 0; r < 16; ++r) ps += p0[r];
#pragma unroll
    for (int r = 0; r < 16; ++r) ps += p1[r];
    { auto rr = __builtin_amdgcn_permlane32_swap(__float_as_uint(ps), __float_as_uint(ps), false, false); ps = __uint_as_float(rr[0]) + __uint_as_float(rr[1]); }
    l_reg = l_reg * alpha + ps;
#define PK4(P, B_, OUT) do { unsigned a0 = cvt_pk_bf16(P[B_+0], P[B_+1]), a1 = cvt_pk_bf16(P[B_+2], P[B_+3]);                          \
        unsigned b0 = cvt_pk_bf16(P[B_+4], P[B_+5]), b1 = cvt_pk_bf16(P[B_+6], P[B_+7]);                                             \
        auto r0 = __builtin_amdgcn_permlane32_swap(a0, b0, false, false); auto r1 = __builtin_amdgcn_permlane32_swap(a1, b1, false, false); \
        u32x4 w = {r0[0], r1[0], r0[1], r1[1]}; OUT = *reinterpret_cast<bf16x8*>(&w); } while (0)
    PK4(p0, 0, pa0); PK4(p0, 8, pa1); PK4(p1, 0, pa2); PK4(p1, 8, pa3);
#undef PK4
}
template <int KB>
__device__ __forceinline__ void qkt(f32x16& p0, f32x16& p1, const char* K_lds, int r32, int hi, const bf16x8* qr, bool act) {
    if (!act) { const float NEG = -__builtin_inff();
#pragma unroll
        for (int r = 0; r < 16; ++r) { p0[r] = NEG; p1[r] = NEG; } return; }
    p0 = f32x16{}; p1 = f32x16{};
    const char* kb[4];
#pragma unroll
    for (int dd = 0; dd < 4; ++dd) kb[dd] = K_lds + KB * SHM_K + KSWZ(r32, (dd * 16 + hi * 8) * 2);
#pragma unroll
    for (int d0 = 0; d0 < 8; ++d0) { const char* a = kb[d0 & 3] + (d0 >> 2) * 128;
        bf16x8 b0 = *reinterpret_cast<const bf16x8*>(a);
        bf16x8 b1 = *reinterpret_cast<const bf16x8*>(a + 32 * 256);
        p0 = __builtin_amdgcn_mfma_f32_32x32x16_bf16(b0, qr[d0], p0, 0, 0, 0);
        p1 = __builtin_amdgcn_mfma_f32_32x32x16_bf16(b1, qr[d0], p1, 0, 0, 0); }
}
template <int VB>
__device__ __forceinline__ void pv_tile(f32x16* o, int vb0, bf16x8 pa0, bf16x8 pa1, bf16x8 pa2, bf16x8 pa3, bool act) {
    if (!act) return;
#define TRRD(dst, off) asm volatile("ds_read_b64_tr_b16 %0, %1 offset:%2" : "=&v"(dst) : "v"(vb0), "i"(off) : "memory")
#define PV_D0(d0) do { s16x4 l0, l1, l2, l3, h0, h1, h2, h3; constexpr int b_ = VB * SHM_V + v_rd_off(d0, 0, 0); \
        TRRD(l0, b_); TRRD(h0, b_ + 2048); TRRD(l1, b_ + 4096); TRRD(h1, b_ + 6144); TRRD(l2, b_ + 8192); TRRD(h2, b_ + 10240); TRRD(l3, b_ + 12288); TRRD(h3, b_ + 14336); \
        asm volatile("s_waitcnt lgkmcnt(0)" ::: "memory"); SBAR();   \
        o[d0] = __builtin_amdgcn_mfma_f32_32x32x16_bf16(pa0, (bf16x8){l0[0], l0[1], l0[2], l0[3], h0[0], h0[1], h0[2], h0[3]}, o[d0], 0, 0, 0);   \
        o[d0] = __builtin_amdgcn_mfma_f32_32x32x16_bf16(pa1, (bf16x8){l1[0], l1[1], l1[2], l1[3], h1[0], h1[1], h1[2], h1[3]}, o[d0], 0, 0, 0);   \
        o[d0] = __builtin_amdgcn_mfma_f32_32x32x16_bf16(pa2, (bf16x8){l2[0], l2[1], l2[2], l2[3], h2[0], h2[1], h2[2], h2[3]}, o[d0], 0, 0, 0);   \
        o[d0] = __builtin_amdgcn_mfma_f32_32x32x16_bf16(pa3, (bf16x8){l3[0], l3[1], l3[2], l3[3], h3[0], h3[1], h3[2], h3[3]}, o[d0], 0, 0, 0); } while (0)
    PV_D0(0); PV_D0(1); PV_D0(2); PV_D0(3);
#undef PV_D0
#undef TRRD
}
__device__ __forceinline__ void mask_bias_tile(f32x16& p0, f32x16& p1, int dq, const float* tab) {
    const float NEG = -__builtin_inff();
#pragma unroll
    for (int r = 0; r < 16; ++r) { const int c = (r & 3) + 8 * (r >> 2); const int d0 = dq - c, d1 = dq - c - 32;
        p0[r] = d0 < 0 ? NEG : p0[r] + tab[d0 > 113 ? 113 : d0];
        p1[r] = d1 < 0 ? NEG : p1[r] + tab[d1 > 113 ? 113 : d1]; }
}
__device__ __forceinline__ void bias_tile(f32x16& p0, f32x16& p1, int dq, const float* tab) {
#pragma unroll
    for (int r = 0; r < 16; ++r) { const int c = (r & 3) + 8 * (r >> 2); const int d0 = dq - c, d1 = dq - c - 32;
        p0[r] += tab[d0 > 113 ? 113 : d0]; p1[r] += tab[d1 > 113 ? 113 : d1]; }
}
__device__ __forceinline__ void kill_tile(f32x16& p0, f32x16& p1, bool ok) {
    const float NEG = -__builtin_inff();
#pragma unroll
    for (int r = 0; r < 16; ++r) { p0[r] = ok ? p0[r] : NEG; p1[r] = ok ? p1[r] : NEG; }
}

struct BlockRef { const bf16_t* Q; const bf16_t* K; const bf16_t* V; bf16_t* O; const float* km; int P0; };
struct Seam { bf16x8 qr[8]; bf16x8 st_v0, st_v1, st_k0, st_k1; };
#define ROW(p, k0, rr) ((p) + (size_t)((k0) + (rr)) * LD + sc)
#define VMW() asm volatile("s_waitcnt vmcnt(0)" ::: "memory")
#define VMWN(n) asm volatile("s_waitcnt vmcnt(%0)" :: "i"(n) : "memory")
#define SLOAD_H(Kp, Vp, k0) do { S.st_v0 = load8(ROW(Vp, k0, sr)); S.st_v1 = load8(ROW(Vp, k0, 32 + sr)); S.st_k0 = load8(ROW(Kp, k0, sr)); S.st_k1 = load8(ROW(Kp, k0, 32 + sr)); } while (0)
#define SWRITE_HK(bf) do { *(bf16x8*)(K_lds + (bf) * SHM_K + kws) = S.st_k0; *(bf16x8*)(K_lds + (bf) * SHM_K + kws + 32 * 256) = S.st_k1; } while (0)
#define SWRITE_HV(bf) do { *(bf16x8*)(V_lds + (bf) * SHM_V + vst0) = S.st_v0; *(bf16x8*)(V_lds + (bf) * SHM_V + vst1) = S.st_v1; } while (0)
#define SWRITE_H(bf) do { SWRITE_HV(bf); SWRITE_HK(bf); } while (0)
__device__ __forceinline__ void prime(const BlockRef& cur, const float* rel_bias, int h, char* lds, Seam& S, int tid) {
    const int wid = __builtin_amdgcn_readfirstlane(tid >> 6), lane = tid & 63, r32 = lane & 31, hi = lane >> 5;
    const int sr = tid >> 4, sc = (tid & 15) * 8, kws = KSWZ(sr, sc * 2); char* K_lds = lds + 2 * SHM_V;
    if (tid < 128) { int bk = tid; if (tid >= 16) { bk = 16 + (int)(__logf((float)tid * (1.f / 16.f)) * (16.f / 2.0794415416798357f)); bk = bk > 31 ? 31 : bk; }
        ((float*)(lds + LDS_TAB))[tid] = tid >= 113 ? 0.f : (rel_bias[bk * 4 + h] - rel_bias[31 * 4 + h]) * LOG2E; }
#pragma unroll
    for (int d0 = 0; d0 < 8; ++d0) S.qr[d0] = load8(cur.Q + (size_t)(wid * QBLK + r32) * LD + d0 * 16 + hi * 8);
    SLOAD_H(cur.K, cur.V, 0); VMW(); SWRITE_HK(0);
    __syncthreads();
}
__device__ __forceinline__ void block(const BlockRef& cur, const BlockRef& nxt, char* lds, Seam& S, int tid) {
    const int wid = __builtin_amdgcn_readfirstlane(tid >> 6), lane = tid & 63, r32 = lane & 31, hi = lane >> 5;
    const int qblk = cur.P0 >> 8, NT = 4 * (qblk + 1);
    const int qlo = cur.P0 + wid * QBLK, qm = qlo + r32 - 4 * hi;
    char* V_lds = lds; char* K_lds = lds + 2 * SHM_V;
    float* ws = (float*)(lds + LDS_WS) + wid * 64; float* li_l = ws, * al_l = ws + 32; const float* tab = (const float*)(lds + LDS_TAB);
    float m_reg = -1e30f, l_reg = 0; f32x16 o[4] = {};
    const int sr = tid >> 4, sc = (tid & 15) * 8, vst0 = v_st(sr, sc), vst1 = v_st(32 + sr, sc), kws = KSWZ(sr, sc * 2);
    const int vb0 = (int)(uintptr_t)V_lds + v_rd_base(lane);
    const bf16_t* Kh = cur.K; const bf16_t* Vh = cur.V;
    unsigned sel = (1u << qblk) - 1u;
    if (qblk > 3) {
        float s[7];
#pragma unroll
        for (int n = 0; n < 7; ++n) { s[n] = -__builtin_inff();
            if (n < qblk) { float a = 0.f; const float* kmn = cur.km + n * 128 + hi * 8;
#pragma unroll
                for (int d0 = 0; d0 < 8; ++d0) { const f32x4 k0 = *(const f32x4*)(kmn + d0 * 16), k1 = *(const f32x4*)(kmn + d0 * 16 + 4); const bf16x8 qv = S.qr[d0];
#pragma unroll
                    for (int j = 0; j < 4; ++j) { a += __uint_as_float(((unsigned)(unsigned short)qv[j]) << 16) * k0[j]; a += __uint_as_float(((unsigned)(unsigned short)qv[4 + j]) << 16) * k1[j]; } }
                s[n] = a + __shfl_xor(a, 32); } }
        sel = 0u;
#pragma unroll
        for (int c = 0; c < 3; ++c) { float best = -__builtin_inff(); int bi = 0;
#pragma unroll
            for (int n = 0; n < 7; ++n) if (s[n] > best) { best = s[n]; bi = n; }
            sel |= 1u << bi;
#pragma unroll
            for (int n = 0; n < 7; ++n) s[n] = (n == bi) ? -__builtin_inff() : s[n]; }
    }
#define RESC(a) do { if (__any((a) < 1.f)) { if (hi == 0) al_l[r32] = (a); asm volatile("s_waitcnt lgkmcnt(0)" ::: "memory");              \
                     for (int d_ = 0; d_ < 4; ++d_) for (int r = 0; r < 16; ++r) o[d_][r] *= al_l[crow(r, hi)]; } } while (0)
#define KBASE(t) ((t) * KVBLK)
#define ACT(t) ((KBASE(t) >> 8) < qblk ? (__any((sel >> (KBASE(t) >> 8)) & 1u) != 0) : (KBASE(t) <= qlo + QBLK - 1))
#define MASKT(P0_, P1_, t) do { const int kb_ = KBASE(t); if (ACT(t)) { if ((kb_ >> 8) < qblk) { if (kb_ + 176 > qlo) bias_tile(P0_, P1_, qm - kb_, tab); kill_tile(P0_, P1_, ((sel >> (kb_ >> 8)) & 1u) != 0u); } \
                                     else mask_bias_tile(P0_, P1_, qm - kb_, tab); } } while (0)
    f32x16 pA0, pA1, pB0, pB1; float mnA, mnB, alA, alB; bf16x8 pa0, pa1, pa2, pa3;
    SWRITE_HV(0); SBAR();
    SLOAD_H(Kh, Vh, KBASE(1));
    SBAR(); qkt<0>(pA0, pA1, K_lds, r32, hi, S.qr, ACT(0));
    MASKT(pA0, pA1, 0); partialSM(pA0, pA1, m_reg, mnA, alA);
    VMW(); SWRITE_H(1);
    __syncthreads();
#define HALF_STEP(PX0, PX1, mnX, alX, PY0, PY1, alY, t, KB, VB, SB) do {                                                      \
        SBAR(); qkt<KB>(PX0, PX1, K_lds, r32, hi, S.qr, ACT(t));                                                          \
        finishSM(PY0, PY1, alY, l_reg, pa0, pa1, pa2, pa3); SBAR();                                                           \
        if ((t) + 1 < NT) { SLOAD_H(Kh, Vh, KBASE((t) + 1)); SBAR(); }                                                        \
        pv_tile<VB>(o, vb0, pa0, pa1, pa2, pa3, ACT((t) - 1)); MASKT(PX0, PX1, (t)); partialSM(PX0, PX1, m_reg, mnX, alX);    \
        __syncthreads();                                                                                                      \
        if ((t) + 1 < NT) { VMW(); SWRITE_H(SB); }                                                                            \
        RESC(alX); __syncthreads(); } while (0)
    for (int t = 1; t + 1 < NT; t += 2) {
        HALF_STEP(pB0, pB1, mnB, alB, pA0, pA1, alA, t, 1, 0, 0);
        HALF_STEP(pA0, pA1, mnA, alA, pB0, pB1, alB, t + 1, 0, 1, 1);
    }
    SBAR(); qkt<1>(pB0, pB1, K_lds, r32, hi, S.qr, ACT(NT - 1)); SBAR();
    SLOAD_H(nxt.K, nxt.V, 0); SBAR();
#pragma unroll
    for (int d0 = 0; d0 < 8; ++d0) S.qr[d0] = load8(nxt.Q + (size_t)(wid * QBLK + r32) * LD + d0 * 16 + hi * 8);
    SBAR();
    finishSM(pA0, pA1, alA, l_reg, pa0, pa1, pa2, pa3); SBAR();
    pv_tile<0>(o, vb0, pa0, pa1, pa2, pa3, ACT(NT - 2));
    MASKT(pB0, pB1, NT - 1); partialSM(pB0, pB1, m_reg, mnB, alB); __syncthreads(); RESC(alB);
    finishSM(pB0, pB1, alB, l_reg, pa0, pa1, pa2, pa3); SBAR(); pv_tile<1>(o, vb0, pa0, pa1, pa2, pa3, ACT(NT - 1));
    SBAR(); VMWN(8); SWRITE_HK(0); SBAR();
    if (hi == 0) li_l[r32] = l_reg; asm volatile("s_waitcnt lgkmcnt(0)" ::: "memory");
    float rli[16];
#pragma unroll
    for (int r = 0; r < 16; ++r) rli[r] = __builtin_amdgcn_rcpf(li_l[crow(r, hi)]);
    bf16_t* Ow = cur.O + (size_t)(wid * QBLK) * LD;
#pragma unroll
    for (int r = 0; r < 16; ++r) { const int orow = crow(r, hi);
#pragma unroll
        for (int d0 = 0; d0 < 4; ++d0) { const float v = o[d0][r] * rli[r]; const float vn = __shfl_xor(v, 1);
            if ((r32 & 1) == 0) *(unsigned*)(Ow + (size_t)orow * LD + d0 * 32 + r32) = cvt_pk_bf16(v, vn); } }
    __syncthreads();
#undef RESC
#undef KBASE
#undef ACT
#undef MASKT
#undef HALF_STEP
}
#undef ROW
#undef VMW
#undef VMWN
#undef SLOAD_H
#undef SWRITE_HK
#undef SWRITE_HV
#undef SWRITE_H
#undef KSWZ
#undef SBAR
}

constexpr int PH_PREP = 0, PH_IN1 = 1, PH_MIX1 = 2, PH_MIX2 = 3, PH_MIX3 = 4, PH_GATES = 5, PH_UPM = 6, PH_OUT = 7, PH_FFN = 8, PH_DOWN = 9, PH_PER_LAYER = 10;
#ifndef PROBE_K
#define PROBE_K -1
#define PROBE_L 0
#define PROBE_N 1
#define PROBE_SUB 15
#endif
struct Args { Inputs in; float* out; unsigned char* ws; int ph_lo, ph_hi, li, mixmask; };

__device__ __forceinline__ void fill_rstd(LAS float* tab, const float* rssp, int bx, int tid) {
#pragma unroll
    for (int j = 0; j < 4; ++j) { const int r = tid + 512 * j; const f32x4* p = (const f32x4*)(rssp + ((size_t)(bx & 7) * 2048 + r) * 16);
        const f32x4 a = p[0], b = p[1], c = p[2], d = p[3]; const f32x4 s = (a + b) + (c + d);
        tab[r] = rsqrtf(((s[0] + s[1]) + (s[2] + s[3])) * (1.f / D) + EPS); }
    __syncthreads();
}
__device__ __forceinline__ int fresh_tid(int wave0) { int ln; asm volatile("v_mbcnt_lo_u32_b32 %0, -1, 0\n\tv_mbcnt_hi_u32_b32 %0, -1, %0" : "=v"(ln)); return wave0 * 64 + ln; }
__global__ void __launch_bounds__(NWAVES * 64, 2) mega_fwd(Args args) {
    extern __shared__ __attribute__((aligned(16))) unsigned char lds[];
    LAS unsigned char* ldsp = (LAS unsigned char*)lds;
    volatile LAS unsigned* MISC = (volatile LAS unsigned*)(ldsp + MISC_OFF);
    const int tid = threadIdx.x; const int wave0 = __builtin_amdgcn_readfirstlane(tid >> 6);
    const int G = gridDim.x; const int bx = blockIdx.x; const int vcu = (G % 8 == 0) ? (bx % 8) * (G / 8) + bx / 8 : bx;
    unsigned char* ws = args.ws;
    float* out = args.out;
    for (int u = tid; u < (LDS_BYTES - LDSCTL_OFF) / 4; u += NWAVES * 64) ((LAS unsigned*)(ldsp + LDSCTL_OFF))[u] = 0u;
    __syncthreads();
    XcdBarrier bar = xcd_barrier_post((unsigned*)(ws + WS_CTL) + CW_BAR + args.li * XCD_BAR_WORDS, MISC + 8);
    const int NGW = G * NWAVES;

    unsigned char* const ws0 = ws; float* const out0 = out; const int bx0 = bx;
    for (int ph = args.ph_lo; ph < args.ph_hi; ++ph) {
        const int l = ph / PH_PER_LAYER, k = ph % PH_PER_LAYER;
        size_t zoff = 0; int bx = bx0; asm volatile("" : "+s"(zoff), "+s"(bx)); unsigned char* ws = ws0 + zoff; float* out = out0 + zoff;
#define KARG(i) (*(const float* const __attribute__((address_space(4)))*)((const __attribute__((address_space(4))) char*)__builtin_amdgcn_kernarg_segment_ptr() + 8 * (i) + zoff))
#define LOAD_INPUTS(v) const __attribute__((address_space(4))) Inputs* v = (const __attribute__((address_space(4))) Inputs*)((const __attribute__((address_space(4))) char*)__builtin_amdgcn_kernarg_segment_ptr() + zoff)
        float* rssp = (float*)(ws + WS_RSSP);
        const int nrep = (k == PROBE_K && l == PROBE_L) ? PROBE_N : 1;
        for (int rep = 0; rep < nrep; ++rep) {
        const int mmask = rep == 0 ? args.mixmask : (args.mixmask & PROBE_SUB); const bool stf = (rep + 1 == nrep);
        if (k == PH_PREP) {
            const int tidl = fresh_tid(wave0), lane = tidl & 63, wave = wave0, gw = vcu * NWAVES + wave;
            LOAD_INPUTS(in);
            float* scr = (float*)(lds + wave * 16384);
            for (int it = gw; it < PREP_ITEMS; it += NGW) prep_item(in, l, ws + WS_W, it, scr, lane);
            if (l == 0) {
                for (int row = gw; row < M; row += NGW) {
                    const f32x4* xr = (const f32x4*)(in->x + (size_t)row * D) + lane; float s = 0.f;
                    unsigned long long* o8 = (unsigned long long*)((bf16_t*)(ws + WS_XB) + (size_t)row * D) + lane;
#pragma unroll
                    for (int j = 0; j < 4; ++j) { const f32x4 v = xr[64 * j]; s += (v.x * v.x + v.y * v.y) + (v.z * v.z + v.w * v.w);
                        o8[64 * j] = (unsigned long long)pk2(v.x, v.y) | ((unsigned long long)pk2(v.z, v.w) << 32); }
                    s = wave_sum(s); if (lane < 16) rssp[(size_t)row * 16 + lane] = (lane == 0) ? s : 0.f;
                }
            }
        } else if (k == PH_IN1) {
            const int tidl = fresh_tid(wave0);
            pg8::Gemm g{(const bf16_t*)(ws + WS_XB), (const bf16_t*)(ws + WS_W + W_IN), M, NIN1, D}; pg8::StaticOrder S; S.init(M, NIN1, G, bx);
            fill_rstd((LAS float*)(ldsp + RSTD_OFF), rssp, bx, tidl);
            pg8::EpiIn1 E{ws, (const LAS float*)(ldsp + RSTD_OFF), KARG(4) + l * 256};
            pg8::gemm_phase<pg8::EpiIn1, pg8::StaticOrder, true, true>(ldsp, g, S, E, tidl);
        } else if (k == PH_MIX1) {
            const int tidl = fresh_tid(wave0), lane = tidl & 63, wave = wave0;
            if (mmask & 2) for (int it = vcu; it < 256; it += G) mix::prepass_item(ws, KARG(8) + l * 128, KARG(9) + l * 128, it >> 5, (it >> 2) & 7, it & 3, (LAS float*)ldsp, tidl, lane, wave);
            if (mmask & 1) for (int it = vcu; it < 256; it += G) mix::pool_item(ws, KARG(7) + l * 512, it >> 2, it & 3, ldsp, tidl, lane, wave);
            if (mmask & 4) for (int it = vcu; it < 1024; it += G) mix::gla_passA_item(ws, it, ldsp, tidl, lane, wave);
        } else if (k == PH_MIX2) {
            const int tidl = fresh_tid(wave0);
            if (mmask & 4) for (int g0 = vcu * 512 + tidl; g0 < 32 * 4096; g0 += G * 512) mix::gla_scan(ws, g0);
            if (mmask & 8) for (int it = vcu; it < 256; it += G) {
                const int bh = it >> 3, qb = it & 7, b = bh >> 2, h = bh & 3; const size_t r0 = (size_t)b * SEQ * 512 + h * 128;
                moba::BlockRef cur; cur.Q = (const bf16_t*)(ws + WS_MQ) + r0 + (size_t)qb * 256 * 512; cur.O = (bf16_t*)(ws + (stf ? WS_YC : WS_US)) + r0 + (size_t)qb * 256 * 512;
                cur.K = (const bf16_t*)(ws + WS_MK) + r0; cur.V = (const bf16_t*)(ws + WS_MV) + r0; cur.km = (const float*)(ws + WS_KMEAN) + (size_t)bh * 8 * 128; cur.P0 = qb * 256;
                const int tl = fresh_tid(wave0);
                moba::Seam S; moba::prime(cur, KARG(10), h, (char*)lds, S, tl); moba::block(cur, cur, (char*)lds, S, tl);
            }
        } else if (k == PH_MIX3) {
            const int tidl = fresh_tid(wave0), lane = tidl & 63, wave = wave0;
            if (mmask & 4) for (int it = vcu; it < 1024; it += G) mix::gla_passC_item(ws, KARG(5) + l * 128, it, ldsp, tidl, lane, wave, stf ? WS_YA : WS_US);
        } else if (k == PH_GATES) {
            const int tidl = fresh_tid(wave0);
            pg8::Gemm g{(const bf16_t*)(ws + WS_XB), (const bf16_t*)(ws + WS_W + W_IN) + (size_t)NIN1 * D, M, NGATE, D}; pg8::StaticOrder S; S.init(M, NGATE, G, bx);
            fill_rstd((LAS float*)(ldsp + RSTD_OFF), rssp, bx, tidl);
            pg8::EpiGates E{ws, (const LAS float*)(ldsp + RSTD_OFF)};
            pg8::gemm_phase<pg8::EpiGates, pg8::StaticOrder, true, true>(ldsp, g, S, E, tidl);
        } else if (k == PH_UPM) {
            const int tidl = fresh_tid(wave0);
            pg8::Gemm g{nullptr, nullptr, M, D, 512}; pg8::UpmOrder S; S.so.init(M, D, G, bx);
            S.Y0 = (const bf16_t*)(ws + WS_YA); S.Y1 = (const bf16_t*)(ws + WS_YB); S.Y2 = (const bf16_t*)(ws + WS_YC);
            S.W0 = (const bf16_t*)(ws + WS_W + W_UP); S.W1 = (const bf16_t*)(ws + WS_W + W_UP + MiB); S.W2 = (const bf16_t*)(ws + WS_W + W_UP + 2 * MiB);
            pg8::EpiUpm E{ws};
            pg8::gemm_phase<pg8::EpiUpm, pg8::UpmOrder, true, true>(ldsp, g, S, E, tidl);
        } else if (k == PH_OUT) {
            const int tidl = fresh_tid(wave0);
            pg8::Gemm g{(const bf16_t*)(ws + WS_MERGED), (const bf16_t*)(ws + WS_W + W_OUT), M, D, D}; pg8::StaticOrder S; S.init(M, D, G, bx);
            pg8::EpiRes E{l == 0 ? KARG(0) : out, out, (bf16_t*)(ws + WS_X1B), rssp, stf};
            pg8::gemm_phase<pg8::EpiRes, pg8::StaticOrder, false, true>(ldsp, g, S, E, tidl);
        } else if (k == PH_FFN) {
            const int tidl = fresh_tid(wave0);
            pg8::Gemm g{(const bf16_t*)(ws + WS_X1B), (const bf16_t*)(ws + WS_W + W_GU), M, NGU, D}; pg8::StaticOrder S; S.init(M, NGU, G, bx);
            fill_rstd((LAS float*)(ldsp + RSTD_OFF), rssp, bx, tidl);
            pg8::EpiFfn E{(bf16_t*)(ws + WS_H), (const LAS float*)(ldsp + RSTD_OFF)};
            pg8::gemm_phase<pg8::EpiFfn, pg8::StaticOrder, true, true>(ldsp, g, S, E, tidl);
        } else if (k == PH_DOWN) {
            const int tidl = fresh_tid(wave0);
            pg8::Gemm g{(const bf16_t*)(ws + WS_H), (const bf16_t*)(ws + WS_W + W_DN), M, D, FF}; pg8::StaticOrder S; S.init(M, D, G, bx);
            pg8::EpiRes E{out, out, (l + 1 < DEPTH) ? (bf16_t*)(ws + WS_XB) : nullptr, (l + 1 < DEPTH) ? rssp : nullptr, stf};
            pg8::gemm_phase<pg8::EpiRes, pg8::StaticOrder, false, true>(ldsp, g, S, E, tidl);
        }
        if (rep + 1 < nrep) xcd_barrier(bar);
        }
        if (ph + 1 < args.ph_hi) xcd_barrier(bar);
    }
}

#ifndef MIXMASK
#define MIXMASK 15
#endif
static void launch_mega(const Args& a0, int lo, int hi, int li, int grid, hipStream_t stream) {
    Args a = a0; a.ph_lo = lo; a.ph_hi = hi; a.li = li;
    hipLaunchKernelGGL(mega_fwd, dim3(grid), dim3(NWAVES * 64), LDS_BYTES, stream, a);
}
extern "C" void kernel_launch(void* const* d_in, const int* in_sizes, int n_in, void* d_out, int out_size, void* d_ws, size_t ws_size, hipStream_t stream) {
    static int grid = 0;
    if (grid == 0) {
        if (n_in != 19 || out_size != M * D || ws_size < WS_END2) { fprintf(stderr, "kernel_launch: unexpected shapes (n_in %d out %d ws %zu)\n", n_in, out_size, ws_size); grid = -1; return; }
        int dev = 0, cus = 0;
        if (hipGetDevice(&dev) != hipSuccess || hipDeviceGetAttribute(&cus, hipDeviceAttributeMultiprocessorCount, dev) != hipSuccess) { grid = -1; return; }
        if (hipFuncSetAttribute((const void*)mega_fwd, hipFuncAttributeMaxDynamicSharedMemorySize, LDS_BYTES) != hipSuccess) { fprintf(stderr, "kernel_launch: hipFuncSetAttribute failed\n"); grid = -1; return; }
        int per_cu = 0; (void)hipOccupancyMaxActiveBlocksPerMultiprocessor(&per_cu, (const void*)mega_fwd, NWAVES * 64, LDS_BYTES); (void)hipGetLastError();
        if (per_cu < 1) fprintf(stderr, "kernel_launch: occupancy query reports %d blocks per CU\n", per_cu);
        grid = cus;
    }
    if (grid < 0) return;
    (void)hipMemsetAsync((char*)d_ws + WS_CTL, 0, CTL_BYTES, stream);
    Args a{}; { const float** ap = (const float**)&a.in; for (int i = 0; i < 19; ++i) ap[i] = (const float*)d_in[i]; }
    a.out = (float*)d_out; a.ws = (unsigned char*)d_ws;
    a.mixmask = 15;
    launch_mega(a, 0, DEPTH * PH_PER_LAYER, 0, grid, stream);
}
```

```cpp
#include <hip/hip_runtime.h>
#include <cstdint>
#include <cstdio>

typedef unsigned short bf16_t;
typedef short bf16x8 __attribute__((ext_vector_type(8)));
typedef float f32x4 __attribute__((ext_vector_type(4)));

constexpr int BATCH = 8, SEQ = 2048, D = 1024, M = BATCH * SEQ, DEPTH = 2;
constexpr int IN_COLS = 6672, NIN1 = 3840, NGATE = 3072, NIN = NIN1 + NGATE;
constexpr int FF = 2816, NGU = 2 * FF;
constexpr int C_GLR = 1024;
constexpr float EPS = 1e-6f;
constexpr float LOG2E = 1.4426950408889634f;
constexpr float QSCALE = 0.08838834764831845f * LOG2E;

constexpr size_t MiB = 1u << 20;
constexpr size_t WS_CTL = 0, CTL_BYTES = 1 * MiB;
constexpr size_t WS_RSS = 1 * MiB;
constexpr size_t WS_KMEAN = 230 * MiB;
constexpr size_t WS_W = 2 * MiB;
constexpr size_t W_IN = 0, W_UP = 13 * MiB + 512 * 1024, W_OUT = W_UP + 3 * MiB, W_GU = W_OUT + 2 * MiB, W_DN = W_GU + 11 * MiB, W_PW = W_DN + 5 * MiB + 512 * 1024;
constexpr size_t WS_XB = 38 * MiB;
constexpr size_t WS_GQ = 70 * MiB, WS_GK = 78 * MiB, WS_GG = 86 * MiB;
constexpr size_t WS_GV = 102 * MiB, WS_PU = 118 * MiB;
constexpr size_t WS_MK = 134 * MiB, WS_MV = 150 * MiB;
constexpr size_t WS_SR = 166 * MiB, WS_MQ = 182 * MiB;
constexpr size_t WS_YB = 198 * MiB, WS_US = 214 * MiB;
constexpr size_t WS_SGA = 70 * MiB, WS_SGB = 102 * MiB, WS_SGC = 134 * MiB;
constexpr size_t WS_MERGED = WS_XB, WS_X1B = 70 * MiB, WS_H = 102 * MiB;
constexpr size_t WS_END = 231 * MiB;

__device__ __forceinline__ float bf2f(bf16_t h) { return __uint_as_float(((unsigned)h) << 16); }
__device__ __forceinline__ bf16_t f2bf(float f) { unsigned u = __float_as_uint(f); return (bf16_t)((u + 0x7fffu + ((u >> 16) & 1u)) >> 16); }
__device__ __forceinline__ unsigned pk2(float lo, float hi) { return (unsigned)f2bf(lo) | ((unsigned)f2bf(hi) << 16); }
__device__ __forceinline__ float wave_sum(float v) {
#pragma unroll
    for (int o = 1; o < 64; o <<= 1) v += __shfl_xor(v, o);
    return v;
}
__device__ __forceinline__ float wave_max(float v) {
#pragma unroll
    for (int o = 1; o < 64; o <<= 1) v = fmaxf(v, __shfl_xor(v, o));
    return v;
}
__device__ __forceinline__ float sigmoidf_(float x) { return 1.f / (1.f + __expf(-x)); }
__device__ __forceinline__ float siluf_(float x) { return x / (1.f + __expf(-x)); }
__device__ __forceinline__ float logsigmoidf_(float x) { return fminf(x, 0.f) - log1pf(__expf(-fabsf(x))); }

struct Inputs {
    const float *x, *norm1_w, *w_in, *wg2, *bg, *gla_nw, *pool_w, *pool_scale, *qn_w, *kn_w, *rel_bias, *w_up_a, *w_up_b, *w_up_c, *w_out, *norm2_w, *w_gate, *w_up, *w_down;
};

template <class F>
__device__ __forceinline__ void transpose_item(F src, int K, bf16_t* dst, int k0, int n0, float* scr, int lane) {
    float tv[32];
#pragma unroll
    for (int i = 0; i < 32; ++i) tv[i] = src(k0 + i, n0 + lane);
#pragma unroll
    for (int i = 0; i < 32; ++i) scr[i * 65 + lane] = tv[i];
    __builtin_amdgcn_s_waitcnt(0xc07f); asm volatile("" ::: "memory");
    const int c = lane & 3;
#pragma unroll
    for (int j = 0; j < 4; ++j) {
        const int n = (lane >> 2) + 16 * j; const float* s = scr + (8 * c) * 65 + n;
        uint4 o; o.x = pk2(s[0], s[65]); o.y = pk2(s[130], s[195]); o.z = pk2(s[260], s[325]); o.w = pk2(s[390], s[455]);
        *(uint4*)(dst + (size_t)(n0 + n) * K + k0 + 8 * c) = o;
    }
    __builtin_amdgcn_s_waitcnt(0xc07f); asm volatile("" ::: "memory");
}
constexpr int PI_IN = 32 * (NIN / 64), PI_UP = 16 * 16, PI_OUT = 32 * 16, PI_GU = 32 * (NGU / 64), PI_DN = 88 * 16, PI_PW = 4 * 2;
constexpr int PREP_ITEMS = PI_IN + 3 * PI_UP + PI_OUT + PI_GU + PI_DN + 4 * PI_PW;
template <class InP>
__device__ __forceinline__ void prep_item(InP inp, int l, unsigned char* wsw, int it, float* scr, int lane) {
    if (it < PI_IN) {
        const int nb = NIN / 64, kb = it / nb, n0 = 64 * (it % nb), k0 = 32 * kb;
        const float* w = inp->w_in + (size_t)l * D * IN_COLS; const float* nw = inp->norm1_w + l * D; bf16_t* dst = (bf16_t*)(wsw + W_IN);
        if (n0 >= 512 && n0 < 768) {
            const float* g2 = inp->wg2 + (size_t)l * 16 * 256 + (n0 - 512) + lane; float g2v[16];
#pragma unroll
            for (int r = 0; r < 16; ++r) g2v[r] = g2[r * 256];
            transpose_item([&](int k, int n) { const f32x4* wr = (const f32x4*)(w + (size_t)k * IN_COLS + C_GLR); float s = 0.f;
#pragma unroll
                for (int r4 = 0; r4 < 4; ++r4) { const f32x4 v = wr[r4]; s += v[0] * g2v[4 * r4] + v[1] * g2v[4 * r4 + 1] + v[2] * g2v[4 * r4 + 2] + v[3] * g2v[4 * r4 + 3]; }
                return s * nw[k]; }, D, dst, k0, n0, scr, lane);
        } else {
            const int off = n0 < 512 ? 0 : (n0 < 1280 ? -256 : -240);
            transpose_item([&](int k, int n) { return w[(size_t)k * IN_COLS + n + off] * nw[k]; }, D, dst, k0, n0, scr, lane);
        }
        return;
    }
    it -= PI_IN;
    if (it < 3 * PI_UP) {
        const int br = it / PI_UP; it %= PI_UP; const int kb = it / 16, n0 = 64 * (it % 16), k0 = 32 * kb;
        const float* w = (br == 0 ? inp->w_up_a : br == 1 ? inp->w_up_b : inp->w_up_c) + (size_t)l * 512 * D;
        transpose_item([&](int k, int n) { return w[(size_t)k * D + n]; }, 512, (bf16_t*)(wsw + W_UP + br * MiB), k0, n0, scr, lane);
        return;
    }
    it -= 3 * PI_UP;
    if (it < PI_OUT) {
        const int kb = it / 16, n0 = 64 * (it % 16), k0 = 32 * kb; const float* w = inp->w_out + (size_t)l * D * D;
        transpose_item([&](int k, int n) { return w[(size_t)k * D + n]; }, D, (bf16_t*)(wsw + W_OUT), k0, n0, scr, lane);
        return;
    }
    it -= PI_OUT;
    if (it < PI_GU) {
        const int nb = NGU / 64, kb = it / nb, n0 = 64 * (it % nb), k0 = 32 * kb;
        const int pn = n0 >> 8, i0 = n0 & 255; const float* w = ((i0 < 128) ? inp->w_gate : inp->w_up) + (size_t)l * D * FF; const float* nw = inp->norm2_w + l * D;
        const int coff = 128 * pn + (i0 & 127) - n0;
        transpose_item([&](int k, int n) { return w[(size_t)k * FF + n + coff] * nw[k]; }, D, (bf16_t*)(wsw + W_GU), k0, n0, scr, lane);
        return;
    }
    it -= PI_GU;
    if (it < PI_DN) {
        const int kb = it / 16, n0 = 64 * (it % 16), k0 = 32 * kb; const float* w = inp->w_down + (size_t)l * FF * D;
        transpose_item([&](int k, int n) { return w[(size_t)k * D + n]; }, FF, (bf16_t*)(wsw + W_DN), k0, n0, scr, lane);
        return;
    }
    it -= PI_DN;
    { const int g = it / PI_PW; it %= PI_PW; const int kb = it / 2, n0 = 64 * (it % 2), k0 = 32 * kb; const float* w = inp->pool_w + ((size_t)l * 4 + g) * 128 * 128;
      transpose_item([&](int k, int n) { return w[(size_t)k * 128 + n]; }, 128, (bf16_t*)(wsw + W_PW) + g * 128 * 128, k0, n0, scr, lane); }
}
__global__ void __launch_bounds__(256) k_prep(Inputs in, int l, unsigned char* ws) {
    __shared__ float scr[4][32 * 65];
    const int lane = threadIdx.x & 63, wave = threadIdx.x >> 6;
    for (int it = blockIdx.x * 4 + wave; it < PREP_ITEMS; it += gridDim.x * 4) prep_item(&in, l, ws + WS_W, it, scr[wave], lane);
}

__global__ void __launch_bounds__(256) k_rows(const float* src, bf16_t* dst, float* rss) {
    const int lane = threadIdx.x & 63, row = blockIdx.x * 4 + (threadIdx.x >> 6);
    const f32x4* xr = (const f32x4*)(src + (size_t)row * D) + lane; float s = 0.f;
    unsigned long long* o8 = (unsigned long long*)(dst + (size_t)row * D) + lane;
#pragma unroll
    for (int j = 0; j < 4; ++j) { const f32x4 v = xr[64 * j]; s += (v.x * v.x + v.y * v.y) + (v.z * v.z + v.w * v.w);
        o8[64 * j] = (unsigned long long)pk2(v.x, v.y) | ((unsigned long long)pk2(v.z, v.w) << 32); }
    s = wave_sum(s); if (lane == 0) rss[row] = s;
}

__device__ __forceinline__ void ngemm32(const bf16_t* A, int lda, const bf16_t* Bt, int ldb, int K, f32x4 (&acc)[2][2], int lane) {
    const int r = lane & 15, q = lane >> 4;
    for (int k0 = 0; k0 < K; k0 += 32) {
        bf16x8 a[2], b[2];
#pragma unroll
        for (int i = 0; i < 2; ++i) { a[i] = *(const bf16x8*)(A + (size_t)(i * 16 + r) * lda + k0 + 8 * q); b[i] = *(const bf16x8*)(Bt + (size_t)(i * 16 + r) * ldb + k0 + 8 * q); }
#pragma unroll
        for (int i = 0; i < 2; ++i)
#pragma unroll
            for (int j = 0; j < 2; ++j) acc[i][j] = __builtin_amdgcn_mfma_f32_16x16x32_bf16(a[i], b[j], acc[i][j], 0, 0, 0);
    }
}
#define NG_PRE const int lane = threadIdx.x & 63, wave = threadIdx.x >> 6; const int row0 = blockIdx.y * 64 + (wave >> 1) * 32, col0 = blockIdx.x * 64 + (wave & 1) * 32; \
    f32x4 acc[2][2]; for (int i = 0; i < 2; ++i) for (int j = 0; j < 2; ++j) acc[i][j] = (f32x4){0.f, 0.f, 0.f, 0.f};
#define NG_FOR for (int i = 0; i < 2; ++i) for (int j = 0; j < 2; ++j) for (int rg = 0; rg < 4; ++rg) { const int row = row0 + i * 16 + (lane >> 4) * 4 + rg, col = col0 + j * 16 + (lane & 15);

__global__ void __launch_bounds__(256) k_inproj1(unsigned char* ws, const float* bg) {
    NG_PRE
    ngemm32((const bf16_t*)(ws + WS_XB) + (size_t)row0 * D, D, (const bf16_t*)(ws + WS_W + W_IN) + (size_t)col0 * D, D, D, acc, lane);
    const float* rss = (const float*)(ws + WS_RSS);
    NG_FOR
        const float v = acc[i][j][rg] * rsqrtf(rss[row] * (1.f / D) + EPS);
        const int t = col >> 8, c = col & 255;
        if (t == 0) ((bf16_t*)(ws + WS_GQ))[(size_t)row * 256 + c] = f2bf(v * 0.125f);
        else if (t == 1) ((bf16_t*)(ws + WS_GK))[(size_t)row * 256 + c] = f2bf(v);
        else if (t == 2) ((float*)(ws + WS_GG))[(size_t)row * 256 + c] = logsigmoidf_(v + bg[c]) * (1.f / 16.f);
        else if (t < 5) ((bf16_t*)(ws + WS_GV))[(size_t)row * 512 + (col - 768)] = f2bf(v);
        else if (t < 7) ((bf16_t*)(ws + WS_SR))[(size_t)row * 512 + (col - 1280)] = f2bf(siluf_(v));
        else if (t < 9) ((bf16_t*)(ws + WS_PU))[(size_t)row * 512 + (col - 1792)] = f2bf(v);
        else if (t < 11) ((bf16_t*)(ws + WS_MQ))[(size_t)row * 512 + (col - 2304)] = f2bf(v);
        else if (t < 13) ((bf16_t*)(ws + WS_MK))[(size_t)row * 512 + (col - 2816)] = f2bf(v);
        else ((bf16_t*)(ws + WS_MV))[(size_t)row * 512 + (col - 3328)] = f2bf(v);
    }
}
__global__ void __launch_bounds__(256) k_gates(unsigned char* ws) {
    NG_PRE
    ngemm32((const bf16_t*)(ws + WS_XB) + (size_t)row0 * D, D, (const bf16_t*)(ws + WS_W + W_IN) + (size_t)(NIN1 + col0) * D, D, D, acc, lane);
    const float* rss = (const float*)(ws + WS_RSS);
    NG_FOR
        const float v = acc[i][j][rg] * rsqrtf(rss[row] * (1.f / D) + EPS);
        const int br = col >> 10, c = col & 1023;
        ((bf16_t*)(ws + (br == 0 ? WS_SGA : br == 1 ? WS_SGB : WS_SGC)))[(size_t)row * D + c] = f2bf(sigmoidf_(v));
    }
}
__global__ void __launch_bounds__(256) k_upmerge(unsigned char* ws) {
    NG_PRE
    f32x4 tot[2][2]; for (int i = 0; i < 2; ++i) for (int j = 0; j < 2; ++j) tot[i][j] = (f32x4){0.f, 0.f, 0.f, 0.f};
    for (int br = 0; br < 3; ++br) {
        const bf16_t* Y = (const bf16_t*)(ws + (br == 0 ? WS_SR : br == 1 ? WS_YB : WS_MQ)); const bf16_t* G = (const bf16_t*)(ws + (br == 0 ? WS_SGA : br == 1 ? WS_SGB : WS_SGC));
        for (int i = 0; i < 2; ++i) for (int j = 0; j < 2; ++j) acc[i][j] = (f32x4){0.f, 0.f, 0.f, 0.f};
        ngemm32(Y + (size_t)row0 * 512, 512, (const bf16_t*)(ws + WS_W + W_UP + br * MiB) + (size_t)col0 * 512, 512, 512, acc, lane);
        NG_FOR tot[i][j][rg] += bf2f(G[(size_t)row * D + col]) * acc[i][j][rg]; }
    }
    NG_FOR ((bf16_t*)(ws + WS_MERGED))[(size_t)row * D + col] = f2bf(tot[i][j][rg]); }
}
__global__ void __launch_bounds__(256) k_resgemm(const bf16_t* A, const bf16_t* Bt, int K, const float* resid, float* xout) {
    NG_PRE
    ngemm32(A + (size_t)row0 * K, K, Bt + (size_t)col0 * K, K, K, acc, lane);
    NG_FOR xout[(size_t)row * D + col] = resid[(size_t)row * D + col] + acc[i][j][rg]; }
}
__global__ void __launch_bounds__(256) k_ffn(unsigned char* ws) {
    const int lane = threadIdx.x & 63, wave = threadIdx.x >> 6; const int row0 = blockIdx.y * 64 + (wave >> 1) * 32, j0 = blockIdx.x * 64 + (wave & 1) * 32;
    f32x4 ag[2][2], au[2][2]; for (int i = 0; i < 2; ++i) for (int j = 0; j < 2; ++j) { ag[i][j] = (f32x4){0.f, 0.f, 0.f, 0.f}; au[i][j] = ag[i][j]; }
    const int ng = 256 * (j0 >> 7) + (j0 & 127);
    const bf16_t* A = (const bf16_t*)(ws + WS_X1B) + (size_t)row0 * D; const bf16_t* W = (const bf16_t*)(ws + WS_W + W_GU);
    ngemm32(A, D, W + (size_t)ng * D, D, D, ag, lane);
    ngemm32(A, D, W + (size_t)(ng + 128) * D, D, D, au, lane);
    const float* rss = (const float*)(ws + WS_RSS);
    for (int i = 0; i < 2; ++i) for (int j = 0; j < 2; ++j) for (int rg = 0; rg < 4; ++rg) { const int row = row0 + i * 16 + (lane >> 4) * 4 + rg, col = j0 + j * 16 + (lane & 15);
        const float rs = rsqrtf(rss[row] * (1.f / D) + EPS);
        ((bf16_t*)(ws + WS_H))[(size_t)row * FF + col] = f2bf(siluf_(ag[i][j][rg] * rs) * (au[i][j][rg] * rs)); }
}

__global__ void __launch_bounds__(128) k_gla(unsigned char* ws, const float* nw) {
    const int e = threadIdx.x, b = blockIdx.x >> 2, h = blockIdx.x & 3, lane = e & 63, wave = e >> 6;
    const bf16_t* GQ = (const bf16_t*)(ws + WS_GQ); const bf16_t* GK = (const bf16_t*)(ws + WS_GK); const float* GG = (const float*)(ws + WS_GG);
    const bf16_t* GV = (const bf16_t*)(ws + WS_GV); bf16_t* YA = (bf16_t*)(ws + WS_SR);
    __shared__ float red[2][16]; __shared__ float osh[16][128];
    float S[64];
#pragma unroll
    for (int d = 0; d < 64; ++d) S[d] = 0.f;
    const float nwe = nw[e];
    for (int t0 = 0; t0 < SEQ; t0 += 16) {
#pragma unroll 1
        for (int tt = 0; tt < 16; ++tt) {
            const size_t row = (size_t)b * SEQ + t0 + tt;
            const bf16_t* q = GQ + row * 256 + h * 64; const bf16_t* k = GK + row * 256 + h * 64; const float* g = GG + row * 256 + h * 64;
            const float v = bf2f(GV[row * 512 + h * 128 + e]); float a = 0.f;
#pragma unroll
            for (int d = 0; d < 64; ++d) { S[d] = __expf(g[d]) * S[d] + bf2f(k[d]) * v; a += bf2f(q[d]) * S[d]; }
            osh[tt][e] = a;
            const float s = wave_sum(a * a); if (lane == 0) red[wave][tt] = s;
        }
        __syncthreads();
#pragma unroll 1
        for (int tt = 0; tt < 16; ++tt) { const float rstd = rsqrtf((red[0][tt] + red[1][tt]) * (1.f / 128.f) + EPS);
            const size_t idx = ((size_t)b * SEQ + t0 + tt) * 512 + h * 128 + e; YA[idx] = f2bf(osh[tt][e] * rstd * nwe * bf2f(YA[idx])); }
        __syncthreads();
    }
}

__global__ void __launch_bounds__(256) k_pool(unsigned char* ws, const float* pw, const float* pscale) {
    __shared__ float u[31][128]; __shared__ float p[16][128];
    const int g = blockIdx.x & 3, r0 = (blockIdx.x >> 2) * 16, t0 = r0 & (SEQ - 1), tid = threadIdx.x;
    const bf16_t* PU = (const bf16_t*)(ws + WS_PU);
    for (int x = tid; x < 31 * 128; x += 256) { const int i = x >> 7, c = x & 127, t = t0 - 15 + i; u[i][c] = t >= 0 ? bf2f(PU[(size_t)(r0 - 15 + i) * 512 + g * 128 + c]) : 0.f; }
    __syncthreads();
    const int w = 2 << g;
    for (int x = tid; x < 16 * 128; x += 256) { const int i = x >> 7, c = x & 127, t = t0 + i, cnt = min(t + 1, w); float s = 0.f;
        for (int j = 0; j < cnt; ++j) s += u[15 + i - j][c];
        p[i][c] = s / (float)cnt - u[15 + i][c]; }
    __syncthreads();
    for (int x = tid; x < 16 * 128; x += 256) { const int i = x >> 7, e = x & 127; float y = 0.f;
        for (int c = 0; c < 128; ++c) y += p[i][c] * pw[((size_t)g * 128 + c) * 128 + e];
        ((bf16_t*)(ws + WS_YB))[(size_t)(r0 + i) * 512 + g * 128 + e] = f2bf(y * pscale[g * 128 + e]); }
}

__global__ void __launch_bounds__(256) k_prepass(unsigned char* ws, const float* qw, const float* kw) {
    __shared__ float part[4][128];
    const int lane = threadIdx.x & 63, wave = threadIdx.x >> 6; const int h = blockIdx.x & 3, blk = (blockIdx.x >> 2) & 7, b = blockIdx.x >> 5;
    unsigned* MQ = (unsigned*)(ws + WS_MQ); unsigned* MK = (unsigned*)(ws + WS_MK);
    const float qw0 = qw[2 * lane] * QSCALE, qw1 = qw[2 * lane + 1] * QSCALE, kw0 = kw[2 * lane], kw1 = kw[2 * lane + 1];
    float c0 = 0.f, c1 = 0.f;
    for (int r = 0; r < 64; ++r) {
        const size_t idx = ((size_t)b * SEQ + blk * 256 + wave * 64 + r) * 256 + h * 64 + lane;
        { const unsigned v = MQ[idx]; const float a = __uint_as_float(v << 16), c = __uint_as_float(v & 0xffff0000u); const float rs = rsqrtf(wave_sum(a * a + c * c) * (1.f / 128.f) + EPS); MQ[idx] = pk2(a * rs * qw0, c * rs * qw1); }
        { const unsigned v = MK[idx]; const float a = __uint_as_float(v << 16), c = __uint_as_float(v & 0xffff0000u); const float rs = rsqrtf(wave_sum(a * a + c * c) * (1.f / 128.f) + EPS);
          const float k0 = a * rs * kw0, k1 = c * rs * kw1; c0 += k0; c1 += k1; MK[idx] = pk2(k0, k1); }
    }
    part[wave][2 * lane] = c0; part[wave][2 * lane + 1] = c1;
    __syncthreads();
    if (threadIdx.x < 128) ((float*)(ws + WS_KMEAN))[(((size_t)b * 4 + h) * 8 + blk) * 128 + threadIdx.x] = ((part[0][threadIdx.x] + part[1][threadIdx.x]) + (part[2][threadIdx.x] + part[3][threadIdx.x])) * (1.f / 256.f);
}

__global__ void __launch_bounds__(256) k_moba(unsigned char* ws, const float* rel_bias) {
    __shared__ float tab[4][132]; __shared__ float qs[4][128]; __shared__ float ps[4][1024];
    const int lane = threadIdx.x & 63, wave = threadIdx.x >> 6;
    const int gw = blockIdx.x * 4 + wave; const int t = gw & (SEQ - 1), h = (gw >> 11) & 3, b = gw >> 13;
    for (int x = threadIdx.x; x < 129; x += 256) { int bk = x; if (x >= 16) { bk = 16 + (int)(logf((float)x / 16.f) / 2.0794415416798357f * 16.f); if (bk > 31) bk = 31; } tab[0][x] = rel_bias[bk * 4 + h] * LOG2E; }
    __syncthreads();
    const size_t row = (size_t)b * SEQ + t; const int qblk = t >> 8;
    unsigned* QN = (unsigned*)(ws + WS_MQ); const bf16_t* KN = (const bf16_t*)(ws + WS_MK); const unsigned* MV = (const unsigned*)(ws + WS_MV);
    const unsigned qv = QN[row * 256 + h * 64 + lane]; const float q0 = __uint_as_float(qv << 16), q1 = __uint_as_float(qv & 0xffff0000u);
    qs[wave][2 * lane] = q0; qs[wave][2 * lane + 1] = q1;
    const float* km = (const float*)(ws + WS_KMEAN) + ((size_t)b * 4 + h) * 8 * 128;
    float sc[8];
#pragma unroll
    for (int n = 0; n < 8; ++n) sc[n] = (n < qblk) ? wave_sum(q0 * km[n * 128 + 2 * lane] + q1 * km[n * 128 + 2 * lane + 1]) : -INFINITY;
    int blks[4]; int nvalid = 0;
#pragma unroll
    for (int s = 0; s < 3; ++s) { float best = -INFINITY; int bi = -1;
#pragma unroll
        for (int n = 0; n < 8; ++n) if (sc[n] > best) { best = sc[n]; bi = n; }
        blks[s] = bi;
#pragma unroll
        for (int n = 0; n < 8; ++n) if (n == bi) sc[n] = -INFINITY; }
    blks[3] = qblk;
    __builtin_amdgcn_s_waitcnt(0xc07f);
    float lg[4][4]; float mx = -INFINITY;
#pragma unroll
    for (int s = 0; s < 4; ++s) {
        const int blk = blks[s];
#pragma unroll
        for (int i = 0; i < 4; ++i) {
            lg[s][i] = -INFINITY;
            if (blk >= 0) { const int j = lane + 64 * i, tk = blk * 256 + j, dist = t - tk;
                if (dist >= 0) { const bf16_t* kr = KN + ((size_t)b * SEQ + tk) * 512 + h * 128; float dsum = 0.f;
                    for (int c = 0; c < 16; ++c) { const bf16x8 kk = *(const bf16x8*)(kr + c * 8);
#pragma unroll
                        for (int x = 0; x < 8; ++x) dsum += bf2f((bf16_t)kk[x]) * qs[wave][c * 8 + x]; }
                    lg[s][i] = dsum + tab[0][dist > 128 ? 128 : dist]; mx = fmaxf(mx, lg[s][i]); } }
        }
    }
    mx = wave_max(mx); float sum = 0.f;
#pragma unroll
    for (int s = 0; s < 4; ++s)
#pragma unroll
        for (int i = 0; i < 4; ++i) { const float pp = exp2f(lg[s][i] - mx); sum += pp; ps[wave][s * 256 + lane + 64 * i] = pp; }
    sum = wave_sum(sum);
    __builtin_amdgcn_s_waitcnt(0xc07f);
    float o0 = 0.f, o1 = 0.f;
#pragma unroll
    for (int s = 0; s < 4; ++s) { const int blk = blks[s]; if (blk < 0) continue; const int jn = (s == 3) ? (t & 255) + 1 : 256;
        const unsigned* vr = MV + ((size_t)b * SEQ + blk * 256) * 256 + h * 64 + lane;
        for (int j = 0; j < jn; ++j) { const float pp = ps[wave][s * 256 + j]; const unsigned v = vr[(size_t)j * 256]; o0 += pp * __uint_as_float(v << 16); o1 += pp * __uint_as_float(v & 0xffff0000u); } }
    const float inv = 1.f / sum;
    QN[row * 256 + h * 64 + lane] = pk2(o0 * inv, o1 * inv);
}


namespace pg8 {
#define PG8_LAS __attribute__((address_space(3)))
typedef unsigned u32x4 __attribute__((ext_vector_type(4)));
constexpr int BM = 256, BK = 64, HALF = 128, HTB = HALF * BK * 2, STAGE_BYTES = 8 * HTB, NXCD = 8, WGM = 8;
__host__ __device__ __forceinline__ int lds_byte(int r, int c) { const int st = (r >> 4) * 2 + (c >> 5), rr = r & 15, cc = c & 31, ob = rr * 64 + cc * 2; return st * 1024 + (ob ^ (((ob >> 9) & 1) << 5)); }
__host__ __device__ __forceinline__ void stage_rc(int b, int& R, int& C) { const int st = b / 1024, sb = b % 1024, swz = sb ^ (((sb >> 9) & 1) << 5); R = (st >> 1) * 16 + swz / 64; C = (st & 1) * 32 + (swz % 64) / 2; }
__host__ __device__ __forceinline__ int perm32(int rho) { const int n = rho >> 4, i = rho & 15; return 8 * (i >> 2) + 4 * n + (i & 3); }
struct Unit { int pm, pn, br; };
struct Gemm { const bf16_t* A; const bf16_t* Bt; int M, N, K; };
struct StaticOrder {
    int nM, nN, nwg, G, c;
    __device__ void init(int M_, int N_, int G_, int c_) { nM = M_ / BM; nN = N_ / BM; nwg = nM * nN; G = G_; c = c_; }
    __device__ bool next(int i, Unit& u) const {
        const long L = (long)i * G + c; if (L >= nwg) return false;
        int wgid = (int)L; { const int q = nwg / NXCD, r = nwg % NXCD, xcd = wgid % NXCD, off = wgid / NXCD; wgid = (xcd < r ? xcd * (q + 1) : r * (q + 1) + (xcd - r) * q) + off; }
        const int nig = WGM * nN, gid = wgid / nig, fm = gid * WGM, gsz = (nM - fm) < WGM ? (nM - fm) : WGM;
        u.pm = fm + ((wgid % nig) % gsz); u.pn = (wgid % nig) / gsz; u.br = 0; return true;
    }
    __device__ __forceinline__ const char* pa(const Unit& u, const Gemm& g) const { return (const char*)g.A + (size_t)u.pm * (size_t)(BM * 2) * g.K; }
    __device__ __forceinline__ const char* pb(const Unit& u, const Gemm& g) const { return (const char*)g.Bt + (size_t)u.pn * (size_t)(BM * 2) * g.K; }
    __device__ __forceinline__ void a_ready(const Unit&) const {}
    __device__ __forceinline__ void done(const Unit&) const {}
};
struct UpmOrder {
    StaticOrder so; const bf16_t *Y0, *Y1, *Y2, *W0, *W1, *W2;
    __device__ bool next(int i, Unit& u) const { if (i >= 3) return false; if (!so.next(0, u)) return false; u.br = i; return true; }
    __device__ __forceinline__ const char* pa(const Unit& u, const Gemm& g) const { const bf16_t* y = u.br == 0 ? Y0 : (u.br == 1 ? Y1 : Y2); return (const char*)y + (size_t)u.pm * (size_t)(BM * 2) * g.K; }
    __device__ __forceinline__ const char* pb(const Unit& u, const Gemm& g) const { const bf16_t* w = u.br == 0 ? W0 : (u.br == 1 ? W1 : W2); return (const char*)w + (size_t)u.pn * (size_t)(BM * 2) * g.K; }
    __device__ __forceinline__ void a_ready(const Unit&) const {}
    __device__ __forceinline__ void done(const Unit&) const {}
};
typedef float f32x2_t __attribute__((ext_vector_type(2))); typedef __bf16 bf16x2_t __attribute__((ext_vector_type(2)));
__device__ __forceinline__ unsigned cvt_pk_bf16(float lo, float hi) { const f32x2_t v = {lo, hi}; const bf16x2_t b = __builtin_convertvector(v, bf16x2_t); return __builtin_bit_cast(unsigned, b); }
__device__ __forceinline__ u32x4 pack8(const f32x4& a, const f32x4& b) { u32x4 w; w.x = cvt_pk_bf16(a[0], a[1]); w.y = cvt_pk_bf16(a[2], a[3]); w.z = cvt_pk_bf16(b[0], b[1]); w.w = cvt_pk_bf16(b[2], b[3]); return w; }
__device__ __forceinline__ void unpack8(const u32x4& w, f32x4& a, f32x4& b) {
    a[0] = __uint_as_float(w.x << 16); a[1] = __uint_as_float(w.x & 0xffff0000u); a[2] = __uint_as_float(w.y << 16); a[3] = __uint_as_float(w.y & 0xffff0000u);
    b[0] = __uint_as_float(w.z << 16); b[1] = __uint_as_float(w.z & 0xffff0000u); b[2] = __uint_as_float(w.w << 16); b[3] = __uint_as_float(w.w & 0xffff0000u);
}
__device__ __forceinline__ void row_rstd(const PG8_LAS float* tab, const Unit& u, int wr, int fr, float (&rs)[2][4]) {
#pragma unroll
    for (int ai = 0; ai < 2; ++ai)
#pragma unroll
        for (int m = 0; m < 4; ++m) rs[ai][m] = tab[(u.pm & 7) * BM + ai * HALF + wr * 64 + m * 16 + fr];
}
struct EpiIn1 {
    static constexpr bool PERM = true, AFTER_DRAIN = false;
    unsigned char* ws; const PG8_LAS float* rstab; const float* bg;
    __device__ __forceinline__ void operator()(const f32x4 (&acc)[2][2][4][2], const Unit& u, int wr, int wc, int fr, int fq) const {
        asm volatile("" : "+v"(fr), "+v"(fq));
        const int row0 = u.pm * BM + wr * 64 + fr, cw = wc * 32 + 8 * fq; const int pn = u.pn;
        float rs[2][4]; row_rstd(rstab, u, wr, fr, rs);
        if (pn == 2) {
            float* G = (float*)(ws + WS_GG); size_t zb = 0; asm volatile("" : "+s"(zb)); const float* bgl = bg + zb;
#pragma unroll
            for (int bj = 0; bj < 2; ++bj) { const int c = bj * HALF + cw; const f32x4 b0 = *(const f32x4*)(bgl + c), b1 = *(const f32x4*)(bgl + c + 4);
#pragma unroll
                for (int ai = 0; ai < 2; ++ai)
#pragma unroll
                    for (int m = 0; m < 4; ++m) { const float r = rs[ai][m]; f32x4 v0 = acc[ai][bj][m][0] * r + b0, v1 = acc[ai][bj][m][1] * r + b1;
#pragma unroll
                        for (int x = 0; x < 4; ++x) { v0[x] = (fminf(v0[x], 0.f) - __logf(1.f + __expf(-fabsf(v0[x])))) * 0.0625f; v1[x] = (fminf(v1[x], 0.f) - __logf(1.f + __expf(-fabsf(v1[x])))) * 0.0625f; }
                        float* p = G + (size_t)(row0 + ai * HALF + m * 16) * 256 + c; *(f32x4*)p = v0; *(f32x4*)(p + 4) = v1; asm volatile("" ::: "memory"); } }
            return;
        }
        bf16_t* base; int ldc, coff; float sc = 1.f; bool silu = false;
        if (pn == 0) { base = (bf16_t*)(ws + WS_GQ); ldc = 256; coff = 0; sc = 0.125f; }
        else if (pn == 1) { base = (bf16_t*)(ws + WS_GK); ldc = 256; coff = 0; }
        else { ldc = 512; const int k = (pn - 3) >> 1; coff = ((pn - 3) & 1) * 256; silu = (k == 1);
            base = (bf16_t*)(ws + (k == 0 ? WS_GV : k == 1 ? WS_SR : k == 2 ? WS_PU : k == 3 ? WS_MQ : k == 4 ? WS_MK : WS_MV)); }
#pragma unroll
        for (int ai = 0; ai < 2; ++ai)
#pragma unroll
            for (int m = 0; m < 4; ++m) { const float r = rs[ai][m] * sc; bf16_t* rowp = base + (size_t)(row0 + ai * HALF + m * 16) * ldc + coff + cw;
#pragma unroll
                for (int bj = 0; bj < 2; ++bj) { f32x4 v0 = acc[ai][bj][m][0] * r, v1 = acc[ai][bj][m][1] * r;
                    if (silu) {
#pragma unroll
                        for (int x = 0; x < 4; ++x) { v0[x] = siluf_(v0[x]); v1[x] = siluf_(v1[x]); } }
                    *(u32x4*)(rowp + bj * HALF) = pack8(v0, v1); } asm volatile("" ::: "memory"); }
    }
};
struct EpiGates {
    static constexpr bool PERM = true, AFTER_DRAIN = false;
    unsigned char* ws; const PG8_LAS float* rstab;
    __device__ __forceinline__ void operator()(const f32x4 (&acc)[2][2][4][2], const Unit& u, int wr, int wc, int fr, int fq) const {
        asm volatile("" : "+v"(fr), "+v"(fq));
        const int row0 = u.pm * BM + wr * 64 + fr, cw = wc * 32 + 8 * fq; const int br = u.pn >> 2;
        float rs[2][4]; row_rstd(rstab, u, wr, fr, rs);
        bf16_t* base = (bf16_t*)(ws + (br == 0 ? WS_SGA : br == 1 ? WS_SGB : WS_SGC)) + (u.pn & 3) * 256 + cw;
#pragma unroll
        for (int ai = 0; ai < 2; ++ai)
#pragma unroll
            for (int m = 0; m < 4; ++m) { const float r = rs[ai][m]; bf16_t* rowp = base + (size_t)(row0 + ai * HALF + m * 16) * D;
#pragma unroll
                for (int bj = 0; bj < 2; ++bj) { f32x4 v0 = acc[ai][bj][m][0] * r, v1 = acc[ai][bj][m][1] * r;
#pragma unroll
                    for (int x = 0; x < 4; ++x) { v0[x] = sigmoidf_(v0[x]); v1[x] = sigmoidf_(v1[x]); }
                    *(u32x4*)(rowp + bj * HALF) = pack8(v0, v1); } asm volatile("" ::: "memory"); }
    }
};
struct EpiUpm {
    static constexpr bool PERM = true, AFTER_DRAIN = false;
    unsigned char* ws;
    __device__ __forceinline__ void operator()(const f32x4 (&acc)[2][2][4][2], const Unit& u, int wr, int wc, int fr, int fq) const {
        asm volatile("" : "+v"(fr), "+v"(fq));
        const int row0 = u.pm * BM + wr * 64 + fr, col0 = u.pn * BM + wc * 32 + 8 * fq; const int br = u.br;
        const bf16_t* G = (const bf16_t*)(ws + (br == 0 ? WS_SGA : br == 1 ? WS_SGB : WS_SGC)); bf16_t* O = (bf16_t*)(ws + WS_MERGED);
#pragma unroll
        for (int ai = 0; ai < 2; ++ai)
#pragma unroll
            for (int m = 0; m < 4; ++m) { const size_t off = (size_t)(row0 + ai * HALF + m * 16) * D + col0;
#pragma unroll
                for (int bj = 0; bj < 2; ++bj) { f32x4 g0, g1; unpack8(*(const u32x4*)(G + off + bj * HALF), g0, g1);
                    f32x4 v0 = acc[ai][bj][m][0] * g0, v1 = acc[ai][bj][m][1] * g1;
                    if (br != 0) { f32x4 p0, p1; unpack8(*(const u32x4*)(O + off + bj * HALF), p0, p1); v0 += p0; v1 += p1; }
                    *(u32x4*)(O + off + bj * HALF) = pack8(v0, v1); } }
    }
};
struct EpiRes {
    static constexpr bool PERM = true, AFTER_DRAIN = false;
    const float* resid; float* xout; bf16_t* xb; float* rssp; bool st;
    __device__ __forceinline__ void operator()(const f32x4 (&acc)[2][2][4][2], const Unit& u, int wr, int wc, int fr, int fq) const {
        asm volatile("" : "+v"(fr), "+v"(fq));
        const int row0 = u.pm * BM + wr * 64 + fr, col0 = u.pn * BM + wc * 32 + 8 * fq;
#pragma unroll
        for (int ai = 0; ai < 2; ++ai)
#pragma unroll
            for (int m = 0; m < 4; ++m) { const int row = row0 + ai * HALF + m * 16; const size_t off = (size_t)row * D + col0; float s = 0.f;
#pragma unroll
                for (int bj = 0; bj < 2; ++bj) { const f32x4 r0 = *(const f32x4*)(resid + off + bj * HALF), r1 = *(const f32x4*)(resid + off + bj * HALF + 4);
                    const f32x4 v0 = acc[ai][bj][m][0] + r0, v1 = acc[ai][bj][m][1] + r1;
                    if (st) { *(f32x4*)(xout + off + bj * HALF) = v0; *(f32x4*)(xout + off + bj * HALF + 4) = v1; }
                    if (xb && st) *(u32x4*)(xb + off + bj * HALF) = pack8(v0, v1);
                    s += ((v0[0] * v0[0] + v0[1] * v0[1]) + (v0[2] * v0[2] + v0[3] * v0[3])) + ((v1[0] * v1[0] + v1[1] * v1[1]) + (v1[2] * v1[2] + v1[3] * v1[3])); }
                s += __shfl_xor(s, 16); s += __shfl_xor(s, 32);
                if (fq == 0 && rssp && st) rssp[(size_t)row * 16 + u.pn * 4 + wc] = s; }
    }
};
struct EpiFfn {
    static constexpr bool PERM = true, AFTER_DRAIN = false;
    bf16_t* H; const PG8_LAS float* rstab;
    __device__ __forceinline__ void operator()(const f32x4 (&acc)[2][2][4][2], const Unit& u, int wr, int wc, int fr, int fq) const {
        asm volatile("" : "+v"(fr), "+v"(fq));
        const int row0 = u.pm * BM + wr * 64 + fr, col0 = u.pn * HALF + wc * 32 + 8 * fq;
        float rs[2][4]; row_rstd(rstab, u, wr, fr, rs);
#pragma unroll
        for (int ai = 0; ai < 2; ++ai)
#pragma unroll
            for (int m = 0; m < 4; ++m) { const float r = rs[ai][m]; f32x4 g0 = acc[ai][0][m][0] * r, g1 = acc[ai][0][m][1] * r; const f32x4 u0 = acc[ai][1][m][0] * r, u1 = acc[ai][1][m][1] * r;
#pragma unroll
                for (int x = 0; x < 4; ++x) { g0[x] = siluf_(g0[x]) * u0[x]; g1[x] = siluf_(g1[x]) * u1[x]; }
                *(u32x4*)(H + (size_t)(row0 + ai * HALF + m * 16) * FF + col0) = pack8(g0, g1); asm volatile("" ::: "memory"); }
    }
};
template <class Epi, class Sched, bool ALIGN_EPI = false, bool SP2 = false>
__device__ __forceinline__ void gemm_phase(PG8_LAS unsigned char* lds, const Gemm g, const Sched& S, const Epi& E, const int tid) {
    const int wid = __builtin_amdgcn_readfirstlane(tid >> 6), lane = tid & 63, wr = wid >> 2, wc = wid & 3, fr = lane & 15, fq = lane >> 4;
    const int K = g.K, nt = K / BK;
    unsigned voffA[2], voffB[2];
#pragma unroll
    for (int i = 0; i < 2; ++i) { int R, C; stage_rc(tid * 16 + i * 8192, R, C); const int Rb = Epi::PERM ? ((R & ~31) + perm32(R & 31)) : R;
        voffA[i] = (unsigned)(R * K + C) * 2u; voffB[i] = (unsigned)(Rb * K + C) * 2u; }
    const size_t kstep = (size_t)(BK * 2);
    const size_t hstep = (size_t)HALF * K * 2;
    const unsigned ldsw = (unsigned)wid * 1024u;
    const int aoff = lds_byte(wr * 64 + fr, fq * 8), boff = lds_byte(wc * 32 + fr, fq * 8);
#define PG8_SA(b, h) (((b) * 2 + (h)) * HTB)
#define PG8_SB(b, h) ((4 + (b) * 2 + (h)) * HTB)
#define PG8_STAGE(bufoff, gbase, voff) do { _Pragma("unroll") for (int _i = 0; _i < 2; ++_i) \
        __builtin_amdgcn_global_load_lds((const unsigned*)((const char*)(gbase) + (voff)[_i]), (PG8_LAS unsigned*)(lds + (bufoff) + ldsw + _i * 8192), 16, 0, 0); } while (0)
#define PG8_LDA(dst, b, h) do { _Pragma("unroll") for (int m = 0; m < 4; ++m) _Pragma("unroll") for (int k = 0; k < 2; ++k) dst[m][k] = *(const PG8_LAS bf16x8*)(lds + PG8_SA(b, h) + aoff + m * 2048 + k * 1024); } while (0)
#define PG8_LDB(dst, b, h) do { _Pragma("unroll") for (int n = 0; n < 2; ++n) _Pragma("unroll") for (int k = 0; k < 2; ++k) dst[n][k] = *(const PG8_LAS bf16x8*)(lds + PG8_SB(b, h) + boff + n * 2048 + k * 1024); } while (0)
#define PG8_MMA(ai, bj, At, Bt) do { __builtin_amdgcn_s_setprio(1); _Pragma("unroll") for (int m = 0; m < 4; ++m) _Pragma("unroll") for (int n = 0; n < 2; ++n) _Pragma("unroll") for (int k = 0; k < 2; ++k) \
        acc[ai][bj][m][n] = __builtin_amdgcn_mfma_f32_16x16x32_bf16(Bt[n][k], At[m][k], acc[ai][bj][m][n], 0, 0, 0); __builtin_amdgcn_s_setprio(0); } while (0)
#define PG8_WAIT_V(n) asm volatile("s_waitcnt vmcnt(" #n ")" ::: "memory")
#define PG8_WAIT_L(n) asm volatile("s_waitcnt lgkmcnt(" #n ")" ::: "memory")
#define PG8_BAR __builtin_amdgcn_s_barrier()
#define PG8_SCHED __builtin_amdgcn_sched_barrier(0)
    Unit cur, nxt; int ui = 0;
    if (!S.next(0, cur)) return;
    f32x4 acc[2][2][4][2];
#pragma unroll
    for (int a = 0; a < 2; ++a)
#pragma unroll
        for (int b = 0; b < 2; ++b)
#pragma unroll
            for (int m = 0; m < 4; ++m)
#pragma unroll
                for (int n = 0; n < 2; ++n) acc[a][b][m][n] = (f32x4){0.f, 0.f, 0.f, 0.f};
    bf16x8 At[4][2], B0[2][2], B1[2][2];
    const char* cA = S.pa(cur, g); const char* cB = S.pb(cur, g);
    S.a_ready(cur);
    if constexpr (SP2) {
        PG8_STAGE(PG8_SB(0, 0), cB, voffB); PG8_STAGE(PG8_SB(0, 1), cB + hstep, voffB); PG8_STAGE(PG8_SA(0, 0), cA, voffA); PG8_STAGE(PG8_SA(0, 1), cA + hstep, voffA);
        if (wr == 1) PG8_BAR;
        PG8_WAIT_V(2); PG8_BAR;
        PG8_STAGE(PG8_SB(1, 0), cB + kstep, voffB); PG8_STAGE(PG8_SA(1, 0), cA + kstep, voffA); PG8_STAGE(PG8_SB(1, 1), cB + hstep + kstep, voffB);
        PG8_WAIT_V(6); PG8_BAR;
    } else {
        PG8_STAGE(PG8_SB(0, 0), cB, voffB); PG8_STAGE(PG8_SA(0, 0), cA, voffA); PG8_STAGE(PG8_SB(0, 1), cB + hstep, voffB); PG8_STAGE(PG8_SA(0, 1), cA + hstep, voffA);
        if (wr == 1) PG8_BAR;
        PG8_WAIT_V(4); PG8_BAR;
        PG8_STAGE(PG8_SB(1, 0), cB + kstep, voffB); PG8_STAGE(PG8_SA(1, 0), cA + kstep, voffA); PG8_STAGE(PG8_SB(1, 1), cB + hstep + kstep, voffB);
        PG8_WAIT_V(6); PG8_BAR;
    }
    for (;;) {
        const bool has_next = S.next(ui + 1, nxt);
        const char* nA = has_next ? S.pa(nxt, g) : cA; const char* nB = has_next ? S.pb(nxt, g) : cB;
        for (int t = 0; t < nt; t += 2) {
            const bool last = (t == nt - 2);
            const char* a1 = cA + (size_t)(t + 1) * kstep;
            const char* a2 = last ? nA : cA + (size_t)(t + 2) * kstep; const char* b2 = last ? nB : cB + (size_t)(t + 2) * kstep;
            const char* a3 = a2 + kstep; const char* b3 = b2 + kstep;
            if (last && has_next) S.a_ready(nxt);
            if constexpr (SP2) {
            PG8_LDB(B0, 0, 0); PG8_LDB(B1, 0, 1); PG8_SCHED; PG8_LDA(At, 0, 0); PG8_STAGE(PG8_SA(1, 1), a1 + hstep, voffA);
            PG8_WAIT_V(8); PG8_WAIT_L(0); PG8_BAR; PG8_MMA(0, 0, At, B0); PG8_MMA(0, 1, At, B1); PG8_BAR; PG8_SCHED;
            PG8_LDA(At, 0, 1); PG8_STAGE(PG8_SB(0, 0), b2, voffB); PG8_STAGE(PG8_SB(0, 1), b2 + hstep, voffB); PG8_STAGE(PG8_SA(0, 0), a2, voffA);
            PG8_WAIT_V(8); PG8_WAIT_L(0); PG8_BAR; PG8_MMA(1, 0, At, B0); PG8_MMA(1, 1, At, B1); PG8_BAR; PG8_SCHED;
            PG8_LDB(B0, 1, 0); PG8_LDB(B1, 1, 1); PG8_SCHED; PG8_LDA(At, 1, 0); PG8_STAGE(PG8_SA(0, 1), a2 + hstep, voffA);
            PG8_WAIT_V(8); PG8_WAIT_L(0); PG8_BAR; PG8_MMA(0, 0, At, B0); PG8_MMA(0, 1, At, B1); PG8_BAR; PG8_SCHED;
            PG8_LDA(At, 1, 1); PG8_STAGE(PG8_SB(1, 0), b3, voffB); PG8_STAGE(PG8_SB(1, 1), b3 + hstep, voffB); PG8_STAGE(PG8_SA(1, 0), a3, voffA);
            PG8_WAIT_V(8); PG8_WAIT_L(0); PG8_BAR; PG8_MMA(1, 0, At, B0); PG8_MMA(1, 1, At, B1); PG8_BAR; PG8_SCHED;
            } else {
            PG8_LDB(B0, 0, 0); PG8_SCHED; PG8_LDA(At, 0, 0); PG8_STAGE(PG8_SA(1, 1), a1 + hstep, voffA);
            PG8_WAIT_L(8); PG8_BAR; PG8_WAIT_L(0); PG8_MMA(0, 0, At, B0); PG8_BAR; PG8_SCHED;
            PG8_LDB(B1, 0, 1); PG8_STAGE(PG8_SB(0, 0), b2, voffB);
            PG8_BAR; PG8_WAIT_L(0); PG8_MMA(0, 1, At, B1); PG8_BAR;
            PG8_LDA(At, 0, 1); PG8_STAGE(PG8_SA(0, 0), a2, voffA);
            PG8_BAR; PG8_WAIT_L(0); PG8_MMA(1, 0, At, B0); PG8_BAR; PG8_SCHED;
            PG8_STAGE(PG8_SB(0, 1), b2 + hstep, voffB);
            PG8_WAIT_V(6); PG8_BAR; PG8_MMA(1, 1, At, B1); PG8_BAR;
            PG8_LDB(B0, 1, 0); PG8_SCHED; PG8_LDA(At, 1, 0); PG8_STAGE(PG8_SA(0, 1), a2 + hstep, voffA);
            PG8_WAIT_L(8); PG8_BAR; PG8_WAIT_L(0); PG8_MMA(0, 0, At, B0); PG8_BAR; PG8_SCHED;
            PG8_LDB(B1, 1, 1); PG8_STAGE(PG8_SB(1, 0), b3, voffB);
            PG8_BAR; PG8_WAIT_L(0); PG8_MMA(0, 1, At, B1); PG8_BAR;
            PG8_LDA(At, 1, 1); PG8_STAGE(PG8_SA(1, 0), a3, voffA);
            PG8_BAR; PG8_WAIT_L(0); PG8_MMA(1, 0, At, B0); PG8_BAR; PG8_SCHED;
            PG8_STAGE(PG8_SB(1, 1), b3 + hstep, voffB);
            PG8_WAIT_V(6); PG8_BAR; PG8_MMA(1, 1, At, B1); PG8_BAR;
            }
        }
        if constexpr (ALIGN_EPI) { if (wr == 0) PG8_BAR; }
        if constexpr (!Epi::AFTER_DRAIN) { E(acc, cur, wr, wc, fr, fq); S.done(cur); }
        if (!has_next) break;
#pragma unroll
        for (int a = 0; a < 2; ++a)
#pragma unroll
            for (int b = 0; b < 2; ++b)
#pragma unroll
                for (int m = 0; m < 4; ++m)
#pragma unroll
                    for (int n = 0; n < 2; ++n) acc[a][b][m][n] = (f32x4){0.f, 0.f, 0.f, 0.f};
        cur = nxt; cA = nA; cB = nB; ++ui;
        if constexpr (ALIGN_EPI) { if (wr == 1) PG8_BAR; }
    }
    PG8_WAIT_V(0);
    if constexpr (!ALIGN_EPI) { if (wr == 0) PG8_BAR; }
    PG8_BAR;
    if constexpr (Epi::AFTER_DRAIN) { E.fused(acc, cur, wr, wc, fr, fq, lds, wid, lane); S.done(cur); }
#undef PG8_SA
#undef PG8_SB
#undef PG8_STAGE
#undef PG8_LDA
#undef PG8_LDB
#undef PG8_MMA
#undef PG8_WAIT_V
#undef PG8_WAIT_L
#undef PG8_BAR
#undef PG8_SCHED
}
}

constexpr int NWAVES = 8;
constexpr int RING_BYTES = 131072, LDSCTL_OFF = RING_BYTES, MISC_OFF = LDSCTL_OFF + 320, RSTD_OFF = RING_BYTES + 1024, LDS_BYTES = 147456;
constexpr int CW_BAR = 4096;
#define GAS __attribute__((address_space(1)))
#define LAS __attribute__((address_space(3)))
typedef GAS unsigned gu32;
#define RLX_AGENT __ATOMIC_RELAXED, __HIP_MEMORY_SCOPE_AGENT
#define XB_TMO      128
#define XB_XCNT(j)  (256  + 64 * (j))
#define XB_XSUB(j)  (1280 + 64 * (j))
#define XB_XGEN(j)  (2304 + 64 * (j))
#define XB_TOP      3328
#define XB_TOPGEN   3392
#define XCD_BAR_WORDS 3456
#define XB_SPIN_CAP (1u << 18)

__device__ __forceinline__ unsigned xb_ld(unsigned* p)              { return __hip_atomic_load(p, __ATOMIC_RELAXED, __HIP_MEMORY_SCOPE_AGENT); }
__device__ __forceinline__ unsigned xb_add(unsigned* p, unsigned v) { return __hip_atomic_fetch_add(p, v, __ATOMIC_RELAXED, __HIP_MEMORY_SCOPE_AGENT); }
__device__ __forceinline__ unsigned xb_xcc_id() { return (unsigned)__builtin_amdgcn_s_getreg((3 << 11) | 20) & 0xFu; }
#define XB_SPIN(cond, bar) do { unsigned _sp = 0; while (cond) { __builtin_amdgcn_s_sleep(1); \
    if ((++_sp & 255u) == 0u) { if (xb_ld(&(bar)[XB_TMO])) break; if (_sp > XB_SPIN_CAP) { atomicAdd(&(bar)[XB_TMO], 1u); break; } } } } while (0)

struct XcdBarrier {
    unsigned* bar; unsigned x;
    volatile LAS unsigned* st;
};

__device__ __forceinline__ XcdBarrier xcd_barrier_post(unsigned* bar, volatile LAS unsigned* st) {
    XcdBarrier b; b.bar = bar; b.x = xb_xcc_id(); b.st = st;
    if (threadIdx.x == 0) (void)xb_add(&bar[XB_XCNT(b.x)], 1u);
    return b;
}
__device__ __forceinline__ void xcd_barrier_complete(unsigned* bar, unsigned x, unsigned& nloc, unsigned& nx) {
    const unsigned G = gridDim.x * gridDim.y * gridDim.z;
    unsigned sum, cnt, mine, sp = 0u;
    for (;;) {
        sum = 0u; cnt = 0u; mine = 0u;
#pragma unroll
        for (unsigned j = 0; j < 16; ++j) { const unsigned c = xb_ld(&bar[XB_XCNT(j)]); sum += c; cnt += (c > 0u) ? 1u : 0u; mine = (j == x) ? c : mine; }
        if (sum == G) break;
        __builtin_amdgcn_s_sleep(1);
        if ((++sp & 255u) == 0u) { if (xb_ld(&bar[XB_TMO])) break; if (sp > XB_SPIN_CAP) { atomicAdd(&bar[XB_TMO], 1u); break; } }
    }
    nloc = mine > 0u ? mine : 1u; nx = cnt > 0u ? cnt : 1u;
}

__device__ __forceinline__ void xcd_barrier(const XcdBarrier& b) {
    asm volatile("s_waitcnt vmcnt(0)" ::: "memory");
    __syncthreads();
    if (threadIdx.x == 0) {
        unsigned* bar = b.bar;
        __builtin_amdgcn_s_waitcnt(0);
        unsigned nloc = b.st[0], nx = b.st[1];
        if (nloc == 0u) { xcd_barrier_complete(bar, b.x, nloc, nx); b.st[0] = nloc; b.st[1] = nx; }
        const unsigned old = xb_add(&bar[XB_XSUB(b.x)], 1u);
        const unsigned gen = old / nloc;
        if (old + 1u == (gen + 1u) * nloc) {
            __builtin_amdgcn_fence(__ATOMIC_RELEASE, "agent");
            asm volatile("s_waitcnt vmcnt(0)" ::: "memory");
            const unsigned og = xb_add(&bar[XB_TOP], 1u);
            const unsigned tg = og / nx;
            if (og + 1u == (tg + 1u) * nx) xb_add(&bar[XB_TOPGEN], 1u);
            else XB_SPIN(xb_ld(&bar[XB_TOPGEN]) == tg, bar);
            __builtin_amdgcn_fence(__ATOMIC_ACQUIRE, "agent");
            xb_add(&bar[XB_XGEN(b.x)], 1u);
            asm volatile("s_waitcnt vmcnt(0)" ::: "memory");
        } else {
            XB_SPIN(xb_ld(&bar[XB_XGEN(b.x)]) == gen, bar);
            __builtin_amdgcn_fence(__ATOMIC_ACQUIRE, "agent");
            asm volatile("s_waitcnt vmcnt(0)" ::: "memory");
        }
    }
    __syncthreads();
}

constexpr size_t WS_RSSP = WS_RSS;
constexpr size_t WS_KMEAN2 = 230 * MiB;
constexpr size_t WS_DL = 230 * MiB + 256 * 1024;
constexpr size_t WS_YC = WS_MQ;
constexpr size_t WS_YA = WS_SR;
constexpr size_t WS_S2 = 232 * MiB;
constexpr size_t WS_END2 = 248 * MiB;


namespace mix {
typedef unsigned u32x4 __attribute__((ext_vector_type(4)));
typedef unsigned u32x2 __attribute__((ext_vector_type(2)));
#define MIX_LAS __attribute__((address_space(3)))
using pg8::pack8; using pg8::unpack8; using pg8::cvt_pk_bf16;
#define MIX_BAR() do { asm volatile("s_waitcnt vmcnt(0) lgkmcnt(0)" ::: "memory"); __builtin_amdgcn_s_barrier(); asm volatile("" ::: "memory"); } while (0)

__device__ __forceinline__ void prepass_item(unsigned char* ws, const float* qw, const float* kw, int b, int blk, int h, MIX_LAS float* part, int tid, int lane, int wave) {
    const int sub = lane >> 4, c8 = (lane & 15) * 8;
    f32x4 qw0 = *(const f32x4*)(qw + c8) * QSCALE, qw1 = *(const f32x4*)(qw + c8 + 4) * QSCALE; const f32x4 kw0 = *(const f32x4*)(kw + c8), kw1 = *(const f32x4*)(kw + c8 + 4);
    f32x4 cs0 = {0.f, 0.f, 0.f, 0.f}, cs1 = cs0;
    bf16_t* MQ = (bf16_t*)(ws + WS_MQ); bf16_t* MK = (bf16_t*)(ws + WS_MK);
#pragma unroll 4
    for (int it = 0; it < 8; ++it) {
        const size_t off = ((size_t)b * SEQ + blk * 256 + wave * 32 + it * 4 + sub) * 512 + h * 128 + c8;
        { f32x4 a, c; unpack8(*(const u32x4*)(MQ + off), a, c); float ss = ((a[0] * a[0] + a[1] * a[1]) + (a[2] * a[2] + a[3] * a[3])) + ((c[0] * c[0] + c[1] * c[1]) + (c[2] * c[2] + c[3] * c[3]));
          ss += __shfl_xor(ss, 1); ss += __shfl_xor(ss, 2); ss += __shfl_xor(ss, 4); ss += __shfl_xor(ss, 8); const float rs = rsqrtf(ss * (1.f / 128.f) + EPS);
          *(u32x4*)(MQ + off) = pack8(a * rs * qw0, c * rs * qw1); }
        { f32x4 a, c; unpack8(*(const u32x4*)(MK + off), a, c); float ss = ((a[0] * a[0] + a[1] * a[1]) + (a[2] * a[2] + a[3] * a[3])) + ((c[0] * c[0] + c[1] * c[1]) + (c[2] * c[2] + c[3] * c[3]));
          ss += __shfl_xor(ss, 1); ss += __shfl_xor(ss, 2); ss += __shfl_xor(ss, 4); ss += __shfl_xor(ss, 8); const float rs = rsqrtf(ss * (1.f / 128.f) + EPS);
          a = a * rs * kw0; c = c * rs * kw1; cs0 += a; cs1 += c; *(u32x4*)(MK + off) = pack8(a, c); }
    }
#pragma unroll
    for (int j = 0; j < 4; ++j) { cs0[j] += __shfl_xor(cs0[j], 16); cs0[j] += __shfl_xor(cs0[j], 32); cs1[j] += __shfl_xor(cs1[j], 16); cs1[j] += __shfl_xor(cs1[j], 32); }
    if (sub == 0) { *(MIX_LAS f32x4*)(part + wave * 128 + c8) = cs0; *(MIX_LAS f32x4*)(part + wave * 128 + c8 + 4) = cs1; }
    MIX_BAR();
    if (tid < 128) { float s = 0.f;
#pragma unroll
        for (int w = 0; w < 8; ++w) s += part[w * 128 + tid];
        ((float*)(ws + WS_KMEAN))[(((size_t)b * 4 + h) * 8 + blk) * 128 + tid] = s * (1.f / 256.f); }
    MIX_BAR();
}

constexpr int PSTR = 272;
__device__ __forceinline__ void pool_item(unsigned char* ws, const float* pscale, int pm, int g, MIX_LAS unsigned char* lds, int tid, int lane, int wave) {
    MIX_LAS unsigned char* P = lds; MIX_LAS unsigned char* W = lds + 256 * PSTR;
    const bf16_t* PW = (const bf16_t*)(ws + WS_W + W_PW) + g * 128 * 128;
#pragma unroll
    for (int j = 0; j < 4; ++j) { const int id = tid + 512 * j, e = id >> 4, cc = id & 15; *(MIX_LAS u32x4*)(W + e * PSTR + cc * 16) = *(const u32x4*)(PW + e * 128 + cc * 8); }
    {
        const int cp = tid & 63, seg = tid >> 6, w = 2 << g; const int row0 = pm * 256 + seg * 32, t0 = row0 & (SEQ - 1);
        const unsigned* PU = (const unsigned*)(ws + WS_PU) + g * 64 + cp;
        float s0 = 0.f, s1 = 0.f;
        for (int j = 1; j < w; ++j) if (t0 - j >= 0) { const unsigned v = PU[(size_t)(row0 - j) * 256]; s0 += __uint_as_float(v << 16); s1 += __uint_as_float(v & 0xffff0000u); }
#pragma unroll 8
        for (int r = 0; r < 32; ++r) {
            const int t = t0 + r; const unsigned v = PU[(size_t)(row0 + r) * 256]; const float u0 = __uint_as_float(v << 16), u1 = __uint_as_float(v & 0xffff0000u);
            s0 += u0; s1 += u1; const float ic = 1.f / (float)min(t + 1, w);
            *(MIX_LAS unsigned*)(P + (seg * 32 + r) * PSTR + cp * 4) = cvt_pk_bf16(s0 * ic - u0, s1 * ic - u1);
            if (t - w + 1 >= 0) { const unsigned o = PU[(size_t)(row0 + r - w + 1) * 256]; s0 -= __uint_as_float(o << 16); s1 -= __uint_as_float(o & 0xffff0000u); }
        }
    }
    MIX_BAR();
    f32x4 acc[8][2];
#pragma unroll
    for (int n = 0; n < 8; ++n) { acc[n][0] = (f32x4){0.f, 0.f, 0.f, 0.f}; acc[n][1] = acc[n][0]; }
    const int r = lane & 15, q = lane >> 4;
#pragma unroll
    for (int kk = 0; kk < 4; ++kk) {
        bf16x8 pf[2];
#pragma unroll
        for (int m = 0; m < 2; ++m) pf[m] = *(const MIX_LAS bf16x8*)(P + (wave * 32 + m * 16 + r) * PSTR + (kk * 32 + 8 * q) * 2);
#pragma unroll
        for (int n = 0; n < 8; ++n) { const bf16x8 wf = *(const MIX_LAS bf16x8*)(W + (n * 16 + r) * PSTR + (kk * 32 + 8 * q) * 2);
#pragma unroll
            for (int m = 0; m < 2; ++m) acc[n][m] = __builtin_amdgcn_mfma_f32_16x16x32_bf16(wf, pf[m], acc[n][m], 0, 0, 0); }
    }
    bf16_t* YB = (bf16_t*)(ws + WS_YB);
#pragma unroll
    for (int n = 0; n < 8; ++n) { const f32x4 sc = *(const f32x4*)(pscale + g * 128 + n * 16 + 4 * q);
#pragma unroll
        for (int m = 0; m < 2; ++m) { const f32x4 y = acc[n][m] * sc; u32x2 o; o.x = cvt_pk_bf16(y[0], y[1]); o.y = cvt_pk_bf16(y[2], y[3]);
            *(u32x2*)(YB + (size_t)(pm * 256 + wave * 32 + m * 16 + r) * 512 + g * 128 + n * 16 + 4 * q) = o; } }
    MIX_BAR();
}

constexpr int GSTR = 144;
constexpr int GL_SEG = 0, GL_QE = 2048, GL_KE = GL_QE + 64 * GSTR, GL_VT = GL_KE + 64 * GSTR, GL_P = GL_VT + 128 * GSTR, GL_RED = GL_P + 64 * GSTR;
__device__ __forceinline__ void gla_cumsum(const float* GG, size_t row0, int h, MIX_LAS unsigned char* lds, int d, int seg, float (&bc)[8], float& bL) {
    const float* g = GG + (row0 + seg * 8) * 256 + h * 64 + d; float c = 0.f;
#pragma unroll
    for (int j = 0; j < 8; ++j) { c += g[j * 256]; bc[j] = c; }
    MIX_LAS float* SEG = (MIX_LAS float*)(lds + GL_SEG); SEG[seg * 64 + d] = c;
    MIX_BAR();
    float off = 0.f, tot = 0.f;
#pragma unroll
    for (int s = 0; s < 8; ++s) { const float v = SEG[s * 64 + d]; tot += v; off += (s < seg) ? v : 0.f; }
#pragma unroll
    for (int j = 0; j < 8; ++j) bc[j] += off;
    bL = tot;
}
__device__ __forceinline__ void gla_vt(const bf16_t* GV, size_t row0, int h, MIX_LAS unsigned char* lds, int tid) {
    const int e = tid & 127, tq = tid >> 7; const bf16_t* v = GV + (row0 + tq * 16) * 512 + h * 128 + e; unsigned w[8];
#pragma unroll
    for (int j = 0; j < 8; ++j) w[j] = (unsigned)v[(2 * j) * 512] | ((unsigned)v[(2 * j + 1) * 512] << 16);
    MIX_LAS u32x4* p = (MIX_LAS u32x4*)(lds + GL_VT + e * GSTR + tq * 32); p[0] = (u32x4){w[0], w[1], w[2], w[3]}; p[1] = (u32x4){w[4], w[5], w[6], w[7]};
}
__device__ __forceinline__ void gla_passA_item(unsigned char* ws, int cid, MIX_LAS unsigned char* lds, int tid, int lane, int wave) {
    const int d = tid & 63, seg = tid >> 6, bh = cid >> 5, n = cid & 31, b = bh >> 2, h = bh & 3; const size_t row0 = (size_t)b * SEQ + n * 64;
    float bc[8], bL;
    const bf16_t* gk = (const bf16_t*)(ws + WS_GK) + (row0 + seg * 8) * 256 + h * 64 + d; float kv[8];
#pragma unroll
    for (int j = 0; j < 8; ++j) kv[j] = bf2f(gk[j * 256]);
    gla_vt((const bf16_t*)(ws + WS_GV), row0, h, lds, tid);
    gla_cumsum((const float*)(ws + WS_GG), row0, h, lds, d, seg, bc, bL);
    { f32x4 a, c;
#pragma unroll
      for (int j = 0; j < 4; ++j) { a[j] = kv[j] * __expf(bL - bc[j]); c[j] = kv[4 + j] * __expf(bL - bc[4 + j]); }
      *(MIX_LAS u32x4*)(lds + GL_KE + d * GSTR + seg * 16) = pack8(a, c); }
    if (seg == 0) ((float*)(ws + WS_DL))[(size_t)cid * 64 + d] = __expf(bL);
    MIX_BAR();
    const int r = lane & 15, q = lane >> 4; f32x4 acc[4];
#pragma unroll
    for (int dt = 0; dt < 4; ++dt) acc[dt] = (f32x4){0.f, 0.f, 0.f, 0.f};
#pragma unroll
    for (int kk = 0; kk < 2; ++kk) { const bf16x8 vf = *(const MIX_LAS bf16x8*)(lds + GL_VT + (wave * 16 + r) * GSTR + (kk * 32 + 8 * q) * 2);
#pragma unroll
        for (int dt = 0; dt < 4; ++dt) { const bf16x8 kf = *(const MIX_LAS bf16x8*)(lds + GL_KE + (dt * 16 + r) * GSTR + (kk * 32 + 8 * q) * 2);
            acc[dt] = __builtin_amdgcn_mfma_f32_16x16x32_bf16(kf, vf, acc[dt], 0, 0, 0); } }
    bf16_t* US = (bf16_t*)(ws + WS_US) + ((size_t)cid * 128 + wave * 16 + r) * 64;
#pragma unroll
    for (int dt = 0; dt < 4; ++dt) { u32x2 o; o.x = cvt_pk_bf16(acc[dt][0], acc[dt][1]); o.y = cvt_pk_bf16(acc[dt][2], acc[dt][3]); *(u32x2*)(US + dt * 16 + 4 * q) = o; }
    MIX_BAR();
}
__device__ __forceinline__ void gla_scan(unsigned char* ws, int gtid) {
    const int bh = gtid >> 12, e = (gtid >> 5) & 127, dp = gtid & 31;
    const size_t uoff = (((size_t)bh * 32) * 128 + e) * 32 + dp; const unsigned* US = (const unsigned*)(ws + WS_US) + uoff; unsigned* S2 = (unsigned*)(ws + WS_S2) + uoff; const float* DLp = (const float*)(ws + WS_DL) + (size_t)bh * 32 * 64 + 2 * dp;
    float s0 = 0.f, s1 = 0.f;
#pragma unroll 8
    for (int n = 0; n < 32; ++n) { const unsigned u = US[(size_t)n * 128 * 32]; const float d0 = DLp[n * 64], d1 = DLp[n * 64 + 1];
        S2[(size_t)n * 128 * 32] = cvt_pk_bf16(s0, s1);
        s0 = d0 * s0 + __uint_as_float(u << 16); s1 = d1 * s1 + __uint_as_float(u & 0xffff0000u); }
}
__device__ __forceinline__ void gla_passC_item(unsigned char* ws, const float* nw, int cid, MIX_LAS unsigned char* lds, int tid, int lane, int wave, size_t ya_off) {
    const int d = tid & 63, seg = tid >> 6, bh = cid >> 5, n = cid & 31, b = bh >> 2, h = bh & 3; const size_t row0 = (size_t)b * SEQ + n * 64;
    float bc[8], bL;
    const bf16_t* gk = (const bf16_t*)(ws + WS_GK) + (row0 + seg * 8) * 256 + h * 64 + d; const bf16_t* gq = (const bf16_t*)(ws + WS_GQ) + (row0 + seg * 8) * 256 + h * 64 + d; float kv[8], qv[8];
#pragma unroll
    for (int j = 0; j < 8; ++j) { kv[j] = bf2f(gk[j * 256]); qv[j] = bf2f(gq[j * 256]); }
    const int r = lane & 15, q = lane >> 4, it2 = wave & 3, eh = wave >> 2;
    bf16x8 sfr[4][2]; { const bf16_t* ST = (const bf16_t*)(ws + WS_S2) + (size_t)cid * 128 * 64;
#pragma unroll
        for (int nn = 0; nn < 4; ++nn)
#pragma unroll
            for (int kk = 0; kk < 2; ++kk) sfr[nn][kk] = *(const bf16x8*)(ST + ((eh * 4 + nn) * 16 + r) * 64 + kk * 32 + 8 * q); }
    const size_t yoff = (row0 + it2 * 16 + r) * 512 + h * 128 + eh * 64 + 4 * q; u32x2 srv[4];
#pragma unroll
    for (int nn = 0; nn < 4; ++nn) srv[nn] = *(const u32x2*)((const bf16_t*)(ws + WS_SR) + yoff + nn * 16);
    gla_vt((const bf16_t*)(ws + WS_GV), row0, h, lds, tid);
    gla_cumsum((const float*)(ws + WS_GG), row0, h, lds, d, seg, bc, bL);
#pragma unroll
    for (int j = 0; j < 8; ++j) { const float ex = __expf(bc[j]);
        *(MIX_LAS bf16_t*)(lds + GL_QE + (seg * 8 + j) * GSTR + 2 * d) = f2bf(qv[j] * ex);
        *(MIX_LAS bf16_t*)(lds + GL_KE + (seg * 8 + j) * GSTR + 2 * d) = f2bf(kv[j] * __expf(-bc[j])); }
    MIX_BAR();
    {
        const int it = wave >> 1;
#pragma unroll
        for (int jj = 0; jj < 2; ++jj) { const int jt = 2 * (wave & 1) + jj; f32x4 acc = {0.f, 0.f, 0.f, 0.f};
            if (jt <= it) {
#pragma unroll
                for (int kk = 0; kk < 2; ++kk) { const bf16x8 qf = *(const MIX_LAS bf16x8*)(lds + GL_QE + (it * 16 + r) * GSTR + (kk * 32 + 8 * q) * 2);
                    const bf16x8 kf = *(const MIX_LAS bf16x8*)(lds + GL_KE + (jt * 16 + r) * GSTR + (kk * 32 + 8 * q) * 2);
                    acc = __builtin_amdgcn_mfma_f32_16x16x32_bf16(qf, kf, acc, 0, 0, 0); }
                if (jt == it) {
#pragma unroll
                    for (int x = 0; x < 4; ++x) if (r > 4 * q + x) acc[x] = 0.f; } }
#pragma unroll
            for (int x = 0; x < 4; ++x) *(MIX_LAS bf16_t*)(lds + GL_P + (it * 16 + 4 * q + x) * GSTR + (jt * 16 + r) * 2) = f2bf(acc[x]); }
    }
    MIX_BAR();
    const int it = it2; f32x4 acc[4];
    {
        bf16x8 pf[2], qf[2];
#pragma unroll
        for (int kk = 0; kk < 2; ++kk) { pf[kk] = *(const MIX_LAS bf16x8*)(lds + GL_P + (it * 16 + r) * GSTR + (kk * 32 + 8 * q) * 2); qf[kk] = *(const MIX_LAS bf16x8*)(lds + GL_QE + (it * 16 + r) * GSTR + (kk * 32 + 8 * q) * 2); }
#pragma unroll
        for (int nn = 0; nn < 4; ++nn) { const int et = eh * 4 + nn; acc[nn] = (f32x4){0.f, 0.f, 0.f, 0.f};
#pragma unroll
            for (int kk = 0; kk < 2; ++kk) { const bf16x8 vf = *(const MIX_LAS bf16x8*)(lds + GL_VT + (et * 16 + r) * GSTR + (kk * 32 + 8 * q) * 2);
                const bf16x8 sf = sfr[nn][kk];
                acc[nn] = __builtin_amdgcn_mfma_f32_16x16x32_bf16(vf, pf[kk], acc[nn], 0, 0, 0);
                acc[nn] = __builtin_amdgcn_mfma_f32_16x16x32_bf16(sf, qf[kk], acc[nn], 0, 0, 0); } }
    }
    float ss = 0.f;
#pragma unroll
    for (int nn = 0; nn < 4; ++nn) ss += (acc[nn][0] * acc[nn][0] + acc[nn][1] * acc[nn][1]) + (acc[nn][2] * acc[nn][2] + acc[nn][3] * acc[nn][3]);
    ss += __shfl_xor(ss, 16); ss += __shfl_xor(ss, 32);
    MIX_LAS float* RED = (MIX_LAS float*)(lds + GL_RED);
    if (q == 0) RED[eh * 64 + it * 16 + r] = ss;
    MIX_BAR();
    const float rstd = rsqrtf((RED[it * 16 + r] + RED[64 + it * 16 + r]) * (1.f / 128.f) + EPS);
    bf16_t* YA = (bf16_t*)(ws + ya_off) + yoff;
#pragma unroll
    for (int nn = 0; nn < 4; ++nn) { const u32x2 sr = srv[nn]; const f32x4 w4 = *(const f32x4*)(nw + eh * 64 + nn * 16 + 4 * q);
        const float y0 = acc[nn][0] * rstd * w4[0] * __uint_as_float(sr.x << 16), y1 = acc[nn][1] * rstd * w4[1] * __uint_as_float(sr.x & 0xffff0000u);
        const float y2 = acc[nn][2] * rstd * w4[2] * __uint_as_float(sr.y << 16), y3 = acc[nn][3] * rstd * w4[3] * __uint_as_float(sr.y & 0xffff0000u);
        u32x2 o; o.x = cvt_pk_bf16(y0, y1); o.y = cvt_pk_bf16(y2, y3); *(u32x2*)(YA + nn * 16) = o; }
    MIX_BAR();
}
}

namespace moba {
typedef short s16x4 __attribute__((ext_vector_type(4)));
typedef float f32x16 __attribute__((ext_vector_type(16)));
typedef unsigned u32x4 __attribute__((ext_vector_type(4)));
using pg8::cvt_pk_bf16;
constexpr int D = 128, LD = 512, NW = 8, QBLK = 32, KVBLK = 64, QB = 256;
constexpr int SHM_V = KVBLK * D * 2, SHM_K = KVBLK * D * 2;
constexpr int LDS_WS = 2 * SHM_V + 2 * SHM_K, LDS_TAB = LDS_WS + NW * 64 * 4, LDS_BYTES = LDS_TAB + 512;
constexpr float THR2 = 11.5f;
#define KSWZ(row, colB) ((row) * 256 + ((colB) ^ (((row) & 7) << 4)))
#define SBAR() __builtin_amdgcn_sched_barrier(0)
__device__ __forceinline__ int v_st(int k, int c) { const int kk = (k & ~0xC) | ((k & 4) << 1) | ((k & 8) >> 1); return ((kk >> 3) * 4 + (c >> 5)) * 512 + ((kk & 7) * 32 + (c & 31)) * 2; }
__device__ __forceinline__ int v_rd_base(int lane) { return ((lane & 3) << 3) | (((lane >> 2) & 3) << 6) | (((lane >> 4) & 1) << 5) | (((lane >> 5) & 1) << 8); }
constexpr int v_rd_off(int d0, int ks, int half) { return d0 * 512 + ks * 4096 + half * 2048; }
__device__ __forceinline__ int crow(int r, int hi) { return (r & 3) + 8 * (r >> 2) + 4 * hi; }
__device__ __forceinline__ bf16x8 load8(const bf16_t* p) { return *reinterpret_cast<const bf16x8*>(p); }

__device__ __forceinline__ void partialSM(f32x16& p, float& m_reg, float& mn, float& alpha) {
    float pmax = p[0];
#pragma unroll
    for (int r = 1; r < 16; ++r) pmax = fmaxf(pmax, p[r]);
    { auto rr = __builtin_amdgcn_permlane32_swap(__float_as_uint(pmax), __float_as_uint(pmax), false, false); pmax = fmaxf(__uint_as_float(rr[0]), __uint_as_float(rr[1])); }
    if (__builtin_expect(__all((pmax - m_reg) <= THR2), 1)) { mn = m_reg; alpha = 1.f; }
    else { mn = fmaxf(m_reg, pmax); alpha = __builtin_amdgcn_exp2f(m_reg - mn); m_reg = mn; }
#pragma unroll
    for (int r = 0; r < 16; ++r) p[r] = p[r] - mn;
#pragma unroll
    for (int r = 0; r < 8; ++r) p[r] = __builtin_amdgcn_exp2f(p[r]);
}
__device__ __forceinline__ void finishSM(f32x16& p, float alpha, float& l_reg, bf16x8& pa0, bf16x8& pa1) {
#pragma unroll
    for (int r = 8; r < 16; ++r) p[r] = __builtin_amdgcn_exp2f(p[r]);
    float ps = 0;
#pragma unroll
    for (int r = 0; r < 16; ++r) ps += p[r];
    { auto rr = __builtin_amdgcn_permlane32_swap(__float_as_uint(ps), __float_as_uint(ps), false, false); ps = __uint_as_float(rr[0]) + __uint_as_float(rr[1]); }
    l_reg = l_reg * alpha + ps;
#define PK4(P, B_, OUT) do { unsigned a0 = cvt_pk_bf16(P[B_+0], P[B_+1]), a1 = cvt_pk_bf16(P[B_+2], P[B_+3]);                          \
        unsigned b0 = cvt_pk_bf16(P[B_+4], P[B_+5]), b1 = cvt_pk_bf16(P[B_+6], P[B_+7]);                                             \
        auto r0 = __builtin_amdgcn_permlane32_swap(a0, b0, false, false); auto r1 = __builtin_amdgcn_permlane32_swap(a1, b1, false, false); \
        u32x4 w = {r0[0], r1[0], r0[1], r1[1]}; OUT = *reinterpret_cast<bf16x8*>(&w); } while (0)
    PK4(p, 0, pa0); PK4(p, 8, pa1);
#undef PK4
}
template <int KB>
__device__ __forceinline__ void qkt(f32x16& p, const char* K_lds, int krow, int hi, const bf16x8* qr, bool act) {
    if (!act) { const float NEG = -__builtin_inff();
#pragma unroll
        for (int r = 0; r < 16; ++r) p[r] = NEG;
        return; }
    p = f32x16{};
    const char* kb[4];
#pragma unroll
    for (int dd = 0; dd < 4; ++dd) kb[dd] = K_lds + KB * SHM_K + KSWZ(krow, (dd * 16 + hi * 8) * 2);
#pragma unroll
    for (int d0 = 0; d0 < 8; ++d0) { const char* a = kb[d0 & 3] + (d0 >> 2) * 128;
        const bf16x8 b0 = *reinterpret_cast<const bf16x8*>(a);
        p = __builtin_amdgcn_mfma_f32_32x32x16_bf16(b0, qr[d0], p, 0, 0, 0); }
}
template <int VB>
__device__ __forceinline__ void pv_tile(f32x16* o, int vb0, bf16x8 pa0, bf16x8 pa1, bool act) {
    if (!act) return;
#define TRRD(dst, off) asm volatile("ds_read_b64_tr_b16 %0, %1 offset:%2" : "=&v"(dst) : "v"(vb0), "i"(off) : "memory")
#define PV_D0(d0) do { s16x4 l0, l1, h0, h1; constexpr int b_ = VB * SHM_V + v_rd_off(d0, 0, 0); \
        TRRD(l0, b_); TRRD(h0, b_ + 2048); TRRD(l1, b_ + 4096); TRRD(h1, b_ + 6144); \
        asm volatile("s_waitcnt lgkmcnt(0)" ::: "memory"); SBAR();   \
        o[d0] = __builtin_amdgcn_mfma_f32_32x32x16_bf16(pa0, (bf16x8){l0[0], l0[1], l0[2], l0[3], h0[0], h0[1], h0[2], h0[3]}, o[d0], 0, 0, 0);   \
        o[d0] = __builtin_amdgcn_mfma_f32_32x32x16_bf16(pa1, (bf16x8){l1[0], l1[1], l1[2], l1[3], h1[0], h1[1], h1[2], h1[3]}, o[d0], 0, 0, 0); } while (0)
    PV_D0(0); PV_D0(1); PV_D0(2); PV_D0(3);
#undef PV_D0
#undef TRRD
}
__device__ __forceinline__ void mask_bias_tile(f32x16& p, int dq, const float* tab) {
    const float NEG = -__builtin_inff();
#pragma unroll
    for (int r = 0; r < 16; ++r) { const int c = (r & 3) + 8 * (r >> 2); const int d0 = dq - c; p[r] = d0 < 0 ? NEG : p[r] + tab[d0 > 113 ? 113 : d0]; }
}
__device__ __forceinline__ void bias_tile(f32x16& p, int dq, const float* tab) {
#pragma unroll
    for (int r = 0; r < 16; ++r) { const int c = (r & 3) + 8 * (r >> 2); const int d0 = dq - c; p[r] += tab[d0 > 113 ? 113 : d0]; }
}
__device__ __forceinline__ void kill_tile(f32x16& p, bool ok) {
    const float NEG = -__builtin_inff();
#pragma unroll
    for (int r = 0; r < 16; ++r) p[r] = ok ? p[r] : NEG;
}

struct BlockRef { const bf16_t* Q; const bf16_t* K; const bf16_t* V; bf16_t* O; const float* km; int P0; };
struct Seam { bf16x8 qr[8]; bf16x8 st_v0, st_v1, st_k0, st_k1; };
#define ROW(p, k0, rr) ((p) + (size_t)((k0) + (rr)) * LD + sc)
#define VMW() asm volatile("s_waitcnt vmcnt(0)" ::: "memory")
#define SLOAD_H(Kp, Vp, k0) do { S.st_v0 = load8(ROW(Vp, k0, sr)); S.st_v1 = load8(ROW(Vp, k0, 32 + sr)); S.st_k0 = load8(ROW(Kp, k0, sr)); S.st_k1 = load8(ROW(Kp, k0, 32 + sr)); } while (0)
#define SWRITE_HK(bf) do { *(bf16x8*)(K_lds + (bf) * SHM_K + kws) = S.st_k0; *(bf16x8*)(K_lds + (bf) * SHM_K + kws + 32 * 256) = S.st_k1; } while (0)
#define SWRITE_HV(bf) do { *(bf16x8*)(V_lds + (bf) * SHM_V + vst0) = S.st_v0; *(bf16x8*)(V_lds + (bf) * SHM_V + vst1) = S.st_v1; } while (0)
#define SWRITE_H(bf) do { SWRITE_HV(bf); SWRITE_HK(bf); } while (0)
__device__ __forceinline__ void prime(const BlockRef& cur, const float* rel_bias, int h, char* lds, Seam& S, int tid) {
    const int wid = __builtin_amdgcn_readfirstlane(tid >> 6), lane = tid & 63, r32 = lane & 31, hi = lane >> 5, rg = wid & 3;
    const int sr = tid >> 4, sc = (tid & 15) * 8, kws = KSWZ(sr, sc * 2); char* K_lds = lds + 2 * SHM_V;
    __syncthreads();
    if (tid < 128) { int bk = tid; if (tid >= 16) { bk = 16 + (int)(__logf((float)tid * (1.f / 16.f)) * (16.f / 2.0794415416798357f)); bk = bk > 31 ? 31 : bk; }
        ((float*)(lds + LDS_TAB))[tid] = tid >= 113 ? 0.f : (rel_bias[bk * 4 + h] - rel_bias[31 * 4 + h]) * LOG2E; }
#pragma unroll
    for (int d0 = 0; d0 < 8; ++d0) S.qr[d0] = load8(cur.Q + (size_t)(rg * QBLK + r32) * LD + d0 * 16 + hi * 8);
    SLOAD_H(cur.K, cur.V, 0); VMW(); SWRITE_HK(0);
    __syncthreads();
}
__device__ __forceinline__ void block(const BlockRef& cur, char* lds, Seam& S, int tid) {
    const int wid = __builtin_amdgcn_readfirstlane(tid >> 6), lane = tid & 63, r32 = lane & 31, hi = lane >> 5, rg = wid & 3, kh = wid >> 2;
    const int qblk = cur.P0 >> 8, NT = 4 * qblk + 2 + 2 * ((cur.P0 >> 7) & 1);
    const int qlo = cur.P0 + rg * QBLK, qm = qlo + r32 - 4 * hi - 32 * kh;
    char* V_lds = lds; char* K_lds = lds + 2 * SHM_V;
    float* ws = (float*)(lds + LDS_WS) + wid * 64; float* li_l = ws, * al_l = ws + 32; const float* tab = (const float*)(lds + LDS_TAB);
    float m_reg = -1e30f, l_reg = 0; f32x16 o[4] = {};
    const int sr = tid >> 4, sc = (tid & 15) * 8, vst0 = v_st(sr, sc), vst1 = v_st(32 + sr, sc), kws = KSWZ(sr, sc * 2);
    const int vb0 = (int)(uintptr_t)V_lds + v_rd_base(lane) + kh * 8192, krow = r32 + 32 * kh;
    const bf16_t* Kh = cur.K; const bf16_t* Vh = cur.V;
    unsigned sel = (1u << qblk) - 1u;
    if (qblk > 3) {
        float s[7];
#pragma unroll
        for (int n = 0; n < 7; ++n) { s[n] = -__builtin_inff();
            if (n < qblk) { float a = 0.f; const float* kmn = cur.km + n * 128 + hi * 8;
#pragma unroll
                for (int d0 = 0; d0 < 8; ++d0) { const f32x4 k0 = *(const f32x4*)(kmn + d0 * 16), k1 = *(const f32x4*)(kmn + d0 * 16 + 4); const bf16x8 qv = S.qr[d0];
#pragma unroll
                    for (int j = 0; j < 4; ++j) { a += __uint_as_float(((unsigned)(unsigned short)qv[j]) << 16) * k0[j]; a += __uint_as_float(((unsigned)(unsigned short)qv[4 + j]) << 16) * k1[j]; } }
                s[n] = a + __shfl_xor(a, 32); } }
        sel = 0u;
#pragma unroll
        for (int c = 0; c < 3; ++c) { float best = -__builtin_inff(); int bi = 0;
#pragma unroll
            for (int n = 0; n < 7; ++n) if (s[n] > best) { best = s[n]; bi = n; }
            sel |= 1u << bi;
#pragma unroll
            for (int n = 0; n < 7; ++n) s[n] = (n == bi) ? -__builtin_inff() : s[n]; }
    }
#define RESC(a) do { if (__any((a) < 1.f)) { if (hi == 0) al_l[r32] = (a); asm volatile("s_waitcnt lgkmcnt(0)" ::: "memory");              \
                     for (int d_ = 0; d_ < 4; ++d_) for (int r = 0; r < 16; ++r) o[d_][r] *= al_l[crow(r, hi)]; } } while (0)
#define KBASE(t) ((t) * KVBLK)
#define ACT(t) ((KBASE(t) >> 8) < qblk ? (__any((sel >> (KBASE(t) >> 8)) & 1u) != 0) : (KBASE(t) + 32 * kh <= qlo + QBLK - 1))
#define MASKT(P_, t) do { const int kb_ = KBASE(t); if (ACT(t)) { if ((kb_ >> 8) < qblk) { if (kb_ + 176 > qlo) bias_tile(P_, qm - kb_, tab); kill_tile(P_, ((sel >> (kb_ >> 8)) & 1u) != 0u); } \
                                     else mask_bias_tile(P_, qm - kb_, tab); } } while (0)
    f32x16 pA, pB; float mnA, mnB, alA, alB; bf16x8 pa0, pa1;
    SWRITE_HV(0); SBAR();
    SLOAD_H(Kh, Vh, KBASE(1));
    SBAR(); qkt<0>(pA, K_lds, krow, hi, S.qr, ACT(0));
    MASKT(pA, 0); partialSM(pA, m_reg, mnA, alA);
    VMW(); SWRITE_H(1); SBAR(); SLOAD_H(Kh, Vh, KBASE(2)); SBAR();
    __syncthreads();
#define HALF_STEP(PX, mnX, alX, PY, alY, t, KB, VB, SB) do {                                                      \
        SBAR(); qkt<KB>(PX, K_lds, krow, hi, S.qr, ACT(t));                                                          \
        finishSM(PY, alY, l_reg, pa0, pa1); SBAR();                                                           \
        pv_tile<VB>(o, vb0, pa0, pa1, ACT((t) - 1)); MASKT(PX, (t)); partialSM(PX, m_reg, mnX, alX);    \
        __syncthreads();                                                                                                      \
        if ((t) + 1 < NT) { VMW(); SWRITE_H(SB); SBAR(); if ((t) + 2 < NT) { SLOAD_H(Kh, Vh, KBASE((t) + 2)); } SBAR(); }          \
        RESC(alX); __syncthreads(); } while (0)
    for (int t = 1; t + 1 < NT; t += 2) {
        HALF_STEP(pB, mnB, alB, pA, alA, t, 1, 0, 0);
        HALF_STEP(pA, mnA, alA, pB, alB, t + 1, 0, 1, 1);
    }
    SBAR(); qkt<1>(pB, K_lds, krow, hi, S.qr, ACT(NT - 1)); SBAR();
    finishSM(pA, alA, l_reg, pa0, pa1); SBAR();
    pv_tile<0>(o, vb0, pa0, pa1, ACT(NT - 2));
    MASKT(pB, NT - 1); partialSM(pB, m_reg, mnB, alB); __syncthreads(); RESC(alB);
    finishSM(pB, alB, l_reg, pa0, pa1); SBAR(); pv_tile<1>(o, vb0, pa0, pa1, ACT(NT - 1));
    __syncthreads();
    float* mls = (float*)(lds + LDS_WS) + (rg + 4) * 64;
    float* osh = (float*)lds + (size_t)rg * 64 * 64;
    if (kh == 1) { if (hi == 0) { mls[r32] = m_reg; mls[32 + r32] = l_reg; }
#pragma unroll
        for (int d0 = 0; d0 < 4; ++d0)
#pragma unroll
            for (int r = 0; r < 16; ++r) osh[(d0 * 16 + r) * 64 + lane] = o[d0][r]; }
    __syncthreads();
    if (kh == 0) {
        const float m1 = mls[r32], l1 = mls[32 + r32]; const float mm = fmaxf(m_reg, m1); const float a0 = __builtin_amdgcn_exp2f(m_reg - mm), a1 = __builtin_amdgcn_exp2f(m1 - mm);
        const float il = __builtin_amdgcn_rcpf(l_reg * a0 + l1 * a1);
        if (hi == 0) { li_l[r32] = a0 * il; al_l[r32] = a1 * il; } asm volatile("s_waitcnt lgkmcnt(0)" ::: "memory");
        bf16_t* Ow = cur.O + (size_t)(rg * QBLK) * LD;
#pragma unroll
        for (int r = 0; r < 16; ++r) { const int orow = crow(r, hi); const float f0 = li_l[orow], f1 = al_l[orow];
#pragma unroll
            for (int d0 = 0; d0 < 4; ++d0) { const float v = o[d0][r] * f0 + osh[(d0 * 16 + r) * 64 + lane] * f1; const float vn = __shfl_xor(v, 1);
                if ((r32 & 1) == 0) *(unsigned*)(Ow + (size_t)orow * LD + d0 * 32 + r32) = cvt_pk_bf16(v, vn); } }
    }
#undef RESC
#undef KBASE
#undef ACT
#undef MASKT
#undef HALF_STEP
}
#undef ROW
#undef VMW
#undef SLOAD_H
#undef SWRITE_HK
#undef SWRITE_HV
#undef SWRITE_H
#undef KSWZ
#undef SBAR
}

constexpr int PH_PREP = 0, PH_IN1 = 1, PH_MIX1 = 2, PH_MIX2 = 3, PH_MIX3 = 4, PH_GATES = 5, PH_UPM = 6, PH_OUT = 7, PH_FFN = 8, PH_DOWN = 9, PH_PER_LAYER = 10;
#ifndef PROBE_K
#define PROBE_K -1
#define PROBE_L 0
#define PROBE_N 1
#define PROBE_SUB 15
#endif
struct Args { Inputs in; float* out; unsigned char* ws; int ph_lo, ph_hi, li, mixmask; };

__device__ __forceinline__ void fill_rstd(LAS float* tab, const float* rssp, int bx, int tid) {
#pragma unroll
    for (int j = 0; j < 4; ++j) { const int r = tid + 512 * j; const f32x4* p = (const f32x4*)(rssp + ((size_t)(bx & 7) * 2048 + r) * 16);
        const f32x4 a = p[0], b = p[1], c = p[2], d = p[3]; const f32x4 s = (a + b) + (c + d);
        tab[r] = rsqrtf(((s[0] + s[1]) + (s[2] + s[3])) * (1.f / D) + EPS); }
    __syncthreads();
}
__device__ __forceinline__ int fresh_tid(int wave0) { int ln; asm volatile("v_mbcnt_lo_u32_b32 %0, -1, 0\n\tv_mbcnt_hi_u32_b32 %0, -1, %0" : "=v"(ln)); return wave0 * 64 + ln; }
__global__ void __launch_bounds__(NWAVES * 64, 2) mega_fwd(Args args) {
    extern __shared__ __attribute__((aligned(16))) unsigned char lds[];
    LAS unsigned char* ldsp = (LAS unsigned char*)lds;
    volatile LAS unsigned* MISC = (volatile LAS unsigned*)(ldsp + MISC_OFF);
    const int tid = threadIdx.x; const int wave0 = __builtin_amdgcn_readfirstlane(tid >> 6);
    const int G = gridDim.x; const int bx = blockIdx.x; const int vcu = (G % 8 == 0) ? (bx % 8) * (G / 8) + bx / 8 : bx;
    unsigned char* ws = args.ws;
    float* out = args.out;
    for (int u = tid; u < (LDS_BYTES - LDSCTL_OFF) / 4; u += NWAVES * 64) ((LAS unsigned*)(ldsp + LDSCTL_OFF))[u] = 0u;
    __syncthreads();
    XcdBarrier bar = xcd_barrier_post((unsigned*)(ws + WS_CTL) + CW_BAR + args.li * XCD_BAR_WORDS, MISC + 8);
    const int NGW = G * NWAVES;

    unsigned char* const ws0 = ws; float* const out0 = out; const int bx0 = bx;
    for (int ph = args.ph_lo; ph < args.ph_hi; ++ph) {
        const int l = ph / PH_PER_LAYER, k = ph % PH_PER_LAYER;
        size_t zoff = 0; int bx = bx0; asm volatile("" : "+s"(zoff), "+s"(bx)); unsigned char* ws = ws0 + zoff; float* out = out0 + zoff;
#define KARG(i) (*(const float* const __attribute__((address_space(4)))*)((const __attribute__((address_space(4))) char*)__builtin_amdgcn_kernarg_segment_ptr() + 8 * (i) + zoff))
#define LOAD_INPUTS(v) const __attribute__((address_space(4))) Inputs* v = (const __attribute__((address_space(4))) Inputs*)((const __attribute__((address_space(4))) char*)__builtin_amdgcn_kernarg_segment_ptr() + zoff)
        float* rssp = (float*)(ws + WS_RSSP);
        const int nrep = (k == PROBE_K && l == PROBE_L) ? PROBE_N : 1;
        for (int rep = 0; rep < nrep; ++rep) {
        const int mmask = rep == 0 ? args.mixmask : (args.mixmask & PROBE_SUB); const bool stf = (rep + 1 == nrep);
        if (k == PH_PREP) {
            const int tidl = fresh_tid(wave0), lane = tidl & 63, wave = wave0, gw = vcu * NWAVES + wave;
            LOAD_INPUTS(in);
            float* scr = (float*)(lds + wave * 16384);
            for (int it = gw; it < PREP_ITEMS; it += NGW) prep_item(in, l, ws + WS_W, it, scr, lane);
            if (l == 0) {
                for (int row = gw; row < M; row += NGW) {
                    const f32x4* xr = (const f32x4*)(in->x + (size_t)row * D) + lane; float s = 0.f;
                    unsigned long long* o8 = (unsigned long long*)((bf16_t*)(ws + WS_XB) + (size_t)row * D) + lane;
#pragma unroll
                    for (int j = 0; j < 4; ++j) { const f32x4 v = xr[64 * j]; s += (v.x * v.x + v.y * v.y) + (v.z * v.z + v.w * v.w);
                        o8[64 * j] = (unsigned long long)pk2(v.x, v.y) | ((unsigned long long)pk2(v.z, v.w) << 32); }
                    s = wave_sum(s); if (lane < 16) rssp[(size_t)row * 16 + lane] = (lane == 0) ? s : 0.f;
                }
            }
        } else if (k == PH_IN1) {
            const int tidl = fresh_tid(wave0);
            pg8::Gemm g{(const bf16_t*)(ws + WS_XB), (const bf16_t*)(ws + WS_W + W_IN), M, NIN1, D}; pg8::StaticOrder S; S.init(M, NIN1, G, bx);
            fill_rstd((LAS float*)(ldsp + RSTD_OFF), rssp, bx, tidl);
            pg8::EpiIn1 E{ws, (const LAS float*)(ldsp + RSTD_OFF), KARG(4) + l * 256};
            pg8::gemm_phase<pg8::EpiIn1, pg8::StaticOrder, true, true>(ldsp, g, S, E, tidl);
        } else if (k == PH_MIX1) {
            const int tidl = fresh_tid(wave0), lane = tidl & 63, wave = wave0;
            if (mmask & 2) for (int it = vcu; it < 256; it += G) mix::prepass_item(ws, KARG(8) + l * 128, KARG(9) + l * 128, it >> 5, (it >> 2) & 7, it & 3, (LAS float*)ldsp, tidl, lane, wave);
            if (mmask & 1) for (int it = vcu; it < 256; it += G) mix::pool_item(ws, KARG(7) + l * 512, it >> 2, it & 3, ldsp, tidl, lane, wave);
            if (mmask & 4) for (int it = vcu; it < 1024; it += G) mix::gla_passA_item(ws, it, ldsp, tidl, lane, wave);
        } else if (k == PH_MIX2) {
            const int tidl = fresh_tid(wave0);
            if (mmask & 4) for (int g0 = vcu * 512 + tidl; g0 < 32 * 4096; g0 += G * 512) mix::gla_scan(ws, g0);
            if (mmask & 8) for (int pr = vcu; pr < 256; pr += G) {
                const int bh = pr >> 3, b = bh >> 2, h = bh & 3, rh = pr & 1, a = (pr >> 1) & 3; const size_t r0 = (size_t)b * SEQ * 512 + h * 128;
#pragma unroll 1
                for (int half = 0; half < 2; ++half) { const int qb = half == 0 ? 7 - a : a; const size_t qoff = r0 + (size_t)(qb * 256 + rh * 128) * 512;
                    moba::BlockRef cur; cur.Q = (const bf16_t*)(ws + WS_MQ) + qoff; cur.O = (bf16_t*)(ws + (stf ? WS_YC : WS_US)) + qoff;
                    cur.K = (const bf16_t*)(ws + WS_MK) + r0; cur.V = (const bf16_t*)(ws + WS_MV) + r0; cur.km = (const float*)(ws + WS_KMEAN) + (size_t)bh * 8 * 128; cur.P0 = qb * 256 + rh * 128;
                    const int tl = fresh_tid(wave0);
                    moba::Seam S; moba::prime(cur, KARG(10), h, (char*)lds, S, tl); moba::block(cur, (char*)lds, S, tl); }
            }
        } else if (k == PH_MIX3) {
            const int tidl = fresh_tid(wave0), lane = tidl & 63, wave = wave0;
            if (mmask & 4) for (int it = vcu; it < 1024; it += G) mix::gla_passC_item(ws, KARG(5) + l * 128, it, ldsp, tidl, lane, wave, stf ? WS_YA : WS_US);
        } else if (k == PH_GATES) {
            const int tidl = fresh_tid(wave0);
            pg8::Gemm g{(const bf16_t*)(ws + WS_XB), (const bf16_t*)(ws + WS_W + W_IN) + (size_t)NIN1 * D, M, NGATE, D}; pg8::StaticOrder S; S.init(M, NGATE, G, bx);
            fill_rstd((LAS float*)(ldsp + RSTD_OFF), rssp, bx, tidl);
            pg8::EpiGates E{ws, (const LAS float*)(ldsp + RSTD_OFF)};
            pg8::gemm_phase<pg8::EpiGates, pg8::StaticOrder, true, true>(ldsp, g, S, E, tidl);
        } else if (k == PH_UPM) {
            const int tidl = fresh_tid(wave0);
            pg8::Gemm g{nullptr, nullptr, M, D, 512}; pg8::UpmOrder S; S.so.init(M, D, G, bx);
            S.Y0 = (const bf16_t*)(ws + WS_YA); S.Y1 = (const bf16_t*)(ws + WS_YB); S.Y2 = (const bf16_t*)(ws + WS_YC);
            S.W0 = (const bf16_t*)(ws + WS_W + W_UP); S.W1 = (const bf16_t*)(ws + WS_W + W_UP + MiB); S.W2 = (const bf16_t*)(ws + WS_W + W_UP + 2 * MiB);
            pg8::EpiUpm E{ws};
            pg8::gemm_phase<pg8::EpiUpm, pg8::UpmOrder, true, true>(ldsp, g, S, E, tidl);
        } else if (k == PH_OUT) {
            const int tidl = fresh_tid(wave0);
            pg8::Gemm g{(const bf16_t*)(ws + WS_MERGED), (const bf16_t*)(ws + WS_W + W_OUT), M, D, D}; pg8::StaticOrder S; S.init(M, D, G, bx);
            pg8::EpiRes E{l == 0 ? KARG(0) : out, out, (bf16_t*)(ws + WS_X1B), rssp, stf};
            pg8::gemm_phase<pg8::EpiRes, pg8::StaticOrder, false, true>(ldsp, g, S, E, tidl);
        } else if (k == PH_FFN) {
            const int tidl = fresh_tid(wave0);
            pg8::Gemm g{(const bf16_t*)(ws + WS_X1B), (const bf16_t*)(ws + WS_W + W_GU), M, NGU, D}; pg8::StaticOrder S; S.init(M, NGU, G, bx);
            fill_rstd((LAS float*)(ldsp + RSTD_OFF), rssp, bx, tidl);
            pg8::EpiFfn E{(bf16_t*)(ws + WS_H), (const LAS float*)(ldsp + RSTD_OFF)};
            pg8::gemm_phase<pg8::EpiFfn, pg8::StaticOrder, true, true>(ldsp, g, S, E, tidl);
        } else if (k == PH_DOWN) {
            const int tidl = fresh_tid(wave0);
            pg8::Gemm g{(const bf16_t*)(ws + WS_H), (const bf16_t*)(ws + WS_W + W_DN), M, D, FF}; pg8::StaticOrder S; S.init(M, D, G, bx);
            pg8::EpiRes E{out, out, (l + 1 < DEPTH) ? (bf16_t*)(ws + WS_XB) : nullptr, (l + 1 < DEPTH) ? rssp : nullptr, stf};
            pg8::gemm_phase<pg8::EpiRes, pg8::StaticOrder, false, true>(ldsp, g, S, E, tidl);
        }
        if (rep + 1 < nrep) xcd_barrier(bar);
        }
        if (ph + 1 < args.ph_hi) xcd_barrier(bar);
    }
}

#ifndef MIXMASK
#define MIXMASK 15
#endif
static void launch_mega(const Args& a0, int lo, int hi, int li, int grid, hipStream_t stream) {
    Args a = a0; a.ph_lo = lo; a.ph_hi = hi; a.li = li;
    hipLaunchKernelGGL(mega_fwd, dim3(grid), dim3(NWAVES * 64), LDS_BYTES, stream, a);
}
extern "C" void kernel_launch(void* const* d_in, const int* in_sizes, int n_in, void* d_out, int out_size, void* d_ws, size_t ws_size, hipStream_t stream) {
    static int grid = 0;
    if (grid == 0) {
        if (n_in != 19 || out_size != M * D || ws_size < WS_END2) { fprintf(stderr, "kernel_launch: unexpected shapes (n_in %d out %d ws %zu)\n", n_in, out_size, ws_size); grid = -1; return; }
        int dev = 0, cus = 0;
        if (hipGetDevice(&dev) != hipSuccess || hipDeviceGetAttribute(&cus, hipDeviceAttributeMultiprocessorCount, dev) != hipSuccess) { grid = -1; return; }
        if (hipFuncSetAttribute((const void*)mega_fwd, hipFuncAttributeMaxDynamicSharedMemorySize, LDS_BYTES) != hipSuccess) { fprintf(stderr, "kernel_launch: hipFuncSetAttribute failed\n"); grid = -1; return; }
        int per_cu = 0; (void)hipOccupancyMaxActiveBlocksPerMultiprocessor(&per_cu, (const void*)mega_fwd, NWAVES * 64, LDS_BYTES); (void)hipGetLastError();
        if (per_cu < 1) fprintf(stderr, "kernel_launch: occupancy query reports %d blocks per CU\n", per_cu);
        grid = cus;
    }
    if (grid < 0) return;
    (void)hipMemsetAsync((char*)d_ws + WS_CTL, 0, CTL_BYTES, stream);
    Args a{}; { const float** ap = (const float**)&a.in; for (int i = 0; i < 19; ++i) ap[i] = (const float*)d_in[i]; }
    a.out = (float*)d_out; a.ws = (unsigned char*)d_ws;
    a.mixmask = 15;
    launch_mega(a, 0, DEPTH * PH_PER_LAYER, 0, grid, stream);
}
```

```cpp
#include <hip/hip_runtime.h>
#include <cstdint>
#include <cstdio>

typedef unsigned short bf16_t;
typedef short bf16x8 __attribute__((ext_vector_type(8)));
typedef float f32x4 __attribute__((ext_vector_type(4)));

constexpr int BATCH = 8, SEQ = 2048, D = 1024, M = BATCH * SEQ, DEPTH = 2;
constexpr int IN_COLS = 6672, NIN1 = 3840, NGATE = 3072, NIN = NIN1 + NGATE;
constexpr int FF = 2816, NGU = 2 * FF;
constexpr int C_GLR = 1024;
constexpr float EPS = 1e-6f;
constexpr float LOG2E = 1.4426950408889634f;
constexpr float QSCALE = 0.08838834764831845f * LOG2E;

constexpr size_t MiB = 1u << 20;
constexpr size_t WS_CTL = 0, CTL_BYTES = 1 * MiB;
constexpr size_t WS_RSS = 1 * MiB;
constexpr size_t WS_KMEAN = 230 * MiB;
constexpr size_t WS_W = 2 * MiB;
constexpr size_t W_IN = 0, W_UP = 13 * MiB + 512 * 1024, W_OUT = W_UP + 3 * MiB, W_GU = W_OUT + 2 * MiB, W_DN = W_GU + 11 * MiB, W_PW = W_DN + 5 * MiB + 512 * 1024;
constexpr size_t WS_XB = 38 * MiB;
constexpr size_t WS_GQ = 70 * MiB, WS_GK = 78 * MiB, WS_GG = 86 * MiB;
constexpr size_t WS_GV = 102 * MiB, WS_PU = 118 * MiB;
constexpr size_t WS_MK = 134 * MiB, WS_MV = 150 * MiB;
constexpr size_t WS_SR = 166 * MiB, WS_MQ = 182 * MiB;
constexpr size_t WS_YB = 198 * MiB, WS_US = 214 * MiB;
constexpr size_t WS_SGA = 70 * MiB, WS_SGB = 102 * MiB, WS_SGC = 134 * MiB;
constexpr size_t WS_MERGED = WS_XB, WS_X1B = 70 * MiB, WS_H = 102 * MiB;
constexpr size_t WS_END = 231 * MiB;

__device__ __forceinline__ float bf2f(bf16_t h) { return __uint_as_float(((unsigned)h) << 16); }
__device__ __forceinline__ bf16_t f2bf(float f) { unsigned u = __float_as_uint(f); return (bf16_t)((u + 0x7fffu + ((u >> 16) & 1u)) >> 16); }
__device__ __forceinline__ unsigned pk2(float lo, float hi) { return (unsigned)f2bf(lo) | ((unsigned)f2bf(hi) << 16); }
__device__ __forceinline__ float wave_sum(float v) {
#pragma unroll
    for (int o = 1; o < 64; o <<= 1) v += __shfl_xor(v, o);
    return v;
}
__device__ __forceinline__ float wave_max(float v) {
#pragma unroll
    for (int o = 1; o < 64; o <<= 1) v = fmaxf(v, __shfl_xor(v, o));
    return v;
}
__device__ __forceinline__ float sigmoidf_(float x) { return 1.f / (1.f + __expf(-x)); }
__device__ __forceinline__ float siluf_(float x) { return x / (1.f + __expf(-x)); }
__device__ __forceinline__ float logsigmoidf_(float x) { return fminf(x, 0.f) - log1pf(__expf(-fabsf(x))); }

struct Inputs {
    const float *x, *norm1_w, *w_in, *wg2, *bg, *gla_nw, *pool_w, *pool_scale, *qn_w, *kn_w, *rel_bias, *w_up_a, *w_up_b, *w_up_c, *w_out, *norm2_w, *w_gate, *w_up, *w_down;
};

template <class F>
__device__ __forceinline__ void transpose_item(F src, int K, bf16_t* dst, int k0, int n0, float* scr, int lane) {
    float tv[32];
#pragma unroll
    for (int i = 0; i < 32; ++i) tv[i] = src(k0 + i, n0 + lane);
#pragma unroll
    for (int i = 0; i < 32; ++i) scr[i * 65 + lane] = tv[i];
    __builtin_amdgcn_s_waitcnt(0xc07f); asm volatile("" ::: "memory");
    const int c = lane & 3;
#pragma unroll
    for (int j = 0; j < 4; ++j) {
        const int n = (lane >> 2) + 16 * j; const float* s = scr + (8 * c) * 65 + n;
        uint4 o; o.x = pk2(s[0], s[65]); o.y = pk2(s[130], s[195]); o.z = pk2(s[260], s[325]); o.w = pk2(s[390], s[455]);
        *(uint4*)(dst + (size_t)(n0 + n) * K + k0 + 8 * c) = o;
    }
    __builtin_amdgcn_s_waitcnt(0xc07f); asm volatile("" ::: "memory");
}
constexpr int PI_IN = 32 * (NIN / 64), PI_UP = 16 * 16, PI_OUT = 32 * 16, PI_GU = 32 * (NGU / 64), PI_DN = 88 * 16, PI_PW = 4 * 2;
constexpr int PREP_ITEMS = PI_IN + 3 * PI_UP + PI_OUT + PI_GU + PI_DN + 4 * PI_PW;
template <class InP>
__device__ __forceinline__ void prep_item(InP inp, int l, unsigned char* wsw, int it, float* scr, int lane) {
    if (it < PI_IN) {
        const int nb = NIN / 64, kb = it / nb, n0 = 64 * (it % nb), k0 = 32 * kb;
        const float* w = inp->w_in + (size_t)l * D * IN_COLS; const float* nw = inp->norm1_w + l * D; bf16_t* dst = (bf16_t*)(wsw + W_IN);
        if (n0 >= 512 && n0 < 768) {
            const float* g2 = inp->wg2 + (size_t)l * 16 * 256 + (n0 - 512) + lane; float g2v[16];
#pragma unroll
            for (int r = 0; r < 16; ++r) g2v[r] = g2[r * 256];
            transpose_item([&](int k, int n) { const f32x4* wr = (const f32x4*)(w + (size_t)k * IN_COLS + C_GLR); float s = 0.f;
#pragma unroll
                for (int r4 = 0; r4 < 4; ++r4) { const f32x4 v = wr[r4]; s += v[0] * g2v[4 * r4] + v[1] * g2v[4 * r4 + 1] + v[2] * g2v[4 * r4 + 2] + v[3] * g2v[4 * r4 + 3]; }
                return s * nw[k]; }, D, dst, k0, n0, scr, lane);
        } else {
            const int off = n0 < 512 ? 0 : (n0 < 1280 ? -256 : -240);
            transpose_item([&](int k, int n) { return w[(size_t)k * IN_COLS + n + off] * nw[k]; }, D, dst, k0, n0, scr, lane);
        }
        return;
    }
    it -= PI_IN;
    if (it < 3 * PI_UP) {
        const int br = it / PI_UP; it %= PI_UP; const int kb = it / 16, n0 = 64 * (it % 16), k0 = 32 * kb;
        const float* w = (br == 0 ? inp->w_up_a : br == 1 ? inp->w_up_b : inp->w_up_c) + (size_t)l * 512 * D;
        transpose_item([&](int k, int n) { return w[(size_t)k * D + n]; }, 512, (bf16_t*)(wsw + W_UP + br * MiB), k0, n0, scr, lane);
        return;
    }
    it -= 3 * PI_UP;
    if (it < PI_OUT) {
        const int kb = it / 16, n0 = 64 * (it % 16), k0 = 32 * kb; const float* w = inp->w_out + (size_t)l * D * D;
        transpose_item([&](int k, int n) { return w[(size_t)k * D + n]; }, D, (bf16_t*)(wsw + W_OUT), k0, n0, scr, lane);
        return;
    }
    it -= PI_OUT;
    if (it < PI_GU) {
        const int nb = NGU / 64, kb = it / nb, n0 = 64 * (it % nb), k0 = 32 * kb;
        const int pn = n0 >> 8, i0 = n0 & 255; const float* w = ((i0 < 128) ? inp->w_gate : inp->w_up) + (size_t)l * D * FF; const float* nw = inp->norm2_w + l * D;
        const int coff = 128 * pn + (i0 & 127) - n0;
        transpose_item([&](int k, int n) { return w[(size_t)k * FF + n + coff] * nw[k]; }, D, (bf16_t*)(wsw + W_GU), k0, n0, scr, lane);
        return;
    }
    it -= PI_GU;
    if (it < PI_DN) {
        const int kb = it / 16, n0 = 64 * (it % 16), k0 = 32 * kb; const float* w = inp->w_down + (size_t)l * FF * D;
        transpose_item([&](int k, int n) { return w[(size_t)k * D + n]; }, FF, (bf16_t*)(wsw + W_DN), k0, n0, scr, lane);
        return;
    }
    it -= PI_DN;
    { const int g = it / PI_PW; it %= PI_PW; const int kb = it / 2, n0 = 64 * (it % 2), k0 = 32 * kb; const float* w = inp->pool_w + ((size_t)l * 4 + g) * 128 * 128;
      transpose_item([&](int k, int n) { return w[(size_t)k * 128 + n]; }, 128, (bf16_t*)(wsw + W_PW) + g * 128 * 128, k0, n0, scr, lane); }
}
__global__ void __launch_bounds__(256) k_prep(Inputs in, int l, unsigned char* ws) {
    __shared__ float scr[4][32 * 65];
    const int lane = threadIdx.x & 63, wave = threadIdx.x >> 6;
    for (int it = blockIdx.x * 4 + wave; it < PREP_ITEMS; it += gridDim.x * 4) prep_item(&in, l, ws + WS_W, it, scr[wave], lane);
}

__global__ void __launch_bounds__(256) k_rows(const float* src, bf16_t* dst, float* rss) {
    const int lane = threadIdx.x & 63, row = blockIdx.x * 4 + (threadIdx.x >> 6);
    const f32x4* xr = (const f32x4*)(src + (size_t)row * D) + lane; float s = 0.f;
    unsigned long long* o8 = (unsigned long long*)(dst + (size_t)row * D) + lane;
#pragma unroll
    for (int j = 0; j < 4; ++j) { const f32x4 v = xr[64 * j]; s += (v.x * v.x + v.y * v.y) + (v.z * v.z + v.w * v.w);
        o8[64 * j] = (unsigned long long)pk2(v.x, v.y) | ((unsigned long long)pk2(v.z, v.w) << 32); }
    s = wave_sum(s); if (lane == 0) rss[row] = s;
}

__device__ __forceinline__ void ngemm32(const bf16_t* A, int lda, const bf16_t* Bt, int ldb, int K, f32x4 (&acc)[2][2], int lane) {
    const int r = lane & 15, q = lane >> 4;
    for (int k0 = 0; k0 < K; k0 += 32) {
        bf16x8 a[2], b[2];
#pragma unroll
        for (int i = 0; i < 2; ++i) { a[i] = *(const bf16x8*)(A + (size_t)(i * 16 + r) * lda + k0 + 8 * q); b[i] = *(const bf16x8*)(Bt + (size_t)(i * 16 + r) * ldb + k0 + 8 * q); }
#pragma unroll
        for (int i = 0; i < 2; ++i)
#pragma unroll
            for (int j = 0; j < 2; ++j) acc[i][j] = __builtin_amdgcn_mfma_f32_16x16x32_bf16(a[i], b[j], acc[i][j], 0, 0, 0);
    }
}
#define NG_PRE const int lane = threadIdx.x & 63, wave = threadIdx.x >> 6; const int row0 = blockIdx.y * 64 + (wave >> 1) * 32, col0 = blockIdx.x * 64 + (wave & 1) * 32; \
    f32x4 acc[2][2]; for (int i = 0; i < 2; ++i) for (int j = 0; j < 2; ++j) acc[i][j] = (f32x4){0.f, 0.f, 0.f, 0.f};
#define NG_FOR for (int i = 0; i < 2; ++i) for (int j = 0; j < 2; ++j) for (int rg = 0; rg < 4; ++rg) { const int row = row0 + i * 16 + (lane >> 4) * 4 + rg, col = col0 + j * 16 + (lane & 15);

__global__ void __launch_bounds__(256) k_inproj1(unsigned char* ws, const float* bg) {
    NG_PRE
    ngemm32((const bf16_t*)(ws + WS_XB) + (size_t)row0 * D, D, (const bf16_t*)(ws + WS_W + W_IN) + (size_t)col0 * D, D, D, acc, lane);
    const float* rss = (const float*)(ws + WS_RSS);
    NG_FOR
        const float v = acc[i][j][rg] * rsqrtf(rss[row] * (1.f / D) + EPS);
        const int t = col >> 8, c = col & 255;
        if (t == 0) ((bf16_t*)(ws + WS_GQ))[(size_t)row * 256 + c] = f2bf(v * 0.125f);
        else if (t == 1) ((bf16_t*)(ws + WS_GK))[(size_t)row * 256 + c] = f2bf(v);
        else if (t == 2) ((float*)(ws + WS_GG))[(size_t)row * 256 + c] = logsigmoidf_(v + bg[c]) * (1.f / 16.f);
        else if (t < 5) ((bf16_t*)(ws + WS_GV))[(size_t)row * 512 + (col - 768)] = f2bf(v);
        else if (t < 7) ((bf16_t*)(ws + WS_SR))[(size_t)row * 512 + (col - 1280)] = f2bf(siluf_(v));
        else if (t < 9) ((bf16_t*)(ws + WS_PU))[(size_t)row * 512 + (col - 1792)] = f2bf(v);
        else if (t < 11) ((bf16_t*)(ws + WS_MQ))[(size_t)row * 512 + (col - 2304)] = f2bf(v);
        else if (t < 13) ((bf16_t*)(ws + WS_MK))[(size_t)row * 512 + (col - 2816)] = f2bf(v);
        else ((bf16_t*)(ws + WS_MV))[(size_t)row * 512 + (col - 3328)] = f2bf(v);
    }
}
__global__ void __launch_bounds__(256) k_gates(unsigned char* ws) {
    NG_PRE
    ngemm32((const bf16_t*)(ws + WS_XB) + (size_t)row0 * D, D, (const bf16_t*)(ws + WS_W + W_IN) + (size_t)(NIN1 + col0) * D, D, D, acc, lane);
    const float* rss = (const float*)(ws + WS_RSS);
    NG_FOR
        const float v = acc[i][j][rg] * rsqrtf(rss[row] * (1.f / D) + EPS);
        const int br = col >> 10, c = col & 1023;
        ((bf16_t*)(ws + (br == 0 ? WS_SGA : br == 1 ? WS_SGB : WS_SGC)))[(size_t)row * D + c] = f2bf(sigmoidf_(v));
    }
}
__global__ void __launch_bounds__(256) k_upmerge(unsigned char* ws) {
    NG_PRE
    f32x4 tot[2][2]; for (int i = 0; i < 2; ++i) for (int j = 0; j < 2; ++j) tot[i][j] = (f32x4){0.f, 0.f, 0.f, 0.f};
    for (int br = 0; br < 3; ++br) {
        const bf16_t* Y = (const bf16_t*)(ws + (br == 0 ? WS_SR : br == 1 ? WS_YB : WS_MQ)); const bf16_t* G = (const bf16_t*)(ws + (br == 0 ? WS_SGA : br == 1 ? WS_SGB : WS_SGC));
        for (int i = 0; i < 2; ++i) for (int j = 0; j < 2; ++j) acc[i][j] = (f32x4){0.f, 0.f, 0.f, 0.f};
        ngemm32(Y + (size_t)row0 * 512, 512, (const bf16_t*)(ws + WS_W + W_UP + br * MiB) + (size_t)col0 * 512, 512, 512, acc, lane);
        NG_FOR tot[i][j][rg] += bf2f(G[(size_t)row * D + col]) * acc[i][j][rg]; }
    }
    NG_FOR ((bf16_t*)(ws + WS_MERGED))[(size_t)row * D + col] = f2bf(tot[i][j][rg]); }
}
__global__ void __launch_bounds__(256) k_resgemm(const bf16_t* A, const bf16_t* Bt, int K, const float* resid, float* xout) {
    NG_PRE
    ngemm32(A + (size_t)row0 * K, K, Bt + (size_t)col0 * K, K, K, acc, lane);
    NG_FOR xout[(size_t)row * D + col] = resid[(size_t)row * D + col] + acc[i][j][rg]; }
}
__global__ void __launch_bounds__(256) k_ffn(unsigned char* ws) {
    const int lane = threadIdx.x & 63, wave = threadIdx.x >> 6; const int row0 = blockIdx.y * 64 + (wave >> 1) * 32, j0 = blockIdx.x * 64 + (wave & 1) * 32;
    f32x4 ag[2][2], au[2][2]; for (int i = 0; i < 2; ++i) for (int j = 0; j < 2; ++j) { ag[i][j] = (f32x4){0.f, 0.f, 0.f, 0.f}; au[i][j] = ag[i][j]; }
    const int ng = 256 * (j0 >> 7) + (j0 & 127);
    const bf16_t* A = (const bf16_t*)(ws + WS_X1B) + (size_t)row0 * D; const bf16_t* W = (const bf16_t*)(ws + WS_W + W_GU);
    ngemm32(A, D, W + (size_t)ng * D, D, D, ag, lane);
    ngemm32(A, D, W + (size_t)(ng + 128) * D, D, D, au, lane);
    const float* rss = (const float*)(ws + WS_RSS);
    for (int i = 0; i < 2; ++i) for (int j = 0; j < 2; ++j) for (int rg = 0; rg < 4; ++rg) { const int row = row0 + i * 16 + (lane >> 4) * 4 + rg, col = j0 + j * 16 + (lane & 15);
        const float rs = rsqrtf(rss[row] * (1.f / D) + EPS);
        ((bf16_t*)(ws + WS_H))[(size_t)row * FF + col] = f2bf(siluf_(ag[i][j][rg] * rs) * (au[i][j][rg] * rs)); }
}

__global__ void __launch_bounds__(128) k_gla(unsigned char* ws, const float* nw) {
    const int e = threadIdx.x, b = blockIdx.x >> 2, h = blockIdx.x & 3, lane = e & 63, wave = e >> 6;
    const bf16_t* GQ = (const bf16_t*)(ws + WS_GQ); const bf16_t* GK = (const bf16_t*)(ws + WS_GK); const float* GG = (const float*)(ws + WS_GG);
    const bf16_t* GV = (const bf16_t*)(ws + WS_GV); bf16_t* YA = (bf16_t*)(ws + WS_SR);
    __shared__ float red[2][16]; __shared__ float osh[16][128];
    float S[64];
#pragma unroll
    for (int d = 0; d < 64; ++d) S[d] = 0.f;
    const float nwe = nw[e];
    for (int t0 = 0; t0 < SEQ; t0 += 16) {
#pragma unroll 1
        for (int tt = 0; tt < 16; ++tt) {
            const size_t row = (size_t)b * SEQ + t0 + tt;
            const bf16_t* q = GQ + row * 256 + h * 64; const bf16_t* k = GK + row * 256 + h * 64; const float* g = GG + row * 256 + h * 64;
            const float v = bf2f(GV[row * 512 + h * 128 + e]); float a = 0.f;
#pragma unroll
            for (int d = 0; d < 64; ++d) { S[d] = __expf(g[d]) * S[d] + bf2f(k[d]) * v; a += bf2f(q[d]) * S[d]; }
            osh[tt][e] = a;
            const float s = wave_sum(a * a); if (lane == 0) red[wave][tt] = s;
        }
        __syncthreads();
#pragma unroll 1
        for (int tt = 0; tt < 16; ++tt) { const float rstd = rsqrtf((red[0][tt] + red[1][tt]) * (1.f / 128.f) + EPS);
            const size_t idx = ((size_t)b * SEQ + t0 + tt) * 512 + h * 128 + e; YA[idx] = f2bf(osh[tt][e] * rstd * nwe * bf2f(YA[idx])); }
        __syncthreads();
    }
}

__global__ void __launch_bounds__(256) k_pool(unsigned char* ws, const float* pw, const float* pscale) {
    __shared__ float u[31][128]; __shared__ float p[16][128];
    const int g = blockIdx.x & 3, r0 = (blockIdx.x >> 2) * 16, t0 = r0 & (SEQ - 1), tid = threadIdx.x;
    const bf16_t* PU = (const bf16_t*)(ws + WS_PU);
    for (int x = tid; x < 31 * 128; x += 256) { const int i = x >> 7, c = x & 127, t = t0 - 15 + i; u[i][c] = t >= 0 ? bf2f(PU[(size_t)(r0 - 15 + i) * 512 + g * 128 + c]) : 0.f; }
    __syncthreads();
    const int w = 2 << g;
    for (int x = tid; x < 16 * 128; x += 256) { const int i = x >> 7, c = x & 127, t = t0 + i, cnt = min(t + 1, w); float s = 0.f;
        for (int j = 0; j < cnt; ++j) s += u[15 + i - j][c];
        p[i][c] = s / (float)cnt - u[15 + i][c]; }
    __syncthreads();
    for (int x = tid; x < 16 * 128; x += 256) { const int i = x >> 7, e = x & 127; float y = 0.f;
        for (int c = 0; c < 128; ++c) y += p[i][c] * pw[((size_t)g * 128 + c) * 128 + e];
        ((bf16_t*)(ws + WS_YB))[(size_t)(r0 + i) * 512 + g * 128 + e] = f2bf(y * pscale[g * 128 + e]); }
}

__global__ void __launch_bounds__(256) k_prepass(unsigned char* ws, const float* qw, const float* kw) {
    __shared__ float part[4][128];
    const int lane = threadIdx.x & 63, wave = threadIdx.x >> 6; const int h = blockIdx.x & 3, blk = (blockIdx.x >> 2) & 7, b = blockIdx.x >> 5;
    unsigned* MQ = (unsigned*)(ws + WS_MQ); unsigned* MK = (unsigned*)(ws + WS_MK);
    const float qw0 = qw[2 * lane] * QSCALE, qw1 = qw[2 * lane + 1] * QSCALE, kw0 = kw[2 * lane], kw1 = kw[2 * lane + 1];
    float c0 = 0.f, c1 = 0.f;
    for (int r = 0; r < 64; ++r) {
        const size_t idx = ((size_t)b * SEQ + blk * 256 + wave * 64 + r) * 256 + h * 64 + lane;
        { const unsigned v = MQ[idx]; const float a = __uint_as_float(v << 16), c = __uint_as_float(v & 0xffff0000u); const float rs = rsqrtf(wave_sum(a * a + c * c) * (1.f / 128.f) + EPS); MQ[idx] = pk2(a * rs * qw0, c * rs * qw1); }
        { const unsigned v = MK[idx]; const float a = __uint_as_float(v << 16), c = __uint_as_float(v & 0xffff0000u); const float rs = rsqrtf(wave_sum(a * a + c * c) * (1.f / 128.f) + EPS);
          const float k0 = a * rs * kw0, k1 = c * rs * kw1; c0 += k0; c1 += k1; MK[idx] = pk2(k0, k1); }
    }
    part[wave][2 * lane] = c0; part[wave][2 * lane + 1] = c1;
    __syncthreads();
    if (threadIdx.x < 128) ((float*)(ws + WS_KMEAN))[(((size_t)b * 4 + h) * 8 + blk) * 128 + threadIdx.x] = ((part[0][threadIdx.x] + part[1][threadIdx.x]) + (part[2][threadIdx.x] + part[3][threadIdx.x])) * (1.f / 256.f);
}

__global__ void __launch_bounds__(256) k_moba(unsigned char* ws, const float* rel_bias) {
    __shared__ float tab[4][132]; __shared__ float qs[4][128]; __shared__ float ps[4][1024];
    const int lane = threadIdx.x & 63, wave = threadIdx.x >> 6;
    const int gw = blockIdx.x * 4 + wave; const int t = gw & (SEQ - 1), h = (gw >> 11) & 3, b = gw >> 13;
    for (int x = threadIdx.x; x < 129; x += 256) { int bk = x; if (x >= 16) { bk = 16 + (int)(logf((float)x / 16.f) / 2.0794415416798357f * 16.f); if (bk > 31) bk = 31; } tab[0][x] = rel_bias[bk * 4 + h] * LOG2E; }
    __syncthreads();
    const size_t row = (size_t)b * SEQ + t; const int qblk = t >> 8;
    unsigned* QN = (unsigned*)(ws + WS_MQ); const bf16_t* KN = (const bf16_t*)(ws + WS_MK); const unsigned* MV = (const unsigned*)(ws + WS_MV);
    const unsigned qv = QN[row * 256 + h * 64 + lane]; const float q0 = __uint_as_float(qv << 16), q1 = __uint_as_float(qv & 0xffff0000u);
    qs[wave][2 * lane] = q0; qs[wave][2 * lane + 1] = q1;
    const float* km = (const float*)(ws + WS_KMEAN) + ((size_t)b * 4 + h) * 8 * 128;
    float sc[8];
#pragma unroll
    for (int n = 0; n < 8; ++n) sc[n] = (n < qblk) ? wave_sum(q0 * km[n * 128 + 2 * lane] + q1 * km[n * 128 + 2 * lane + 1]) : -INFINITY;
    int blks[4]; int nvalid = 0;
#pragma unroll
    for (int s = 0; s < 3; ++s) { float best = -INFINITY; int bi = -1;
#pragma unroll
        for (int n = 0; n < 8; ++n) if (sc[n] > best) { best = sc[n]; bi = n; }
        blks[s] = bi;
#pragma unroll
        for (int n = 0; n < 8; ++n) if (n == bi) sc[n] = -INFINITY; }
    blks[3] = qblk;
    __builtin_amdgcn_s_waitcnt(0xc07f);
    float lg[4][4]; float mx = -INFINITY;
#pragma unroll
    for (int s = 0; s < 4; ++s) {
        const int blk = blks[s];
#pragma unroll
        for (int i = 0; i < 4; ++i) {
            lg[s][i] = -INFINITY;
            if (blk >= 0) { const int j = lane + 64 * i, tk = blk * 256 + j, dist = t - tk;
                if (dist >= 0) { const bf16_t* kr = KN + ((size_t)b * SEQ + tk) * 512 + h * 128; float dsum = 0.f;
                    for (int c = 0; c < 16; ++c) { const bf16x8 kk = *(const bf16x8*)(kr + c * 8);
#pragma unroll
                        for (int x = 0; x < 8; ++x) dsum += bf2f((bf16_t)kk[x]) * qs[wave][c * 8 + x]; }
                    lg[s][i] = dsum + tab[0][dist > 128 ? 128 : dist]; mx = fmaxf(mx, lg[s][i]); } }
        }
    }
    mx = wave_max(mx); float sum = 0.f;
#pragma unroll
    for (int s = 0; s < 4; ++s)
#pragma unroll
        for (int i = 0; i < 4; ++i) { const float pp = exp2f(lg[s][i] - mx); sum += pp; ps[wave][s * 256 + lane + 64 * i] = pp; }
    sum = wave_sum(sum);
    __builtin_amdgcn_s_waitcnt(0xc07f);
    float o0 = 0.f, o1 = 0.f;
#pragma unroll
    for (int s = 0; s < 4; ++s) { const int blk = blks[s]; if (blk < 0) continue; const int jn = (s == 3) ? (t & 255) + 1 : 256;
        const unsigned* vr = MV + ((size_t)b * SEQ + blk * 256) * 256 + h * 64 + lane;
        for (int j = 0; j < jn; ++j) { const float pp = ps[wave][s * 256 + j]; const unsigned v = vr[(size_t)j * 256]; o0 += pp * __uint_as_float(v << 16); o1 += pp * __uint_as_float(v & 0xffff0000u); } }
    const float inv = 1.f / sum;
    QN[row * 256 + h * 64 + lane] = pk2(o0 * inv, o1 * inv);
}


namespace pg8 {
#define PG8_LAS __attribute__((address_space(3)))
typedef unsigned u32x4 __attribute__((ext_vector_type(4)));
constexpr int BM = 256, BK = 64, HALF = 128, HTB = HALF * BK * 2, STAGE_BYTES = 8 * HTB, NXCD = 8, WGM = 8;
__host__ __device__ __forceinline__ int lds_byte(int r, int c) { const int st = (r >> 4) * 2 + (c >> 5), rr = r & 15, cc = c & 31, ob = rr * 64 + cc * 2; return st * 1024 + (ob ^ (((ob >> 9) & 1) << 5)); }
__host__ __device__ __forceinline__ void stage_rc(int b, int& R, int& C) { const int st = b / 1024, sb = b % 1024, swz = sb ^ (((sb >> 9) & 1) << 5); R = (st >> 1) * 16 + swz / 64; C = (st & 1) * 32 + (swz % 64) / 2; }
__host__ __device__ __forceinline__ int perm32(int rho) { const int n = rho >> 4, i = rho & 15; return 8 * (i >> 2) + 4 * n + (i & 3); }
struct Unit { int pm, pn, br; };
struct Gemm { const bf16_t* A; const bf16_t* Bt; int M, N, K; };
struct StaticOrder {
    int nM, nN, nwg, G, c;
    __device__ void init(int M_, int N_, int G_, int c_) { nM = M_ / BM; nN = N_ / BM; nwg = nM * nN; G = G_; c = c_; }
    __device__ bool next(int i, Unit& u) const {
        const long L = (long)i * G + c; if (L >= nwg) return false;
        int wgid = (int)L; { const int q = nwg / NXCD, r = nwg % NXCD, xcd = wgid % NXCD, off = wgid / NXCD; wgid = (xcd < r ? xcd * (q + 1) : r * (q + 1) + (xcd - r) * q) + off; }
        const int nig = WGM * nN, gid = wgid / nig, fm = gid * WGM, gsz = (nM - fm) < WGM ? (nM - fm) : WGM;
        u.pm = fm + ((wgid % nig) % gsz); u.pn = (wgid % nig) / gsz; u.br = 0; return true;
    }
    __device__ __forceinline__ const char* pa(const Unit& u, const Gemm& g) const { return (const char*)g.A + (size_t)u.pm * (size_t)(BM * 2) * g.K; }
    __device__ __forceinline__ const char* pb(const Unit& u, const Gemm& g) const { return (const char*)g.Bt + (size_t)u.pn * (size_t)(BM * 2) * g.K; }
    __device__ __forceinline__ void a_ready(const Unit&) const {}
    __device__ __forceinline__ void done(const Unit&) const {}
};
struct UpmOrder {
    StaticOrder so; const bf16_t *Y0, *Y1, *Y2, *W0, *W1, *W2;
    __device__ bool next(int i, Unit& u) const { if (i >= 3) return false; if (!so.next(0, u)) return false; u.br = i; return true; }
    __device__ __forceinline__ const char* pa(const Unit& u, const Gemm& g) const { const bf16_t* y = u.br == 0 ? Y0 : (u.br == 1 ? Y1 : Y2); return (const char*)y + (size_t)u.pm * (size_t)(BM * 2) * g.K; }
    __device__ __forceinline__ const char* pb(const Unit& u, const Gemm& g) const { const bf16_t* w = u.br == 0 ? W0 : (u.br == 1 ? W1 : W2); return (const char*)w + (size_t)u.pn * (size_t)(BM * 2) * g.K; }
    __device__ __forceinline__ void a_ready(const Unit&) const {}
    __device__ __forceinline__ void done(const Unit&) const {}
};
typedef float f32x2_t __attribute__((ext_vector_type(2))); typedef __bf16 bf16x2_t __attribute__((ext_vector_type(2)));
__device__ __forceinline__ unsigned cvt_pk_bf16(float lo, float hi) { const f32x2_t v = {lo, hi}; const bf16x2_t b = __builtin_convertvector(v, bf16x2_t); return __builtin_bit_cast(unsigned, b); }
__device__ __forceinline__ u32x4 pack8(const f32x4& a, const f32x4& b) { u32x4 w; w.x = cvt_pk_bf16(a[0], a[1]); w.y = cvt_pk_bf16(a[2], a[3]); w.z = cvt_pk_bf16(b[0], b[1]); w.w = cvt_pk_bf16(b[2], b[3]); return w; }
__device__ __forceinline__ void unpack8(const u32x4& w, f32x4& a, f32x4& b) {
    a[0] = __uint_as_float(w.x << 16); a[1] = __uint_as_float(w.x & 0xffff0000u); a[2] = __uint_as_float(w.y << 16); a[3] = __uint_as_float(w.y & 0xffff0000u);
    b[0] = __uint_as_float(w.z << 16); b[1] = __uint_as_float(w.z & 0xffff0000u); b[2] = __uint_as_float(w.w << 16); b[3] = __uint_as_float(w.w & 0xffff0000u);
}
__device__ __forceinline__ void row_rstd(const PG8_LAS float* tab, const Unit& u, int wr, int fr, float (&rs)[2][4]) {
#pragma unroll
    for (int ai = 0; ai < 2; ++ai)
#pragma unroll
        for (int m = 0; m < 4; ++m) rs[ai][m] = tab[(u.pm & 7) * BM + ai * HALF + wr * 64 + m * 16 + fr];
}
struct EpiIn1 {
    static constexpr bool PERM = true, AFTER_DRAIN = false;
    unsigned char* ws; const PG8_LAS float* rstab; const float* bg;
    __device__ __forceinline__ void operator()(const f32x4 (&acc)[2][2][4][2], const Unit& u, int wr, int wc, int fr, int fq) const {
        asm volatile("" : "+v"(fr), "+v"(fq));
        const int row0 = u.pm * BM + wr * 64 + fr, cw = wc * 32 + 8 * fq; const int pn = u.pn;
        float rs[2][4]; row_rstd(rstab, u, wr, fr, rs);
        if (pn == 2) {
            float* G = (float*)(ws + WS_GG); size_t zb = 0; asm volatile("" : "+s"(zb)); const float* bgl = bg + zb;
#pragma unroll
            for (int bj = 0; bj < 2; ++bj) { const int c = bj * HALF + cw; const f32x4 b0 = *(const f32x4*)(bgl + c), b1 = *(const f32x4*)(bgl + c + 4);
#pragma unroll
                for (int ai = 0; ai < 2; ++ai)
#pragma unroll
                    for (int m = 0; m < 4; ++m) { const float r = rs[ai][m]; f32x4 v0 = acc[ai][bj][m][0] * r + b0, v1 = acc[ai][bj][m][1] * r + b1;
#pragma unroll
                        for (int x = 0; x < 4; ++x) { v0[x] = (fminf(v0[x], 0.f) - __logf(1.f + __expf(-fabsf(v0[x])))) * 0.0625f; v1[x] = (fminf(v1[x], 0.f) - __logf(1.f + __expf(-fabsf(v1[x])))) * 0.0625f; }
                        float* p = G + (size_t)(row0 + ai * HALF + m * 16) * 256 + c; *(f32x4*)p = v0; *(f32x4*)(p + 4) = v1; asm volatile("" ::: "memory"); } }
            return;
        }
        bf16_t* base; int ldc, coff; float sc = 1.f; bool silu = false;
        if (pn == 0) { base = (bf16_t*)(ws + WS_GQ); ldc = 256; coff = 0; sc = 0.125f; }
        else if (pn == 1) { base = (bf16_t*)(ws + WS_GK); ldc = 256; coff = 0; }
        else { ldc = 512; const int k = (pn - 3) >> 1; coff = ((pn - 3) & 1) * 256; silu = (k == 1);
            base = (bf16_t*)(ws + (k == 0 ? WS_GV : k == 1 ? WS_SR : k == 2 ? WS_PU : k == 3 ? WS_MQ : k == 4 ? WS_MK : WS_MV)); }
#pragma unroll
        for (int ai = 0; ai < 2; ++ai)
#pragma unroll
            for (int m = 0; m < 4; ++m) { const float r = rs[ai][m] * sc; bf16_t* rowp = base + (size_t)(row0 + ai * HALF + m * 16) * ldc + coff + cw;
#pragma unroll
                for (int bj = 0; bj < 2; ++bj) { f32x4 v0 = acc[ai][bj][m][0] * r, v1 = acc[ai][bj][m][1] * r;
                    if (silu) {
#pragma unroll
                        for (int x = 0; x < 4; ++x) { v0[x] = siluf_(v0[x]); v1[x] = siluf_(v1[x]); } }
                    *(u32x4*)(rowp + bj * HALF) = pack8(v0, v1); } asm volatile("" ::: "memory"); }
    }
};
struct EpiGates {
    static constexpr bool PERM = true, AFTER_DRAIN = false;
    unsigned char* ws; const PG8_LAS float* rstab;
    __device__ __forceinline__ void operator()(const f32x4 (&acc)[2][2][4][2], const Unit& u, int wr, int wc, int fr, int fq) const {
        asm volatile("" : "+v"(fr), "+v"(fq));
        const int row0 = u.pm * BM + wr * 64 + fr, cw = wc * 32 + 8 * fq; const int br = u.pn >> 2;
        float rs[2][4]; row_rstd(rstab, u, wr, fr, rs);
        bf16_t* base = (bf16_t*)(ws + (br == 0 ? WS_SGA : br == 1 ? WS_SGB : WS_SGC)) + (u.pn & 3) * 256 + cw;
#pragma unroll
        for (int ai = 0; ai < 2; ++ai)
#pragma unroll
            for (int m = 0; m < 4; ++m) { const float r = rs[ai][m]; bf16_t* rowp = base + (size_t)(row0 + ai * HALF + m * 16) * D;
#pragma unroll
                for (int bj = 0; bj < 2; ++bj) { f32x4 v0 = acc[ai][bj][m][0] * r, v1 = acc[ai][bj][m][1] * r;
#pragma unroll
                    for (int x = 0; x < 4; ++x) { v0[x] = sigmoidf_(v0[x]); v1[x] = sigmoidf_(v1[x]); }
                    *(u32x4*)(rowp + bj * HALF) = pack8(v0, v1); } asm volatile("" ::: "memory"); }
    }
};
struct EpiUpm {
    static constexpr bool PERM = true, AFTER_DRAIN = false;
    unsigned char* ws;
    __device__ __forceinline__ void operator()(const f32x4 (&acc)[2][2][4][2], const Unit& u, int wr, int wc, int fr, int fq) const {
        asm volatile("" : "+v"(fr), "+v"(fq));
        const int row0 = u.pm * BM + wr * 64 + fr, col0 = u.pn * BM + wc * 32 + 8 * fq; const int br = u.br;
        const bf16_t* G = (const bf16_t*)(ws + (br == 0 ? WS_SGA : br == 1 ? WS_SGB : WS_SGC)); bf16_t* O = (bf16_t*)(ws + WS_MERGED);
#pragma unroll
        for (int ai = 0; ai < 2; ++ai)
#pragma unroll
            for (int m = 0; m < 4; ++m) { const size_t off = (size_t)(row0 + ai * HALF + m * 16) * D + col0;
#pragma unroll
                for (int bj = 0; bj < 2; ++bj) { f32x4 g0, g1; unpack8(*(const u32x4*)(G + off + bj * HALF), g0, g1);
                    f32x4 v0 = acc[ai][bj][m][0] * g0, v1 = acc[ai][bj][m][1] * g1;
                    if (br != 0) { f32x4 p0, p1; unpack8(*(const u32x4*)(O + off + bj * HALF), p0, p1); v0 += p0; v1 += p1; }
                    *(u32x4*)(O + off + bj * HALF) = pack8(v0, v1); } }
    }
};
struct EpiRes {
    static constexpr bool PERM = true, AFTER_DRAIN = false;
    const float* resid; float* xout; bf16_t* xb; float* rssp; bool st;
    __device__ __forceinline__ void operator()(const f32x4 (&acc)[2][2][4][2], const Unit& u, int wr, int wc, int fr, int fq) const {
        asm volatile("" : "+v"(fr), "+v"(fq));
        const int row0 = u.pm * BM + wr * 64 + fr, col0 = u.pn * BM + wc * 32 + 8 * fq;
#pragma unroll
        for (int ai = 0; ai < 2; ++ai)
#pragma unroll
            for (int m = 0; m < 4; ++m) { const int row = row0 + ai * HALF + m * 16; const size_t off = (size_t)row * D + col0; float s = 0.f;
#pragma unroll
                for (int bj = 0; bj < 2; ++bj) { const f32x4 r0 = *(const f32x4*)(resid + off + bj * HALF), r1 = *(const f32x4*)(resid + off + bj * HALF + 4);
                    const f32x4 v0 = acc[ai][bj][m][0] + r0, v1 = acc[ai][bj][m][1] + r1;
                    if (st) { *(f32x4*)(xout + off + bj * HALF) = v0; *(f32x4*)(xout + off + bj * HALF + 4) = v1; }
                    if (xb && st) *(u32x4*)(xb + off + bj * HALF) = pack8(v0, v1);
                    s += ((v0[0] * v0[0] + v0[1] * v0[1]) + (v0[2] * v0[2] + v0[3] * v0[3])) + ((v1[0] * v1[0] + v1[1] * v1[1]) + (v1[2] * v1[2] + v1[3] * v1[3])); }
                s += __shfl_xor(s, 16); s += __shfl_xor(s, 32);
                if (fq == 0 && rssp && st) rssp[(size_t)row * 16 + u.pn * 4 + wc] = s; }
    }
};
struct EpiFfn {
    static constexpr bool PERM = true, AFTER_DRAIN = false;
    bf16_t* H; const PG8_LAS float* rstab;
    __device__ __forceinline__ void operator()(const f32x4 (&acc)[2][2][4][2], const Unit& u, int wr, int wc, int fr, int fq) const {
        asm volatile("" : "+v"(fr), "+v"(fq));
        const int row0 = u.pm * BM + wr * 64 + fr, col0 = u.pn * HALF + wc * 32 + 8 * fq;
        float rs[2][4]; row_rstd(rstab, u, wr, fr, rs);
#pragma unroll
        for (int ai = 0; ai < 2; ++ai)
#pragma unroll
            for (int m = 0; m < 4; ++m) { const float r = rs[ai][m]; f32x4 g0 = acc[ai][0][m][0] * r, g1 = acc[ai][0][m][1] * r; const f32x4 u0 = acc[ai][1][m][0] * r, u1 = acc[ai][1][m][1] * r;
#pragma unroll
                for (int x = 0; x < 4; ++x) { g0[x] = siluf_(g0[x]) * u0[x]; g1[x] = siluf_(g1[x]) * u1[x]; }
                *(u32x4*)(H + (size_t)(row0 + ai * HALF + m * 16) * FF + col0) = pack8(g0, g1); asm volatile("" ::: "memory"); }
    }
};
template <class Epi, class Sched, bool ALIGN_EPI = false, bool SP2 = false>
__device__ __forceinline__ void gemm_phase(PG8_LAS unsigned char* lds, const Gemm g, const Sched& S, const Epi& E, const int tid) {
    const int wid = __builtin_amdgcn_readfirstlane(tid >> 6), lane = tid & 63, wr = wid >> 2, wc = wid & 3, fr = lane & 15, fq = lane >> 4;
    const int K = g.K, nt = K / BK;
    unsigned voffA[2], voffB[2];
#pragma unroll
    for (int i = 0; i < 2; ++i) { int R, C; stage_rc(tid * 16 + i * 8192, R, C); const int Rb = Epi::PERM ? ((R & ~31) + perm32(R & 31)) : R;
        voffA[i] = (unsigned)(R * K + C) * 2u; voffB[i] = (unsigned)(Rb * K + C) * 2u; }
    const size_t kstep = (size_t)(BK * 2);
    const size_t hstep = (size_t)HALF * K * 2;
    const unsigned ldsw = (unsigned)wid * 1024u;
    const int aoff = lds_byte(wr * 64 + fr, fq * 8), boff = lds_byte(wc * 32 + fr, fq * 8);
#define PG8_SA(b, h) (((b) * 2 + (h)) * HTB)
#define PG8_SB(b, h) ((4 + (b) * 2 + (h)) * HTB)
#define PG8_STAGE(bufoff, gbase, voff) do { _Pragma("unroll") for (int _i = 0; _i < 2; ++_i) \
        __builtin_amdgcn_global_load_lds((const unsigned*)((const char*)(gbase) + (voff)[_i]), (PG8_LAS unsigned*)(lds + (bufoff) + ldsw + _i * 8192), 16, 0, 0); } while (0)
#define PG8_LDA(dst, b, h) do { _Pragma("unroll") for (int m = 0; m < 4; ++m) _Pragma("unroll") for (int k = 0; k < 2; ++k) dst[m][k] = *(const PG8_LAS bf16x8*)(lds + PG8_SA(b, h) + aoff + m * 2048 + k * 1024); } while (0)
#define PG8_LDB(dst, b, h) do { _Pragma("unroll") for (int n = 0; n < 2; ++n) _Pragma("unroll") for (int k = 0; k < 2; ++k) dst[n][k] = *(const PG8_LAS bf16x8*)(lds + PG8_SB(b, h) + boff + n * 2048 + k * 1024); } while (0)
#define PG8_MMA(ai, bj, At, Bt) do { __builtin_amdgcn_s_setprio(1); _Pragma("unroll") for (int m = 0; m < 4; ++m) _Pragma("unroll") for (int n = 0; n < 2; ++n) _Pragma("unroll") for (int k = 0; k < 2; ++k) \
        acc[ai][bj][m][n] = __builtin_amdgcn_mfma_f32_16x16x32_bf16(Bt[n][k], At[m][k], acc[ai][bj][m][n], 0, 0, 0); __builtin_amdgcn_s_setprio(0); } while (0)
#define PG8_WAIT_V(n) asm volatile("s_waitcnt vmcnt(" #n ")" ::: "memory")
#define PG8_WAIT_L(n) asm volatile("s_waitcnt lgkmcnt(" #n ")" ::: "memory")
#define PG8_BAR __builtin_amdgcn_s_barrier()
#define PG8_SCHED __builtin_amdgcn_sched_barrier(0)
    Unit cur, nxt; int ui = 0;
    if (!S.next(0, cur)) return;
    f32x4 acc[2][2][4][2];
#pragma unroll
    for (int a = 0; a < 2; ++a)
#pragma unroll
        for (int b = 0; b < 2; ++b)
#pragma unroll
            for (int m = 0; m < 4; ++m)
#pragma unroll
                for (int n = 0; n < 2; ++n) acc[a][b][m][n] = (f32x4){0.f, 0.f, 0.f, 0.f};
    bf16x8 At[4][2], B0[2][2], B1[2][2];
    const char* cA = S.pa(cur, g); const char* cB = S.pb(cur, g);
    S.a_ready(cur);
    if constexpr (SP2) {
        PG8_STAGE(PG8_SB(0, 0), cB, voffB); PG8_STAGE(PG8_SB(0, 1), cB + hstep, voffB); PG8_STAGE(PG8_SA(0, 0), cA, voffA); PG8_STAGE(PG8_SA(0, 1), cA + hstep, voffA);
        if (wr == 1) PG8_BAR;
        PG8_WAIT_V(2); PG8_BAR;
        PG8_STAGE(PG8_SB(1, 0), cB + kstep, voffB); PG8_STAGE(PG8_SA(1, 0), cA + kstep, voffA); PG8_STAGE(PG8_SB(1, 1), cB + hstep + kstep, voffB);
        PG8_WAIT_V(6); PG8_BAR;
    } else {
        PG8_STAGE(PG8_SB(0, 0), cB, voffB); PG8_STAGE(PG8_SA(0, 0), cA, voffA); PG8_STAGE(PG8_SB(0, 1), cB + hstep, voffB); PG8_STAGE(PG8_SA(0, 1), cA + hstep, voffA);
        if (wr == 1) PG8_BAR;
        PG8_WAIT_V(4); PG8_BAR;
        PG8_STAGE(PG8_SB(1, 0), cB + kstep, voffB); PG8_STAGE(PG8_SA(1, 0), cA + kstep, voffA); PG8_STAGE(PG8_SB(1, 1), cB + hstep + kstep, voffB);
        PG8_WAIT_V(6); PG8_BAR;
    }
    for (;;) {
        const bool has_next = S.next(ui + 1, nxt);
        const char* nA = has_next ? S.pa(nxt, g) : cA; const char* nB = has_next ? S.pb(nxt, g) : cB;
        for (int t = 0; t < nt; t += 2) {
            const bool last = (t == nt - 2);
            const char* a1 = cA + (size_t)(t + 1) * kstep;
            const char* a2 = last ? nA : cA + (size_t)(t + 2) * kstep; const char* b2 = last ? nB : cB + (size_t)(t + 2) * kstep;
            const char* a3 = a2 + kstep; const char* b3 = b2 + kstep;
            if (last && has_next) S.a_ready(nxt);
            if constexpr (SP2) {
            PG8_LDB(B0, 0, 0); PG8_LDB(B1, 0, 1); PG8_SCHED; PG8_LDA(At, 0, 0); PG8_STAGE(PG8_SA(1, 1), a1 + hstep, voffA);
            PG8_WAIT_V(8); PG8_WAIT_L(0); PG8_BAR; PG8_MMA(0, 0, At, B0); PG8_MMA(0, 1, At, B1); PG8_BAR; PG8_SCHED;
            PG8_LDA(At, 0, 1); PG8_STAGE(PG8_SB(0, 0), b2, voffB); PG8_STAGE(PG8_SB(0, 1), b2 + hstep, voffB); PG8_STAGE(PG8_SA(0, 0), a2, voffA);
            PG8_WAIT_V(8); PG8_WAIT_L(0); PG8_BAR; PG8_MMA(1, 0, At, B0); PG8_MMA(1, 1, At, B1); PG8_BAR; PG8_SCHED;
            PG8_LDB(B0, 1, 0); PG8_LDB(B1, 1, 1); PG8_SCHED; PG8_LDA(At, 1, 0); PG8_STAGE(PG8_SA(0, 1), a2 + hstep, voffA);
            PG8_WAIT_V(8); PG8_WAIT_L(0); PG8_BAR; PG8_MMA(0, 0, At, B0); PG8_MMA(0, 1, At, B1); PG8_BAR; PG8_SCHED;
            PG8_LDA(At, 1, 1); PG8_STAGE(PG8_SB(1, 0), b3, voffB); PG8_STAGE(PG8_SB(1, 1), b3 + hstep, voffB); PG8_STAGE(PG8_SA(1, 0), a3, voffA);
            PG8_WAIT_V(8); PG8_WAIT_L(0); PG8_BAR; PG8_MMA(1, 0, At, B0); PG8_MMA(1, 1, At, B1); PG8_BAR; PG8_SCHED;
            } else {
            PG8_LDB(B0, 0, 0); PG8_SCHED; PG8_LDA(At, 0, 0); PG8_STAGE(PG8_SA(1, 1), a1 + hstep, voffA);
            PG8_WAIT_L(8); PG8_BAR; PG8_WAIT_L(0); PG8_MMA(0, 0, At, B0); PG8_BAR; PG8_SCHED;
            PG8_LDB(B1, 0, 1); PG8_STAGE(PG8_SB(0, 0), b2, voffB);
            PG8_BAR; PG8_WAIT_L(0); PG8_MMA(0, 1, At, B1); PG8_BAR;
            PG8_LDA(At, 0, 1); PG8_STAGE(PG8_SA(0, 0), a2, voffA);
            PG8_BAR; PG8_WAIT_L(0); PG8_MMA(1, 0, At, B0); PG8_BAR; PG8_SCHED;
            PG8_STAGE(PG8_SB(0, 1), b2 + hstep, voffB);
            PG8_WAIT_V(6); PG8_BAR; PG8_MMA(1, 1, At, B1); PG8_BAR;
            PG8_LDB(B0, 1, 0); PG8_SCHED; PG8_LDA(At, 1, 0); PG8_STAGE(PG8_SA(0, 1), a2 + hstep, voffA);
            PG8_WAIT_L(8); PG8_BAR; PG8_WAIT_L(0); PG8_MMA(0, 0, At, B0); PG8_BAR; PG8_SCHED;
            PG8_LDB(B1, 1, 1); PG8_STAGE(PG8_SB(1, 0), b3, voffB);
            PG8_BAR; PG8_WAIT_L(0); PG8_MMA(0, 1, At, B1); PG8_BAR;
            PG8_LDA(At, 1, 1); PG8_STAGE(PG8_SA(1, 0), a3, voffA);
            PG8_BAR; PG8_WAIT_L(0); PG8_MMA(1, 0, At, B0); PG8_BAR; PG8_SCHED;
            PG8_STAGE(PG8_SB(1, 1), b3 + hstep, voffB);
            PG8_WAIT_V(6); PG8_BAR; PG8_MMA(1, 1, At, B1); PG8_BAR;
            }
        }
        if constexpr (ALIGN_EPI) { if (wr == 0) PG8_BAR; }
        if constexpr (!Epi::AFTER_DRAIN) { E(acc, cur, wr, wc, fr, fq); S.done(cur); }
        if (!has_next) break;
#pragma unroll
        for (int a = 0; a < 2; ++a)
#pragma unroll
            for (int b = 0; b < 2; ++b)
#pragma unroll
                for (int m = 0; m < 4; ++m)
#pragma unroll
                    for (int n = 0; n < 2; ++n) acc[a][b][m][n] = (f32x4){0.f, 0.f, 0.f, 0.f};
        cur = nxt; cA = nA; cB = nB; ++ui;
        if constexpr (ALIGN_EPI) { if (wr == 1) PG8_BAR; }
    }
    PG8_WAIT_V(0);
    if constexpr (!ALIGN_EPI) { if (wr == 0) PG8_BAR; }
    PG8_BAR;
    if constexpr (Epi::AFTER_DRAIN) { E.fused(acc, cur, wr, wc, fr, fq, lds, wid, lane); S.done(cur); }
#undef PG8_SA
#undef PG8_SB
#undef PG8_STAGE
#undef PG8_LDA
#undef PG8_LDB
#undef PG8_MMA
#undef PG8_WAIT_V
#undef PG8_WAIT_L
#undef PG8_BAR
#undef PG8_SCHED
}
}

constexpr int NWAVES = 8;
constexpr int RING_BYTES = 131072, LDSCTL_OFF = RING_BYTES, MISC_OFF = LDSCTL_OFF + 320, RSTD_OFF = RING_BYTES + 1024, LDS_BYTES = 147456;
constexpr int CW_BAR = 4096;
#define GAS __attribute__((address_space(1)))
#define LAS __attribute__((address_space(3)))
typedef GAS unsigned gu32;
#define RLX_AGENT __ATOMIC_RELAXED, __HIP_MEMORY_SCOPE_AGENT
#define XB_TMO      128
#define XB_XCNT(j)  (256  + 64 * (j))
#define XB_XSUB(j)  (1280 + 64 * (j))
#define XB_XGEN(j)  (2304 + 64 * (j))
#define XB_TOP      3328
#define XB_TOPGEN   3392
#define XCD_BAR_WORDS 3456
#define XB_SPIN_CAP (1u << 18)

__device__ __forceinline__ unsigned xb_ld(unsigned* p)              { return __hip_atomic_load(p, __ATOMIC_RELAXED, __HIP_MEMORY_SCOPE_AGENT); }
__device__ __forceinline__ unsigned xb_add(unsigned* p, unsigned v) { return __hip_atomic_fetch_add(p, v, __ATOMIC_RELAXED, __HIP_MEMORY_SCOPE_AGENT); }
__device__ __forceinline__ unsigned xb_xcc_id() { return (unsigned)__builtin_amdgcn_s_getreg((3 << 11) | 20) & 0xFu; }
#define XB_SPIN(cond, bar) do { unsigned _sp = 0; while (cond) { __builtin_amdgcn_s_sleep(1); \
    if ((++_sp & 255u) == 0u) { if (xb_ld(&(bar)[XB_TMO])) break; if (_sp > XB_SPIN_CAP) { atomicAdd(&(bar)[XB_TMO], 1u); break; } } } } while (0)

struct XcdBarrier {
    unsigned* bar; unsigned x;
    volatile LAS unsigned* st;
};

__device__ __forceinline__ XcdBarrier xcd_barrier_post(unsigned* bar, volatile LAS unsigned* st) {
    XcdBarrier b; b.bar = bar; b.x = xb_xcc_id(); b.st = st;
    if (threadIdx.x == 0) (void)xb_add(&bar[XB_XCNT(b.x)], 1u);
    return b;
}
__device__ __forceinline__ void xcd_barrier_complete(unsigned* bar, unsigned x, unsigned& nloc, unsigned& nx) {
    const unsigned G = gridDim.x * gridDim.y * gridDim.z;
    unsigned sum, cnt, mine, sp = 0u;
    for (;;) {
        sum = 0u; cnt = 0u; mine = 0u;
#pragma unroll
        for (unsigned j = 0; j < 16; ++j) { const unsigned c = xb_ld(&bar[XB_XCNT(j)]); sum += c; cnt += (c > 0u) ? 1u : 0u; mine = (j == x) ? c : mine; }
        if (sum == G) break;
        __builtin_amdgcn_s_sleep(1);
        if ((++sp & 255u) == 0u) { if (xb_ld(&bar[XB_TMO])) break; if (sp > XB_SPIN_CAP) { atomicAdd(&bar[XB_TMO], 1u); break; } }
    }
    nloc = mine > 0u ? mine : 1u; nx = cnt > 0u ? cnt : 1u;
}

__device__ __forceinline__ void xcd_barrier(const XcdBarrier& b) {
    asm volatile("s_waitcnt vmcnt(0)" ::: "memory");
    __syncthreads();
    if (threadIdx.x == 0) {
        unsigned* bar = b.bar;
        __builtin_amdgcn_s_waitcnt(0);
        unsigned nloc = b.st[0], nx = b.st[1];
        if (nloc == 0u) { xcd_barrier_complete(bar, b.x, nloc, nx); b.st[0] = nloc; b.st[1] = nx; }
        const unsigned old = xb_add(&bar[XB_XSUB(b.x)], 1u);
        const unsigned gen = old / nloc;
        if (old + 1u == (gen + 1u) * nloc) {
            __builtin_amdgcn_fence(__ATOMIC_RELEASE, "agent");
            asm volatile("s_waitcnt vmcnt(0)" ::: "memory");
            const unsigned og = xb_add(&bar[XB_TOP], 1u);
            const unsigned tg = og / nx;
            if (og + 1u == (tg + 1u) * nx) xb_add(&bar[XB_TOPGEN], 1u);
            else XB_SPIN(xb_ld(&bar[XB_TOPGEN]) == tg, bar);
            __builtin_amdgcn_fence(__ATOMIC_ACQUIRE, "agent");
            xb_add(&bar[XB_XGEN(b.x)], 1u);
            asm volatile("s_waitcnt vmcnt(0)" ::: "memory");
        } else {
            XB_SPIN(xb_ld(&bar[XB_XGEN(b.x)]) == gen, bar);
            __builtin_amdgcn_fence(__ATOMIC_ACQUIRE, "agent");
            asm volatile("s_waitcnt vmcnt(0)" ::: "memory");
        }
    }
    __syncthreads();
}

constexpr size_t WS_RSSP = WS_RSS;
constexpr size_t WS_KMEAN2 = 230 * MiB;
constexpr size_t WS_DL = 230 * MiB + 256 * 1024;
constexpr size_t WS_YC = WS_MQ;
constexpr size_t WS_YA = WS_SR;
constexpr size_t WS_S2 = 232 * MiB;
constexpr size_t WS_END2 = 248 * MiB;


namespace mix {
typedef unsigned u32x4 __attribute__((ext_vector_type(4)));
typedef unsigned u32x2 __attribute__((ext_vector_type(2)));
#define MIX_LAS __attribute__((address_space(3)))
using pg8::pack8; using pg8::unpack8; using pg8::cvt_pk_bf16;
#define MIX_BAR() do { asm volatile("s_waitcnt vmcnt(0) lgkmcnt(0)" ::: "memory"); __builtin_amdgcn_s_barrier(); asm volatile("" ::: "memory"); } while (0)

__device__ __forceinline__ void prepass_item(unsigned char* ws, const float* qw, const float* kw, int b, int blk, int h, MIX_LAS float* part, int tid, int lane, int wave) {
    const int sub = lane >> 4, c8 = (lane & 15) * 8;
    f32x4 qw0 = *(const f32x4*)(qw + c8) * QSCALE, qw1 = *(const f32x4*)(qw + c8 + 4) * QSCALE; const f32x4 kw0 = *(const f32x4*)(kw + c8), kw1 = *(const f32x4*)(kw + c8 + 4);
    f32x4 cs0 = {0.f, 0.f, 0.f, 0.f}, cs1 = cs0;
    bf16_t* MQ = (bf16_t*)(ws + WS_MQ); bf16_t* MK = (bf16_t*)(ws + WS_MK);
#pragma unroll 4
    for (int it = 0; it < 8; ++it) {
        const size_t off = ((size_t)b * SEQ + blk * 256 + wave * 32 + it * 4 + sub) * 512 + h * 128 + c8;
        { f32x4 a, c; unpack8(*(const u32x4*)(MQ + off), a, c); float ss = ((a[0] * a[0] + a[1] * a[1]) + (a[2] * a[2] + a[3] * a[3])) + ((c[0] * c[0] + c[1] * c[1]) + (c[2] * c[2] + c[3] * c[3]));
          ss += __shfl_xor(ss, 1); ss += __shfl_xor(ss, 2); ss += __shfl_xor(ss, 4); ss += __shfl_xor(ss, 8); const float rs = rsqrtf(ss * (1.f / 128.f) + EPS);
          *(u32x4*)(MQ + off) = pack8(a * rs * qw0, c * rs * qw1); }
        { f32x4 a, c; unpack8(*(const u32x4*)(MK + off), a, c); float ss = ((a[0] * a[0] + a[1] * a[1]) + (a[2] * a[2] + a[3] * a[3])) + ((c[0] * c[0] + c[1] * c[1]) + (c[2] * c[2] + c[3] * c[3]));
          ss += __shfl_xor(ss, 1); ss += __shfl_xor(ss, 2); ss += __shfl_xor(ss, 4); ss += __shfl_xor(ss, 8); const float rs = rsqrtf(ss * (1.f / 128.f) + EPS);
          a = a * rs * kw0; c = c * rs * kw1; cs0 += a; cs1 += c; *(u32x4*)(MK + off) = pack8(a, c); }
    }
#pragma unroll
    for (int j = 0; j < 4; ++j) { cs0[j] += __shfl_xor(cs0[j], 16); cs0[j] += __shfl_xor(cs0[j], 32); cs1[j] += __shfl_xor(cs1[j], 16); cs1[j] += __shfl_xor(cs1[j], 32); }
    if (sub == 0) { *(MIX_LAS f32x4*)(part + wave * 128 + c8) = cs0; *(MIX_LAS f32x4*)(part + wave * 128 + c8 + 4) = cs1; }
    MIX_BAR();
    if (tid < 128) { float s = 0.f;
#pragma unroll
        for (int w = 0; w < 8; ++w) s += part[w * 128 + tid];
        ((float*)(ws + WS_KMEAN))[(((size_t)b * 4 + h) * 8 + blk) * 128 + tid] = s * (1.f / 256.f); }
    MIX_BAR();
}

constexpr int PSTR = 272;
__device__ __forceinline__ void pool_item(unsigned char* ws, const float* pscale, int pm, int g, MIX_LAS unsigned char* lds, int tid, int lane, int wave) {
    MIX_LAS unsigned char* P = lds; MIX_LAS unsigned char* W = lds + 256 * PSTR;
    const bf16_t* PW = (const bf16_t*)(ws + WS_W + W_PW) + g * 128 * 128;
#pragma unroll
    for (int j = 0; j < 4; ++j) { const int id = tid + 512 * j, e = id >> 4, cc = id & 15; *(MIX_LAS u32x4*)(W + e * PSTR + cc * 16) = *(const u32x4*)(PW + e * 128 + cc * 8); }
    {
        const int cp = tid & 63, seg = tid >> 6, w = 2 << g; const int row0 = pm * 256 + seg * 32, t0 = row0 & (SEQ - 1);
        const unsigned* PU = (const unsigned*)(ws + WS_PU) + g * 64 + cp;
        float s0 = 0.f, s1 = 0.f;
        for (int j = 1; j < w; ++j) if (t0 - j >= 0) { const unsigned v = PU[(size_t)(row0 - j) * 256]; s0 += __uint_as_float(v << 16); s1 += __uint_as_float(v & 0xffff0000u); }
#pragma unroll 8
        for (int r = 0; r < 32; ++r) {
            const int t = t0 + r; const unsigned v = PU[(size_t)(row0 + r) * 256]; const float u0 = __uint_as_float(v << 16), u1 = __uint_as_float(v & 0xffff0000u);
            s0 += u0; s1 += u1; const float ic = 1.f / (float)min(t + 1, w);
            *(MIX_LAS unsigned*)(P + (seg * 32 + r) * PSTR + cp * 4) = cvt_pk_bf16(s0 * ic - u0, s1 * ic - u1);
            if (t - w + 1 >= 0) { const unsigned o = PU[(size_t)(row0 + r - w + 1) * 256]; s0 -= __uint_as_float(o << 16); s1 -= __uint_as_float(o & 0xffff0000u); }
        }
    }
    MIX_BAR();
    f32x4 acc[8][2];
#pragma unroll
    for (int n = 0; n < 8; ++n) { acc[n][0] = (f32x4){0.f, 0.f, 0.f, 0.f}; acc[n][1] = acc[n][0]; }
    const int r = lane & 15, q = lane >> 4;
#pragma unroll
    for (int kk = 0; kk < 4; ++kk) {
        bf16x8 pf[2];
#pragma unroll
        for (int m = 0; m < 2; ++m) pf[m] = *(const MIX_LAS bf16x8*)(P + (wave * 32 + m * 16 + r) * PSTR + (kk * 32 + 8 * q) * 2);
#pragma unroll
        for (int n = 0; n < 8; ++n) { const bf16x8 wf = *(const MIX_LAS bf16x8*)(W + (n * 16 + r) * PSTR + (kk * 32 + 8 * q) * 2);
#pragma unroll
            for (int m = 0; m < 2; ++m) acc[n][m] = __builtin_amdgcn_mfma_f32_16x16x32_bf16(wf, pf[m], acc[n][m], 0, 0, 0); }
    }
    bf16_t* YB = (bf16_t*)(ws + WS_YB);
#pragma unroll
    for (int n = 0; n < 8; ++n) { const f32x4 sc = *(const f32x4*)(pscale + g * 128 + n * 16 + 4 * q);
#pragma unroll
        for (int m = 0; m < 2; ++m) { const f32x4 y = acc[n][m] * sc; u32x2 o; o.x = cvt_pk_bf16(y[0], y[1]); o.y = cvt_pk_bf16(y[2], y[3]);
            *(u32x2*)(YB + (size_t)(pm * 256 + wave * 32 + m * 16 + r) * 512 + g * 128 + n * 16 + 4 * q) = o; } }
    MIX_BAR();
}

constexpr int GSTR = 144;
constexpr int GL_SEG = 0, GL_QE = 2048, GL_KE = GL_QE + 64 * GSTR, GL_VT = GL_KE + 64 * GSTR, GL_P = GL_VT + 128 * GSTR, GL_RED = GL_P + 64 * GSTR;
__device__ __forceinline__ void gla_cumsum(const float* GG, size_t row0, int h, MIX_LAS unsigned char* lds, int d, int seg, float (&bc)[8], float& bL) {
    const float* g = GG + (row0 + seg * 8) * 256 + h * 64 + d; float c = 0.f;
#pragma unroll
    for (int j = 0; j < 8; ++j) { c += g[j * 256]; bc[j] = c; }
    MIX_LAS float* SEG = (MIX_LAS float*)(lds + GL_SEG); SEG[seg * 64 + d] = c;
    MIX_BAR();
    float off = 0.f, tot = 0.f;
#pragma unroll
    for (int s = 0; s < 8; ++s) { const float v = SEG[s * 64 + d]; tot += v; off += (s < seg) ? v : 0.f; }
#pragma unroll
    for (int j = 0; j < 8; ++j) bc[j] += off;
    bL = tot;
}
__device__ __forceinline__ void gla_vt(const bf16_t* GV, size_t row0, int h, MIX_LAS unsigned char* lds, int tid) {
    const int e = tid & 127, tq = tid >> 7; const bf16_t* v = GV + (row0 + tq * 16) * 512 + h * 128 + e; unsigned w[8];
#pragma unroll
    for (int j = 0; j < 8; ++j) w[j] = (unsigned)v[(2 * j) * 512] | ((unsigned)v[(2 * j + 1) * 512] << 16);
    MIX_LAS u32x4* p = (MIX_LAS u32x4*)(lds + GL_VT + e * GSTR + tq * 32); p[0] = (u32x4){w[0], w[1], w[2], w[3]}; p[1] = (u32x4){w[4], w[5], w[6], w[7]};
}
__device__ __forceinline__ void gla_passA_item(unsigned char* ws, int cid, MIX_LAS unsigned char* lds, int tid, int lane, int wave) {
    const int d = tid & 63, seg = tid >> 6, bh = cid >> 5, n = cid & 31, b = bh >> 2, h = bh & 3; const size_t row0 = (size_t)b * SEQ + n * 64;
    float bc[8], bL;
    const bf16_t* gk = (const bf16_t*)(ws + WS_GK) + (row0 + seg * 8) * 256 + h * 64 + d; float kv[8];
#pragma unroll
    for (int j = 0; j < 8; ++j) kv[j] = bf2f(gk[j * 256]);
    gla_vt((const bf16_t*)(ws + WS_GV), row0, h, lds, tid);
    gla_cumsum((const float*)(ws + WS_GG), row0, h, lds, d, seg, bc, bL);
    { f32x4 a, c;
#pragma unroll
      for (int j = 0; j < 4; ++j) { a[j] = kv[j] * __expf(bL - bc[j]); c[j] = kv[4 + j] * __expf(bL - bc[4 + j]); }
      *(MIX_LAS u32x4*)(lds + GL_KE + d * GSTR + seg * 16) = pack8(a, c); }
    if (seg == 0) ((float*)(ws + WS_DL))[(size_t)cid * 64 + d] = __expf(bL);
    MIX_BAR();
    const int r = lane & 15, q = lane >> 4; f32x4 acc[4];
#pragma unroll
    for (int dt = 0; dt < 4; ++dt) acc[dt] = (f32x4){0.f, 0.f, 0.f, 0.f};
#pragma unroll
    for (int kk = 0; kk < 2; ++kk) { const bf16x8 vf = *(const MIX_LAS bf16x8*)(lds + GL_VT + (wave * 16 + r) * GSTR + (kk * 32 + 8 * q) * 2);
#pragma unroll
        for (int dt = 0; dt < 4; ++dt) { const bf16x8 kf = *(const MIX_LAS bf16x8*)(lds + GL_KE + (dt * 16 + r) * GSTR + (kk * 32 + 8 * q) * 2);
            acc[dt] = __builtin_amdgcn_mfma_f32_16x16x32_bf16(kf, vf, acc[dt], 0, 0, 0); } }
    bf16_t* US = (bf16_t*)(ws + WS_US) + ((size_t)cid * 128 + wave * 16 + r) * 64;
#pragma unroll
    for (int dt = 0; dt < 4; ++dt) { u32x2 o; o.x = cvt_pk_bf16(acc[dt][0], acc[dt][1]); o.y = cvt_pk_bf16(acc[dt][2], acc[dt][3]); *(u32x2*)(US + dt * 16 + 4 * q) = o; }
    MIX_BAR();
}
__device__ __forceinline__ void gla_scan(unsigned char* ws, int gtid) {
    const int bh = gtid >> 12, e = (gtid >> 5) & 127, dp = gtid & 31;
    const size_t uoff = (((size_t)bh * 32) * 128 + e) * 32 + dp; const unsigned* US = (const unsigned*)(ws + WS_US) + uoff; unsigned* S2 = (unsigned*)(ws + WS_S2) + uoff; const float* DLp = (const float*)(ws + WS_DL) + (size_t)bh * 32 * 64 + 2 * dp;
    float s0 = 0.f, s1 = 0.f;
#pragma unroll 8
    for (int n = 0; n < 32; ++n) { const unsigned u = US[(size_t)n * 128 * 32]; const float d0 = DLp[n * 64], d1 = DLp[n * 64 + 1];
        S2[(size_t)n * 128 * 32] = cvt_pk_bf16(s0, s1);
        s0 = d0 * s0 + __uint_as_float(u << 16); s1 = d1 * s1 + __uint_as_float(u & 0xffff0000u); }
}
__device__ __forceinline__ void gla_passC_item(unsigned char* ws, const float* nw, int cid, MIX_LAS unsigned char* lds, int tid, int lane, int wave, size_t ya_off) {
    const int d = tid & 63, seg = tid >> 6, bh = cid >> 5, n = cid & 31, b = bh >> 2, h = bh & 3; const size_t row0 = (size_t)b * SEQ + n * 64;
    float bc[8], bL;
    const bf16_t* gk = (const bf16_t*)(ws + WS_GK) + (row0 + seg * 8) * 256 + h * 64 + d; const bf16_t* gq = (const bf16_t*)(ws + WS_GQ) + (row0 + seg * 8) * 256 + h * 64 + d; float kv[8], qv[8];
#pragma unroll
    for (int j = 0; j < 8; ++j) { kv[j] = bf2f(gk[j * 256]); qv[j] = bf2f(gq[j * 256]); }
    const int r = lane & 15, q = lane >> 4, it2 = wave & 3, eh = wave >> 2;
    bf16x8 sfr[4][2]; { const bf16_t* ST = (const bf16_t*)(ws + WS_S2) + (size_t)cid * 128 * 64;
#pragma unroll
        for (int nn = 0; nn < 4; ++nn)
#pragma unroll
            for (int kk = 0; kk < 2; ++kk) sfr[nn][kk] = *(const bf16x8*)(ST + ((eh * 4 + nn) * 16 + r) * 64 + kk * 32 + 8 * q); }
    const size_t yoff = (row0 + it2 * 16 + r) * 512 + h * 128 + eh * 64 + 4 * q; u32x2 srv[4];
#pragma unroll
    for (int nn = 0; nn < 4; ++nn) srv[nn] = *(const u32x2*)((const bf16_t*)(ws + WS_SR) + yoff + nn * 16);
    gla_vt((const bf16_t*)(ws + WS_GV), row0, h, lds, tid);
    gla_cumsum((const float*)(ws + WS_GG), row0, h, lds, d, seg, bc, bL);
#pragma unroll
    for (int j = 0; j < 8; ++j) { const float ex = __expf(bc[j]);
        *(MIX_LAS bf16_t*)(lds + GL_QE + (seg * 8 + j) * GSTR + 2 * d) = f2bf(qv[j] * ex);
        *(MIX_LAS bf16_t*)(lds + GL_KE + (seg * 8 + j) * GSTR + 2 * d) = f2bf(kv[j] * __expf(-bc[j])); }
    MIX_BAR();
    {
        const int it = wave >> 1;
#pragma unroll
        for (int jj = 0; jj < 2; ++jj) { const int jt = 2 * (wave & 1) + jj; f32x4 acc = {0.f, 0.f, 0.f, 0.f};
            if (jt <= it) {
#pragma unroll
                for (int kk = 0; kk < 2; ++kk) { const bf16x8 qf = *(const MIX_LAS bf16x8*)(lds + GL_QE + (it * 16 + r) * GSTR + (kk * 32 + 8 * q) * 2);
                    const bf16x8 kf = *(const MIX_LAS bf16x8*)(lds + GL_KE + (jt * 16 + r) * GSTR + (kk * 32 + 8 * q) * 2);
                    acc = __builtin_amdgcn_mfma_f32_16x16x32_bf16(qf, kf, acc, 0, 0, 0); }
                if (jt == it) {
#pragma unroll
                    for (int x = 0; x < 4; ++x) if (r > 4 * q + x) acc[x] = 0.f; } }
#pragma unroll
            for (int x = 0; x < 4; ++x) *(MIX_LAS bf16_t*)(lds + GL_P + (it * 16 + 4 * q + x) * GSTR + (jt * 16 + r) * 2) = f2bf(acc[x]); }
    }
    MIX_BAR();
    const int it = it2; f32x4 acc[4];
    {
        bf16x8 pf[2], qf[2];
#pragma unroll
        for (int kk = 0; kk < 2; ++kk) { pf[kk] = *(const MIX_LAS bf16x8*)(lds + GL_P + (it * 16 + r) * GSTR + (kk * 32 + 8 * q) * 2); qf[kk] = *(const MIX_LAS bf16x8*)(lds + GL_QE + (it * 16 + r) * GSTR + (kk * 32 + 8 * q) * 2); }
#pragma unroll
        for (int nn = 0; nn < 4; ++nn) { const int et = eh * 4 + nn; acc[nn] = (f32x4){0.f, 0.f, 0.f, 0.f};
#pragma unroll
            for (int kk = 0; kk < 2; ++kk) { const bf16x8 vf = *(const MIX_LAS bf16x8*)(lds + GL_VT + (et * 16 + r) * GSTR + (kk * 32 + 8 * q) * 2);
                const bf16x8 sf = sfr[nn][kk];
                acc[nn] = __builtin_amdgcn_mfma_f32_16x16x32_bf16(vf, pf[kk], acc[nn], 0, 0, 0);
                acc[nn] = __builtin_amdgcn_mfma_f32_16x16x32_bf16(sf, qf[kk], acc[nn], 0, 0, 0); } }
    }
    float ss = 0.f;
#pragma unroll
    for (int nn = 0; nn < 4; ++nn) ss += (acc[nn][0] * acc[nn][0] + acc[nn][1] * acc[nn][1]) + (acc[nn][2] * acc[nn][2] + acc[nn][3] * acc[nn][3]);
    ss += __shfl_xor(ss, 16); ss += __shfl_xor(ss, 32);
    MIX_LAS float* RED = (MIX_LAS float*)(lds + GL_RED);
    if (q == 0) RED[eh * 64 + it * 16 + r] = ss;
    MIX_BAR();
    const float rstd = rsqrtf((RED[it * 16 + r] + RED[64 + it * 16 + r]) * (1.f / 128.f) + EPS);
    bf16_t* YA = (bf16_t*)(ws + ya_off) + yoff;
#pragma unroll
    for (int nn = 0; nn < 4; ++nn) { const u32x2 sr = srv[nn]; const f32x4 w4 = *(const f32x4*)(nw + eh * 64 + nn * 16 + 4 * q);
        const float y0 = acc[nn][0] * rstd * w4[0] * __uint_as_float(sr.x << 16), y1 = acc[nn][1] * rstd * w4[1] * __uint_as_float(sr.x & 0xffff0000u);
        const float y2 = acc[nn][2] * rstd * w4[2] * __uint_as_float(sr.y << 16), y3 = acc[nn][3] * rstd * w4[3] * __uint_as_float(sr.y & 0xffff0000u);
        u32x2 o; o.x = cvt_pk_bf16(y0, y1); o.y = cvt_pk_bf16(y2, y3); *(u32x2*)(YA + nn * 16) = o; }
    MIX_BAR();
}
}

namespace moba {
typedef short s16x4 __attribute__((ext_vector_type(4)));
typedef float f32x16 __attribute__((ext_vector_type(16)));
typedef unsigned u32x4 __attribute__((ext_vector_type(4)));
using pg8::cvt_pk_bf16;
constexpr int D = 128, LD = 512, NW = 8, QBLK = 32, KVBLK = 128, QB = 256;
constexpr int SHM_V = KVBLK * D * 2, SHM_K = KVBLK * D * 2;
constexpr int LDS_WS = 131072 + 1024, LDS_TAB = LDS_WS + NW * 64 * 4, LDS_BYTES = LDS_TAB + 512;
constexpr float THR2 = 11.5f;
#define KSWZ(row, colB) ((row) * 256 + ((colB) ^ (((row) & 7) << 4)))
#define SBAR() __builtin_amdgcn_sched_barrier(0)
__device__ __forceinline__ int v_st(int k, int c) { const int kk = (k & ~0xC) | ((k & 4) << 1) | ((k & 8) >> 1); return ((kk >> 3) * 4 + (c >> 5)) * 512 + ((kk & 7) * 32 + (c & 31)) * 2; }
__device__ __forceinline__ int v_rd_base(int lane) { return ((lane & 3) << 3) | (((lane >> 2) & 3) << 6) | (((lane >> 4) & 1) << 5) | (((lane >> 5) & 1) << 8); }
constexpr int v_rd_off(int d0, int ks, int half) { return d0 * 512 + ks * 4096 + half * 2048; }
__device__ __forceinline__ int crow(int r, int hi) { return (r & 3) + 8 * (r >> 2) + 4 * hi; }
__device__ __forceinline__ bf16x8 load8(const bf16_t* p) { return *reinterpret_cast<const bf16x8*>(p); }

__device__ __forceinline__ void partialSM(f32x16& p0, f32x16& p1, float& m_reg, float& mn, float& alpha) {
    float pmax = p0[0];
#pragma unroll
    for (int r = 1; r < 16; ++r) pmax = fmaxf(pmax, p0[r]);
#pragma unroll
    for (int r = 0; r < 16; ++r) pmax = fmaxf(pmax, p1[r]);
    { auto rr = __builtin_amdgcn_permlane32_swap(__float_as_uint(pmax), __float_as_uint(pmax), false, false); pmax = fmaxf(__uint_as_float(rr[0]), __uint_as_float(rr[1])); }
    if (__builtin_expect(__all((pmax - m_reg) <= THR2), 1)) { mn = m_reg; alpha = 1.f; }
    else { mn = fmaxf(m_reg, pmax); alpha = __builtin_amdgcn_exp2f(m_reg - mn); m_reg = mn; }
#pragma unroll
    for (int r = 0; r < 16; ++r) p0[r] = p0[r] - mn;
#pragma unroll
    for (int r = 0; r < 16; ++r) p1[r] = p1[r] - mn;
#pragma unroll
    for (int r = 0; r < 16; ++r) p0[r] = __builtin_amdgcn_exp2f(p0[r]);
}
__device__ __forceinline__ void finishSM(f32x16& p0, f32x16& p1, float alpha, float& l_reg, bf16x8& pa0, bf16x8& pa1, bf16x8& pa2, bf16x8& pa3) {
#pragma unroll
    for (int r = 0; r < 16; ++r) p1[r] = __builtin_amdgcn_exp2f(p1[r]);
    float ps = 0;
#pragma unroll
    for (int r = 0; r < 16; ++r) ps += p0[r];
#pragma unroll
    for (int r = 0; r < 16; ++r) ps += p1[r];
    { auto rr = __builtin_amdgcn_permlane32_swap(__float_as_uint(ps), __float_as_uint(ps), false, false); ps = __uint_as_float(rr[0]) + __uint_as_float(rr[1]); }
    l_reg = l_reg * alpha + ps;
#define PK4(P, B_, OUT) do { unsigned a0 = cvt_pk_bf16(P[B_+0], P[B_+1]), a1 = cvt_pk_bf16(P[B_+2], P[B_+3]);                          \
        unsigned b0 = cvt_pk_bf16(P[B_+4], P[B_+5]), b1 = cvt_pk_bf16(P[B_+6], P[B_+7]);                                             \
        auto r0 = __builtin_amdgcn_permlane32_swap(a0, b0, false, false); auto r1 = __builtin_amdgcn_permlane32_swap(a1, b1, false, false); \
        u32x4 w = {r0[0], r1[0], r0[1], r1[1]}; OUT = *reinterpret_cast<bf16x8*>(&w); } while (0)
    PK4(p0, 0, pa0); PK4(p0, 8, pa1); PK4(p1, 0, pa2); PK4(p1, 8, pa3);
#undef PK4
}
template <int KB>
__device__ __forceinline__ void qkt(f32x16& p0, f32x16& p1, const char* K_lds, int krow, int hi, const bf16x8* qr, bool act) {
    if (!act) { const float NEG = -__builtin_inff();
#pragma unroll
        for (int r = 0; r < 16; ++r) { p0[r] = NEG; p1[r] = NEG; } return; }
    p0 = f32x16{}; p1 = f32x16{};
    const char* kb[4];
#pragma unroll
    for (int dd = 0; dd < 4; ++dd) kb[dd] = K_lds + KB * SHM_K + KSWZ(krow, (dd * 16 + hi * 8) * 2);
#pragma unroll
    for (int d0 = 0; d0 < 8; ++d0) { const char* a = kb[d0 & 3] + (d0 >> 2) * 128;
        bf16x8 b0 = *reinterpret_cast<const bf16x8*>(a);
        bf16x8 b1 = *reinterpret_cast<const bf16x8*>(a + 32 * 256);
        p0 = __builtin_amdgcn_mfma_f32_32x32x16_bf16(b0, qr[d0], p0, 0, 0, 0);
        p1 = __builtin_amdgcn_mfma_f32_32x32x16_bf16(b1, qr[d0], p1, 0, 0, 0); }
}
template <int VB>
__device__ __forceinline__ void pv_tile(f32x16* o, int vb0, bf16x8 pa0, bf16x8 pa1, bf16x8 pa2, bf16x8 pa3, bool act) {
    if (!act) return;
#define TRRD(dst, off) asm volatile("ds_read_b64_tr_b16 %0, %1 offset:%2" : "=&v"(dst) : "v"(vb0), "i"(off) : "memory")
#define PV_D0(d0) do { s16x4 l0, l1, l2, l3, h0, h1, h2, h3; constexpr int b_ = VB * SHM_V + v_rd_off(d0, 0, 0); \
        TRRD(l0, b_); TRRD(h0, b_ + 2048); TRRD(l1, b_ + 4096); TRRD(h1, b_ + 6144); TRRD(l2, b_ + 8192); TRRD(h2, b_ + 10240); TRRD(l3, b_ + 12288); TRRD(h3, b_ + 14336); \
        asm volatile("s_waitcnt lgkmcnt(0)" ::: "memory"); SBAR();   \
        o[d0] = __builtin_amdgcn_mfma_f32_32x32x16_bf16(pa0, (bf16x8){l0[0], l0[1], l0[2], l0[3], h0[0], h0[1], h0[2], h0[3]}, o[d0], 0, 0, 0);   \
        o[d0] = __builtin_amdgcn_mfma_f32_32x32x16_bf16(pa1, (bf16x8){l1[0], l1[1], l1[2], l1[3], h1[0], h1[1], h1[2], h1[3]}, o[d0], 0, 0, 0);   \
        o[d0] = __builtin_amdgcn_mfma_f32_32x32x16_bf16(pa2, (bf16x8){l2[0], l2[1], l2[2], l2[3], h2[0], h2[1], h2[2], h2[3]}, o[d0], 0, 0, 0);   \
        o[d0] = __builtin_amdgcn_mfma_f32_32x32x16_bf16(pa3, (bf16x8){l3[0], l3[1], l3[2], l3[3], h3[0], h3[1], h3[2], h3[3]}, o[d0], 0, 0, 0); } while (0)
    PV_D0(0); PV_D0(1); PV_D0(2); PV_D0(3);
#undef PV_D0
#undef TRRD
}
__device__ __forceinline__ void mask_bias_tile(f32x16& p0, f32x16& p1, int dq, const float* tab) {
    const float NEG = -__builtin_inff();
#pragma unroll
    for (int r = 0; r < 16; ++r) { const int c = (r & 3) + 8 * (r >> 2); const int d0 = dq - c, d1 = dq - c - 32;
        p0[r] = d0 < 0 ? NEG : p0[r] + tab[d0 > 113 ? 113 : d0];
        p1[r] = d1 < 0 ? NEG : p1[r] + tab[d1 > 113 ? 113 : d1]; }
}
__device__ __forceinline__ void bias_tile(f32x16& p0, f32x16& p1, int dq, const float* tab) {
#pragma unroll
    for (int r = 0; r < 16; ++r) { const int c = (r & 3) + 8 * (r >> 2); const int d0 = dq - c, d1 = dq - c - 32;
        p0[r] += tab[d0 > 113 ? 113 : d0]; p1[r] += tab[d1 > 113 ? 113 : d1]; }
}
__device__ __forceinline__ void kill_tile(f32x16& p0, f32x16& p1, bool ok) {
    const float NEG = -__builtin_inff();
#pragma unroll
    for (int r = 0; r < 16; ++r) { p0[r] = ok ? p0[r] : NEG; p1[r] = ok ? p1[r] : NEG; }
}

struct BlockRef { const bf16_t* Q; const bf16_t* K; const bf16_t* V; bf16_t* O; const float* km; int P0; };
struct Seam { bf16x8 qr[8]; bf16x8 st_v0, st_v1, st_v2, st_v3, st_k0, st_k1, st_k2, st_k3; };
#define ROW(p, k0, rr) ((p) + (size_t)((k0) + (rr)) * LD + sc)
#define VMW() asm volatile("s_waitcnt vmcnt(0)" ::: "memory")
#define SLOAD_H(Kp, Vp, k0) do { S.st_v0 = load8(ROW(Vp, k0, sr)); S.st_v1 = load8(ROW(Vp, k0, 32 + sr)); S.st_v2 = load8(ROW(Vp, k0, 64 + sr)); S.st_v3 = load8(ROW(Vp, k0, 96 + sr)); \
                                 S.st_k0 = load8(ROW(Kp, k0, sr)); S.st_k1 = load8(ROW(Kp, k0, 32 + sr)); S.st_k2 = load8(ROW(Kp, k0, 64 + sr)); S.st_k3 = load8(ROW(Kp, k0, 96 + sr)); } while (0)
#define SWRITE_HK(bf) do { *(bf16x8*)(K_lds + (bf) * SHM_K + kws) = S.st_k0; *(bf16x8*)(K_lds + (bf) * SHM_K + kws + 32 * 256) = S.st_k1; *(bf16x8*)(K_lds + (bf) * SHM_K + kws + 64 * 256) = S.st_k2; *(bf16x8*)(K_lds + (bf) * SHM_K + kws + 96 * 256) = S.st_k3; } while (0)
#define SWRITE_HV(bf) do { *(bf16x8*)(V_lds + (bf) * SHM_V + vst0) = S.st_v0; *(bf16x8*)(V_lds + (bf) * SHM_V + vst1) = S.st_v1; *(bf16x8*)(V_lds + (bf) * SHM_V + 16384 + vst0) = S.st_v2; *(bf16x8*)(V_lds + (bf) * SHM_V + 16384 + vst1) = S.st_v3; } while (0)
#define SWRITE_H(bf) do { SWRITE_HV(bf); SWRITE_HK(bf); } while (0)
__device__ __forceinline__ void prime(const BlockRef& cur, const float* rel_bias, int h, char* lds, Seam& S, int tid) {
    const int wid = __builtin_amdgcn_readfirstlane(tid >> 6), lane = tid & 63, r32 = lane & 31, hi = lane >> 5, rg = wid & 3;
    const int sr = tid >> 4, sc = (tid & 15) * 8, kws = KSWZ(sr, sc * 2); char* K_lds = lds + 2 * SHM_V;
    __syncthreads();
    if (tid < 128) { int bk = tid; if (tid >= 16) { bk = 16 + (int)(__logf((float)tid * (1.f / 16.f)) * (16.f / 2.0794415416798357f)); bk = bk > 31 ? 31 : bk; }
        ((float*)(lds + LDS_TAB))[tid] = tid >= 113 ? 0.f : (rel_bias[bk * 4 + h] - rel_bias[31 * 4 + h]) * LOG2E; }
#pragma unroll
    for (int d0 = 0; d0 < 8; ++d0) S.qr[d0] = load8(cur.Q + (size_t)(rg * QBLK + r32) * LD + d0 * 16 + hi * 8);
    SLOAD_H(cur.K, cur.V, 0); VMW(); SWRITE_HK(0);
    __syncthreads();
}
__device__ __forceinline__ void block(const BlockRef& cur, char* lds, Seam& S, int tid) {
    const int wid = __builtin_amdgcn_readfirstlane(tid >> 6), lane = tid & 63, r32 = lane & 31, hi = lane >> 5, rg = wid & 3, kh = wid >> 2;
    const int qblk = cur.P0 >> 8, NT = 2 * qblk + 2;
    const int qlo = cur.P0 + rg * QBLK, qm = qlo + r32 - 4 * hi - 64 * kh;
    char* V_lds = lds; char* K_lds = lds + 2 * SHM_V;
    float* ws = (float*)(lds + LDS_WS) + wid * 64; float* li_l = ws, * al_l = ws + 32; const float* tab = (const float*)(lds + LDS_TAB);
    float m_reg = -1e30f, l_reg = 0; f32x16 o[4] = {};
    const int sr = tid >> 4, sc = (tid & 15) * 8, vst0 = v_st(sr, sc), vst1 = v_st(32 + sr, sc), kws = KSWZ(sr, sc * 2);
    const int vb0 = (int)(uintptr_t)V_lds + v_rd_base(lane) + kh * 16384, krow = r32 + 64 * kh;
    const bf16_t* Kh = cur.K; const bf16_t* Vh = cur.V;
    unsigned sel = (1u << qblk) - 1u;
    if (qblk > 3) {
        float s[7];
#pragma unroll
        for (int n = 0; n < 7; ++n) { s[n] = -__builtin_inff();
            if (n < qblk) { float a = 0.f; const float* kmn = cur.km + n * 128 + hi * 8;
#pragma unroll
                for (int d0 = 0; d0 < 8; ++d0) { const f32x4 k0 = *(const f32x4*)(kmn + d0 * 16), k1 = *(const f32x4*)(kmn + d0 * 16 + 4); const bf16x8 qv = S.qr[d0];
#pragma unroll
                    for (int j = 0; j < 4; ++j) { a += __uint_as_float(((unsigned)(unsigned short)qv[j]) << 16) * k0[j]; a += __uint_as_float(((unsigned)(unsigned short)qv[4 + j]) << 16) * k1[j]; } }
                s[n] = a + __shfl_xor(a, 32); } }
        sel = 0u;
#pragma unroll
        for (int c = 0; c < 3; ++c) { float best = -__builtin_inff(); int bi = 0;
#pragma unroll
            for (int n = 0; n < 7; ++n) if (s[n] > best) { best = s[n]; bi = n; }
            sel |= 1u << bi;
#pragma unroll
            for (int n = 0; n < 7; ++n) s[n] = (n == bi) ? -__builtin_inff() : s[n]; }
    }
#define RESC(a) do { if (__any((a) < 1.f)) { if (hi == 0) al_l[r32] = (a); asm volatile("s_waitcnt lgkmcnt(0)" ::: "memory");              \
                     for (int d_ = 0; d_ < 4; ++d_) for (int r = 0; r < 16; ++r) o[d_][r] *= al_l[crow(r, hi)]; } } while (0)
#define KBASE(t) ((t) * KVBLK)
#define ACT(t) ((KBASE(t) >> 8) < qblk ? (__any((sel >> (KBASE(t) >> 8)) & 1u) != 0) : (KBASE(t) + 64 * kh <= qlo + QBLK - 1))
#define MASKT(P0_, P1_, t) do { const int kb_ = KBASE(t); if (ACT(t)) { if ((kb_ >> 8) < qblk) { if (kb_ + 64 * kh + 176 > qlo) bias_tile(P0_, P1_, qm - kb_, tab); kill_tile(P0_, P1_, ((sel >> (kb_ >> 8)) & 1u) != 0u); } \
                                     else mask_bias_tile(P0_, P1_, qm - kb_, tab); } } while (0)
    f32x16 pA0, pA1, pB0, pB1; float mnA, mnB, alA, alB; bf16x8 pa0, pa1, pa2, pa3;
    SWRITE_HV(0); SBAR();
    SLOAD_H(Kh, Vh, KBASE(1));
    SBAR(); qkt<0>(pA0, pA1, K_lds, krow, hi, S.qr, ACT(0));
    MASKT(pA0, pA1, 0); partialSM(pA0, pA1, m_reg, mnA, alA);
    VMW(); SWRITE_H(1); SBAR(); if (2 < NT) { SLOAD_H(Kh, Vh, KBASE(2)); } SBAR();
    __syncthreads();
#define HALF_STEP(PX0, PX1, mnX, alX, PY0, PY1, alY, t, KB, VB, SB) do {                                                      \
        SBAR(); qkt<KB>(PX0, PX1, K_lds, krow, hi, S.qr, ACT(t));                                                          \
        finishSM(PY0, PY1, alY, l_reg, pa0, pa1, pa2, pa3); SBAR();                                                           \
        pv_tile<VB>(o, vb0, pa0, pa1, pa2, pa3, ACT((t) - 1)); MASKT(PX0, PX1, (t)); partialSM(PX0, PX1, m_reg, mnX, alX);    \
        __syncthreads();                                                                                                      \
        if ((t) + 1 < NT) { VMW(); SWRITE_H(SB); SBAR(); if ((t) + 2 < NT) { SLOAD_H(Kh, Vh, KBASE((t) + 2)); } SBAR(); }          \
        RESC(alX); __syncthreads(); } while (0)
    for (int t = 1; t + 1 < NT; t += 2) {
        HALF_STEP(pB0, pB1, mnB, alB, pA0, pA1, alA, t, 1, 0, 0);
        HALF_STEP(pA0, pA1, mnA, alA, pB0, pB1, alB, t + 1, 0, 1, 1);
    }
    SBAR(); qkt<1>(pB0, pB1, K_lds, krow, hi, S.qr, ACT(NT - 1)); SBAR();
    finishSM(pA0, pA1, alA, l_reg, pa0, pa1, pa2, pa3); SBAR();
    pv_tile<0>(o, vb0, pa0, pa1, pa2, pa3, ACT(NT - 2));
    MASKT(pB0, pB1, NT - 1); partialSM(pB0, pB1, m_reg, mnB, alB); __syncthreads(); RESC(alB);
    finishSM(pB0, pB1, alB, l_reg, pa0, pa1, pa2, pa3); SBAR(); pv_tile<1>(o, vb0, pa0, pa1, pa2, pa3, ACT(NT - 1));
    __syncthreads();
    float* mls = (float*)(lds + LDS_WS) + (rg + 4) * 64;
    float* osh = (float*)lds + (size_t)rg * 64 * 64;
    if (kh == 1) { if (hi == 0) { mls[r32] = m_reg; mls[32 + r32] = l_reg; }
#pragma unroll
        for (int d0 = 0; d0 < 4; ++d0)
#pragma unroll
            for (int r = 0; r < 16; ++r) osh[(d0 * 16 + r) * 64 + lane] = o[d0][r]; }
    __syncthreads();
    if (kh == 0) {
        const float m1 = mls[r32], l1 = mls[32 + r32]; const float mm = fmaxf(m_reg, m1); const float a0 = __builtin_amdgcn_exp2f(m_reg - mm), a1 = __builtin_amdgcn_exp2f(m1 - mm);
        const float il = __builtin_amdgcn_rcpf(l_reg * a0 + l1 * a1);
        if (hi == 0) { li_l[r32] = a0 * il; al_l[r32] = a1 * il; } asm volatile("s_waitcnt lgkmcnt(0)" ::: "memory");
        bf16_t* Ow = cur.O + (size_t)(rg * QBLK) * LD;
#pragma unroll
        for (int r = 0; r < 16; ++r) { const int orow = crow(r, hi); const float f0 = li_l[orow], f1 = al_l[orow];
#pragma unroll
            for (int d0 = 0; d0 < 4; ++d0) { const float v = o[d0][r] * f0 + osh[(d0 * 16 + r) * 64 + lane] * f1; const float vn = __shfl_xor(v, 1);
                if ((r32 & 1) == 0) *(unsigned*)(Ow + (size_t)orow * LD + d0 * 32 + r32) = cvt_pk_bf16(v, vn); } }
    }
#undef RESC
#undef KBASE
#undef ACT
#undef MASKT
#undef HALF_STEP
}
#undef ROW
#undef VMW
#undef SLOAD_H
#undef SWRITE_HK
#undef SWRITE_HV
#undef SWRITE_H
#undef KSWZ
#undef SBAR
}

constexpr int PH_PREP = 0, PH_IN1 = 1, PH_MIX1 = 2, PH_MIX2 = 3, PH_MIX3 = 4, PH_GATES = 5, PH_UPM = 6, PH_OUT = 7, PH_FFN = 8, PH_DOWN = 9, PH_PER_LAYER = 10;
#ifndef PROBE_K
#define PROBE_K -1
#define PROBE_L 0
#define PROBE_N 1
#define PROBE_SUB 15
#endif
struct Args { Inputs in; float* out; unsigned char* ws; int ph_lo, ph_hi, li, mixmask; };

__device__ __forceinline__ void fill_rstd(LAS float* tab, const float* rssp, int bx, int tid) {
#pragma unroll
    for (int j = 0; j < 4; ++j) { const int r = tid + 512 * j; const f32x4* p = (const f32x4*)(rssp + ((size_t)(bx & 7) * 2048 + r) * 16);
        const f32x4 a = p[0], b = p[1], c = p[2], d = p[3]; const f32x4 s = (a + b) + (c + d);
        tab[r] = rsqrtf(((s[0] + s[1]) + (s[2] + s[3])) * (1.f / D) + EPS); }
    __syncthreads();
}
__device__ __forceinline__ int fresh_tid(int wave0) { int ln; asm volatile("v_mbcnt_lo_u32_b32 %0, -1, 0\n\tv_mbcnt_hi_u32_b32 %0, -1, %0" : "=v"(ln)); return wave0 * 64 + ln; }
__global__ void __launch_bounds__(NWAVES * 64, 2) mega_fwd(Args args) {
    extern __shared__ __attribute__((aligned(16))) unsigned char lds[];
    LAS unsigned char* ldsp = (LAS unsigned char*)lds;
    volatile LAS unsigned* MISC = (volatile LAS unsigned*)(ldsp + MISC_OFF);
    const int tid = threadIdx.x; const int wave0 = __builtin_amdgcn_readfirstlane(tid >> 6);
    const int G = gridDim.x; const int bx = blockIdx.x; const int vcu = (G % 8 == 0) ? (bx % 8) * (G / 8) + bx / 8 : bx;
    unsigned char* ws = args.ws;
    float* out = args.out;
    for (int u = tid; u < (LDS_BYTES - LDSCTL_OFF) / 4; u += NWAVES * 64) ((LAS unsigned*)(ldsp + LDSCTL_OFF))[u] = 0u;
    __syncthreads();
    XcdBarrier bar = xcd_barrier_post((unsigned*)(ws + WS_CTL) + CW_BAR + args.li * XCD_BAR_WORDS, MISC + 8);
    const int NGW = G * NWAVES;

    unsigned char* const ws0 = ws; float* const out0 = out; const int bx0 = bx;
    for (int ph = args.ph_lo; ph < args.ph_hi; ++ph) {
        const int l = ph / PH_PER_LAYER, k = ph % PH_PER_LAYER;
        size_t zoff = 0; int bx = bx0; asm volatile("" : "+s"(zoff), "+s"(bx)); unsigned char* ws = ws0 + zoff; float* out = out0 + zoff;
#define KARG(i) (*(const float* const __attribute__((address_space(4)))*)((const __attribute__((address_space(4))) char*)__builtin_amdgcn_kernarg_segment_ptr() + 8 * (i) + zoff))
#define LOAD_INPUTS(v) const __attribute__((address_space(4))) Inputs* v = (const __attribute__((address_space(4))) Inputs*)((const __attribute__((address_space(4))) char*)__builtin_amdgcn_kernarg_segment_ptr() + zoff)
        float* rssp = (float*)(ws + WS_RSSP);
        const int nrep = (k == PROBE_K && l == PROBE_L) ? PROBE_N : 1;
        for (int rep = 0; rep < nrep; ++rep) {
        const int mmask = rep == 0 ? args.mixmask : (args.mixmask & PROBE_SUB); const bool stf = (rep + 1 == nrep);
        if (k == PH_PREP) {
            const int tidl = fresh_tid(wave0), lane = tidl & 63, wave = wave0, gw = vcu * NWAVES + wave;
            LOAD_INPUTS(in);
            float* scr = (float*)(lds + wave * 16384);
            for (int it = gw; it < PREP_ITEMS; it += NGW) prep_item(in, l, ws + WS_W, it, scr, lane);
            if (l == 0) {
                for (int row = gw; row < M; row += NGW) {
                    const f32x4* xr = (const f32x4*)(in->x + (size_t)row * D) + lane; float s = 0.f;
                    unsigned long long* o8 = (unsigned long long*)((bf16_t*)(ws + WS_XB) + (size_t)row * D) + lane;
#pragma unroll
                    for (int j = 0; j < 4; ++j) { const f32x4 v = xr[64 * j]; s += (v.x * v.x + v.y * v.y) + (v.z * v.z + v.w * v.w);
                        o8[64 * j] = (unsigned long long)pk2(v.x, v.y) | ((unsigned long long)pk2(v.z, v.w) << 32); }
                    s = wave_sum(s); if (lane < 16) rssp[(size_t)row * 16 + lane] = (lane == 0) ? s : 0.f;
                }
            }
        } else if (k == PH_IN1) {
            const int tidl = fresh_tid(wave0);
            pg8::Gemm g{(const bf16_t*)(ws + WS_XB), (const bf16_t*)(ws + WS_W + W_IN), M, NIN1, D}; pg8::StaticOrder S; S.init(M, NIN1, G, bx);
            fill_rstd((LAS float*)(ldsp + RSTD_OFF), rssp, bx, tidl);
            pg8::EpiIn1 E{ws, (const LAS float*)(ldsp + RSTD_OFF), KARG(4) + l * 256};
            pg8::gemm_phase<pg8::EpiIn1, pg8::StaticOrder, true, true>(ldsp, g, S, E, tidl);
        } else if (k == PH_MIX1) {
            const int tidl = fresh_tid(wave0), lane = tidl & 63, wave = wave0;
            if (mmask & 2) for (int it = vcu; it < 256; it += G) mix::prepass_item(ws, KARG(8) + l * 128, KARG(9) + l * 128, it >> 5, (it >> 2) & 7, it & 3, (LAS float*)ldsp, tidl, lane, wave);
            if (mmask & 1) for (int it = vcu; it < 256; it += G) mix::pool_item(ws, KARG(7) + l * 512, it >> 2, it & 3, ldsp, tidl, lane, wave);
            if (mmask & 4) for (int it = vcu; it < 1024; it += G) mix::gla_passA_item(ws, it, ldsp, tidl, lane, wave);
        } else if (k == PH_MIX2) {
            const int tidl = fresh_tid(wave0);
            if (mmask & 4) for (int g0 = vcu * 512 + tidl; g0 < 32 * 4096; g0 += G * 512) mix::gla_scan(ws, g0);
            if (mmask & 8) for (int pr = vcu; pr < 256; pr += G) {
                const int bh = pr >> 3, b = bh >> 2, h = bh & 3, rh = pr & 1, a = (pr >> 1) & 3; const size_t r0 = (size_t)b * SEQ * 512 + h * 128;
#pragma unroll 1
                for (int half = 0; half < 2; ++half) { const int qb = half == 0 ? 7 - a : a; const size_t qoff = r0 + (size_t)(qb * 256 + rh * 128) * 512;
                    moba::BlockRef cur; cur.Q = (const bf16_t*)(ws + WS_MQ) + qoff; cur.O = (bf16_t*)(ws + (stf ? WS_YC : WS_US)) + qoff;
                    cur.K = (const bf16_t*)(ws + WS_MK) + r0; cur.V = (const bf16_t*)(ws + WS_MV) + r0; cur.km = (const float*)(ws + WS_KMEAN) + (size_t)bh * 8 * 128; cur.P0 = qb * 256 + rh * 128;
                    const int tl = fresh_tid(wave0);
                    moba::Seam S; moba::prime(cur, KARG(10), h, (char*)lds, S, tl); moba::block(cur, (char*)lds, S, tl); }
            }
        } else if (k == PH_MIX3) {
            const int tidl = fresh_tid(wave0), lane = tidl & 63, wave = wave0;
            if (mmask & 4) for (int it = vcu; it < 1024; it += G) mix::gla_passC_item(ws, KARG(5) + l * 128, it, ldsp, tidl, lane, wave, stf ? WS_YA : WS_US);
        } else if (k == PH_GATES) {
            const int tidl = fresh_tid(wave0);
            pg8::Gemm g{(const bf16_t*)(ws + WS_XB), (const bf16_t*)(ws + WS_W + W_IN) + (size_t)NIN1 * D, M, NGATE, D}; pg8::StaticOrder S; S.init(M, NGATE, G, bx);
            fill_rstd((LAS float*)(ldsp + RSTD_OFF), rssp, bx, tidl);
            pg8::EpiGates E{ws, (const LAS float*)(ldsp + RSTD_OFF)};
            pg8::gemm_phase<pg8::EpiGates, pg8::StaticOrder, true, true>(ldsp, g, S, E, tidl);
        } else if (k == PH_UPM) {
            const int tidl = fresh_tid(wave0);
            pg8::Gemm g{nullptr, nullptr, M, D, 512}; pg8::UpmOrder S; S.so.init(M, D, G, bx);
            S.Y0 = (const bf16_t*)(ws + WS_YA); S.Y1 = (const bf16_t*)(ws + WS_YB); S.Y2 = (const bf16_t*)(ws + WS_YC);
            S.W0 = (const bf16_t*)(ws + WS_W + W_UP); S.W1 = (const bf16_t*)(ws + WS_W + W_UP + MiB); S.W2 = (const bf16_t*)(ws + WS_W + W_UP + 2 * MiB);
            pg8::EpiUpm E{ws};
            pg8::gemm_phase<pg8::EpiUpm, pg8::UpmOrder, true, true>(ldsp, g, S, E, tidl);
        } else if (k == PH_OUT) {
            const int tidl = fresh_tid(wave0);
            pg8::Gemm g{(const bf16_t*)(ws + WS_MERGED), (const bf16_t*)(ws + WS_W + W_OUT), M, D, D}; pg8::StaticOrder S; S.init(M, D, G, bx);
            pg8::EpiRes E{l == 0 ? KARG(0) : out, out, (bf16_t*)(ws + WS_X1B), rssp, stf};
            pg8::gemm_phase<pg8::EpiRes, pg8::StaticOrder, false, true>(ldsp, g, S, E, tidl);
        } else if (k == PH_FFN) {
            const int tidl = fresh_tid(wave0);
            pg8::Gemm g{(const bf16_t*)(ws + WS_X1B), (const bf16_t*)(ws + WS_W + W_GU), M, NGU, D}; pg8::StaticOrder S; S.init(M, NGU, G, bx);
            fill_rstd((LAS float*)(ldsp + RSTD_OFF), rssp, bx, tidl);
            pg8::EpiFfn E{(bf16_t*)(ws + WS_H), (const LAS float*)(ldsp + RSTD_OFF)};
            pg8::gemm_phase<pg8::EpiFfn, pg8::StaticOrder, true, true>(ldsp, g, S, E, tidl);
        } else if (k == PH_DOWN) {
            const int tidl = fresh_tid(wave0);
            pg8::Gemm g{(const bf16_t*)(ws + WS_H), (const bf16_t*)(ws + WS_W + W_DN), M, D, FF}; pg8::StaticOrder S; S.init(M, D, G, bx);
            pg8::EpiRes E{out, out, (l + 1 < DEPTH) ? (bf16_t*)(ws + WS_XB) : nullptr, (l + 1 < DEPTH) ? rssp : nullptr, stf};
            pg8::gemm_phase<pg8::EpiRes, pg8::StaticOrder, false, true>(ldsp, g, S, E, tidl);
        }
        if (rep + 1 < nrep) xcd_barrier(bar);
        }
        if (ph + 1 < args.ph_hi) xcd_barrier(bar);
    }
}

#ifndef MIXMASK
#define MIXMASK 15
#endif
static void launch_mega(const Args& a0, int lo, int hi, int li, int grid, hipStream_t stream) {
    Args a = a0; a.ph_lo = lo; a.ph_hi = hi; a.li = li;
    hipLaunchKernelGGL(mega_fwd, dim3(grid), dim3(NWAVES * 64), LDS_BYTES, stream, a);
}
extern "C" void kernel_launch(void* const* d_in, const int* in_sizes, int n_in, void* d_out, int out_size, void* d_ws, size_t ws_size, hipStream_t stream) {
    static int grid = 0;
    if (grid == 0) {
        if (n_in != 19 || out_size != M * D || ws_size < WS_END2) { fprintf(stderr, "kernel_launch: unexpected shapes (n_in %d out %d ws %zu)\n", n_in, out_size, ws_size); grid = -1; return; }
        int dev = 0, cus = 0;
        if (hipGetDevice(&dev) != hipSuccess || hipDeviceGetAttribute(&cus, hipDeviceAttributeMultiprocessorCount, dev) != hipSuccess) { grid = -1; return; }
        if (hipFuncSetAttribute((const void*)mega_fwd, hipFuncAttributeMaxDynamicSharedMemorySize, LDS_BYTES) != hipSuccess) { fprintf(stderr, "kernel_launch: hipFuncSetAttribute failed\n"); grid = -1; return; }
        int per_cu = 0; (void)hipOccupancyMaxActiveBlocksPerMultiprocessor(&per_cu, (const void*)mega_fwd, NWAVES * 64, LDS_BYTES); (void)hipGetLastError();
        if (per_cu < 1) fprintf(stderr, "kernel_launch: occupancy query reports %d blocks per CU\n", per_cu);
        grid = cus;
    }
    if (grid < 0) return;
    (void)hipMemsetAsync((char*)d_ws + WS_CTL, 0, CTL_BYTES, stream);
    Args a{}; { const float** ap = (const float**)&a.in; for (int i = 0; i < 19; ++i) ap[i] = (const float*)d_in[i]; }
    a.out = (float*)d_out; a.ws = (unsigned char*)d_ws;
    a.mixmask = 15;
    launch_mega(a, 0, DEPTH * PH_PER_LAYER, 0, grid, stream);
}
```

```cpp
#include <hip/hip_runtime.h>
#include <cstdint>
#include <cstdio>

typedef unsigned short bf16_t;
typedef short bf16x8 __attribute__((ext_vector_type(8)));
typedef float f32x4 __attribute__((ext_vector_type(4)));

constexpr int BATCH = 8, SEQ = 2048, D = 1024, M = BATCH * SEQ, DEPTH = 2;
constexpr int IN_COLS = 6672, NIN1 = 3840, NGATE = 3072, NIN = NIN1 + NGATE;
constexpr int FF = 2816, NGU = 2 * FF;
constexpr int C_GLR = 1024;
constexpr float EPS = 1e-6f;
constexpr float LOG2E = 1.4426950408889634f;
constexpr float QSCALE = 0.08838834764831845f * LOG2E;

constexpr size_t MiB = 1u << 20;
constexpr size_t WS_CTL = 0, CTL_BYTES = 1 * MiB;
constexpr size_t WS_RSS = 1 * MiB;
constexpr size_t WS_KMEAN = 230 * MiB;
constexpr size_t WS_W = 2 * MiB;
constexpr size_t W_IN = 0, W_UP = 13 * MiB + 512 * 1024, W_OUT = W_UP + 3 * MiB, W_GU = W_OUT + 2 * MiB, W_DN = W_GU + 11 * MiB, W_PW = W_DN + 5 * MiB + 512 * 1024;
constexpr size_t WS_XB = 38 * MiB;
constexpr size_t WS_GQ = 70 * MiB, WS_GK = 78 * MiB, WS_GG = 86 * MiB;
constexpr size_t WS_GV = 102 * MiB, WS_PU = 118 * MiB;
constexpr size_t WS_MK = 134 * MiB, WS_MV = 150 * MiB;
constexpr size_t WS_SR = 166 * MiB, WS_MQ = 182 * MiB;
constexpr size_t WS_YB = 198 * MiB, WS_US = 214 * MiB;
constexpr size_t WS_SGA = 70 * MiB, WS_SGB = 102 * MiB, WS_SGC = 134 * MiB;
constexpr size_t WS_MERGED = WS_XB, WS_X1B = 70 * MiB, WS_H = 102 * MiB;
constexpr size_t WS_END = 231 * MiB;

__device__ __forceinline__ float bf2f(bf16_t h) { return __uint_as_float(((unsigned)h) << 16); }
__device__ __forceinline__ bf16_t f2bf(float f) { unsigned u = __float_as_uint(f); return (bf16_t)((u + 0x7fffu + ((u >> 16) & 1u)) >> 16); }
__device__ __forceinline__ unsigned pk2(float lo, float hi) { return (unsigned)f2bf(lo) | ((unsigned)f2bf(hi) << 16); }
__device__ __forceinline__ float wave_sum(float v) {
#pragma unroll
    for (int o = 1; o < 64; o <<= 1) v += __shfl_xor(v, o);
    return v;
}
__device__ __forceinline__ float wave_max(float v) {
#pragma unroll
    for (int o = 1; o < 64; o <<= 1) v = fmaxf(v, __shfl_xor(v, o));
    return v;
}
__device__ __forceinline__ float sigmoidf_(float x) { return 1.f / (1.f + __expf(-x)); }
__device__ __forceinline__ float siluf_(float x) { return x / (1.f + __expf(-x)); }
__device__ __forceinline__ float logsigmoidf_(float x) { return fminf(x, 0.f) - log1pf(__expf(-fabsf(x))); }

struct Inputs {
    const float *x, *norm1_w, *w_in, *wg2, *bg, *gla_nw, *pool_w, *pool_scale, *qn_w, *kn_w, *rel_bias, *w_up_a, *w_up_b, *w_up_c, *w_out, *norm2_w, *w_gate, *w_up, *w_down;
};

template <class F>
__device__ __forceinline__ void transpose_item(F src, int K, bf16_t* dst, int k0, int n0, float* scr, int lane) {
    float tv[32];
#pragma unroll
    for (int i = 0; i < 32; ++i) tv[i] = src(k0 + i, n0 + lane);
#pragma unroll
    for (int i = 0; i < 32; ++i) scr[i * 65 + lane] = tv[i];
    __builtin_amdgcn_s_waitcnt(0xc07f); asm volatile("" ::: "memory");
    const int c = lane & 3;
#pragma unroll
    for (int j = 0; j < 4; ++j) {
        const int n = (lane >> 2) + 16 * j; const float* s = scr + (8 * c) * 65 + n;
        uint4 o; o.x = pk2(s[0], s[65]); o.y = pk2(s[130], s[195]); o.z = pk2(s[260], s[325]); o.w = pk2(s[390], s[455]);
        *(uint4*)(dst + (size_t)(n0 + n) * K + k0 + 8 * c) = o;
    }
    __builtin_amdgcn_s_waitcnt(0xc07f); asm volatile("" ::: "memory");
}
constexpr int PI_IN = 32 * (NIN / 64), PI_UP = 16 * 16, PI_OUT = 32 * 16, PI_GU = 32 * (NGU / 64), PI_DN = 88 * 16, PI_PW = 4 * 2;
constexpr int PREP_ITEMS = PI_IN + 3 * PI_UP + PI_OUT + PI_GU + PI_DN + 4 * PI_PW;
template <class InP>
__device__ __forceinline__ void prep_item(InP inp, int l, unsigned char* wsw, int it, float* scr, int lane) {
    if (it < PI_IN) {
        const int nb = NIN / 64, kb = it / nb, n0 = 64 * (it % nb), k0 = 32 * kb;
        const float* w = inp->w_in + (size_t)l * D * IN_COLS; const float* nw = inp->norm1_w + l * D; bf16_t* dst = (bf16_t*)(wsw + W_IN);
        if (n0 >= 512 && n0 < 768) {
            const float* g2 = inp->wg2 + (size_t)l * 16 * 256 + (n0 - 512) + lane; float g2v[16];
#pragma unroll
            for (int r = 0; r < 16; ++r) g2v[r] = g2[r * 256];
            transpose_item([&](int k, int n) { const f32x4* wr = (const f32x4*)(w + (size_t)k * IN_COLS + C_GLR); float s = 0.f;
#pragma unroll
                for (int r4 = 0; r4 < 4; ++r4) { const f32x4 v = wr[r4]; s += v[0] * g2v[4 * r4] + v[1] * g2v[4 * r4 + 1] + v[2] * g2v[4 * r4 + 2] + v[3] * g2v[4 * r4 + 3]; }
                return s * nw[k]; }, D, dst, k0, n0, scr, lane);
        } else {
            const int off = n0 < 512 ? 0 : (n0 < 1280 ? -256 : -240);
            transpose_item([&](int k, int n) { return w[(size_t)k * IN_COLS + n + off] * nw[k]; }, D, dst, k0, n0, scr, lane);
        }
        return;
    }
    it -= PI_IN;
    if (it < 3 * PI_UP) {
        const int br = it / PI_UP; it %= PI_UP; const int kb = it / 16, n0 = 64 * (it % 16), k0 = 32 * kb;
        const float* w = (br == 0 ? inp->w_up_a : br == 1 ? inp->w_up_b : inp->w_up_c) + (size_t)l * 512 * D;
        transpose_item([&](int k, int n) { return w[(size_t)k * D + n]; }, 512, (bf16_t*)(wsw + W_UP + br * MiB), k0, n0, scr, lane);
        return;
    }
    it -= 3 * PI_UP;
    if (it < PI_OUT) {
        const int kb = it / 16, n0 = 64 * (it % 16), k0 = 32 * kb; const float* w = inp->w_out + (size_t)l * D * D;
        transpose_item([&](int k, int n) { return w[(size_t)k * D + n]; }, D, (bf16_t*)(wsw + W_OUT), k0, n0, scr, lane);
        return;
    }
    it -= PI_OUT;
    if (it < PI_GU) {
        const int nb = NGU / 64, kb = it / nb, n0 = 64 * (it % nb), k0 = 32 * kb;
        const int pn = n0 >> 8, i0 = n0 & 255; const float* w = ((i0 < 128) ? inp->w_gate : inp->w_up) + (size_t)l * D * FF; const float* nw = inp->norm2_w + l * D;
        const int coff = 128 * pn + (i0 & 127) - n0;
        transpose_item([&](int k, int n) { return w[(size_t)k * FF + n + coff] * nw[k]; }, D, (bf16_t*)(wsw + W_GU), k0, n0, scr, lane);
        return;
    }
    it -= PI_GU;
    if (it < PI_DN) {
        const int kb = it / 16, n0 = 64 * (it % 16), k0 = 32 * kb; const float* w = inp->w_down + (size_t)l * FF * D;
        transpose_item([&](int k, int n) { return w[(size_t)k * D + n]; }, FF, (bf16_t*)(wsw + W_DN), k0, n0, scr, lane);
        return;
    }
    it -= PI_DN;
    { const int g = it / PI_PW; it %= PI_PW; const int kb = it / 2, n0 = 64 * (it % 2), k0 = 32 * kb; const float* w = inp->pool_w + ((size_t)l * 4 + g) * 128 * 128;
      transpose_item([&](int k, int n) { return w[(size_t)k * 128 + n]; }, 128, (bf16_t*)(wsw + W_PW) + g * 128 * 128, k0, n0, scr, lane); }
}
__global__ void __launch_bounds__(256) k_prep(Inputs in, int l, unsigned char* ws) {
    __shared__ float scr[4][32 * 65];
    const int lane = threadIdx.x & 63, wave = threadIdx.x >> 6;
    for (int it = blockIdx.x * 4 + wave; it < PREP_ITEMS; it += gridDim.x * 4) prep_item(&in, l, ws + WS_W, it, scr[wave], lane);
}

__global__ void __launch_bounds__(256) k_rows(const float* src, bf16_t* dst, float* rss) {
    const int lane = threadIdx.x & 63, row = blockIdx.x * 4 + (threadIdx.x >> 6);
    const f32x4* xr = (const f32x4*)(src + (size_t)row * D) + lane; float s = 0.f;
    unsigned long long* o8 = (unsigned long long*)(dst + (size_t)row * D) + lane;
#pragma unroll
    for (int j = 0; j < 4; ++j) { const f32x4 v = xr[64 * j]; s += (v.x * v.x + v.y * v.y) + (v.z * v.z + v.w * v.w);
        o8[64 * j] = (unsigned long long)pk2(v.x, v.y) | ((unsigned long long)pk2(v.z, v.w) << 32); }
    s = wave_sum(s); if (lane == 0) rss[row] = s;
}

__device__ __forceinline__ void ngemm32(const bf16_t* A, int lda, const bf16_t* Bt, int ldb, int K, f32x4 (&acc)[2][2], int lane) {
    const int r = lane & 15, q = lane >> 4;
    for (int k0 = 0; k0 < K; k0 += 32) {
        bf16x8 a[2], b[2];
#pragma unroll
        for (int i = 0; i < 2; ++i) { a[i] = *(const bf16x8*)(A + (size_t)(i * 16 + r) * lda + k0 + 8 * q); b[i] = *(const bf16x8*)(Bt + (size_t)(i * 16 + r) * ldb + k0 + 8 * q); }
#pragma unroll
        for (int i = 0; i < 2; ++i)
#pragma unroll
            for (int j = 0; j < 2; ++j) acc[i][j] = __builtin_amdgcn_mfma_f32_16x16x32_bf16(a[i], b[j], acc[i][j], 0, 0, 0);
    }
}
#define NG_PRE const int lane = threadIdx.x & 63, wave = threadIdx.x >> 6; const int row0 = blockIdx.y * 64 + (wave >> 1) * 32, col0 = blockIdx.x * 64 + (wave & 1) * 32; \
    f32x4 acc[2][2]; for (int i = 0; i < 2; ++i) for (int j = 0; j < 2; ++j) acc[i][j] = (f32x4){0.f, 0.f, 0.f, 0.f};
#define NG_FOR for (int i = 0; i < 2; ++i) for (int j = 0; j < 2; ++j) for (int rg = 0; rg < 4; ++rg) { const int row = row0 + i * 16 + (lane >> 4) * 4 + rg, col = col0 + j * 16 + (lane & 15);

__global__ void __launch_bounds__(256) k_inproj1(unsigned char* ws, const float* bg) {
    NG_PRE
    ngemm32((const bf16_t*)(ws + WS_XB) + (size_t)row0 * D, D, (const bf16_t*)(ws + WS_W + W_IN) + (size_t)col0 * D, D, D, acc, lane);
    const float* rss = (const float*)(ws + WS_RSS);
    NG_FOR
        const float v = acc[i][j][rg] * rsqrtf(rss[row] * (1.f / D) + EPS);
        const int t = col >> 8, c = col & 255;
        if (t == 0) ((bf16_t*)(ws + WS_GQ))[(size_t)row * 256 + c] = f2bf(v * 0.125f);
        else if (t == 1) ((bf16_t*)(ws + WS_GK))[(size_t)row * 256 + c] = f2bf(v);
        else if (t == 2) ((float*)(ws + WS_GG))[(size_t)row * 256 + c] = logsigmoidf_(v + bg[c]) * (1.f / 16.f);
        else if (t < 5) ((bf16_t*)(ws + WS_GV))[(size_t)row * 512 + (col - 768)] = f2bf(v);
        else if (t < 7) ((bf16_t*)(ws + WS_SR))[(size_t)row * 512 + (col - 1280)] = f2bf(siluf_(v));
        else if (t < 9) ((bf16_t*)(ws + WS_PU))[(size_t)row * 512 + (col - 1792)] = f2bf(v);
        else if (t < 11) ((bf16_t*)(ws + WS_MQ))[(size_t)row * 512 + (col - 2304)] = f2bf(v);
        else if (t < 13) ((bf16_t*)(ws + WS_MK))[(size_t)row * 512 + (col - 2816)] = f2bf(v);
        else ((bf16_t*)(ws + WS_MV))[(size_t)row * 512 + (col - 3328)] = f2bf(v);
    }
}
__global__ void __launch_bounds__(256) k_gates(unsigned char* ws) {
    NG_PRE
    ngemm32((const bf16_t*)(ws + WS_XB) + (size_t)row0 * D, D, (const bf16_t*)(ws + WS_W + W_IN) + (size_t)(NIN1 + col0) * D, D, D, acc, lane);
    const float* rss = (const float*)(ws + WS_RSS);
    NG_FOR
        const float v = acc[i][j][rg] * rsqrtf(rss[row] * (1.f / D) + EPS);
        const int br = col >> 10, c = col & 1023;
        ((bf16_t*)(ws + (br == 0 ? WS_SGA : br == 1 ? WS_SGB : WS_SGC)))[(size_t)row * D + c] = f2bf(sigmoidf_(v));
    }
}
__global__ void __launch_bounds__(256) k_upmerge(unsigned char* ws) {
    NG_PRE
    f32x4 tot[2][2]; for (int i = 0; i < 2; ++i) for (int j = 0; j < 2; ++j) tot[i][j] = (f32x4){0.f, 0.f, 0.f, 0.f};
    for (int br = 0; br < 3; ++br) {
        const bf16_t* Y = (const bf16_t*)(ws + (br == 0 ? WS_SR : br == 1 ? WS_YB : WS_MQ)); const bf16_t* G = (const bf16_t*)(ws + (br == 0 ? WS_SGA : br == 1 ? WS_SGB : WS_SGC));
        for (int i = 0; i < 2; ++i) for (int j = 0; j < 2; ++j) acc[i][j] = (f32x4){0.f, 0.f, 0.f, 0.f};
        ngemm32(Y + (size_t)row0 * 512, 512, (const bf16_t*)(ws + WS_W + W_UP + br * MiB) + (size_t)col0 * 512, 512, 512, acc, lane);
        NG_FOR tot[i][j][rg] += bf2f(G[(size_t)row * D + col]) * acc[i][j][rg]; }
    }
    NG_FOR ((bf16_t*)(ws + WS_MERGED))[(size_t)row * D + col] = f2bf(tot[i][j][rg]); }
}
__global__ void __launch_bounds__(256) k_resgemm(const bf16_t* A, const bf16_t* Bt, int K, const float* resid, float* xout) {
    NG_PRE
    ngemm32(A + (size_t)row0 * K, K, Bt + (size_t)col0 * K, K, K, acc, lane);
    NG_FOR xout[(size_t)row * D + col] = resid[(size_t)row * D + col] + acc[i][j][rg]; }
}
__global__ void __launch_bounds__(256) k_ffn(unsigned char* ws) {
    const int lane = threadIdx.x & 63, wave = threadIdx.x >> 6; const int row0 = blockIdx.y * 64 + (wave >> 1) * 32, j0 = blockIdx.x * 64 + (wave & 1) * 32;
    f32x4 ag[2][2], au[2][2]; for (int i = 0; i < 2; ++i) for (int j = 0; j < 2; ++j) { ag[i][j] = (f32x4){0.f, 0.f, 0.f, 0.f}; au[i][j] = ag[i][j]; }
    const int ng = 256 * (j0 >> 7) + (j0 & 127);
    const bf16_t* A = (const bf16_t*)(ws + WS_X1B) + (size_t)row0 * D; const bf16_t* W = (const bf16_t*)(ws + WS_W + W_GU);
    ngemm32(A, D, W + (size_t)ng * D, D, D, ag, lane);
    ngemm32(A, D, W + (size_t)(ng + 128) * D, D, D, au, lane);
    const float* rss = (const float*)(ws + WS_RSS);
    for (int i = 0; i < 2; ++i) for (int j = 0; j < 2; ++j) for (int rg = 0; rg < 4; ++rg) { const int row = row0 + i * 16 + (lane >> 4) * 4 + rg, col = j0 + j * 16 + (lane & 15);
        const float rs = rsqrtf(rss[row] * (1.f / D) + EPS);
        ((bf16_t*)(ws + WS_H))[(size_t)row * FF + col] = f2bf(siluf_(ag[i][j][rg] * rs) * (au[i][j][rg] * rs)); }
}

__global__ void __launch_bounds__(128) k_gla(unsigned char* ws, const float* nw) {
    const int e = threadIdx.x, b = blockIdx.x >> 2, h = blockIdx.x & 3, lane = e & 63, wave = e >> 6;
    const bf16_t* GQ = (const bf16_t*)(ws + WS_GQ); const bf16_t* GK = (const bf16_t*)(ws + WS_GK); const float* GG = (const float*)(ws + WS_GG);
    const bf16_t* GV = (const bf16_t*)(ws + WS_GV); bf16_t* YA = (bf16_t*)(ws + WS_SR);
    __shared__ float red[2][16]; __shared__ float osh[16][128];
    float S[64];
#pragma unroll
    for (int d = 0; d < 64; ++d) S[d] = 0.f;
    const float nwe = nw[e];
    for (int t0 = 0; t0 < SEQ; t0 += 16) {
#pragma unroll 1
        for (int tt = 0; tt < 16; ++tt) {
            const size_t row = (size_t)b * SEQ + t0 + tt;
            const bf16_t* q = GQ + row * 256 + h * 64; const bf16_t* k = GK + row * 256 + h * 64; const float* g = GG + row * 256 + h * 64;
            const float v = bf2f(GV[row * 512 + h * 128 + e]); float a = 0.f;
#pragma unroll
            for (int d = 0; d < 64; ++d) { S[d] = __expf(g[d]) * S[d] + bf2f(k[d]) * v; a += bf2f(q[d]) * S[d]; }
            osh[tt][e] = a;
            const float s = wave_sum(a * a); if (lane == 0) red[wave][tt] = s;
        }
        __syncthreads();
#pragma unroll 1
        for (int tt = 0; tt < 16; ++tt) { const float rstd = rsqrtf((red[0][tt] + red[1][tt]) * (1.f / 128.f) + EPS);
            const size_t idx = ((size_t)b * SEQ + t0 + tt) * 512 + h * 128 + e; YA[idx] = f2bf(osh[tt][e] * rstd * nwe * bf2f(YA[idx])); }
        __syncthreads();
    }
}

__global__ void __launch_bounds__(256) k_pool(unsigned char* ws, const float* pw, const float* pscale) {
    __shared__ float u[31][128]; __shared__ float p[16][128];
    const int g = blockIdx.x & 3, r0 = (blockIdx.x >> 2) * 16, t0 = r0 & (SEQ - 1), tid = threadIdx.x;
    const bf16_t* PU = (const bf16_t*)(ws + WS_PU);
    for (int x = tid; x < 31 * 128; x += 256) { const int i = x >> 7, c = x & 127, t = t0 - 15 + i; u[i][c] = t >= 0 ? bf2f(PU[(size_t)(r0 - 15 + i) * 512 + g * 128 + c]) : 0.f; }
    __syncthreads();
    const int w = 2 << g;
    for (int x = tid; x < 16 * 128; x += 256) { const int i = x >> 7, c = x & 127, t = t0 + i, cnt = min(t + 1, w); float s = 0.f;
        for (int j = 0; j < cnt; ++j) s += u[15 + i - j][c];
        p[i][c] = s / (float)cnt - u[15 + i][c]; }
    __syncthreads();
    for (int x = tid; x < 16 * 128; x += 256) { const int i = x >> 7, e = x & 127; float y = 0.f;
        for (int c = 0; c < 128; ++c) y += p[i][c] * pw[((size_t)g * 128 + c) * 128 + e];
        ((bf16_t*)(ws + WS_YB))[(size_t)(r0 + i) * 512 + g * 128 + e] = f2bf(y * pscale[g * 128 + e]); }
}

__global__ void __launch_bounds__(256) k_prepass(unsigned char* ws, const float* qw, const float* kw) {
    __shared__ float part[4][128];
    const int lane = threadIdx.x & 63, wave = threadIdx.x >> 6; const int h = blockIdx.x & 3, blk = (blockIdx.x >> 2) & 7, b = blockIdx.x >> 5;
    unsigned* MQ = (unsigned*)(ws + WS_MQ); unsigned* MK = (unsigned*)(ws + WS_MK);
    const float qw0 = qw[2 * lane] * QSCALE, qw1 = qw[2 * lane + 1] * QSCALE, kw0 = kw[2 * lane], kw1 = kw[2 * lane + 1];
    float c0 = 0.f, c1 = 0.f;
    for (int r = 0; r < 64; ++r) {
        const size_t idx = ((size_t)b * SEQ + blk * 256 + wave * 64 + r) * 256 + h * 64 + lane;
        { const unsigned v = MQ[idx]; const float a = __uint_as_float(v << 16), c = __uint_as_float(v & 0xffff0000u); const float rs = rsqrtf(wave_sum(a * a + c * c) * (1.f / 128.f) + EPS); MQ[idx] = pk2(a * rs * qw0, c * rs * qw1); }
        { const unsigned v = MK[idx]; const float a = __uint_as_float(v << 16), c = __uint_as_float(v & 0xffff0000u); const float rs = rsqrtf(wave_sum(a * a + c * c) * (1.f / 128.f) + EPS);
          const float k0 = a * rs * kw0, k1 = c * rs * kw1; c0 += k0; c1 += k1; MK[idx] = pk2(k0, k1); }
    }
    part[wave][2 * lane] = c0; part[wave][2 * lane + 1] = c1;
    __syncthreads();
    if (threadIdx.x < 128) ((float*)(ws + WS_KMEAN))[(((size_t)b * 4 + h) * 8 + blk) * 128 + threadIdx.x] = ((part[0][threadIdx.x] + part[1][threadIdx.x]) + (part[2][threadIdx.x] + part[3][threadIdx.x])) * (1.f / 256.f);
}

__global__ void __launch_bounds__(256) k_moba(unsigned char* ws, const float* rel_bias) {
    __shared__ float tab[4][132]; __shared__ float qs[4][128]; __shared__ float ps[4][1024];
    const int lane = threadIdx.x & 63, wave = threadIdx.x >> 6;
    const int gw = blockIdx.x * 4 + wave; const int t = gw & (SEQ - 1), h = (gw >> 11) & 3, b = gw >> 13;
    for (int x = threadIdx.x; x < 129; x += 256) { int bk = x; if (x >= 16) { bk = 16 + (int)(logf((float)x / 16.f) / 2.0794415416798357f * 16.f); if (bk > 31) bk = 31; } tab[0][x] = rel_bias[bk * 4 + h] * LOG2E; }
    __syncthreads();
    const size_t row = (size_t)b * SEQ + t; const int qblk = t >> 8;
    unsigned* QN = (unsigned*)(ws + WS_MQ); const bf16_t* KN = (const bf16_t*)(ws + WS_MK); const unsigned* MV = (const unsigned*)(ws + WS_MV);
    const unsigned qv = QN[row * 256 + h * 64 + lane]; const float q0 = __uint_as_float(qv << 16), q1 = __uint_as_float(qv & 0xffff0000u);
    qs[wave][2 * lane] = q0; qs[wave][2 * lane + 1] = q1;
    const float* km = (const float*)(ws + WS_KMEAN) + ((size_t)b * 4 + h) * 8 * 128;
    float sc[8];
#pragma unroll
    for (int n = 0; n < 8; ++n) sc[n] = (n < qblk) ? wave_sum(q0 * km[n * 128 + 2 * lane] + q1 * km[n * 128 + 2 * lane + 1]) : -INFINITY;
    int blks[4]; int nvalid = 0;
#pragma unroll
    for (int s = 0; s < 3; ++s) { float best = -INFINITY; int bi = -1;
#pragma unroll
        for (int n = 0; n < 8; ++n) if (sc[n] > best) { best = sc[n]; bi = n; }
        blks[s] = bi;
#pragma unroll
        for (int n = 0; n < 8; ++n) if (n == bi) sc[n] = -INFINITY; }
    blks[3] = qblk;
    __builtin_amdgcn_s_waitcnt(0xc07f);
    float lg[4][4]; float mx = -INFINITY;
#pragma unroll
    for (int s = 0; s < 4; ++s) {
        const int blk = blks[s];
#pragma unroll
        for (int i = 0; i < 4; ++i) {
            lg[s][i] = -INFINITY;
            if (blk >= 0) { const int j = lane + 64 * i, tk = blk * 256 + j, dist = t - tk;
                if (dist >= 0) { const bf16_t* kr = KN + ((size_t)b * SEQ + tk) * 512 + h * 128; float dsum = 0.f;
                    for (int c = 0; c < 16; ++c) { const bf16x8 kk = *(const bf16x8*)(kr + c * 8);
#pragma unroll
                        for (int x = 0; x < 8; ++x) dsum += bf2f((bf16_t)kk[x]) * qs[wave][c * 8 + x]; }
                    lg[s][i] = dsum + tab[0][dist > 128 ? 128 : dist]; mx = fmaxf(mx, lg[s][i]); } }
        }
    }
    mx = wave_max(mx); float sum = 0.f;
#pragma unroll
    for (int s = 0; s < 4; ++s)
#pragma unroll
        for (int i = 0; i < 4; ++i) { const float pp = exp2f(lg[s][i] - mx); sum += pp; ps[wave][s * 256 + lane + 64 * i] = pp; }
    sum = wave_sum(sum);
    __builtin_amdgcn_s_waitcnt(0xc07f);
    float o0 = 0.f, o1 = 0.f;
#pragma unroll
    for (int s = 0; s < 4; ++s) { const int blk = blks[s]; if (blk < 0) continue; const int jn = (s == 3) ? (t & 255) + 1 : 256;
        const unsigned* vr = MV + ((size_t)b * SEQ + blk * 256) * 256 + h * 64 + lane;
        for (int j = 0; j < jn; ++j) { const float pp = ps[wave][s * 256 + j]; const unsigned v = vr[(size_t)j * 256]; o0 += pp * __uint_as_float(v << 16); o1 += pp * __uint_as_float(v & 0xffff0000u); } }
    const float inv = 1.f / sum;
    QN[row * 256 + h * 64 + lane] = pk2(o0 * inv, o1 * inv);
}


template <int K> __device__ __forceinline__ float swz_xor(float v) { return __int_as_float(__builtin_amdgcn_ds_swizzle(__float_as_int(v), (K << 10) | 0x1f)); }
__device__ __forceinline__ float half_sum(float v) { auto rr = __builtin_amdgcn_permlane32_swap(__float_as_uint(v), __float_as_uint(v), false, false); return __uint_as_float(rr[0]) + __uint_as_float(rr[1]); }
__device__ __forceinline__ float wave_sum_s(float v) { v += swz_xor<1>(v); v += swz_xor<2>(v); v += swz_xor<4>(v); v += swz_xor<8>(v); v += swz_xor<16>(v); return half_sum(v); }
namespace pg8 {
#define PG8_LAS __attribute__((address_space(3)))
typedef unsigned u32x4 __attribute__((ext_vector_type(4)));
constexpr int BM = 256, BK = 64, HALF = 128, HTB = HALF * BK * 2, STAGE_BYTES = 8 * HTB, NXCD = 8, WGM = 8;
__host__ __device__ __forceinline__ int lds_byte(int r, int c) { const int st = (r >> 4) * 2 + (c >> 5), rr = r & 15, cc = c & 31, ob = rr * 64 + cc * 2; return st * 1024 + (ob ^ (((ob >> 9) & 1) << 5)); }
__host__ __device__ __forceinline__ void stage_rc(int b, int& R, int& C) { const int st = b / 1024, sb = b % 1024, swz = sb ^ (((sb >> 9) & 1) << 5); R = (st >> 1) * 16 + swz / 64; C = (st & 1) * 32 + (swz % 64) / 2; }
__host__ __device__ __forceinline__ int perm32(int rho) { const int n = rho >> 4, i = rho & 15; return 8 * (i >> 2) + 4 * n + (i & 3); }
struct Unit { int pm, pn, br; };
struct Gemm { const bf16_t* A; const bf16_t* Bt; int M, N, K; };
struct StaticOrder {
    int nM, nN, nwg, G, c;
    __device__ void init(int M_, int N_, int G_, int c_) { nM = M_ / BM; nN = N_ / BM; nwg = nM * nN; G = G_; c = c_; }
    __device__ bool next(int i, Unit& u) const {
        const long L = (long)i * G + c; if (L >= nwg) return false;
        int wgid = (int)L; { const int q = nwg / NXCD, r = nwg % NXCD, xcd = wgid % NXCD, off = wgid / NXCD; wgid = (xcd < r ? xcd * (q + 1) : r * (q + 1) + (xcd - r) * q) + off; }
        const int nig = WGM * nN, gid = wgid / nig, fm = gid * WGM, gsz = (nM - fm) < WGM ? (nM - fm) : WGM;
        u.pm = fm + ((wgid % nig) % gsz); u.pn = (wgid % nig) / gsz; u.br = 0; return true;
    }
    __device__ __forceinline__ const char* pa(const Unit& u, const Gemm& g) const { return (const char*)g.A + (size_t)u.pm * (size_t)(BM * 2) * g.K; }
    __device__ __forceinline__ const char* pb(const Unit& u, const Gemm& g) const { return (const char*)g.Bt + (size_t)u.pn * (size_t)(BM * 2) * g.K; }
    __device__ __forceinline__ void a_ready(const Unit&) const {}
    __device__ __forceinline__ void done(const Unit&) const {}
};
struct UpmOrder {
    StaticOrder so; const bf16_t *Y0, *Y1, *Y2, *W0, *W1, *W2;
    __device__ bool next(int i, Unit& u) const { if (i >= 3) return false; if (!so.next(0, u)) return false; u.br = i; return true; }
    __device__ __forceinline__ const char* pa(const Unit& u, const Gemm& g) const { const bf16_t* y = u.br == 0 ? Y0 : (u.br == 1 ? Y1 : Y2); return (const char*)y + (size_t)u.pm * (size_t)(BM * 2) * g.K; }
    __device__ __forceinline__ const char* pb(const Unit& u, const Gemm& g) const { const bf16_t* w = u.br == 0 ? W0 : (u.br == 1 ? W1 : W2); return (const char*)w + (size_t)u.pn * (size_t)(BM * 2) * g.K; }
    __device__ __forceinline__ void a_ready(const Unit&) const {}
    __device__ __forceinline__ void done(const Unit&) const {}
};
typedef float f32x2_t __attribute__((ext_vector_type(2))); typedef __bf16 bf16x2_t __attribute__((ext_vector_type(2)));
__device__ __forceinline__ unsigned cvt_pk_bf16(float lo, float hi) { const f32x2_t v = {lo, hi}; const bf16x2_t b = __builtin_convertvector(v, bf16x2_t); return __builtin_bit_cast(unsigned, b); }
__device__ __forceinline__ u32x4 pack8(const f32x4& a, const f32x4& b) { u32x4 w; w.x = cvt_pk_bf16(a[0], a[1]); w.y = cvt_pk_bf16(a[2], a[3]); w.z = cvt_pk_bf16(b[0], b[1]); w.w = cvt_pk_bf16(b[2], b[3]); return w; }
__device__ __forceinline__ void unpack8(const u32x4& w, f32x4& a, f32x4& b) {
    a[0] = __uint_as_float(w.x << 16); a[1] = __uint_as_float(w.x & 0xffff0000u); a[2] = __uint_as_float(w.y << 16); a[3] = __uint_as_float(w.y & 0xffff0000u);
    b[0] = __uint_as_float(w.z << 16); b[1] = __uint_as_float(w.z & 0xffff0000u); b[2] = __uint_as_float(w.w << 16); b[3] = __uint_as_float(w.w & 0xffff0000u);
}
__device__ __forceinline__ void row_rstd(const PG8_LAS float* tab, const Unit& u, int wr, int fr, float (&rs)[2][4]) {
#pragma unroll
    for (int ai = 0; ai < 2; ++ai)
#pragma unroll
        for (int m = 0; m < 4; ++m) rs[ai][m] = tab[(u.pm & 7) * BM + ai * HALF + wr * 64 + m * 16 + fr];
}
struct EpiIn1 {
    static constexpr bool PERM = true, AFTER_DRAIN = false;
    unsigned char* ws; const PG8_LAS float* rstab; const float* bg;
    __device__ __forceinline__ void operator()(const f32x4 (&acc)[2][2][4][2], const Unit& u, int wr, int wc, int fr, int fq) const {
        asm volatile("" : "+v"(fr), "+v"(fq));
        const int row0 = u.pm * BM + wr * 64 + fr, cw = wc * 32 + 8 * fq; const int pn = u.pn;
        float rs[2][4]; row_rstd(rstab, u, wr, fr, rs);
        if (pn == 2) {
            float* G = (float*)(ws + WS_GG); size_t zb = 0; asm volatile("" : "+s"(zb)); const float* bgl = bg + zb;
#pragma unroll
            for (int bj = 0; bj < 2; ++bj) { const int c = bj * HALF + cw; const f32x4 b0 = *(const f32x4*)(bgl + c), b1 = *(const f32x4*)(bgl + c + 4);
#pragma unroll
                for (int ai = 0; ai < 2; ++ai)
#pragma unroll
                    for (int m = 0; m < 4; ++m) { const float r = rs[ai][m]; f32x4 v0 = acc[ai][bj][m][0] * r + b0, v1 = acc[ai][bj][m][1] * r + b1;
#pragma unroll
                        for (int x = 0; x < 4; ++x) { v0[x] = (fminf(v0[x], 0.f) - __logf(1.f + __expf(-fabsf(v0[x])))) * 0.0625f; v1[x] = (fminf(v1[x], 0.f) - __logf(1.f + __expf(-fabsf(v1[x])))) * 0.0625f; }
                        float* p = G + (size_t)(row0 + ai * HALF + m * 16) * 256 + c; *(f32x4*)p = v0; *(f32x4*)(p + 4) = v1; asm volatile("" ::: "memory"); } }
            return;
        }
        bf16_t* base; int ldc, coff; float sc = 1.f; bool silu = false;
        if (pn == 0) { base = (bf16_t*)(ws + WS_GQ); ldc = 256; coff = 0; sc = 0.125f; }
        else if (pn == 1) { base = (bf16_t*)(ws + WS_GK); ldc = 256; coff = 0; }
        else { ldc = 512; const int k = (pn - 3) >> 1; coff = ((pn - 3) & 1) * 256; silu = (k == 1);
            base = (bf16_t*)(ws + (k == 0 ? WS_GV : k == 1 ? WS_SR : k == 2 ? WS_PU : k == 3 ? WS_MQ : k == 4 ? WS_MK : WS_MV)); }
#pragma unroll
        for (int ai = 0; ai < 2; ++ai)
#pragma unroll
            for (int m = 0; m < 4; ++m) { const float r = rs[ai][m] * sc; bf16_t* rowp = base + (size_t)(row0 + ai * HALF + m * 16) * ldc + coff + cw;
#pragma unroll
                for (int bj = 0; bj < 2; ++bj) { f32x4 v0 = acc[ai][bj][m][0] * r, v1 = acc[ai][bj][m][1] * r;
                    if (silu) {
#pragma unroll
                        for (int x = 0; x < 4; ++x) { v0[x] = siluf_(v0[x]); v1[x] = siluf_(v1[x]); } }
                    *(u32x4*)(rowp + bj * HALF) = pack8(v0, v1); } asm volatile("" ::: "memory"); }
    }
};
struct EpiGates {
    static constexpr bool PERM = true, AFTER_DRAIN = false;
    unsigned char* ws; const PG8_LAS float* rstab;
    __device__ __forceinline__ void operator()(const f32x4 (&acc)[2][2][4][2], const Unit& u, int wr, int wc, int fr, int fq) const {
        asm volatile("" : "+v"(fr), "+v"(fq));
        const int row0 = u.pm * BM + wr * 64 + fr, cw = wc * 32 + 8 * fq; const int br = u.pn >> 2;
        float rs[2][4]; row_rstd(rstab, u, wr, fr, rs);
        bf16_t* base = (bf16_t*)(ws + (br == 0 ? WS_SGA : br == 1 ? WS_SGB : WS_SGC)) + (u.pn & 3) * 256 + cw;
#pragma unroll
        for (int ai = 0; ai < 2; ++ai)
#pragma unroll
            for (int m = 0; m < 4; ++m) { const float r = rs[ai][m]; bf16_t* rowp = base + (size_t)(row0 + ai * HALF + m * 16) * D;
#pragma unroll
                for (int bj = 0; bj < 2; ++bj) { f32x4 v0 = acc[ai][bj][m][0] * r, v1 = acc[ai][bj][m][1] * r;
#pragma unroll
                    for (int x = 0; x < 4; ++x) { v0[x] = sigmoidf_(v0[x]); v1[x] = sigmoidf_(v1[x]); }
                    *(u32x4*)(rowp + bj * HALF) = pack8(v0, v1); } asm volatile("" ::: "memory"); }
    }
};
struct EpiUpm {
    static constexpr bool PERM = true, AFTER_DRAIN = false;
    unsigned char* ws;
    __device__ __forceinline__ void operator()(const f32x4 (&acc)[2][2][4][2], const Unit& u, int wr, int wc, int fr, int fq) const {
        asm volatile("" : "+v"(fr), "+v"(fq));
        const int row0 = u.pm * BM + wr * 64 + fr, col0 = u.pn * BM + wc * 32 + 8 * fq; const int br = u.br;
        const bf16_t* G = (const bf16_t*)(ws + (br == 0 ? WS_SGA : br == 1 ? WS_SGB : WS_SGC)); bf16_t* O = (bf16_t*)(ws + WS_MERGED);
#pragma unroll
        for (int ai = 0; ai < 2; ++ai)
#pragma unroll
            for (int m = 0; m < 4; ++m) { const size_t off = (size_t)(row0 + ai * HALF + m * 16) * D + col0;
#pragma unroll
                for (int bj = 0; bj < 2; ++bj) { f32x4 g0, g1; unpack8(*(const u32x4*)(G + off + bj * HALF), g0, g1);
                    f32x4 v0 = acc[ai][bj][m][0] * g0, v1 = acc[ai][bj][m][1] * g1;
                    if (br != 0) { f32x4 p0, p1; unpack8(*(const u32x4*)(O + off + bj * HALF), p0, p1); v0 += p0; v1 += p1; }
                    *(u32x4*)(O + off + bj * HALF) = pack8(v0, v1); } }
    }
};
struct EpiRes {
    static constexpr bool PERM = true, AFTER_DRAIN = false;
    const float* resid; float* xout; bf16_t* xb; float* rssp; bool st;
    __device__ __forceinline__ void operator()(const f32x4 (&acc)[2][2][4][2], const Unit& u, int wr, int wc, int fr, int fq) const {
        asm volatile("" : "+v"(fr), "+v"(fq));
        const int row0 = u.pm * BM + wr * 64 + fr, col0 = u.pn * BM + wc * 32 + 8 * fq;
#pragma unroll
        for (int ai = 0; ai < 2; ++ai)
#pragma unroll
            for (int m = 0; m < 4; ++m) { const int row = row0 + ai * HALF + m * 16; const size_t off = (size_t)row * D + col0; float s = 0.f;
#pragma unroll
                for (int bj = 0; bj < 2; ++bj) { const f32x4 r0 = *(const f32x4*)(resid + off + bj * HALF), r1 = *(const f32x4*)(resid + off + bj * HALF + 4);
                    const f32x4 v0 = acc[ai][bj][m][0] + r0, v1 = acc[ai][bj][m][1] + r1;
                    if (st) { *(f32x4*)(xout + off + bj * HALF) = v0; *(f32x4*)(xout + off + bj * HALF + 4) = v1; }
                    if (xb && st) *(u32x4*)(xb + off + bj * HALF) = pack8(v0, v1);
                    s += ((v0[0] * v0[0] + v0[1] * v0[1]) + (v0[2] * v0[2] + v0[3] * v0[3])) + ((v1[0] * v1[0] + v1[1] * v1[1]) + (v1[2] * v1[2] + v1[3] * v1[3])); }
                s += swz_xor<16>(s); s = half_sum(s);
                if (fq == 0 && rssp && st) rssp[(size_t)row * 16 + u.pn * 4 + wc] = s; }
    }
};
struct EpiFfn {
    static constexpr bool PERM = true, AFTER_DRAIN = false;
    bf16_t* H; const PG8_LAS float* rstab;
    __device__ __forceinline__ void operator()(const f32x4 (&acc)[2][2][4][2], const Unit& u, int wr, int wc, int fr, int fq) const {
        asm volatile("" : "+v"(fr), "+v"(fq));
        const int row0 = u.pm * BM + wr * 64 + fr, col0 = u.pn * HALF + wc * 32 + 8 * fq;
        float rs[2][4]; row_rstd(rstab, u, wr, fr, rs);
#pragma unroll
        for (int ai = 0; ai < 2; ++ai)
#pragma unroll
            for (int m = 0; m < 4; ++m) { const float r = rs[ai][m]; f32x4 g0 = acc[ai][0][m][0] * r, g1 = acc[ai][0][m][1] * r; const f32x4 u0 = acc[ai][1][m][0] * r, u1 = acc[ai][1][m][1] * r;
#pragma unroll
                for (int x = 0; x < 4; ++x) { g0[x] = siluf_(g0[x]) * u0[x]; g1[x] = siluf_(g1[x]) * u1[x]; }
                *(u32x4*)(H + (size_t)(row0 + ai * HALF + m * 16) * FF + col0) = pack8(g0, g1); asm volatile("" ::: "memory"); }
    }
};
template <class Epi, class Sched, bool ALIGN_EPI = false, bool SP2 = false>
__device__ __forceinline__ void gemm_phase(PG8_LAS unsigned char* lds, const Gemm g, const Sched& S, const Epi& E, const int tid) {
    const int wid = __builtin_amdgcn_readfirstlane(tid >> 6), lane = tid & 63, wr = wid >> 2, wc = wid & 3, fr = lane & 15, fq = lane >> 4;
    const int K = g.K, nt = K / BK;
    unsigned voffA[2], voffB[2];
#pragma unroll
    for (int i = 0; i < 2; ++i) { int R, C; stage_rc(tid * 16 + i * 8192, R, C); const int Rb = Epi::PERM ? ((R & ~31) + perm32(R & 31)) : R;
        voffA[i] = (unsigned)(R * K + C) * 2u; voffB[i] = (unsigned)(Rb * K + C) * 2u; }
    const size_t kstep = (size_t)(BK * 2);
    const size_t hstep = (size_t)HALF * K * 2;
    const unsigned ldsw = (unsigned)wid * 1024u;
    const int aoff = lds_byte(wr * 64 + fr, fq * 8), boff = lds_byte(wc * 32 + fr, fq * 8);
#define PG8_SA(b, h) (((b) * 2 + (h)) * HTB)
#define PG8_SB(b, h) ((4 + (b) * 2 + (h)) * HTB)
#define PG8_STAGE(bufoff, gbase, voff) do { _Pragma("unroll") for (int _i = 0; _i < 2; ++_i) \
        __builtin_amdgcn_global_load_lds((const unsigned*)((const char*)(gbase) + (voff)[_i]), (PG8_LAS unsigned*)(lds + (bufoff) + ldsw + _i * 8192), 16, 0, 0); } while (0)
#define PG8_LDA(dst, b, h) do { _Pragma("unroll") for (int m = 0; m < 4; ++m) _Pragma("unroll") for (int k = 0; k < 2; ++k) dst[m][k] = *(const PG8_LAS bf16x8*)(lds + PG8_SA(b, h) + aoff + m * 2048 + k * 1024); } while (0)
#define PG8_LDB(dst, b, h) do { _Pragma("unroll") for (int n = 0; n < 2; ++n) _Pragma("unroll") for (int k = 0; k < 2; ++k) dst[n][k] = *(const PG8_LAS bf16x8*)(lds + PG8_SB(b, h) + boff + n * 2048 + k * 1024); } while (0)
#define PG8_MMA(ai, bj, At, Bt) do { __builtin_amdgcn_s_setprio(1); _Pragma("unroll") for (int m = 0; m < 4; ++m) _Pragma("unroll") for (int n = 0; n < 2; ++n) _Pragma("unroll") for (int k = 0; k < 2; ++k) \
        acc[ai][bj][m][n] = __builtin_amdgcn_mfma_f32_16x16x32_bf16(Bt[n][k], At[m][k], acc[ai][bj][m][n], 0, 0, 0); __builtin_amdgcn_s_setprio(0); } while (0)
#define PG8_WAIT_V(n) asm volatile("s_waitcnt vmcnt(" #n ")" ::: "memory")
#define PG8_WAIT_L(n) asm volatile("s_waitcnt lgkmcnt(" #n ")" ::: "memory")
#define PG8_BAR __builtin_amdgcn_s_barrier()
#define PG8_SCHED __builtin_amdgcn_sched_barrier(0)
    Unit cur, nxt; int ui = 0;
    if (!S.next(0, cur)) return;
    f32x4 acc[2][2][4][2];
#pragma unroll
    for (int a = 0; a < 2; ++a)
#pragma unroll
        for (int b = 0; b < 2; ++b)
#pragma unroll
            for (int m = 0; m < 4; ++m)
#pragma unroll
                for (int n = 0; n < 2; ++n) acc[a][b][m][n] = (f32x4){0.f, 0.f, 0.f, 0.f};
    bf16x8 At[4][2], B0[2][2], B1[2][2];
    const char* cA = S.pa(cur, g); const char* cB = S.pb(cur, g);
    S.a_ready(cur);
    if constexpr (SP2) {
        PG8_STAGE(PG8_SB(0, 0), cB, voffB); PG8_STAGE(PG8_SB(0, 1), cB + hstep, voffB); PG8_STAGE(PG8_SA(0, 0), cA, voffA); PG8_STAGE(PG8_SA(0, 1), cA + hstep, voffA);
        if (wr == 1) PG8_BAR;
        PG8_WAIT_V(2); PG8_BAR;
        PG8_STAGE(PG8_SB(1, 0), cB + kstep, voffB); PG8_STAGE(PG8_SA(1, 0), cA + kstep, voffA); PG8_STAGE(PG8_SB(1, 1), cB + hstep + kstep, voffB);
        PG8_WAIT_V(6); PG8_BAR;
    } else {
        PG8_STAGE(PG8_SB(0, 0), cB, voffB); PG8_STAGE(PG8_SA(0, 0), cA, voffA); PG8_STAGE(PG8_SB(0, 1), cB + hstep, voffB); PG8_STAGE(PG8_SA(0, 1), cA + hstep, voffA);
        if (wr == 1) PG8_BAR;
        PG8_WAIT_V(4); PG8_BAR;
        PG8_STAGE(PG8_SB(1, 0), cB + kstep, voffB); PG8_STAGE(PG8_SA(1, 0), cA + kstep, voffA); PG8_STAGE(PG8_SB(1, 1), cB + hstep + kstep, voffB);
        PG8_WAIT_V(6); PG8_BAR;
    }
    for (;;) {
        const bool has_next = S.next(ui + 1, nxt);
        const char* nA = has_next ? S.pa(nxt, g) : cA; const char* nB = has_next ? S.pb(nxt, g) : cB;
        for (int t = 0; t < nt; t += 2) {
            const bool last = (t == nt - 2);
            const char* a1 = cA + (size_t)(t + 1) * kstep;
            const char* a2 = last ? nA : cA + (size_t)(t + 2) * kstep; const char* b2 = last ? nB : cB + (size_t)(t + 2) * kstep;
            const char* a3 = a2 + kstep; const char* b3 = b2 + kstep;
            if (last && has_next) S.a_ready(nxt);
            if constexpr (SP2) {
            PG8_LDB(B0, 0, 0); PG8_LDB(B1, 0, 1); PG8_SCHED; PG8_LDA(At, 0, 0); PG8_STAGE(PG8_SA(1, 1), a1 + hstep, voffA);
            PG8_WAIT_V(8); PG8_WAIT_L(0); PG8_BAR; PG8_MMA(0, 0, At, B0); PG8_MMA(0, 1, At, B1); PG8_BAR; PG8_SCHED;
            PG8_LDA(At, 0, 1); PG8_STAGE(PG8_SB(0, 0), b2, voffB); PG8_STAGE(PG8_SB(0, 1), b2 + hstep, voffB); PG8_STAGE(PG8_SA(0, 0), a2, voffA);
            PG8_WAIT_V(8); PG8_WAIT_L(0); PG8_BAR; PG8_MMA(1, 0, At, B0); PG8_MMA(1, 1, At, B1); PG8_BAR; PG8_SCHED;
            PG8_LDB(B0, 1, 0); PG8_LDB(B1, 1, 1); PG8_SCHED; PG8_LDA(At, 1, 0); PG8_STAGE(PG8_SA(0, 1), a2 + hstep, voffA);
            PG8_WAIT_V(8); PG8_WAIT_L(0); PG8_BAR; PG8_MMA(0, 0, At, B0); PG8_MMA(0, 1, At, B1); PG8_BAR; PG8_SCHED;
            PG8_LDA(At, 1, 1); PG8_STAGE(PG8_SB(1, 0), b3, voffB); PG8_STAGE(PG8_SB(1, 1), b3 + hstep, voffB); PG8_STAGE(PG8_SA(1, 0), a3, voffA);
            PG8_WAIT_V(8); PG8_WAIT_L(0); PG8_BAR; PG8_MMA(1, 0, At, B0); PG8_MMA(1, 1, At, B1); PG8_BAR; PG8_SCHED;
            } else {
            PG8_LDB(B0, 0, 0); PG8_SCHED; PG8_LDA(At, 0, 0); PG8_STAGE(PG8_SA(1, 1), a1 + hstep, voffA);
            PG8_WAIT_L(8); PG8_BAR; PG8_WAIT_L(0); PG8_MMA(0, 0, At, B0); PG8_BAR; PG8_SCHED;
            PG8_LDB(B1, 0, 1); PG8_STAGE(PG8_SB(0, 0), b2, voffB);
            PG8_BAR; PG8_WAIT_L(0); PG8_MMA(0, 1, At, B1); PG8_BAR;
            PG8_LDA(At, 0, 1); PG8_STAGE(PG8_SA(0, 0), a2, voffA);
            PG8_BAR; PG8_WAIT_L(0); PG8_MMA(1, 0, At, B0); PG8_BAR; PG8_SCHED;
            PG8_STAGE(PG8_SB(0, 1), b2 + hstep, voffB);
            PG8_WAIT_V(6); PG8_BAR; PG8_MMA(1, 1, At, B1); PG8_BAR;
            PG8_LDB(B0, 1, 0); PG8_SCHED; PG8_LDA(At, 1, 0); PG8_STAGE(PG8_SA(0, 1), a2 + hstep, voffA);
            PG8_WAIT_L(8); PG8_BAR; PG8_WAIT_L(0); PG8_MMA(0, 0, At, B0); PG8_BAR; PG8_SCHED;
            PG8_LDB(B1, 1, 1); PG8_STAGE(PG8_SB(1, 0), b3, voffB);
            PG8_BAR; PG8_WAIT_L(0); PG8_MMA(0, 1, At, B1); PG8_BAR;
            PG8_LDA(At, 1, 1); PG8_STAGE(PG8_SA(1, 0), a3, voffA);
            PG8_BAR; PG8_WAIT_L(0); PG8_MMA(1, 0, At, B0); PG8_BAR; PG8_SCHED;
            PG8_STAGE(PG8_SB(1, 1), b3 + hstep, voffB);
            PG8_WAIT_V(6); PG8_BAR; PG8_MMA(1, 1, At, B1); PG8_BAR;
            }
        }
        if constexpr (ALIGN_EPI) { if (wr == 0) PG8_BAR; }
        if constexpr (!Epi::AFTER_DRAIN) { E(acc, cur, wr, wc, fr, fq); S.done(cur); }
        if (!has_next) break;
#pragma unroll
        for (int a = 0; a < 2; ++a)
#pragma unroll
            for (int b = 0; b < 2; ++b)
#pragma unroll
                for (int m = 0; m < 4; ++m)
#pragma unroll
                    for (int n = 0; n < 2; ++n) acc[a][b][m][n] = (f32x4){0.f, 0.f, 0.f, 0.f};
        cur = nxt; cA = nA; cB = nB; ++ui;
        if constexpr (ALIGN_EPI) { if (wr == 1) PG8_BAR; }
    }
    PG8_WAIT_V(0);
    if constexpr (!ALIGN_EPI) { if (wr == 0) PG8_BAR; }
    PG8_BAR;
    if constexpr (Epi::AFTER_DRAIN) { E.fused(acc, cur, wr, wc, fr, fq, lds, wid, lane); S.done(cur); }
#undef PG8_SA
#undef PG8_SB
#undef PG8_STAGE
#undef PG8_LDA
#undef PG8_LDB
#undef PG8_MMA
#undef PG8_WAIT_V
#undef PG8_WAIT_L
#undef PG8_BAR
#undef PG8_SCHED
}
}

constexpr int NWAVES = 8;
constexpr int RING_BYTES = 131072, LDSCTL_OFF = RING_BYTES, MISC_OFF = LDSCTL_OFF + 320, RSTD_OFF = RING_BYTES + 1024, LDS_BYTES = 147456;
constexpr int CW_BAR = 4096;
#define GAS __attribute__((address_space(1)))
#define LAS __attribute__((address_space(3)))
typedef GAS unsigned gu32;
#define RLX_AGENT __ATOMIC_RELAXED, __HIP_MEMORY_SCOPE_AGENT
#define XB_TMO      128
#define XB_XCNT(j)  (256  + 64 * (j))
#define XB_XSUB(j)  (1280 + 64 * (j))
#define XB_XGEN(j)  (2304 + 64 * (j))
#define XB_TOP      3328
#define XB_TOPGEN   3392
#define XCD_BAR_WORDS 3456
#define XB_SPIN_CAP (1u << 18)

__device__ __forceinline__ unsigned xb_ld(unsigned* p)              { return __hip_atomic_load(p, __ATOMIC_RELAXED, __HIP_MEMORY_SCOPE_AGENT); }
__device__ __forceinline__ unsigned xb_add(unsigned* p, unsigned v) { return __hip_atomic_fetch_add(p, v, __ATOMIC_RELAXED, __HIP_MEMORY_SCOPE_AGENT); }
__device__ __forceinline__ unsigned xb_xcc_id() { return (unsigned)__builtin_amdgcn_s_getreg((3 << 11) | 20) & 0xFu; }
#define XB_SPIN(cond, bar) do { unsigned _sp = 0; while (cond) { __builtin_amdgcn_s_sleep(1); \
    if ((++_sp & 255u) == 0u) { if (xb_ld(&(bar)[XB_TMO])) break; if (_sp > XB_SPIN_CAP) { atomicAdd(&(bar)[XB_TMO], 1u); break; } } } } while (0)

struct XcdBarrier {
    unsigned* bar; unsigned x; int w0;
    volatile LAS unsigned* st;
};

__device__ __forceinline__ XcdBarrier xcd_barrier_post(unsigned* bar, volatile LAS unsigned* st) {
    XcdBarrier b; b.bar = bar; b.x = xb_xcc_id(); b.st = st;
    if (threadIdx.x == 0) (void)xb_add(&bar[XB_XCNT(b.x)], 1u);
    return b;
}
__device__ __forceinline__ void xcd_barrier_complete(unsigned* bar, unsigned x, unsigned& nloc, unsigned& nx) {
    const unsigned G = gridDim.x * gridDim.y * gridDim.z;
    unsigned sum, cnt, mine, sp = 0u;
    for (;;) {
        sum = 0u; cnt = 0u; mine = 0u;
#pragma unroll
        for (unsigned j = 0; j < 16; ++j) { const unsigned c = xb_ld(&bar[XB_XCNT(j)]); sum += c; cnt += (c > 0u) ? 1u : 0u; mine = (j == x) ? c : mine; }
        if (sum == G) break;
        __builtin_amdgcn_s_sleep(1);
        if ((++sp & 255u) == 0u) { if (xb_ld(&bar[XB_TMO])) break; if (sp > XB_SPIN_CAP) { atomicAdd(&bar[XB_TMO], 1u); break; } }
    }
    nloc = mine > 0u ? mine : 1u; nx = cnt > 0u ? cnt : 1u;
}

__device__ __forceinline__ void xcd_barrier(const XcdBarrier& b) {
    asm volatile("s_waitcnt vmcnt(0)" ::: "memory");
    __syncthreads();
    int ln_; asm volatile("v_mbcnt_lo_u32_b32 %0, -1, 0\n\tv_mbcnt_hi_u32_b32 %0, -1, %0" : "=v"(ln_));
    if (b.w0 == 0 && ln_ == 0) {
        unsigned* bar = b.bar;
        __builtin_amdgcn_s_waitcnt(0);
        unsigned nloc = b.st[0], nx = b.st[1];
        if (nloc == 0u) { xcd_barrier_complete(bar, b.x, nloc, nx); b.st[0] = nloc; b.st[1] = nx; }
        const unsigned old = xb_add(&bar[XB_XSUB(b.x)], 1u);
        const unsigned gen = old / nloc;
        if (old + 1u == (gen + 1u) * nloc) {
            __builtin_amdgcn_fence(__ATOMIC_RELEASE, "agent");
            asm volatile("s_waitcnt vmcnt(0)" ::: "memory");
            const unsigned og = xb_add(&bar[XB_TOP], 1u);
            const unsigned tg = og / nx;
            if (og + 1u == (tg + 1u) * nx) xb_add(&bar[XB_TOPGEN], 1u);
            else XB_SPIN(xb_ld(&bar[XB_TOPGEN]) == tg, bar);
            __builtin_amdgcn_fence(__ATOMIC_ACQUIRE, "agent");
            xb_add(&bar[XB_XGEN(b.x)], 1u);
            asm volatile("s_waitcnt vmcnt(0)" ::: "memory");
        } else {
            XB_SPIN(xb_ld(&bar[XB_XGEN(b.x)]) == gen, bar);
            __builtin_amdgcn_fence(__ATOMIC_ACQUIRE, "agent");
            asm volatile("s_waitcnt vmcnt(0)" ::: "memory");
        }
    }
    __syncthreads();
}

constexpr size_t WS_RSSP = WS_RSS;
constexpr size_t WS_KMEAN2 = 230 * MiB;
constexpr size_t WS_DL = 230 * MiB + 256 * 1024;
constexpr size_t WS_YC = WS_MQ;
constexpr size_t WS_YA = WS_SR;
constexpr size_t WS_S2 = 232 * MiB;
constexpr size_t WS_END2 = 248 * MiB;


namespace mix {
typedef unsigned u32x4 __attribute__((ext_vector_type(4)));
typedef unsigned u32x2 __attribute__((ext_vector_type(2)));
#define MIX_LAS __attribute__((address_space(3)))
using pg8::pack8; using pg8::unpack8; using pg8::cvt_pk_bf16;
#define MIX_BAR() do { asm volatile("s_waitcnt vmcnt(0) lgkmcnt(0)" ::: "memory"); __builtin_amdgcn_s_barrier(); asm volatile("" ::: "memory"); } while (0)

__device__ __forceinline__ void prepass_item(unsigned char* ws, const float* qw, const float* kw, int b, int blk, int h, MIX_LAS float* part, int tid, int lane, int wave) {
    const int sub = lane >> 4, c8 = (lane & 15) * 8;
    f32x4 qw0 = *(const f32x4*)(qw + c8) * QSCALE, qw1 = *(const f32x4*)(qw + c8 + 4) * QSCALE; const f32x4 kw0 = *(const f32x4*)(kw + c8), kw1 = *(const f32x4*)(kw + c8 + 4);
    f32x4 cs0 = {0.f, 0.f, 0.f, 0.f}, cs1 = cs0;
    bf16_t* MQ = (bf16_t*)(ws + WS_MQ); bf16_t* MK = (bf16_t*)(ws + WS_MK);
#pragma unroll 4
    for (int it = 0; it < 8; ++it) {
        const size_t off = ((size_t)b * SEQ + blk * 256 + wave * 32 + it * 4 + sub) * 512 + h * 128 + c8;
        { f32x4 a, c; unpack8(*(const u32x4*)(MQ + off), a, c); float ss = ((a[0] * a[0] + a[1] * a[1]) + (a[2] * a[2] + a[3] * a[3])) + ((c[0] * c[0] + c[1] * c[1]) + (c[2] * c[2] + c[3] * c[3]));
          ss += swz_xor<1>(ss); ss += swz_xor<2>(ss); ss += swz_xor<4>(ss); ss += swz_xor<8>(ss); const float rs = rsqrtf(ss * (1.f / 128.f) + EPS);
          *(u32x4*)(MQ + off) = pack8(a * rs * qw0, c * rs * qw1); }
        { f32x4 a, c; unpack8(*(const u32x4*)(MK + off), a, c); float ss = ((a[0] * a[0] + a[1] * a[1]) + (a[2] * a[2] + a[3] * a[3])) + ((c[0] * c[0] + c[1] * c[1]) + (c[2] * c[2] + c[3] * c[3]));
          ss += swz_xor<1>(ss); ss += swz_xor<2>(ss); ss += swz_xor<4>(ss); ss += swz_xor<8>(ss); const float rs = rsqrtf(ss * (1.f / 128.f) + EPS);
          a = a * rs * kw0; c = c * rs * kw1; cs0 += a; cs1 += c; *(u32x4*)(MK + off) = pack8(a, c); }
    }
#pragma unroll
    for (int j = 0; j < 4; ++j) { cs0[j] += swz_xor<16>(cs0[j]); cs0[j] = half_sum(cs0[j]); cs1[j] += swz_xor<16>(cs1[j]); cs1[j] = half_sum(cs1[j]); }
    if (sub == 0) { *(MIX_LAS f32x4*)(part + wave * 128 + c8) = cs0; *(MIX_LAS f32x4*)(part + wave * 128 + c8 + 4) = cs1; }
    MIX_BAR();
    if (tid < 128) { float s = 0.f;
#pragma unroll
        for (int w = 0; w < 8; ++w) s += part[w * 128 + tid];
        ((float*)(ws + WS_KMEAN))[(((size_t)b * 4 + h) * 8 + blk) * 128 + tid] = s * (1.f / 256.f); }
    MIX_BAR();
}

constexpr int PSTR = 272;
__device__ __forceinline__ void pool_item(unsigned char* ws, const float* pscale, int pm, int g, MIX_LAS unsigned char* lds, int tid, int lane, int wave) {
    MIX_LAS unsigned char* P = lds; MIX_LAS unsigned char* W = lds + 256 * PSTR;
    const bf16_t* PW = (const bf16_t*)(ws + WS_W + W_PW) + g * 128 * 128;
#pragma unroll
    for (int j = 0; j < 4; ++j) { const int id = tid + 512 * j, e = id >> 4, cc = id & 15; *(MIX_LAS u32x4*)(W + e * PSTR + cc * 16) = *(const u32x4*)(PW + e * 128 + cc * 8); }
    {
        const int cp = tid & 63, seg = tid >> 6, w = 2 << g; const int row0 = pm * 256 + seg * 32, t0 = row0 & (SEQ - 1);
        const unsigned* PU = (const unsigned*)(ws + WS_PU) + g * 64 + cp;
        float s0 = 0.f, s1 = 0.f;
        for (int j = 1; j < w; ++j) if (t0 - j >= 0) { const unsigned v = PU[(size_t)(row0 - j) * 256]; s0 += __uint_as_float(v << 16); s1 += __uint_as_float(v & 0xffff0000u); }
#pragma unroll 8
        for (int r = 0; r < 32; ++r) {
            const int t = t0 + r; const unsigned v = PU[(size_t)(row0 + r) * 256]; const float u0 = __uint_as_float(v << 16), u1 = __uint_as_float(v & 0xffff0000u);
            s0 += u0; s1 += u1; const float ic = 1.f / (float)min(t + 1, w);
            *(MIX_LAS unsigned*)(P + (seg * 32 + r) * PSTR + cp * 4) = cvt_pk_bf16(s0 * ic - u0, s1 * ic - u1);
            if (t - w + 1 >= 0) { const unsigned o = PU[(size_t)(row0 + r - w + 1) * 256]; s0 -= __uint_as_float(o << 16); s1 -= __uint_as_float(o & 0xffff0000u); }
        }
    }
    MIX_BAR();
    f32x4 acc[8][2];
#pragma unroll
    for (int n = 0; n < 8; ++n) { acc[n][0] = (f32x4){0.f, 0.f, 0.f, 0.f}; acc[n][1] = acc[n][0]; }
    const int r = lane & 15, q = lane >> 4;
#pragma unroll
    for (int kk = 0; kk < 4; ++kk) {
        bf16x8 pf[2];
#pragma unroll
        for (int m = 0; m < 2; ++m) pf[m] = *(const MIX_LAS bf16x8*)(P + (wave * 32 + m * 16 + r) * PSTR + (kk * 32 + 8 * q) * 2);
#pragma unroll
        for (int n = 0; n < 8; ++n) { const bf16x8 wf = *(const MIX_LAS bf16x8*)(W + (n * 16 + r) * PSTR + (kk * 32 + 8 * q) * 2);
#pragma unroll
            for (int m = 0; m < 2; ++m) acc[n][m] = __builtin_amdgcn_mfma_f32_16x16x32_bf16(wf, pf[m], acc[n][m], 0, 0, 0); }
    }
    bf16_t* YB = (bf16_t*)(ws + WS_YB);
#pragma unroll
    for (int n = 0; n < 8; ++n) { const f32x4 sc = *(const f32x4*)(pscale + g * 128 + n * 16 + 4 * q);
#pragma unroll
        for (int m = 0; m < 2; ++m) { const f32x4 y = acc[n][m] * sc; u32x2 o; o.x = cvt_pk_bf16(y[0], y[1]); o.y = cvt_pk_bf16(y[2], y[3]);
            *(u32x2*)(YB + (size_t)(pm * 256 + wave * 32 + m * 16 + r) * 512 + g * 128 + n * 16 + 4 * q) = o; } }
    MIX_BAR();
}

constexpr int GSTR = 144;
constexpr int GL_SEG = 0, GL_QE = 2048, GL_KE = GL_QE + 64 * GSTR, GL_VT = GL_KE + 64 * GSTR, GL_P = GL_VT + 128 * GSTR, GL_RED = GL_P + 64 * GSTR;
__device__ __forceinline__ void gla_cumsum(const float* GG, size_t row0, int h, MIX_LAS unsigned char* lds, int d, int seg, float (&bc)[8], float& bL) {
    const float* g = GG + (row0 + seg * 8) * 256 + h * 64 + d; float c = 0.f;
#pragma unroll
    for (int j = 0; j < 8; ++j) { c += g[j * 256]; bc[j] = c; }
    MIX_LAS float* SEG = (MIX_LAS float*)(lds + GL_SEG); SEG[seg * 64 + d] = c;
    MIX_BAR();
    float off = 0.f, tot = 0.f;
#pragma unroll
    for (int s = 0; s < 8; ++s) { const float v = SEG[s * 64 + d]; tot += v; off += (s < seg) ? v : 0.f; }
#pragma unroll
    for (int j = 0; j < 8; ++j) bc[j] += off;
    bL = tot;
}
__device__ __forceinline__ void gla_vt(const bf16_t* GV, size_t row0, int h, MIX_LAS unsigned char* lds, int tid) {
    const int e = tid & 127, tq = tid >> 7; const bf16_t* v = GV + (row0 + tq * 16) * 512 + h * 128 + e; unsigned w[8];
#pragma unroll
    for (int j = 0; j < 8; ++j) w[j] = (unsigned)v[(2 * j) * 512] | ((unsigned)v[(2 * j + 1) * 512] << 16);
    MIX_LAS u32x4* p = (MIX_LAS u32x4*)(lds + GL_VT + e * GSTR + tq * 32); p[0] = (u32x4){w[0], w[1], w[2], w[3]}; p[1] = (u32x4){w[4], w[5], w[6], w[7]};
}
__device__ __forceinline__ void gla_passA_item(unsigned char* ws, int cid, MIX_LAS unsigned char* lds, int tid, int lane, int wave) {
    const int d = tid & 63, seg = tid >> 6, bh = cid >> 5, n = cid & 31, b = bh >> 2, h = bh & 3; const size_t row0 = (size_t)b * SEQ + n * 64;
    float bc[8], bL;
    const bf16_t* gk = (const bf16_t*)(ws + WS_GK) + (row0 + seg * 8) * 256 + h * 64 + d; float kv[8];
#pragma unroll
    for (int j = 0; j < 8; ++j) kv[j] = bf2f(gk[j * 256]);
    gla_vt((const bf16_t*)(ws + WS_GV), row0, h, lds, tid);
    gla_cumsum((const float*)(ws + WS_GG), row0, h, lds, d, seg, bc, bL);
    { f32x4 a, c;
#pragma unroll
      for (int j = 0; j < 4; ++j) { a[j] = kv[j] * __expf(bL - bc[j]); c[j] = kv[4 + j] * __expf(bL - bc[4 + j]); }
      *(MIX_LAS u32x4*)(lds + GL_KE + d * GSTR + seg * 16) = pack8(a, c); }
    if (seg == 0) ((float*)(ws + WS_DL))[(size_t)cid * 64 + d] = __expf(bL);
    MIX_BAR();
    const int r = lane & 15, q = lane >> 4; f32x4 acc[4];
#pragma unroll
    for (int dt = 0; dt < 4; ++dt) acc[dt] = (f32x4){0.f, 0.f, 0.f, 0.f};
#pragma unroll
    for (int kk = 0; kk < 2; ++kk) { const bf16x8 vf = *(const MIX_LAS bf16x8*)(lds + GL_VT + (wave * 16 + r) * GSTR + (kk * 32 + 8 * q) * 2);
#pragma unroll
        for (int dt = 0; dt < 4; ++dt) { const bf16x8 kf = *(const MIX_LAS bf16x8*)(lds + GL_KE + (dt * 16 + r) * GSTR + (kk * 32 + 8 * q) * 2);
            acc[dt] = __builtin_amdgcn_mfma_f32_16x16x32_bf16(kf, vf, acc[dt], 0, 0, 0); } }
    bf16_t* US = (bf16_t*)(ws + WS_US) + ((size_t)cid * 128 + wave * 16 + r) * 64;
#pragma unroll
    for (int dt = 0; dt < 4; ++dt) { u32x2 o; o.x = cvt_pk_bf16(acc[dt][0], acc[dt][1]); o.y = cvt_pk_bf16(acc[dt][2], acc[dt][3]); *(u32x2*)(US + dt * 16 + 4 * q) = o; }
    MIX_BAR();
}
__device__ __forceinline__ void gla_scan(unsigned char* ws, int gtid) {
    const int bh = gtid >> 12, e = (gtid >> 5) & 127, dp = gtid & 31;
    const size_t uoff = (((size_t)bh * 32) * 128 + e) * 32 + dp; const unsigned* US = (const unsigned*)(ws + WS_US) + uoff; unsigned* S2 = (unsigned*)(ws + WS_S2) + uoff; const float* DLp = (const float*)(ws + WS_DL) + (size_t)bh * 32 * 64 + 2 * dp;
    float s0 = 0.f, s1 = 0.f;
#pragma unroll 8
    for (int n = 0; n < 32; ++n) { const unsigned u = US[(size_t)n * 128 * 32]; const float d0 = DLp[n * 64], d1 = DLp[n * 64 + 1];
        S2[(size_t)n * 128 * 32] = cvt_pk_bf16(s0, s1);
        s0 = d0 * s0 + __uint_as_float(u << 16); s1 = d1 * s1 + __uint_as_float(u & 0xffff0000u); }
}
__device__ __forceinline__ void gla_passC_item(unsigned char* ws, const float* nw, int cid, MIX_LAS unsigned char* lds, int tid, int lane, int wave, size_t ya_off) {
    const int d = tid & 63, seg = tid >> 6, bh = cid >> 5, n = cid & 31, b = bh >> 2, h = bh & 3; const size_t row0 = (size_t)b * SEQ + n * 64;
    float bc[8], bL;
    const bf16_t* gk = (const bf16_t*)(ws + WS_GK) + (row0 + seg * 8) * 256 + h * 64 + d; const bf16_t* gq = (const bf16_t*)(ws + WS_GQ) + (row0 + seg * 8) * 256 + h * 64 + d; float kv[8], qv[8];
#pragma unroll
    for (int j = 0; j < 8; ++j) { kv[j] = bf2f(gk[j * 256]); qv[j] = bf2f(gq[j * 256]); }
    const int r = lane & 15, q = lane >> 4, it2 = wave & 3, eh = wave >> 2;
    bf16x8 sfr[4][2]; { const bf16_t* ST = (const bf16_t*)(ws + WS_S2) + (size_t)cid * 128 * 64;
#pragma unroll
        for (int nn = 0; nn < 4; ++nn)
#pragma unroll
            for (int kk = 0; kk < 2; ++kk) sfr[nn][kk] = *(const bf16x8*)(ST + ((eh * 4 + nn) * 16 + r) * 64 + kk * 32 + 8 * q); }
    const size_t yoff = (row0 + it2 * 16 + r) * 512 + h * 128 + eh * 64 + 4 * q; u32x2 srv[4];
#pragma unroll
    for (int nn = 0; nn < 4; ++nn) srv[nn] = *(const u32x2*)((const bf16_t*)(ws + WS_SR) + yoff + nn * 16);
    gla_vt((const bf16_t*)(ws + WS_GV), row0, h, lds, tid);
    gla_cumsum((const float*)(ws + WS_GG), row0, h, lds, d, seg, bc, bL);
#pragma unroll
    for (int j = 0; j < 8; ++j) { const float ex = __expf(bc[j]);
        *(MIX_LAS bf16_t*)(lds + GL_QE + (seg * 8 + j) * GSTR + 2 * d) = f2bf(qv[j] * ex);
        *(MIX_LAS bf16_t*)(lds + GL_KE + (seg * 8 + j) * GSTR + 2 * d) = f2bf(kv[j] * __expf(-bc[j])); }
    MIX_BAR();
    {
        const int it = wave >> 1;
#pragma unroll
        for (int jj = 0; jj < 2; ++jj) { const int jt = 2 * (wave & 1) + jj; f32x4 acc = {0.f, 0.f, 0.f, 0.f};
            if (jt <= it) {
#pragma unroll
                for (int kk = 0; kk < 2; ++kk) { const bf16x8 qf = *(const MIX_LAS bf16x8*)(lds + GL_QE + (it * 16 + r) * GSTR + (kk * 32 + 8 * q) * 2);
                    const bf16x8 kf = *(const MIX_LAS bf16x8*)(lds + GL_KE + (jt * 16 + r) * GSTR + (kk * 32 + 8 * q) * 2);
                    acc = __builtin_amdgcn_mfma_f32_16x16x32_bf16(qf, kf, acc, 0, 0, 0); }
                if (jt == it) {
#pragma unroll
                    for (int x = 0; x < 4; ++x) if (r > 4 * q + x) acc[x] = 0.f; } }
#pragma unroll
            for (int x = 0; x < 4; ++x) *(MIX_LAS bf16_t*)(lds + GL_P + (it * 16 + 4 * q + x) * GSTR + (jt * 16 + r) * 2) = f2bf(acc[x]); }
    }
    MIX_BAR();
    const int it = it2; f32x4 acc[4];
    {
        bf16x8 pf[2], qf[2];
#pragma unroll
        for (int kk = 0; kk < 2; ++kk) { pf[kk] = *(const MIX_LAS bf16x8*)(lds + GL_P + (it * 16 + r) * GSTR + (kk * 32 + 8 * q) * 2); qf[kk] = *(const MIX_LAS bf16x8*)(lds + GL_QE + (it * 16 + r) * GSTR + (kk * 32 + 8 * q) * 2); }
#pragma unroll
        for (int nn = 0; nn < 4; ++nn) { const int et = eh * 4 + nn; acc[nn] = (f32x4){0.f, 0.f, 0.f, 0.f};
#pragma unroll
            for (int kk = 0; kk < 2; ++kk) { const bf16x8 vf = *(const MIX_LAS bf16x8*)(lds + GL_VT + (et * 16 + r) * GSTR + (kk * 32 + 8 * q) * 2);
                const bf16x8 sf = sfr[nn][kk];
                acc[nn] = __builtin_amdgcn_mfma_f32_16x16x32_bf16(vf, pf[kk], acc[nn], 0, 0, 0);
                acc[nn] = __builtin_amdgcn_mfma_f32_16x16x32_bf16(sf, qf[kk], acc[nn], 0, 0, 0); } }
    }
    float ss = 0.f;
#pragma unroll
    for (int nn = 0; nn < 4; ++nn) ss += (acc[nn][0] * acc[nn][0] + acc[nn][1] * acc[nn][1]) + (acc[nn][2] * acc[nn][2] + acc[nn][3] * acc[nn][3]);
    ss += swz_xor<16>(ss); ss = half_sum(ss);
    MIX_LAS float* RED = (MIX_LAS float*)(lds + GL_RED);
    if (q == 0) RED[eh * 64 + it * 16 + r] = ss;
    MIX_BAR();
    const float rstd = rsqrtf((RED[it * 16 + r] + RED[64 + it * 16 + r]) * (1.f / 128.f) + EPS);
    bf16_t* YA = (bf16_t*)(ws + ya_off) + yoff;
#pragma unroll
    for (int nn = 0; nn < 4; ++nn) { const u32x2 sr = srv[nn]; const f32x4 w4 = *(const f32x4*)(nw + eh * 64 + nn * 16 + 4 * q);
        const float y0 = acc[nn][0] * rstd * w4[0] * __uint_as_float(sr.x << 16), y1 = acc[nn][1] * rstd * w4[1] * __uint_as_float(sr.x & 0xffff0000u);
        const float y2 = acc[nn][2] * rstd * w4[2] * __uint_as_float(sr.y << 16), y3 = acc[nn][3] * rstd * w4[3] * __uint_as_float(sr.y & 0xffff0000u);
        u32x2 o; o.x = cvt_pk_bf16(y0, y1); o.y = cvt_pk_bf16(y2, y3); *(u32x2*)(YA + nn * 16) = o; }
    MIX_BAR();
}
}

namespace moba {
typedef short s16x4 __attribute__((ext_vector_type(4)));
typedef float f32x16 __attribute__((ext_vector_type(16)));
typedef unsigned u32x4 __attribute__((ext_vector_type(4)));
using pg8::cvt_pk_bf16;
constexpr int D = 128, LD = 512, NW = 8, QBLK = 32, KVBLK = 128, QB = 256;
constexpr int SHM_V = KVBLK * D * 2, SHM_K = KVBLK * D * 2;
constexpr int LDS_WS = 131072 + 1024, LDS_TAB = LDS_WS + NW * 64 * 4, LDS_BYTES = LDS_TAB + 512;
constexpr float THR2 = 11.5f;
#define KSWZ(row, colB) ((row) * 256 + ((colB) ^ (((row) & 7) << 4)))
#define SBAR() __builtin_amdgcn_sched_barrier(0)
__device__ __forceinline__ int v_st(int k, int c) { const int kk = (k & ~0xC) | ((k & 4) << 1) | ((k & 8) >> 1); return ((kk >> 3) * 4 + (c >> 5)) * 512 + ((kk & 7) * 32 + (c & 31)) * 2; }
__device__ __forceinline__ int v_rd_base(int lane) { return ((lane & 3) << 3) | (((lane >> 2) & 3) << 6) | (((lane >> 4) & 1) << 5) | (((lane >> 5) & 1) << 8); }
constexpr int v_rd_off(int d0, int ks, int half) { return d0 * 512 + ks * 4096 + half * 2048; }
__device__ __forceinline__ int crow(int r, int hi) { return (r & 3) + 8 * (r >> 2) + 4 * hi; }
__device__ __forceinline__ bf16x8 load8(const bf16_t* p) { return *reinterpret_cast<const bf16x8*>(p); }

__device__ __forceinline__ void partialSM(f32x16& p0, f32x16& p1, float& m_reg, float& mn, float& alpha) {
    float pmax = p0[0];
#pragma unroll
    for (int r = 1; r < 16; ++r) pmax = fmaxf(pmax, p0[r]);
#pragma unroll
    for (int r = 0; r < 16; ++r) pmax = fmaxf(pmax, p1[r]);
    { auto rr = __builtin_amdgcn_permlane32_swap(__float_as_uint(pmax), __float_as_uint(pmax), false, false); pmax = fmaxf(__uint_as_float(rr[0]), __uint_as_float(rr[1])); }
    if (__builtin_expect(__all((pmax - m_reg) <= THR2), 1)) { mn = m_reg; alpha = 1.f; }
    else { mn = fmaxf(m_reg, pmax); alpha = __builtin_amdgcn_exp2f(m_reg - mn); m_reg = mn; }
#pragma unroll
    for (int r = 0; r < 16; ++r) p0[r] = p0[r] - mn;
#pragma unroll
    for (int r = 0; r < 16; ++r) p1[r] = p1[r] - mn;
#pragma unroll
    for (int r = 0; r < 16; ++r) p0[r] = __builtin_amdgcn_exp2f(p0[r]);
}
__device__ __forceinline__ void finishSM(f32x16& p0, f32x16& p1, float alpha, float& l_reg, bf16x8& pa0, bf16x8& pa1, bf16x8& pa2, bf16x8& pa3) {
#pragma unroll
    for (int r = 0; r < 16; ++r) p1[r] = __builtin_amdgcn_exp2f(p1[r]);
    float ps = 0;
#pragma unroll
    for (int r = 0; r < 16; ++r) ps += p0[r];
#pragma unroll
    for (int r = 0; r < 16; ++r) ps += p1[r];
    { auto rr = __builtin_amdgcn_permlane32_swap(__float_as_uint(ps), __float_as_uint(ps), false, false); ps = __uint_as_float(rr[0]) + __uint_as_float(rr[1]); }
    l_reg = l_reg * alpha + ps;
#define PK4(P, B_, OUT) do { unsigned a0 = cvt_pk_bf16(P[B_+0], P[B_+1]), a1 = cvt_pk_bf16(P[B_+2], P[B_+3]);                          \
        unsigned b0 = cvt_pk_bf16(P[B_+4], P[B_+5]), b1 = cvt_pk_bf16(P[B_+6], P[B_+7]);                                             \
        auto r0 = __builtin_amdgcn_permlane32_swap(a0, b0, false, false); auto r1 = __builtin_amdgcn_permlane32_swap(a1, b1, false, false); \
        u32x4 w = {r0[0], r1[0], r0[1], r1[1]}; OUT = *reinterpret_cast<bf16x8*>(&w); } while (0)
    PK4(p0, 0, pa0); PK4(p0, 8, pa1); PK4(p1, 0, pa2); PK4(p1, 8, pa3);
#undef PK4
}
template <int KB>
__device__ __forceinline__ void qkt(f32x16& p0, f32x16& p1, const char* K_lds, int krow, int hi, const bf16x8* qr, bool act) {
    if (!act) { const float NEG = -__builtin_inff();
#pragma unroll
        for (int r = 0; r < 16; ++r) { p0[r] = NEG; p1[r] = NEG; } return; }
    p0 = f32x16{}; p1 = f32x16{};
    const char* kb[4];
#pragma unroll
    for (int dd = 0; dd < 4; ++dd) kb[dd] = K_lds + KB * SHM_K + KSWZ(krow, (dd * 16 + hi * 8) * 2);
#pragma unroll
    for (int d0 = 0; d0 < 8; ++d0) { const char* a = kb[d0 & 3] + (d0 >> 2) * 128;
        bf16x8 b0 = *reinterpret_cast<const bf16x8*>(a);
        bf16x8 b1 = *reinterpret_cast<const bf16x8*>(a + 32 * 256);
        p0 = __builtin_amdgcn_mfma_f32_32x32x16_bf16(b0, qr[d0], p0, 0, 0, 0);
        p1 = __builtin_amdgcn_mfma_f32_32x32x16_bf16(b1, qr[d0], p1, 0, 0, 0); }
}
template <int VB>
__device__ __forceinline__ void pv_tile(f32x16* o, int vb0, bf16x8 pa0, bf16x8 pa1, bf16x8 pa2, bf16x8 pa3, bool act) {
    if (!act) return;
#define TRRD(dst, off) asm volatile("ds_read_b64_tr_b16 %0, %1 offset:%2" : "=&v"(dst) : "v"(vb0), "i"(off) : "memory")
#define PV_D0(d0) do { s16x4 l0, l1, l2, l3, h0, h1, h2, h3; constexpr int b_ = VB * SHM_V + v_rd_off(d0, 0, 0); \
        TRRD(l0, b_); TRRD(h0, b_ + 2048); TRRD(l1, b_ + 4096); TRRD(h1, b_ + 6144); TRRD(l2, b_ + 8192); TRRD(h2, b_ + 10240); TRRD(l3, b_ + 12288); TRRD(h3, b_ + 14336); \
        asm volatile("s_waitcnt lgkmcnt(0)" ::: "memory"); SBAR();   \
        o[d0] = __builtin_amdgcn_mfma_f32_32x32x16_bf16(pa0, (bf16x8){l0[0], l0[1], l0[2], l0[3], h0[0], h0[1], h0[2], h0[3]}, o[d0], 0, 0, 0);   \
        o[d0] = __builtin_amdgcn_mfma_f32_32x32x16_bf16(pa1, (bf16x8){l1[0], l1[1], l1[2], l1[3], h1[0], h1[1], h1[2], h1[3]}, o[d0], 0, 0, 0);   \
        o[d0] = __builtin_amdgcn_mfma_f32_32x32x16_bf16(pa2, (bf16x8){l2[0], l2[1], l2[2], l2[3], h2[0], h2[1], h2[2], h2[3]}, o[d0], 0, 0, 0);   \
        o[d0] = __builtin_amdgcn_mfma_f32_32x32x16_bf16(pa3, (bf16x8){l3[0], l3[1], l3[2], l3[3], h3[0], h3[1], h3[2], h3[3]}, o[d0], 0, 0, 0); } while (0)
    PV_D0(0); PV_D0(1); PV_D0(2); PV_D0(3);
#undef PV_D0
#undef TRRD
}
__device__ __forceinline__ void mask_bias_tile(f32x16& p0, f32x16& p1, int dq, const float* tab) {
    const float NEG = -__builtin_inff();
#pragma unroll
    for (int r = 0; r < 16; ++r) { const int c = (r & 3) + 8 * (r >> 2); const int d0 = dq - c, d1 = dq - c - 32;
        p0[r] = d0 < 0 ? NEG : p0[r] + tab[d0 > 113 ? 113 : d0];
        p1[r] = d1 < 0 ? NEG : p1[r] + tab[d1 > 113 ? 113 : d1]; }
}
__device__ __forceinline__ void bias_tile(f32x16& p0, f32x16& p1, int dq, const float* tab) {
#pragma unroll
    for (int r = 0; r < 16; ++r) { const int c = (r & 3) + 8 * (r >> 2); const int d0 = dq - c, d1 = dq - c - 32;
        p0[r] += tab[d0 > 113 ? 113 : d0]; p1[r] += tab[d1 > 113 ? 113 : d1]; }
}
__device__ __forceinline__ void kill_tile(f32x16& p0, f32x16& p1, bool ok) {
    const float NEG = -__builtin_inff();
#pragma unroll
    for (int r = 0; r < 16; ++r) { p0[r] = ok ? p0[r] : NEG; p1[r] = ok ? p1[r] : NEG; }
}

struct BlockRef { const bf16_t* Q; const bf16_t* K; const bf16_t* V; bf16_t* O; const float* km; int P0; };
struct Seam { bf16x8 qr[8]; bf16x8 st_v0, st_v1, st_v2, st_v3, st_k0, st_k1, st_k2, st_k3; };
#define ROW(p, k0, rr) ((p) + (size_t)((k0) + (rr)) * LD + sc)
#define VMW() asm volatile("s_waitcnt vmcnt(0)" ::: "memory")
#define SLOAD_H(Kp, Vp, k0) do { S.st_v0 = load8(ROW(Vp, k0, sr)); S.st_v1 = load8(ROW(Vp, k0, 32 + sr)); S.st_v2 = load8(ROW(Vp, k0, 64 + sr)); S.st_v3 = load8(ROW(Vp, k0, 96 + sr)); \
                                 S.st_k0 = load8(ROW(Kp, k0, sr)); S.st_k1 = load8(ROW(Kp, k0, 32 + sr)); S.st_k2 = load8(ROW(Kp, k0, 64 + sr)); S.st_k3 = load8(ROW(Kp, k0, 96 + sr)); } while (0)
#define SWRITE_HK(bf) do { *(bf16x8*)(K_lds + (bf) * SHM_K + kws) = S.st_k0; *(bf16x8*)(K_lds + (bf) * SHM_K + kws + 32 * 256) = S.st_k1; *(bf16x8*)(K_lds + (bf) * SHM_K + kws + 64 * 256) = S.st_k2; *(bf16x8*)(K_lds + (bf) * SHM_K + kws + 96 * 256) = S.st_k3; } while (0)
#define SWRITE_HV(bf) do { *(bf16x8*)(V_lds + (bf) * SHM_V + vst0) = S.st_v0; *(bf16x8*)(V_lds + (bf) * SHM_V + vst1) = S.st_v1; *(bf16x8*)(V_lds + (bf) * SHM_V + 16384 + vst0) = S.st_v2; *(bf16x8*)(V_lds + (bf) * SHM_V + 16384 + vst1) = S.st_v3; } while (0)
#define SWRITE_H(bf) do { SWRITE_HV(bf); SWRITE_HK(bf); } while (0)
__device__ __forceinline__ void prime(const BlockRef& cur, const float* rel_bias, int h, char* lds, Seam& S, int tid) {
    const int wid = __builtin_amdgcn_readfirstlane(tid >> 6), lane = tid & 63, r32 = lane & 31, hi = lane >> 5, rg = wid & 3;
    const int sr = tid >> 4, sc = (tid & 15) * 8, kws = KSWZ(sr, sc * 2); char* K_lds = lds + 2 * SHM_V;
    __syncthreads();
    if (tid < 128) { int bk = tid; if (tid >= 16) { bk = 16 + (int)(__logf((float)tid * (1.f / 16.f)) * (16.f / 2.0794415416798357f)); bk = bk > 31 ? 31 : bk; }
        ((float*)(lds + LDS_TAB))[tid] = tid >= 113 ? 0.f : (rel_bias[bk * 4 + h] - rel_bias[31 * 4 + h]) * LOG2E; }
#pragma unroll
    for (int d0 = 0; d0 < 8; ++d0) S.qr[d0] = load8(cur.Q + (size_t)(rg * QBLK + r32) * LD + d0 * 16 + hi * 8);
    SLOAD_H(cur.K, cur.V, 0); VMW(); SWRITE_HK(0);
    __syncthreads();
}
__device__ __forceinline__ void block(const BlockRef& cur, char* lds, Seam& S, int tid) {
    const int wid = __builtin_amdgcn_readfirstlane(tid >> 6), lane = tid & 63, r32 = lane & 31, hi = lane >> 5, rg = wid & 3, kh = wid >> 2;
    const int qblk = cur.P0 >> 8, NT = 2 * qblk + 2;
    const int qlo = cur.P0 + rg * QBLK, qm = qlo + r32 - 4 * hi - 64 * kh;
    char* V_lds = lds; char* K_lds = lds + 2 * SHM_V;
    float* ws = (float*)(lds + LDS_WS) + wid * 64; float* li_l = ws, * al_l = ws + 32; const float* tab = (const float*)(lds + LDS_TAB);
    float m_reg = -1e30f, l_reg = 0; f32x16 o[4] = {};
    const int sr = tid >> 4, sc = (tid & 15) * 8, vst0 = v_st(sr, sc), vst1 = v_st(32 + sr, sc), kws = KSWZ(sr, sc * 2);
    const int vb0 = (int)(uintptr_t)V_lds + v_rd_base(lane) + kh * 16384, krow = r32 + 64 * kh;
    const bf16_t* Kh = cur.K; const bf16_t* Vh = cur.V;
    unsigned sel = (1u << qblk) - 1u;
    if (qblk > 3) {
        float s[7];
#pragma unroll
        for (int n = 0; n < 7; ++n) { s[n] = -__builtin_inff();
            if (n < qblk) { float a = 0.f; const float* kmn = cur.km + n * 128 + hi * 8;
#pragma unroll
                for (int d0 = 0; d0 < 8; ++d0) { const f32x4 k0 = *(const f32x4*)(kmn + d0 * 16), k1 = *(const f32x4*)(kmn + d0 * 16 + 4); const bf16x8 qv = S.qr[d0];
#pragma unroll
                    for (int j = 0; j < 4; ++j) { a += __uint_as_float(((unsigned)(unsigned short)qv[j]) << 16) * k0[j]; a += __uint_as_float(((unsigned)(unsigned short)qv[4 + j]) << 16) * k1[j]; } }
                s[n] = half_sum(a); } }
        sel = 0u;
#pragma unroll
        for (int c = 0; c < 3; ++c) { float best = -__builtin_inff(); int bi = 0;
#pragma unroll
            for (int n = 0; n < 7; ++n) if (s[n] > best) { best = s[n]; bi = n; }
            sel |= 1u << bi;
#pragma unroll
            for (int n = 0; n < 7; ++n) s[n] = (n == bi) ? -__builtin_inff() : s[n]; }
    }
#define RESC(a) do { if (__any((a) < 1.f)) { if (hi == 0) al_l[r32] = (a); asm volatile("s_waitcnt lgkmcnt(0)" ::: "memory");              \
                     for (int d_ = 0; d_ < 4; ++d_) for (int r = 0; r < 16; ++r) o[d_][r] *= al_l[crow(r, hi)]; } } while (0)
#define KBASE(t) ((t) * KVBLK)
#define ACT(t) ((KBASE(t) >> 8) < qblk ? (__any((sel >> (KBASE(t) >> 8)) & 1u) != 0) : (KBASE(t) + 64 * kh <= qlo + QBLK - 1))
#define MASKT(P0_, P1_, t) do { const int kb_ = KBASE(t); if (ACT(t)) { if ((kb_ >> 8) < qblk) { if (kb_ + 64 * kh + 176 > qlo) bias_tile(P0_, P1_, qm - kb_, tab); kill_tile(P0_, P1_, ((sel >> (kb_ >> 8)) & 1u) != 0u); } \
                                     else mask_bias_tile(P0_, P1_, qm - kb_, tab); } } while (0)
    f32x16 pA0, pA1, pB0, pB1; float mnA, mnB, alA, alB; bf16x8 pa0, pa1, pa2, pa3;
    SWRITE_HV(0); SBAR();
    SLOAD_H(Kh, Vh, KBASE(1));
    SBAR(); qkt<0>(pA0, pA1, K_lds, krow, hi, S.qr, ACT(0));
    MASKT(pA0, pA1, 0); partialSM(pA0, pA1, m_reg, mnA, alA);
    VMW(); SWRITE_H(1); SBAR(); if (2 < NT) { SLOAD_H(Kh, Vh, KBASE(2)); } SBAR();
    __syncthreads();
#define HALF_STEP(PX0, PX1, mnX, alX, PY0, PY1, alY, t, KB, VB, SB) do {                                                      \
        SBAR(); qkt<KB>(PX0, PX1, K_lds, krow, hi, S.qr, ACT(t));                                                          \
        finishSM(PY0, PY1, alY, l_reg, pa0, pa1, pa2, pa3); SBAR();                                                           \
        pv_tile<VB>(o, vb0, pa0, pa1, pa2, pa3, ACT((t) - 1)); MASKT(PX0, PX1, (t)); partialSM(PX0, PX1, m_reg, mnX, alX);    \
        __syncthreads();                                                                                                      \
        if ((t) + 1 < NT) { VMW(); SWRITE_H(SB); SBAR(); if ((t) + 2 < NT) { SLOAD_H(Kh, Vh, KBASE((t) + 2)); } SBAR(); }          \
        RESC(alX); __syncthreads(); } while (0)
    for (int t = 1; t + 1 < NT; t += 2) {
        HALF_STEP(pB0, pB1, mnB, alB, pA0, pA1, alA, t, 1, 0, 0);
        HALF_STEP(pA0, pA1, mnA, alA, pB0, pB1, alB, t + 1, 0, 1, 1);
    }
    SBAR(); qkt<1>(pB0, pB1, K_lds, krow, hi, S.qr, ACT(NT - 1)); SBAR();
    finishSM(pA0, pA1, alA, l_reg, pa0, pa1, pa2, pa3); SBAR();
    pv_tile<0>(o, vb0, pa0, pa1, pa2, pa3, ACT(NT - 2));
    MASKT(pB0, pB1, NT - 1); partialSM(pB0, pB1, m_reg, mnB, alB); __syncthreads(); RESC(alB);
    finishSM(pB0, pB1, alB, l_reg, pa0, pa1, pa2, pa3); SBAR(); pv_tile<1>(o, vb0, pa0, pa1, pa2, pa3, ACT(NT - 1));
    __syncthreads();
    float* mls = (float*)(lds + LDS_WS) + (rg + 4) * 64;
    float* osh = (float*)lds + (size_t)rg * 64 * 64;
    if (kh == 1) { if (hi == 0) { mls[r32] = m_reg; mls[32 + r32] = l_reg; }
#pragma unroll
        for (int d0 = 0; d0 < 4; ++d0)
#pragma unroll
            for (int r = 0; r < 16; ++r) osh[(d0 * 16 + r) * 64 + lane] = o[d0][r]; }
    __syncthreads();
    if (kh == 0) {
        const float m1 = mls[r32], l1 = mls[32 + r32]; const float mm = fmaxf(m_reg, m1); const float a0 = __builtin_amdgcn_exp2f(m_reg - mm), a1 = __builtin_amdgcn_exp2f(m1 - mm);
        const float il = __builtin_amdgcn_rcpf(l_reg * a0 + l1 * a1);
        if (hi == 0) { li_l[r32] = a0 * il; al_l[r32] = a1 * il; } asm volatile("s_waitcnt lgkmcnt(0)" ::: "memory");
        bf16_t* Ow = cur.O + (size_t)(rg * QBLK) * LD;
#pragma unroll
        for (int r = 0; r < 16; ++r) { const int orow = crow(r, hi); const float f0 = li_l[orow], f1 = al_l[orow];
#pragma unroll
            for (int d0 = 0; d0 < 4; ++d0) { const float v = o[d0][r] * f0 + osh[(d0 * 16 + r) * 64 + lane] * f1; const float vn = swz_xor<1>(v);
                if ((r32 & 1) == 0) *(unsigned*)(Ow + (size_t)orow * LD + d0 * 32 + r32) = cvt_pk_bf16(v, vn); } }
    }
#undef RESC
#undef KBASE
#undef ACT
#undef MASKT
#undef HALF_STEP
}
#undef ROW
#undef VMW
#undef SLOAD_H
#undef SWRITE_HK
#undef SWRITE_HV
#undef SWRITE_H
#undef KSWZ
#undef SBAR
}

constexpr int PH_PREP = 0, PH_IN1 = 1, PH_MIX1 = 2, PH_MIX2 = 3, PH_MIX3 = 4, PH_GATES = 5, PH_UPM = 6, PH_OUT = 7, PH_FFN = 8, PH_DOWN = 9, PH_PER_LAYER = 10;
#ifndef PROBE_K
#define PROBE_K -1
#define PROBE_L 0
#define PROBE_N 1
#define PROBE_SUB 15
#endif
struct Args { Inputs in; float* out; unsigned char* ws; int ph_lo, ph_hi, li, mixmask; };

__device__ __forceinline__ void fill_rstd(LAS float* tab, const float* rssp, int bx, int tid) {
#pragma unroll
    for (int j = 0; j < 4; ++j) { const int r = tid + 512 * j; const f32x4* p = (const f32x4*)(rssp + ((size_t)(bx & 7) * 2048 + r) * 16);
        const f32x4 a = p[0], b = p[1], c = p[2], d = p[3]; const f32x4 s = (a + b) + (c + d);
        tab[r] = rsqrtf(((s[0] + s[1]) + (s[2] + s[3])) * (1.f / D) + EPS); }
    __syncthreads();
}
__device__ __forceinline__ int fresh_tid(int wave0) { int ln; asm volatile("v_mbcnt_lo_u32_b32 %0, -1, 0\n\tv_mbcnt_hi_u32_b32 %0, -1, %0" : "=v"(ln)); return wave0 * 64 + ln; }
__global__ void __launch_bounds__(NWAVES * 64, 2) mega_fwd(Args args) {
    extern __shared__ __attribute__((aligned(16))) unsigned char lds[];
    LAS unsigned char* ldsp = (LAS unsigned char*)lds;
    volatile LAS unsigned* MISC = (volatile LAS unsigned*)(ldsp + MISC_OFF);
    const int tid = threadIdx.x; const int wave0 = __builtin_amdgcn_readfirstlane(tid >> 6);
    const int G = gridDim.x; const int bx = blockIdx.x; const int vcu = (G % 8 == 0) ? (bx % 8) * (G / 8) + bx / 8 : bx;
    unsigned char* ws = args.ws;
    float* out = args.out;
    for (int u = tid; u < (LDS_BYTES - LDSCTL_OFF) / 4; u += NWAVES * 64) ((LAS unsigned*)(ldsp + LDSCTL_OFF))[u] = 0u;
    __syncthreads();
    XcdBarrier bar = xcd_barrier_post((unsigned*)(ws + WS_CTL) + CW_BAR + args.li * XCD_BAR_WORDS, MISC + 8); bar.w0 = wave0;
    const int NGW = G * NWAVES;

    unsigned char* const ws0 = ws; float* const out0 = out; const int bx0 = bx;
    for (int ph = args.ph_lo; ph < args.ph_hi; ++ph) {
        const int l = ph / PH_PER_LAYER, k = ph % PH_PER_LAYER;
        size_t zoff = 0; int bx = bx0; asm volatile("" : "+s"(zoff), "+s"(bx)); unsigned char* ws = ws0 + zoff; float* out = out0 + zoff;
#define KARG(i) (*(const float* const __attribute__((address_space(4)))*)((const __attribute__((address_space(4))) char*)__builtin_amdgcn_kernarg_segment_ptr() + 8 * (i) + zoff))
#define LOAD_INPUTS(v) const __attribute__((address_space(4))) Inputs* v = (const __attribute__((address_space(4))) Inputs*)((const __attribute__((address_space(4))) char*)__builtin_amdgcn_kernarg_segment_ptr() + zoff)
        float* rssp = (float*)(ws + WS_RSSP);
        const int nrep = (k == PROBE_K && l == PROBE_L) ? PROBE_N : 1;
        for (int rep = 0; rep < nrep; ++rep) {
        const int mmask = rep == 0 ? args.mixmask : (args.mixmask & PROBE_SUB); const bool stf = (rep + 1 == nrep);
        if (k == PH_PREP) {
            const int tidl = fresh_tid(wave0), lane = tidl & 63, wave = wave0, gw = vcu * NWAVES + wave;
            LOAD_INPUTS(in);
            float* scr = (float*)(lds + wave * 16384);
            for (int it = gw; it < PREP_ITEMS; it += NGW) prep_item(in, l, ws + WS_W, it, scr, lane);
            if (l == 0) {
                for (int row = gw; row < M; row += NGW) {
                    const f32x4* xr = (const f32x4*)(in->x + (size_t)row * D) + lane; float s = 0.f;
                    unsigned long long* o8 = (unsigned long long*)((bf16_t*)(ws + WS_XB) + (size_t)row * D) + lane;
#pragma unroll
                    for (int j = 0; j < 4; ++j) { const f32x4 v = xr[64 * j]; s += (v.x * v.x + v.y * v.y) + (v.z * v.z + v.w * v.w);
                        o8[64 * j] = (unsigned long long)pk2(v.x, v.y) | ((unsigned long long)pk2(v.z, v.w) << 32); }
                    s = wave_sum_s(s); if (lane < 16) rssp[(size_t)row * 16 + lane] = (lane == 0) ? s : 0.f;
                }
            }
        } else if (k == PH_IN1) {
            const int tidl = fresh_tid(wave0);
            pg8::Gemm g{(const bf16_t*)(ws + WS_XB), (const bf16_t*)(ws + WS_W + W_IN), M, NIN1, D}; pg8::StaticOrder S; S.init(M, NIN1, G, bx);
            fill_rstd((LAS float*)(ldsp + RSTD_OFF), rssp, bx, tidl);
            pg8::EpiIn1 E{ws, (const LAS float*)(ldsp + RSTD_OFF), KARG(4) + l * 256};
            pg8::gemm_phase<pg8::EpiIn1, pg8::StaticOrder, true, true>(ldsp, g, S, E, tidl);
        } else if (k == PH_MIX1) {
            const int tidl = fresh_tid(wave0), lane = tidl & 63, wave = wave0;
            if (mmask & 2) for (int it = vcu; it < 256; it += G) mix::prepass_item(ws, KARG(8) + l * 128, KARG(9) + l * 128, it >> 5, (it >> 2) & 7, it & 3, (LAS float*)ldsp, tidl, lane, wave);
            if (mmask & 1) for (int it = vcu; it < 256; it += G) mix::pool_item(ws, KARG(7) + l * 512, it >> 2, it & 3, ldsp, tidl, lane, wave);
            if (mmask & 4) for (int it = vcu; it < 1024; it += G) mix::gla_passA_item(ws, it, ldsp, tidl, lane, wave);
        } else if (k == PH_MIX2) {
            const int tidl = fresh_tid(wave0);
            if (mmask & 4) for (int g0 = vcu * 512 + tidl; g0 < 32 * 4096; g0 += G * 512) mix::gla_scan(ws, g0);
            if (mmask & 8) for (int pr = vcu; pr < 256; pr += G) {
                const int bh = pr >> 3, b = bh >> 2, h = bh & 3, rh = pr & 1, a = (pr >> 1) & 3; const size_t r0 = (size_t)b * SEQ * 512 + h * 128;
#pragma unroll 1
                for (int half = 0; half < 2; ++half) { const int qb = half == 0 ? 7 - a : a; const size_t qoff = r0 + (size_t)(qb * 256 + rh * 128) * 512;
                    moba::BlockRef cur; cur.Q = (const bf16_t*)(ws + WS_MQ) + qoff; cur.O = (bf16_t*)(ws + (stf ? WS_YC : WS_US)) + qoff;
                    cur.K = (const bf16_t*)(ws + WS_MK) + r0; cur.V = (const bf16_t*)(ws + WS_MV) + r0; cur.km = (const float*)(ws + WS_KMEAN) + (size_t)bh * 8 * 128; cur.P0 = qb * 256 + rh * 128;
                    const int tl = fresh_tid(wave0);
                    moba::Seam S; moba::prime(cur, KARG(10), h, (char*)lds, S, tl); moba::block(cur, (char*)lds, S, tl); }
            }
        } else if (k == PH_MIX3) {
            const int tidl = fresh_tid(wave0), lane = tidl & 63, wave = wave0;
            if (mmask & 4) for (int it = vcu; it < 1024; it += G) mix::gla_passC_item(ws, KARG(5) + l * 128, it, ldsp, tidl, lane, wave, stf ? WS_YA : WS_US);
        } else if (k == PH_GATES) {
            const int tidl = fresh_tid(wave0);
            pg8::Gemm g{(const bf16_t*)(ws + WS_XB), (const bf16_t*)(ws + WS_W + W_IN) + (size_t)NIN1 * D, M, NGATE, D}; pg8::StaticOrder S; S.init(M, NGATE, G, bx);
            fill_rstd((LAS float*)(ldsp + RSTD_OFF), rssp, bx, tidl);
            pg8::EpiGates E{ws, (const LAS float*)(ldsp + RSTD_OFF)};
            pg8::gemm_phase<pg8::EpiGates, pg8::StaticOrder, true, true>(ldsp, g, S, E, tidl);
        } else if (k == PH_UPM) {
            const int tidl = fresh_tid(wave0);
            pg8::Gemm g{nullptr, nullptr, M, D, 512}; pg8::UpmOrder S; S.so.init(M, D, G, bx);
            S.Y0 = (const bf16_t*)(ws + WS_YA); S.Y1 = (const bf16_t*)(ws + WS_YB); S.Y2 = (const bf16_t*)(ws + WS_YC);
            S.W0 = (const bf16_t*)(ws + WS_W + W_UP); S.W1 = (const bf16_t*)(ws + WS_W + W_UP + MiB); S.W2 = (const bf16_t*)(ws + WS_W + W_UP + 2 * MiB);
            pg8::EpiUpm E{ws};
            pg8::gemm_phase<pg8::EpiUpm, pg8::UpmOrder, true, true>(ldsp, g, S, E, tidl);
        } else if (k == PH_OUT) {
            const int tidl = fresh_tid(wave0);
            pg8::Gemm g{(const bf16_t*)(ws + WS_MERGED), (const bf16_t*)(ws + WS_W + W_OUT), M, D, D}; pg8::StaticOrder S; S.init(M, D, G, bx);
            pg8::EpiRes E{l == 0 ? KARG(0) : out, out, (bf16_t*)(ws + WS_X1B), rssp, stf};
            pg8::gemm_phase<pg8::EpiRes, pg8::StaticOrder, false, true>(ldsp, g, S, E, tidl);
        } else if (k == PH_FFN) {
            const int tidl = fresh_tid(wave0);
            pg8::Gemm g{(const bf16_t*)(ws + WS_X1B), (const bf16_t*)(ws + WS_W + W_GU), M, NGU, D}; pg8::StaticOrder S; S.init(M, NGU, G, bx);
            fill_rstd((LAS float*)(ldsp + RSTD_OFF), rssp, bx, tidl);
            pg8::EpiFfn E{(bf16_t*)(ws + WS_H), (const LAS float*)(ldsp + RSTD_OFF)};
            pg8::gemm_phase<pg8::EpiFfn, pg8::StaticOrder, true, true>(ldsp, g, S, E, tidl);
        } else if (k == PH_DOWN) {
            const int tidl = fresh_tid(wave0);
            pg8::Gemm g{(const bf16_t*)(ws + WS_H), (const bf16_t*)(ws + WS_W + W_DN), M, D, FF}; pg8::StaticOrder S; S.init(M, D, G, bx);
            pg8::EpiRes E{out, out, (l + 1 < DEPTH) ? (bf16_t*)(ws + WS_XB) : nullptr, (l + 1 < DEPTH) ? rssp : nullptr, stf};
            pg8::gemm_phase<pg8::EpiRes, pg8::StaticOrder, false, true>(ldsp, g, S, E, tidl);
        }
        if (rep + 1 < nrep) xcd_barrier(bar);
        }
        if (ph + 1 < args.ph_hi) xcd_barrier(bar);
    }
}

#ifndef MIXMASK
#define MIXMASK 15
#endif
static void launch_mega(const Args& a0, int lo, int hi, int li, int grid, hipStream_t stream) {
    Args a = a0; a.ph_lo = lo; a.ph_hi = hi; a.li = li;
    hipLaunchKernelGGL(mega_fwd, dim3(grid), dim3(NWAVES * 64), LDS_BYTES, stream, a);
}
extern "C" void kernel_launch(void* const* d_in, const int* in_sizes, int n_in, void* d_out, int out_size, void* d_ws, size_t ws_size, hipStream_t stream) {
    static int grid = 0;
    if (grid == 0) {
        if (n_in != 19 || out_size != M * D || ws_size < WS_END2) { fprintf(stderr, "kernel_launch: unexpected shapes (n_in %d out %d ws %zu)\n", n_in, out_size, ws_size); grid = -1; return; }
        int dev = 0, cus = 0;
        if (hipGetDevice(&dev) != hipSuccess || hipDeviceGetAttribute(&cus, hipDeviceAttributeMultiprocessorCount, dev) != hipSuccess) { grid = -1; return; }
        if (hipFuncSetAttribute((const void*)mega_fwd, hipFuncAttributeMaxDynamicSharedMemorySize, LDS_BYTES) != hipSuccess) { fprintf(stderr, "kernel_launch: hipFuncSetAttribute failed\n"); grid = -1; return; }
        int per_cu = 0; (void)hipOccupancyMaxActiveBlocksPerMultiprocessor(&per_cu, (const void*)mega_fwd, NWAVES * 64, LDS_BYTES); (void)hipGetLastError();
        if (per_cu < 1) fprintf(stderr, "kernel_launch: occupancy query reports %d blocks per CU\n", per_cu);
        grid = cus;
    }
    if (grid < 0) return;
    (void)hipMemsetAsync((char*)d_ws + WS_CTL, 0, CTL_BYTES, stream);
    Args a{}; { const float** ap = (const float**)&a.in; for (int i = 0; i < 19; ++i) ap[i] = (const float*)d_in[i]; }
    a.out = (float*)d_out; a.ws = (unsigned char*)d_ws;
    a.mixmask = 15;
    launch_mega(a, 0, DEPTH * PH_PER_LAYER, 0, grid, stream);
}
```

```cpp
#include <hip/hip_runtime.h>
#include <cstdint>
#include <cstdio>

typedef unsigned short bf16_t;
typedef short bf16x8 __attribute__((ext_vector_type(8)));
typedef float f32x4 __attribute__((ext_vector_type(4)));

constexpr int BATCH = 8, SEQ = 2048, D = 1024, M = BATCH * SEQ, DEPTH = 2;
constexpr int IN_COLS = 6672, NIN1 = 3840, NGATE = 3072, NIN = NIN1 + NGATE;
constexpr int FF = 2816, NGU = 2 * FF;
constexpr int C_GLR = 1024;
constexpr float EPS = 1e-6f;
constexpr float LOG2E = 1.4426950408889634f;
constexpr float QSCALE = 0.08838834764831845f * LOG2E;

constexpr size_t MiB = 1u << 20;
constexpr size_t WS_CTL = 0, CTL_BYTES = 1 * MiB;
constexpr size_t WS_RSS = 1 * MiB;
constexpr size_t WS_KMEAN = 230 * MiB;
constexpr size_t WS_W = 2 * MiB;
constexpr size_t W_IN = 0, W_UP = 13 * MiB + 512 * 1024, W_OUT = W_UP + 3 * MiB, W_GU = W_OUT + 2 * MiB, W_DN = W_GU + 11 * MiB, W_PW = W_DN + 5 * MiB + 512 * 1024;
constexpr size_t WS_XB = 38 * MiB;
constexpr size_t WS_GQ = 70 * MiB, WS_GK = 78 * MiB, WS_GG = 86 * MiB;
constexpr size_t WS_GV = 102 * MiB, WS_PU = 118 * MiB;
constexpr size_t WS_MK = 134 * MiB, WS_MV = 150 * MiB;
constexpr size_t WS_SR = 166 * MiB, WS_MQ = 182 * MiB;
constexpr size_t WS_YB = 198 * MiB, WS_US = 214 * MiB;
constexpr size_t WS_SGA = 70 * MiB, WS_SGB = 102 * MiB, WS_SGC = 134 * MiB;
constexpr size_t WS_MERGED = WS_XB, WS_X1B = 70 * MiB, WS_H = 102 * MiB;
constexpr size_t WS_END = 231 * MiB;

__device__ __forceinline__ float bf2f(bf16_t h) { return __uint_as_float(((unsigned)h) << 16); }
__device__ __forceinline__ bf16_t f2bf(float f) { unsigned u = __float_as_uint(f); return (bf16_t)((u + 0x7fffu + ((u >> 16) & 1u)) >> 16); }
__device__ __forceinline__ unsigned pk2(float lo, float hi) { return (unsigned)f2bf(lo) | ((unsigned)f2bf(hi) << 16); }
__device__ __forceinline__ float wave_sum(float v) {
#pragma unroll
    for (int o = 1; o < 64; o <<= 1) v += __shfl_xor(v, o);
    return v;
}
__device__ __forceinline__ float wave_max(float v) {
#pragma unroll
    for (int o = 1; o < 64; o <<= 1) v = fmaxf(v, __shfl_xor(v, o));
    return v;
}
__device__ __forceinline__ float sigmoidf_(float x) { return 1.f / (1.f + __expf(-x)); }
__device__ __forceinline__ float siluf_(float x) { return x / (1.f + __expf(-x)); }
__device__ __forceinline__ float logsigmoidf_(float x) { return fminf(x, 0.f) - log1pf(__expf(-fabsf(x))); }

struct Inputs {
    const float *x, *norm1_w, *w_in, *wg2, *bg, *gla_nw, *pool_w, *pool_scale, *qn_w, *kn_w, *rel_bias, *w_up_a, *w_up_b, *w_up_c, *w_out, *norm2_w, *w_gate, *w_up, *w_down;
};

template <class F>
__device__ __forceinline__ void transpose_item(F src, int K, bf16_t* dst, int k0, int n0, float* scr, int lane) {
    float tv[32];
#pragma unroll
    for (int i = 0; i < 32; ++i) tv[i] = src(k0 + i, n0 + lane);
#pragma unroll
    for (int i = 0; i < 32; ++i) scr[i * 65 + lane] = tv[i];
    __builtin_amdgcn_s_waitcnt(0xc07f); asm volatile("" ::: "memory");
    const int c = lane & 3;
#pragma unroll
    for (int j = 0; j < 4; ++j) {
        const int n = (lane >> 2) + 16 * j; const float* s = scr + (8 * c) * 65 + n;
        uint4 o; o.x = pk2(s[0], s[65]); o.y = pk2(s[130], s[195]); o.z = pk2(s[260], s[325]); o.w = pk2(s[390], s[455]);
        *(uint4*)(dst + (size_t)(n0 + n) * K + k0 + 8 * c) = o;
    }
    __builtin_amdgcn_s_waitcnt(0xc07f); asm volatile("" ::: "memory");
}
constexpr int PI_IN = 32 * (NIN / 64), PI_UP = 16 * 16, PI_OUT = 32 * 16, PI_GU = 32 * (NGU / 64), PI_DN = 88 * 16, PI_PW = 4 * 2;
constexpr int PREP_ITEMS = PI_IN + 3 * PI_UP + PI_OUT + PI_GU + PI_DN + 4 * PI_PW;
template <class InP>
__device__ __forceinline__ void prep_item(InP inp, int l, unsigned char* wsw, int it, float* scr, int lane) {
    if (it < PI_IN) {
        const int nb = NIN / 64, kb = it / nb, n0 = 64 * (it % nb), k0 = 32 * kb;
        const float* w = inp->w_in + (size_t)l * D * IN_COLS; const float* nw = inp->norm1_w + l * D; bf16_t* dst = (bf16_t*)(wsw + W_IN);
        if (n0 >= 512 && n0 < 768) {
            const float* g2 = inp->wg2 + (size_t)l * 16 * 256 + (n0 - 512) + lane; float g2v[16];
#pragma unroll
            for (int r = 0; r < 16; ++r) g2v[r] = g2[r * 256];
            transpose_item([&](int k, int n) { const f32x4* wr = (const f32x4*)(w + (size_t)k * IN_COLS + C_GLR); float s = 0.f;
#pragma unroll
                for (int r4 = 0; r4 < 4; ++r4) { const f32x4 v = wr[r4]; s += v[0] * g2v[4 * r4] + v[1] * g2v[4 * r4 + 1] + v[2] * g2v[4 * r4 + 2] + v[3] * g2v[4 * r4 + 3]; }
                return s * nw[k]; }, D, dst, k0, n0, scr, lane);
        } else {
            const int off = n0 < 512 ? 0 : (n0 < 1280 ? -256 : -240);
            transpose_item([&](int k, int n) { return w[(size_t)k * IN_COLS + n + off] * nw[k]; }, D, dst, k0, n0, scr, lane);
        }
        return;
    }
    it -= PI_IN;
    if (it < 3 * PI_UP) {
        const int br = it / PI_UP; it %= PI_UP; const int kb = it / 16, n0 = 64 * (it % 16), k0 = 32 * kb;
        const float* w = (br == 0 ? inp->w_up_a : br == 1 ? inp->w_up_b : inp->w_up_c) + (size_t)l * 512 * D;
        transpose_item([&](int k, int n) { return w[(size_t)k * D + n]; }, 512, (bf16_t*)(wsw + W_UP + br * MiB), k0, n0, scr, lane);
        return;
    }
    it -= 3 * PI_UP;
    if (it < PI_OUT) {
        const int kb = it / 16, n0 = 64 * (it % 16), k0 = 32 * kb; const float* w = inp->w_out + (size_t)l * D * D;
        transpose_item([&](int k, int n) { return w[(size_t)k * D + n]; }, D, (bf16_t*)(wsw + W_OUT), k0, n0, scr, lane);
        return;
    }
    it -= PI_OUT;
    if (it < PI_GU) {
        const int nb = NGU / 64, kb = it / nb, n0 = 64 * (it % nb), k0 = 32 * kb;
        const int pn = n0 >> 8, i0 = n0 & 255; const float* w = ((i0 < 128) ? inp->w_gate : inp->w_up) + (size_t)l * D * FF; const float* nw = inp->norm2_w + l * D;
        const int coff = 128 * pn + (i0 & 127) - n0;
        transpose_item([&](int k, int n) { return w[(size_t)k * FF + n + coff] * nw[k]; }, D, (bf16_t*)(wsw + W_GU), k0, n0, scr, lane);
        return;
    }
    it -= PI_GU;
    if (it < PI_DN) {
        const int kb = it / 16, n0 = 64 * (it % 16), k0 = 32 * kb; const float* w = inp->w_down + (size_t)l * FF * D;
        transpose_item([&](int k, int n) { return w[(size_t)k * D + n]; }, FF, (bf16_t*)(wsw + W_DN), k0, n0, scr, lane);
        return;
    }
    it -= PI_DN;
    { const int g = it / PI_PW; it %= PI_PW; const int kb = it / 2, n0 = 64 * (it % 2), k0 = 32 * kb; const float* w = inp->pool_w + ((size_t)l * 4 + g) * 128 * 128;
      transpose_item([&](int k, int n) { return w[(size_t)k * 128 + n]; }, 128, (bf16_t*)(wsw + W_PW) + g * 128 * 128, k0, n0, scr, lane); }
}
__global__ void __launch_bounds__(256) k_prep(Inputs in, int l, unsigned char* ws) {
    __shared__ float scr[4][32 * 65];
    const int lane = threadIdx.x & 63, wave = threadIdx.x >> 6;
    for (int it = blockIdx.x * 4 + wave; it < PREP_ITEMS; it += gridDim.x * 4) prep_item(&in, l, ws + WS_W, it, scr[wave], lane);
}

__global__ void __launch_bounds__(256) k_rows(const float* src, bf16_t* dst, float* rss) {
    const int lane = threadIdx.x & 63, row = blockIdx.x * 4 + (threadIdx.x >> 6);
    const f32x4* xr = (const f32x4*)(src + (size_t)row * D) + lane; float s = 0.f;
    unsigned long long* o8 = (unsigned long long*)(dst + (size_t)row * D) + lane;
#pragma unroll
    for (int j = 0; j < 4; ++j) { const f32x4 v = xr[64 * j]; s += (v.x * v.x + v.y * v.y) + (v.z * v.z + v.w * v.w);
        o8[64 * j] = (unsigned long long)pk2(v.x, v.y) | ((unsigned long long)pk2(v.z, v.w) << 32); }
    s = wave_sum(s); if (lane == 0) rss[row] = s;
}

__device__ __forceinline__ void ngemm32(const bf16_t* A, int lda, const bf16_t* Bt, int ldb, int K, f32x4 (&acc)[2][2], int lane) {
    const int r = lane & 15, q = lane >> 4;
    for (int k0 = 0; k0 < K; k0 += 32) {
        bf16x8 a[2], b[2];
#pragma unroll
        for (int i = 0; i < 2; ++i) { a[i] = *(const bf16x8*)(A + (size_t)(i * 16 + r) * lda + k0 + 8 * q); b[i] = *(const bf16x8*)(Bt + (size_t)(i * 16 + r) * ldb + k0 + 8 * q); }
#pragma unroll
        for (int i = 0; i < 2; ++i)
#pragma unroll
            for (int j = 0; j < 2; ++j) acc[i][j] = __builtin_amdgcn_mfma_f32_16x16x32_bf16(a[i], b[j], acc[i][j], 0, 0, 0);
    }
}
#define NG_PRE const int lane = threadIdx.x & 63, wave = threadIdx.x >> 6; const int row0 = blockIdx.y * 64 + (wave >> 1) * 32, col0 = blockIdx.x * 64 + (wave & 1) * 32; \
    f32x4 acc[2][2]; for (int i = 0; i < 2; ++i) for (int j = 0; j < 2; ++j) acc[i][j] = (f32x4){0.f, 0.f, 0.f, 0.f};
#define NG_FOR for (int i = 0; i < 2; ++i) for (int j = 0; j < 2; ++j) for (int rg = 0; rg < 4; ++rg) { const int row = row0 + i * 16 + (lane >> 4) * 4 + rg, col = col0 + j * 16 + (lane & 15);

__global__ void __launch_bounds__(256) k_inproj1(unsigned char* ws, const float* bg) {
    NG_PRE
    ngemm32((const bf16_t*)(ws + WS_XB) + (size_t)row0 * D, D, (const bf16_t*)(ws + WS_W + W_IN) + (size_t)col0 * D, D, D, acc, lane);
    const float* rss = (const float*)(ws + WS_RSS);
    NG_FOR
        const float v = acc[i][j][rg] * rsqrtf(rss[row] * (1.f / D) + EPS);
        const int t = col >> 8, c = col & 255;
        if (t == 0) ((bf16_t*)(ws + WS_GQ))[(size_t)row * 256 + c] = f2bf(v * 0.125f);
        else if (t == 1) ((bf16_t*)(ws + WS_GK))[(size_t)row * 256 + c] = f2bf(v);
        else if (t == 2) ((float*)(ws + WS_GG))[(size_t)row * 256 + c] = logsigmoidf_(v + bg[c]) * (1.f / 16.f);
        else if (t < 5) ((bf16_t*)(ws + WS_GV))[(size_t)row * 512 + (col - 768)] = f2bf(v);
        else if (t < 7) ((bf16_t*)(ws + WS_SR))[(size_t)row * 512 + (col - 1280)] = f2bf(siluf_(v));
        else if (t < 9) ((bf16_t*)(ws + WS_PU))[(size_t)row * 512 + (col - 1792)] = f2bf(v);
        else if (t < 11) ((bf16_t*)(ws + WS_MQ))[(size_t)row * 512 + (col - 2304)] = f2bf(v);
        else if (t < 13) ((bf16_t*)(ws + WS_MK))[(size_t)row * 512 + (col - 2816)] = f2bf(v);
        else ((bf16_t*)(ws + WS_MV))[(size_t)row * 512 + (col - 3328)] = f2bf(v);
    }
}
__global__ void __launch_bounds__(256) k_gates(unsigned char* ws) {
    NG_PRE
    ngemm32((const bf16_t*)(ws + WS_XB) + (size_t)row0 * D, D, (const bf16_t*)(ws + WS_W + W_IN) + (size_t)(NIN1 + col0) * D, D, D, acc, lane);
    const float* rss = (const float*)(ws + WS_RSS);
    NG_FOR
        const float v = acc[i][j][rg] * rsqrtf(rss[row] * (1.f / D) + EPS);
        const int br = col >> 10, c = col & 1023;
        ((bf16_t*)(ws + (br == 0 ? WS_SGA : br == 1 ? WS_SGB : WS_SGC)))[(size_t)row * D + c] = f2bf(sigmoidf_(v));
    }
}
__global__ void __launch_bounds__(256) k_upmerge(unsigned char* ws) {
    NG_PRE
    f32x4 tot[2][2]; for (int i = 0; i < 2; ++i) for (int j = 0; j < 2; ++j) tot[i][j] = (f32x4){0.f, 0.f, 0.f, 0.f};
    for (int br = 0; br < 3; ++br) {
        const bf16_t* Y = (const bf16_t*)(ws + (br == 0 ? WS_SR : br == 1 ? WS_YB : WS_MQ)); const bf16_t* G = (const bf16_t*)(ws + (br == 0 ? WS_SGA : br == 1 ? WS_SGB : WS_SGC));
        for (int i = 0; i < 2; ++i) for (int j = 0; j < 2; ++j) acc[i][j] = (f32x4){0.f, 0.f, 0.f, 0.f};
        ngemm32(Y + (size_t)row0 * 512, 512, (const bf16_t*)(ws + WS_W + W_UP + br * MiB) + (size_t)col0 * 512, 512, 512, acc, lane);
        NG_FOR tot[i][j][rg] += bf2f(G[(size_t)row * D + col]) * acc[i][j][rg]; }
    }
    NG_FOR ((bf16_t*)(ws + WS_MERGED))[(size_t)row * D + col] = f2bf(tot[i][j][rg]); }
}
__global__ void __launch_bounds__(256) k_resgemm(const bf16_t* A, const bf16_t* Bt, int K, const float* resid, float* xout) {
    NG_PRE
    ngemm32(A + (size_t)row0 * K, K, Bt + (size_t)col0 * K, K, K, acc, lane);
    NG_FOR xout[(size_t)row * D + col] = resid[(size_t)row * D + col] + acc[i][j][rg]; }
}
__global__ void __launch_bounds__(256) k_ffn(unsigned char* ws) {
    const int lane = threadIdx.x & 63, wave = threadIdx.x >> 6; const int row0 = blockIdx.y * 64 + (wave >> 1) * 32, j0 = blockIdx.x * 64 + (wave & 1) * 32;
    f32x4 ag[2][2], au[2][2]; for (int i = 0; i < 2; ++i) for (int j = 0; j < 2; ++j) { ag[i][j] = (f32x4){0.f, 0.f, 0.f, 0.f}; au[i][j] = ag[i][j]; }
    const int ng = 256 * (j0 >> 7) + (j0 & 127);
    const bf16_t* A = (const bf16_t*)(ws + WS_X1B) + (size_t)row0 * D; const bf16_t* W = (const bf16_t*)(ws + WS_W + W_GU);
    ngemm32(A, D, W + (size_t)ng * D, D, D, ag, lane);
    ngemm32(A, D, W + (size_t)(ng + 128) * D, D, D, au, lane);
    const float* rss = (const float*)(ws + WS_RSS);
    for (int i = 0; i < 2; ++i) for (int j = 0; j < 2; ++j) for (int rg = 0; rg < 4; ++rg) { const int row = row0 + i * 16 + (lane >> 4) * 4 + rg, col = j0 + j * 16 + (lane & 15);
        const float rs = rsqrtf(rss[row] * (1.f / D) + EPS);
        ((bf16_t*)(ws + WS_H))[(size_t)row * FF + col] = f2bf(siluf_(ag[i][j][rg] * rs) * (au[i][j][rg] * rs)); }
}

__global__ void __launch_bounds__(128) k_gla(unsigned char* ws, const float* nw) {
    const int e = threadIdx.x, b = blockIdx.x >> 2, h = blockIdx.x & 3, lane = e & 63, wave = e >> 6;
    const bf16_t* GQ = (const bf16_t*)(ws + WS_GQ); const bf16_t* GK = (const bf16_t*)(ws + WS_GK); const float* GG = (const float*)(ws + WS_GG);
    const bf16_t* GV = (const bf16_t*)(ws + WS_GV); bf16_t* YA = (bf16_t*)(ws + WS_SR);
    __shared__ float red[2][16]; __shared__ float osh[16][128];
    float S[64];
#pragma unroll
    for (int d = 0; d < 64; ++d) S[d] = 0.f;
    const float nwe = nw[e];
    for (int t0 = 0; t0 < SEQ; t0 += 16) {
#pragma unroll 1
        for (int tt = 0; tt < 16; ++tt) {
            const size_t row = (size_t)b * SEQ + t0 + tt;
            const bf16_t* q = GQ + row * 256 + h * 64; const bf16_t* k = GK + row * 256 + h * 64; const float* g = GG + row * 256 + h * 64;
            const float v = bf2f(GV[row * 512 + h * 128 + e]); float a = 0.f;
#pragma unroll
            for (int d = 0; d < 64; ++d) { S[d] = __expf(g[d]) * S[d] + bf2f(k[d]) * v; a += bf2f(q[d]) * S[d]; }
            osh[tt][e] = a;
            const float s = wave_sum(a * a); if (lane == 0) red[wave][tt] = s;
        }
        __syncthreads();
#pragma unroll 1
        for (int tt = 0; tt < 16; ++tt) { const float rstd = rsqrtf((red[0][tt] + red[1][tt]) * (1.f / 128.f) + EPS);
            const size_t idx = ((size_t)b * SEQ + t0 + tt) * 512 + h * 128 + e; YA[idx] = f2bf(osh[tt][e] * rstd * nwe * bf2f(YA[idx])); }
        __syncthreads();
    }
}

__global__ void __launch_bounds__(256) k_pool(unsigned char* ws, const float* pw, const float* pscale) {
    __shared__ float u[31][128]; __shared__ float p[16][128];
    const int g = blockIdx.x & 3, r0 = (blockIdx.x >> 2) * 16, t0 = r0 & (SEQ - 1), tid = threadIdx.x;
    const bf16_t* PU = (const bf16_t*)(ws + WS_PU);
    for (int x = tid; x < 31 * 128; x += 256) { const int i = x >> 7, c = x & 127, t = t0 - 15 + i; u[i][c] = t >= 0 ? bf2f(PU[(size_t)(r0 - 15 + i) * 512 + g * 128 + c]) : 0.f; }
    __syncthreads();
    const int w = 2 << g;
    for (int x = tid; x < 16 * 128; x += 256) { const int i = x >> 7, c = x & 127, t = t0 + i, cnt = min(t + 1, w); float s = 0.f;
        for (int j = 0; j < cnt; ++j) s += u[15 + i - j][c];
        p[i][c] = s / (float)cnt - u[15 + i][c]; }
    __syncthreads();
    for (int x = tid; x < 16 * 128; x += 256) { const int i = x >> 7, e = x & 127; float y = 0.f;
        for (int c = 0; c < 128; ++c) y += p[i][c] * pw[((size_t)g * 128 + c) * 128 + e];
        ((bf16_t*)(ws + WS_YB))[(size_t)(r0 + i) * 512 + g * 128 + e] = f2bf(y * pscale[g * 128 + e]); }
}

__global__ void __launch_bounds__(256) k_prepass(unsigned char* ws, const float* qw, const float* kw) {
    __shared__ float part[4][128];
    const int lane = threadIdx.x & 63, wave = threadIdx.x >> 6; const int h = blockIdx.x & 3, blk = (blockIdx.x >> 2) & 7, b = blockIdx.x >> 5;
    unsigned* MQ = (unsigned*)(ws + WS_MQ); unsigned* MK = (unsigned*)(ws + WS_MK);
    const float qw0 = qw[2 * lane] * QSCALE, qw1 = qw[2 * lane + 1] * QSCALE, kw0 = kw[2 * lane], kw1 = kw[2 * lane + 1];
    float c0 = 0.f, c1 = 0.f;
    for (int r = 0; r < 64; ++r) {
        const size_t idx = ((size_t)b * SEQ + blk * 256 + wave * 64 + r) * 256 + h * 64 + lane;
        { const unsigned v = MQ[idx]; const float a = __uint_as_float(v << 16), c = __uint_as_float(v & 0xffff0000u); const float rs = rsqrtf(wave_sum(a * a + c * c) * (1.f / 128.f) + EPS); MQ[idx] = pk2(a * rs * qw0, c * rs * qw1); }
        { const unsigned v = MK[idx]; const float a = __uint_as_float(v << 16), c = __uint_as_float(v & 0xffff0000u); const float rs = rsqrtf(wave_sum(a * a + c * c) * (1.f / 128.f) + EPS);
          const float k0 = a * rs * kw0, k1 = c * rs * kw1; c0 += k0; c1 += k1; MK[idx] = pk2(k0, k1); }
    }
    part[wave][2 * lane] = c0; part[wave][2 * lane + 1] = c1;
    __syncthreads();
    if (threadIdx.x < 128) ((float*)(ws + WS_KMEAN))[(((size_t)b * 4 + h) * 8 + blk) * 128 + threadIdx.x] = ((part[0][threadIdx.x] + part[1][threadIdx.x]) + (part[2][threadIdx.x] + part[3][threadIdx.x])) * (1.f / 256.f);
}

__global__ void __launch_bounds__(256) k_moba(unsigned char* ws, const float* rel_bias) {
    __shared__ float tab[4][132]; __shared__ float qs[4][128]; __shared__ float ps[4][1024];
    const int lane = threadIdx.x & 63, wave = threadIdx.x >> 6;
    const int gw = blockIdx.x * 4 + wave; const int t = gw & (SEQ - 1), h = (gw >> 11) & 3, b = gw >> 13;
    for (int x = threadIdx.x; x < 129; x += 256) { int bk = x; if (x >= 16) { bk = 16 + (int)(logf((float)x / 16.f) / 2.0794415416798357f * 16.f); if (bk > 31) bk = 31; } tab[0][x] = rel_bias[bk * 4 + h] * LOG2E; }
    __syncthreads();
    const size_t row = (size_t)b * SEQ + t; const int qblk = t >> 8;
    unsigned* QN = (unsigned*)(ws + WS_MQ); const bf16_t* KN = (const bf16_t*)(ws + WS_MK); const unsigned* MV = (const unsigned*)(ws + WS_MV);
    const unsigned qv = QN[row * 256 + h * 64 + lane]; const float q0 = __uint_as_float(qv << 16), q1 = __uint_as_float(qv & 0xffff0000u);
    qs[wave][2 * lane] = q0; qs[wave][2 * lane + 1] = q1;
    const float* km = (const float*)(ws + WS_KMEAN) + ((size_t)b * 4 + h) * 8 * 128;
    float sc[8];
#pragma unroll
    for (int n = 0; n < 8; ++n) sc[n] = (n < qblk) ? wave_sum(q0 * km[n * 128 + 2 * lane] + q1 * km[n * 128 + 2 * lane + 1]) : -INFINITY;
    int blks[4]; int nvalid = 0;
#pragma unroll
    for (int s = 0; s < 3; ++s) { float best = -INFINITY; int bi = -1;
#pragma unroll
        for (int n = 0; n < 8; ++n) if (sc[n] > best) { best = sc[n]; bi = n; }
        blks[s] = bi;
#pragma unroll
        for (int n = 0; n < 8; ++n) if (n == bi) sc[n] = -INFINITY; }
    blks[3] = qblk;
    __builtin_amdgcn_s_waitcnt(0xc07f);
    float lg[4][4]; float mx = -INFINITY;
#pragma unroll
    for (int s = 0; s < 4; ++s) {
        const int blk = blks[s];
#pragma unroll
        for (int i = 0; i < 4; ++i) {
            lg[s][i] = -INFINITY;
            if (blk >= 0) { const int j = lane + 64 * i, tk = blk * 256 + j, dist = t - tk;
                if (dist >= 0) { const bf16_t* kr = KN + ((size_t)b * SEQ + tk) * 512 + h * 128; float dsum = 0.f;
                    for (int c = 0; c < 16; ++c) { const bf16x8 kk = *(const bf16x8*)(kr + c * 8);
#pragma unroll
                        for (int x = 0; x < 8; ++x) dsum += bf2f((bf16_t)kk[x]) * qs[wave][c * 8 + x]; }
                    lg[s][i] = dsum + tab[0][dist > 128 ? 128 : dist]; mx = fmaxf(mx, lg[s][i]); } }
        }
    }
    mx = wave_max(mx); float sum = 0.f;
#pragma unroll
    for (int s = 0; s < 4; ++s)
#pragma unroll
        for (int i = 0; i < 4; ++i) { const float pp = exp2f(lg[s][i] - mx); sum += pp; ps[wave][s * 256 + lane + 64 * i] = pp; }
    sum = wave_sum(sum);
    __builtin_amdgcn_s_waitcnt(0xc07f);
    float o0 = 0.f, o1 = 0.f;
#pragma unroll
    for (int s = 0; s < 4; ++s) { const int blk = blks[s]; if (blk < 0) continue; const int jn = (s == 3) ? (t & 255) + 1 : 256;
        const unsigned* vr = MV + ((size_t)b * SEQ + blk * 256) * 256 + h * 64 + lane;
        for (int j = 0; j < jn; ++j) { const float pp = ps[wave][s * 256 + j]; const unsigned v = vr[(size_t)j * 256]; o0 += pp * __uint_as_float(v << 16); o1 += pp * __uint_as_float(v & 0xffff0000u); } }
    const float inv = 1.f / sum;
    QN[row * 256 + h * 64 + lane] = pk2(o0 * inv, o1 * inv);
}


template <int K> __device__ __forceinline__ float swz_xor(float v) { return __int_as_float(__builtin_amdgcn_ds_swizzle(__float_as_int(v), (K << 10) | 0x1f)); }
__device__ __forceinline__ float half_sum(float v) { auto rr = __builtin_amdgcn_permlane32_swap(__float_as_uint(v), __float_as_uint(v), false, false); return __uint_as_float(rr[0]) + __uint_as_float(rr[1]); }
__device__ __forceinline__ float wave_sum_s(float v) { v += swz_xor<1>(v); v += swz_xor<2>(v); v += swz_xor<4>(v); v += swz_xor<8>(v); v += swz_xor<16>(v); return half_sum(v); }
namespace pg8 {
#define PG8_LAS __attribute__((address_space(3)))
typedef unsigned u32x4 __attribute__((ext_vector_type(4)));
constexpr int BM = 256, BK = 64, HALF = 128, HTB = HALF * BK * 2, STAGE_BYTES = 8 * HTB, NXCD = 8, WGM = 8;
__host__ __device__ __forceinline__ int lds_byte(int r, int c) { const int st = (r >> 4) * 2 + (c >> 5), rr = r & 15, cc = c & 31, ob = rr * 64 + cc * 2; return st * 1024 + (ob ^ (((ob >> 9) & 1) << 5)); }
__host__ __device__ __forceinline__ void stage_rc(int b, int& R, int& C) { const int st = b / 1024, sb = b % 1024, swz = sb ^ (((sb >> 9) & 1) << 5); R = (st >> 1) * 16 + swz / 64; C = (st & 1) * 32 + (swz % 64) / 2; }
__host__ __device__ __forceinline__ int perm32(int rho) { const int n = rho >> 4, i = rho & 15; return 8 * (i >> 2) + 4 * n + (i & 3); }
struct Unit { int pm, pn, br; };
struct Gemm { const bf16_t* A; const bf16_t* Bt; int M, N, K; };
struct StaticOrder {
    int nM, nN, nwg, G, c;
    __device__ void init(int M_, int N_, int G_, int c_) { nM = M_ / BM; nN = N_ / BM; nwg = nM * nN; G = G_; c = c_; }
    __device__ bool next(int i, Unit& u) const {
        const long L = (long)i * G + c; if (L >= nwg) return false;
        int wgid = (int)L; { const int q = nwg / NXCD, r = nwg % NXCD, xcd = wgid % NXCD, off = wgid / NXCD; wgid = (xcd < r ? xcd * (q + 1) : r * (q + 1) + (xcd - r) * q) + off; }
        const int nig = WGM * nN, gid = wgid / nig, fm = gid * WGM, gsz = (nM - fm) < WGM ? (nM - fm) : WGM;
        u.pm = fm + ((wgid % nig) % gsz); u.pn = (wgid % nig) / gsz; u.br = 0; return true;
    }
    __device__ __forceinline__ const char* pa(const Unit& u, const Gemm& g) const { return (const char*)g.A + (size_t)u.pm * (size_t)(BM * 2) * g.K; }
    __device__ __forceinline__ const char* pb(const Unit& u, const Gemm& g) const { return (const char*)g.Bt + (size_t)u.pn * (size_t)(BM * 2) * g.K; }
    __device__ __forceinline__ void a_ready(const Unit&) const {}
    __device__ __forceinline__ void done(const Unit&) const {}
};
struct UpmOrder {
    StaticOrder so; const bf16_t *Y0, *Y1, *Y2, *W0, *W1, *W2;
    __device__ bool next(int i, Unit& u) const { if (i >= 3) return false; if (!so.next(0, u)) return false; u.br = i; return true; }
    __device__ __forceinline__ const char* pa(const Unit& u, const Gemm& g) const { const bf16_t* y = u.br == 0 ? Y0 : (u.br == 1 ? Y1 : Y2); return (const char*)y + (size_t)u.pm * (size_t)(BM * 2) * g.K; }
    __device__ __forceinline__ const char* pb(const Unit& u, const Gemm& g) const { const bf16_t* w = u.br == 0 ? W0 : (u.br == 1 ? W1 : W2); return (const char*)w + (size_t)u.pn * (size_t)(BM * 2) * g.K; }
    __device__ __forceinline__ void a_ready(const Unit&) const {}
    __device__ __forceinline__ void done(const Unit&) const {}
};
typedef float f32x2_t __attribute__((ext_vector_type(2))); typedef __bf16 bf16x2_t __attribute__((ext_vector_type(2)));
__device__ __forceinline__ unsigned cvt_pk_bf16(float lo, float hi) { const f32x2_t v = {lo, hi}; const bf16x2_t b = __builtin_convertvector(v, bf16x2_t); return __builtin_bit_cast(unsigned, b); }
__device__ __forceinline__ u32x4 pack8(const f32x4& a, const f32x4& b) { u32x4 w; w.x = cvt_pk_bf16(a[0], a[1]); w.y = cvt_pk_bf16(a[2], a[3]); w.z = cvt_pk_bf16(b[0], b[1]); w.w = cvt_pk_bf16(b[2], b[3]); return w; }
__device__ __forceinline__ void unpack8(const u32x4& w, f32x4& a, f32x4& b) {
    a[0] = __uint_as_float(w.x << 16); a[1] = __uint_as_float(w.x & 0xffff0000u); a[2] = __uint_as_float(w.y << 16); a[3] = __uint_as_float(w.y & 0xffff0000u);
    b[0] = __uint_as_float(w.z << 16); b[1] = __uint_as_float(w.z & 0xffff0000u); b[2] = __uint_as_float(w.w << 16); b[3] = __uint_as_float(w.w & 0xffff0000u);
}
__device__ __forceinline__ void row_rstd(const PG8_LAS float* tab, const Unit& u, int wr, int fr, float (&rs)[2][4]) {
#pragma unroll
    for (int ai = 0; ai < 2; ++ai)
#pragma unroll
        for (int m = 0; m < 4; ++m) rs[ai][m] = tab[(u.pm & 7) * BM + ai * HALF + wr * 64 + m * 16 + fr];
}
struct EpiIn1 {
    static constexpr bool PERM = true, AFTER_DRAIN = false;
    unsigned char* ws; const PG8_LAS float* rstab; const float* bg;
    __device__ __forceinline__ void operator()(const f32x4 (&acc)[2][2][4][2], const Unit& u, int wr, int wc, int fr, int fq) const {
        asm volatile("" : "+v"(fr), "+v"(fq));
        const int row0 = u.pm * BM + wr * 64 + fr, cw = wc * 32 + 8 * fq; const int pn = u.pn;
        float rs[2][4]; row_rstd(rstab, u, wr, fr, rs);
        if (pn == 2) {
            float* G = (float*)(ws + WS_GG); size_t zb = 0; asm volatile("" : "+s"(zb)); const float* bgl = bg + zb;
#pragma unroll
            for (int bj = 0; bj < 2; ++bj) { const int c = bj * HALF + cw; const f32x4 b0 = *(const f32x4*)(bgl + c), b1 = *(const f32x4*)(bgl + c + 4);
#pragma unroll
                for (int ai = 0; ai < 2; ++ai)
#pragma unroll
                    for (int m = 0; m < 4; ++m) { const float r = rs[ai][m]; f32x4 v0 = acc[ai][bj][m][0] * r + b0, v1 = acc[ai][bj][m][1] * r + b1;
#pragma unroll
                        for (int x = 0; x < 4; ++x) { v0[x] = (fminf(v0[x], 0.f) - __logf(1.f + __expf(-fabsf(v0[x])))) * 0.0625f; v1[x] = (fminf(v1[x], 0.f) - __logf(1.f + __expf(-fabsf(v1[x])))) * 0.0625f; }
                        float* p = G + (size_t)(row0 + ai * HALF + m * 16) * 256 + c; *(f32x4*)p = v0; *(f32x4*)(p + 4) = v1; asm volatile("" ::: "memory"); } }
            return;
        }
        bf16_t* base; int ldc, coff; float sc = 1.f; bool silu = false;
        if (pn == 0) { base = (bf16_t*)(ws + WS_GQ); ldc = 256; coff = 0; sc = 0.125f; }
        else if (pn == 1) { base = (bf16_t*)(ws + WS_GK); ldc = 256; coff = 0; }
        else { ldc = 512; const int k = (pn - 3) >> 1; coff = ((pn - 3) & 1) * 256; silu = (k == 1);
            base = (bf16_t*)(ws + (k == 0 ? WS_GV : k == 1 ? WS_SR : k == 2 ? WS_PU : k == 3 ? WS_MQ : k == 4 ? WS_MK : WS_MV)); }
#pragma unroll
        for (int ai = 0; ai < 2; ++ai)
#pragma unroll
            for (int m = 0; m < 4; ++m) { const float r = rs[ai][m] * sc; bf16_t* rowp = base + (size_t)(row0 + ai * HALF + m * 16) * ldc + coff + cw;
#pragma unroll
                for (int bj = 0; bj < 2; ++bj) { f32x4 v0 = acc[ai][bj][m][0] * r, v1 = acc[ai][bj][m][1] * r;
                    if (silu) {
#pragma unroll
                        for (int x = 0; x < 4; ++x) { v0[x] = siluf_(v0[x]); v1[x] = siluf_(v1[x]); } }
                    *(u32x4*)(rowp + bj * HALF) = pack8(v0, v1); } asm volatile("" ::: "memory"); }
    }
};
struct EpiGates {
    static constexpr bool PERM = true, AFTER_DRAIN = false;
    unsigned char* ws; const PG8_LAS float* rstab;
    __device__ __forceinline__ void operator()(const f32x4 (&acc)[2][2][4][2], const Unit& u, int wr, int wc, int fr, int fq) const {
        asm volatile("" : "+v"(fr), "+v"(fq));
        const int row0 = u.pm * BM + wr * 64 + fr, cw = wc * 32 + 8 * fq; const int br = u.pn >> 2;
        float rs[2][4]; row_rstd(rstab, u, wr, fr, rs);
        bf16_t* base = (bf16_t*)(ws + (br == 0 ? WS_SGA : br == 1 ? WS_SGB : WS_SGC)) + (u.pn & 3) * 256 + cw;
#pragma unroll
        for (int ai = 0; ai < 2; ++ai)
#pragma unroll
            for (int m = 0; m < 4; ++m) { const float r = rs[ai][m]; bf16_t* rowp = base + (size_t)(row0 + ai * HALF + m * 16) * D;
#pragma unroll
                for (int bj = 0; bj < 2; ++bj) { f32x4 v0 = acc[ai][bj][m][0] * r, v1 = acc[ai][bj][m][1] * r;
#pragma unroll
                    for (int x = 0; x < 4; ++x) { v0[x] = sigmoidf_(v0[x]); v1[x] = sigmoidf_(v1[x]); }
                    *(u32x4*)(rowp + bj * HALF) = pack8(v0, v1); } asm volatile("" ::: "memory"); }
    }
};
struct EpiUpm {
    static constexpr bool PERM = true, AFTER_DRAIN = false;
    unsigned char* ws;
    __device__ __forceinline__ void operator()(const f32x4 (&acc)[2][2][4][2], const Unit& u, int wr, int wc, int fr, int fq) const {
        asm volatile("" : "+v"(fr), "+v"(fq));
        const int row0 = u.pm * BM + wr * 64 + fr, col0 = u.pn * BM + wc * 32 + 8 * fq; const int br = u.br;
        const bf16_t* G = (const bf16_t*)(ws + (br == 0 ? WS_SGA : br == 1 ? WS_SGB : WS_SGC)); bf16_t* O = (bf16_t*)(ws + WS_MERGED);
#pragma unroll
        for (int ai = 0; ai < 2; ++ai)
#pragma unroll
            for (int m = 0; m < 4; ++m) { const size_t off = (size_t)(row0 + ai * HALF + m * 16) * D + col0;
#pragma unroll
                for (int bj = 0; bj < 2; ++bj) { f32x4 g0, g1; unpack8(*(const u32x4*)(G + off + bj * HALF), g0, g1);
                    f32x4 v0 = acc[ai][bj][m][0] * g0, v1 = acc[ai][bj][m][1] * g1;
                    if (br != 0) { f32x4 p0, p1; unpack8(*(const u32x4*)(O + off + bj * HALF), p0, p1); v0 += p0; v1 += p1; }
                    *(u32x4*)(O + off + bj * HALF) = pack8(v0, v1); } }
    }
};
struct EpiRes {
    static constexpr bool PERM = true, AFTER_DRAIN = false;
    const float* resid; float* xout; bf16_t* xb; float* rssp; bool st;
    __device__ __forceinline__ void operator()(const f32x4 (&acc)[2][2][4][2], const Unit& u, int wr, int wc, int fr, int fq) const {
        asm volatile("" : "+v"(fr), "+v"(fq));
        const int row0 = u.pm * BM + wr * 64 + fr, col0 = u.pn * BM + wc * 32 + 8 * fq;
#pragma unroll
        for (int ai = 0; ai < 2; ++ai)
#pragma unroll
            for (int m = 0; m < 4; ++m) { const int row = row0 + ai * HALF + m * 16; const size_t off = (size_t)row * D + col0; float s = 0.f;
#pragma unroll
                for (int bj = 0; bj < 2; ++bj) { const f32x4 r0 = *(const f32x4*)(resid + off + bj * HALF), r1 = *(const f32x4*)(resid + off + bj * HALF + 4);
                    const f32x4 v0 = acc[ai][bj][m][0] + r0, v1 = acc[ai][bj][m][1] + r1;
                    if (st) { *(f32x4*)(xout + off + bj * HALF) = v0; *(f32x4*)(xout + off + bj * HALF + 4) = v1; }
                    if (xb && st) *(u32x4*)(xb + off + bj * HALF) = pack8(v0, v1);
                    s += ((v0[0] * v0[0] + v0[1] * v0[1]) + (v0[2] * v0[2] + v0[3] * v0[3])) + ((v1[0] * v1[0] + v1[1] * v1[1]) + (v1[2] * v1[2] + v1[3] * v1[3])); }
                s += swz_xor<16>(s); s = half_sum(s);
                if (fq == 0 && rssp && st) rssp[(size_t)row * 16 + u.pn * 4 + wc] = s; }
    }
};
struct EpiFfn {
    static constexpr bool PERM = true, AFTER_DRAIN = false;
    bf16_t* H; const PG8_LAS float* rstab;
    __device__ __forceinline__ void operator()(const f32x4 (&acc)[2][2][4][2], const Unit& u, int wr, int wc, int fr, int fq) const {
        asm volatile("" : "+v"(fr), "+v"(fq));
        const int row0 = u.pm * BM + wr * 64 + fr, col0 = u.pn * HALF + wc * 32 + 8 * fq;
        float rs[2][4]; row_rstd(rstab, u, wr, fr, rs);
#pragma unroll
        for (int ai = 0; ai < 2; ++ai)
#pragma unroll
            for (int m = 0; m < 4; ++m) { const float r = rs[ai][m]; f32x4 g0 = acc[ai][0][m][0] * r, g1 = acc[ai][0][m][1] * r; const f32x4 u0 = acc[ai][1][m][0] * r, u1 = acc[ai][1][m][1] * r;
#pragma unroll
                for (int x = 0; x < 4; ++x) { g0[x] = siluf_(g0[x]) * u0[x]; g1[x] = siluf_(g1[x]) * u1[x]; }
                *(u32x4*)(H + (size_t)(row0 + ai * HALF + m * 16) * FF + col0) = pack8(g0, g1); asm volatile("" ::: "memory"); }
    }
};
template <class Epi, class Sched, bool ALIGN_EPI = false, bool SP2 = false>
__device__ __forceinline__ void gemm_phase(PG8_LAS unsigned char* lds, const Gemm g, const Sched& S, const Epi& E, const int tid) {
    const int wid = __builtin_amdgcn_readfirstlane(tid >> 6), lane = tid & 63, wr = wid >> 2, wc = wid & 3, fr = lane & 15, fq = lane >> 4;
    const int K = g.K, nt = K / BK;
    unsigned voffA[2], voffB[2];
#pragma unroll
    for (int i = 0; i < 2; ++i) { int R, C; stage_rc(tid * 16 + i * 8192, R, C); const int Rb = Epi::PERM ? ((R & ~31) + perm32(R & 31)) : R;
        voffA[i] = (unsigned)(R * K + C) * 2u; voffB[i] = (unsigned)(Rb * K + C) * 2u; }
    const size_t kstep = (size_t)(BK * 2);
    const size_t hstep = (size_t)HALF * K * 2;
    const unsigned ldsw = (unsigned)wid * 1024u;
    const int aoff = lds_byte(wr * 64 + fr, fq * 8), boff = lds_byte(wc * 32 + fr, fq * 8);
#define PG8_SA(b, h) (((b) * 2 + (h)) * HTB)
#define PG8_SB(b, h) ((4 + (b) * 2 + (h)) * HTB)
#define PG8_STAGE(bufoff, gbase, voff) do { _Pragma("unroll") for (int _i = 0; _i < 2; ++_i) \
        __builtin_amdgcn_global_load_lds((const unsigned*)((const char*)(gbase) + (voff)[_i]), (PG8_LAS unsigned*)(lds + (bufoff) + ldsw + _i * 8192), 16, 0, 0); } while (0)
#define PG8_LDA(dst, b, h) do { _Pragma("unroll") for (int m = 0; m < 4; ++m) _Pragma("unroll") for (int k = 0; k < 2; ++k) dst[m][k] = *(const PG8_LAS bf16x8*)(lds + PG8_SA(b, h) + aoff + m * 2048 + k * 1024); } while (0)
#define PG8_LDB(dst, b, h) do { _Pragma("unroll") for (int n = 0; n < 2; ++n) _Pragma("unroll") for (int k = 0; k < 2; ++k) dst[n][k] = *(const PG8_LAS bf16x8*)(lds + PG8_SB(b, h) + boff + n * 2048 + k * 1024); } while (0)
#define PG8_MMA(ai, bj, At, Bt) do { __builtin_amdgcn_s_setprio(1); _Pragma("unroll") for (int m = 0; m < 4; ++m) _Pragma("unroll") for (int n = 0; n < 2; ++n) _Pragma("unroll") for (int k = 0; k < 2; ++k) \
        acc[ai][bj][m][n] = __builtin_amdgcn_mfma_f32_16x16x32_bf16(Bt[n][k], At[m][k], acc[ai][bj][m][n], 0, 0, 0); __builtin_amdgcn_s_setprio(0); } while (0)
#define PG8_WAIT_V(n) asm volatile("s_waitcnt vmcnt(" #n ")" ::: "memory")
#define PG8_WAIT_L(n) asm volatile("s_waitcnt lgkmcnt(" #n ")" ::: "memory")
#define PG8_BAR __builtin_amdgcn_s_barrier()
#define PG8_SCHED __builtin_amdgcn_sched_barrier(0)
    Unit cur, nxt; int ui = 0;
    if (!S.next(0, cur)) return;
    f32x4 acc[2][2][4][2];
#pragma unroll
    for (int a = 0; a < 2; ++a)
#pragma unroll
        for (int b = 0; b < 2; ++b)
#pragma unroll
            for (int m = 0; m < 4; ++m)
#pragma unroll
                for (int n = 0; n < 2; ++n) acc[a][b][m][n] = (f32x4){0.f, 0.f, 0.f, 0.f};
    bf16x8 At[4][2], B0[2][2], B1[2][2];
    const char* cA = S.pa(cur, g); const char* cB = S.pb(cur, g);
    S.a_ready(cur);
    if constexpr (SP2) {
        PG8_STAGE(PG8_SB(0, 0), cB, voffB); PG8_STAGE(PG8_SB(0, 1), cB + hstep, voffB); PG8_STAGE(PG8_SA(0, 0), cA, voffA); PG8_STAGE(PG8_SA(0, 1), cA + hstep, voffA);
        if (wr == 1) PG8_BAR;
        PG8_WAIT_V(2); PG8_BAR;
        PG8_STAGE(PG8_SB(1, 0), cB + kstep, voffB); PG8_STAGE(PG8_SA(1, 0), cA + kstep, voffA); PG8_STAGE(PG8_SB(1, 1), cB + hstep + kstep, voffB);
        PG8_WAIT_V(6); PG8_BAR;
    } else {
        PG8_STAGE(PG8_SB(0, 0), cB, voffB); PG8_STAGE(PG8_SA(0, 0), cA, voffA); PG8_STAGE(PG8_SB(0, 1), cB + hstep, voffB); PG8_STAGE(PG8_SA(0, 1), cA + hstep, voffA);
        if (wr == 1) PG8_BAR;
        PG8_WAIT_V(4); PG8_BAR;
        PG8_STAGE(PG8_SB(1, 0), cB + kstep, voffB); PG8_STAGE(PG8_SA(1, 0), cA + kstep, voffA); PG8_STAGE(PG8_SB(1, 1), cB + hstep + kstep, voffB);
        PG8_WAIT_V(6); PG8_BAR;
    }
    for (;;) {
        const bool has_next = S.next(ui + 1, nxt);
        const char* nA = has_next ? S.pa(nxt, g) : cA; const char* nB = has_next ? S.pb(nxt, g) : cB;
        for (int t = 0; t < nt; t += 2) {
            const bool last = (t == nt - 2);
            const char* a1 = cA + (size_t)(t + 1) * kstep;
            const char* a2 = last ? nA : cA + (size_t)(t + 2) * kstep; const char* b2 = last ? nB : cB + (size_t)(t + 2) * kstep;
            const char* a3 = a2 + kstep; const char* b3 = b2 + kstep;
            if (last && has_next) S.a_ready(nxt);
            if constexpr (SP2) {
            PG8_LDB(B0, 0, 0); PG8_LDB(B1, 0, 1); PG8_SCHED; PG8_LDA(At, 0, 0); PG8_STAGE(PG8_SA(1, 1), a1 + hstep, voffA);
            PG8_WAIT_V(8); PG8_WAIT_L(0); PG8_BAR; PG8_MMA(0, 0, At, B0); PG8_MMA(0, 1, At, B1); PG8_BAR; PG8_SCHED;
            PG8_LDA(At, 0, 1); PG8_STAGE(PG8_SB(0, 0), b2, voffB); PG8_STAGE(PG8_SB(0, 1), b2 + hstep, voffB); PG8_STAGE(PG8_SA(0, 0), a2, voffA);
            PG8_WAIT_V(8); PG8_WAIT_L(0); PG8_BAR; PG8_MMA(1, 0, At, B0); PG8_MMA(1, 1, At, B1); PG8_BAR; PG8_SCHED;
            PG8_LDB(B0, 1, 0); PG8_LDB(B1, 1, 1); PG8_SCHED; PG8_LDA(At, 1, 0); PG8_STAGE(PG8_SA(0, 1), a2 + hstep, voffA);
            PG8_WAIT_V(8); PG8_WAIT_L(0); PG8_BAR; PG8_MMA(0, 0, At, B0); PG8_MMA(0, 1, At, B1); PG8_BAR; PG8_SCHED;
            PG8_LDA(At, 1, 1); PG8_STAGE(PG8_SB(1, 0), b3, voffB); PG8_STAGE(PG8_SB(1, 1), b3 + hstep, voffB); PG8_STAGE(PG8_SA(1, 0), a3, voffA);
            PG8_WAIT_V(8); PG8_WAIT_L(0); PG8_BAR; PG8_MMA(1, 0, At, B0); PG8_MMA(1, 1, At, B1); PG8_BAR; PG8_SCHED;
            } else {
            PG8_LDB(B0, 0, 0); PG8_SCHED; PG8_LDA(At, 0, 0); PG8_STAGE(PG8_SA(1, 1), a1 + hstep, voffA);
            PG8_WAIT_L(8); PG8_BAR; PG8_WAIT_L(0); PG8_MMA(0, 0, At, B0); PG8_BAR; PG8_SCHED;
            PG8_LDB(B1, 0, 1); PG8_STAGE(PG8_SB(0, 0), b2, voffB);
            PG8_BAR; PG8_WAIT_L(0); PG8_MMA(0, 1, At, B1); PG8_BAR;
            PG8_LDA(At, 0, 1); PG8_STAGE(PG8_SA(0, 0), a2, voffA);
            PG8_BAR; PG8_WAIT_L(0); PG8_MMA(1, 0, At, B0); PG8_BAR; PG8_SCHED;
            PG8_STAGE(PG8_SB(0, 1), b2 + hstep, voffB);
            PG8_WAIT_V(6); PG8_BAR; PG8_MMA(1, 1, At, B1); PG8_BAR;
            PG8_LDB(B0, 1, 0); PG8_SCHED; PG8_LDA(At, 1, 0); PG8_STAGE(PG8_SA(0, 1), a2 + hstep, voffA);
            PG8_WAIT_L(8); PG8_BAR; PG8_WAIT_L(0); PG8_MMA(0, 0, At, B0); PG8_BAR; PG8_SCHED;
            PG8_LDB(B1, 1, 1); PG8_STAGE(PG8_SB(1, 0), b3, voffB);
            PG8_BAR; PG8_WAIT_L(0); PG8_MMA(0, 1, At, B1); PG8_BAR;
            PG8_LDA(At, 1, 1); PG8_STAGE(PG8_SA(1, 0), a3, voffA);
            PG8_BAR; PG8_WAIT_L(0); PG8_MMA(1, 0, At, B0); PG8_BAR; PG8_SCHED;
            PG8_STAGE(PG8_SB(1, 1), b3 + hstep, voffB);
            PG8_WAIT_V(6); PG8_BAR; PG8_MMA(1, 1, At, B1); PG8_BAR;
            }
        }
        if constexpr (ALIGN_EPI) { if (wr == 0) PG8_BAR; }
        if constexpr (!Epi::AFTER_DRAIN) { E(acc, cur, wr, wc, fr, fq); S.done(cur); }
        if (!has_next) break;
#pragma unroll
        for (int a = 0; a < 2; ++a)
#pragma unroll
            for (int b = 0; b < 2; ++b)
#pragma unroll
                for (int m = 0; m < 4; ++m)
#pragma unroll
                    for (int n = 0; n < 2; ++n) acc[a][b][m][n] = (f32x4){0.f, 0.f, 0.f, 0.f};
        cur = nxt; cA = nA; cB = nB; ++ui;
        if constexpr (ALIGN_EPI) { if (wr == 1) PG8_BAR; }
    }
    PG8_WAIT_V(0);
    if constexpr (!ALIGN_EPI) { if (wr == 0) PG8_BAR; }
    PG8_BAR;
    if constexpr (Epi::AFTER_DRAIN) { E.fused(acc, cur, wr, wc, fr, fq, lds, wid, lane); S.done(cur); }
#undef PG8_SA
#undef PG8_SB
#undef PG8_STAGE
#undef PG8_LDA
#undef PG8_LDB
#undef PG8_MMA
#undef PG8_WAIT_V
#undef PG8_WAIT_L
#undef PG8_BAR
#undef PG8_SCHED
}
}

constexpr int NWAVES = 8;
constexpr int RING_BYTES = 131072, LDSCTL_OFF = RING_BYTES, MISC_OFF = LDSCTL_OFF + 320, RSTD_OFF = RING_BYTES + 1024, LDS_BYTES = 147456;
constexpr int CW_BAR = 4096;
#define GAS __attribute__((address_space(1)))
#define LAS __attribute__((address_space(3)))
typedef GAS unsigned gu32;
#define RLX_AGENT __ATOMIC_RELAXED, __HIP_MEMORY_SCOPE_AGENT
#define XB_TMO      128
#define XB_XCNT(j)  (256  + 64 * (j))
#define XB_XSUB(j)  (1280 + 64 * (j))
#define XB_XGEN(j)  (2304 + 64 * (j))
#define XB_TOP      3328
#define XB_TOPGEN   3392
#define XCD_BAR_WORDS 3456
#define XB_SPIN_CAP (1u << 18)

__device__ __forceinline__ unsigned xb_ld(unsigned* p)              { return __hip_atomic_load(p, __ATOMIC_RELAXED, __HIP_MEMORY_SCOPE_AGENT); }
__device__ __forceinline__ unsigned xb_add(unsigned* p, unsigned v) { return __hip_atomic_fetch_add(p, v, __ATOMIC_RELAXED, __HIP_MEMORY_SCOPE_AGENT); }
__device__ __forceinline__ unsigned xb_xcc_id() { return (unsigned)__builtin_amdgcn_s_getreg((3 << 11) | 20) & 0xFu; }
#define XB_SPIN(cond, bar) do { unsigned _sp = 0; while (cond) { __builtin_amdgcn_s_sleep(1); \
    if ((++_sp & 255u) == 0u) { if (xb_ld(&(bar)[XB_TMO])) break; if (_sp > XB_SPIN_CAP) { atomicAdd(&(bar)[XB_TMO], 1u); break; } } } } while (0)

struct XcdBarrier {
    unsigned* bar; unsigned x; int w0;
    volatile LAS unsigned* st;
};

__device__ __forceinline__ XcdBarrier xcd_barrier_post(unsigned* bar, volatile LAS unsigned* st) {
    XcdBarrier b; b.bar = bar; b.x = xb_xcc_id(); b.st = st;
    if (threadIdx.x == 0) (void)xb_add(&bar[XB_XCNT(b.x)], 1u);
    return b;
}
__device__ __forceinline__ void xcd_barrier_complete(unsigned* bar, unsigned x, unsigned& nloc, unsigned& nx) {
    const unsigned G = gridDim.x * gridDim.y * gridDim.z;
    unsigned sum, cnt, mine, sp = 0u;
    for (;;) {
        sum = 0u; cnt = 0u; mine = 0u;
#pragma unroll
        for (unsigned j = 0; j < 16; ++j) { const unsigned c = xb_ld(&bar[XB_XCNT(j)]); sum += c; cnt += (c > 0u) ? 1u : 0u; mine = (j == x) ? c : mine; }
        if (sum == G) break;
        __builtin_amdgcn_s_sleep(1);
        if ((++sp & 255u) == 0u) { if (xb_ld(&bar[XB_TMO])) break; if (sp > XB_SPIN_CAP) { atomicAdd(&bar[XB_TMO], 1u); break; } }
    }
    nloc = mine > 0u ? mine : 1u; nx = cnt > 0u ? cnt : 1u;
}

__device__ __forceinline__ void xcd_barrier(const XcdBarrier& b) {
    asm volatile("s_waitcnt vmcnt(0)" ::: "memory");
    __syncthreads();
    int ln_; asm volatile("v_mbcnt_lo_u32_b32 %0, -1, 0\n\tv_mbcnt_hi_u32_b32 %0, -1, %0" : "=v"(ln_));
    if (b.w0 == 0 && ln_ == 0) {
        unsigned* bar = b.bar;
        __builtin_amdgcn_s_waitcnt(0);
        unsigned nloc = b.st[0], nx = b.st[1];
        if (nloc == 0u) { xcd_barrier_complete(bar, b.x, nloc, nx); b.st[0] = nloc; b.st[1] = nx; }
        const unsigned old = xb_add(&bar[XB_XSUB(b.x)], 1u);
        const unsigned gen = old / nloc;
        if (old + 1u == (gen + 1u) * nloc) {
            __builtin_amdgcn_fence(__ATOMIC_RELEASE, "agent");
            asm volatile("s_waitcnt vmcnt(0)" ::: "memory");
            const unsigned og = xb_add(&bar[XB_TOP], 1u);
            const unsigned tg = og / nx;
            if (og + 1u == (tg + 1u) * nx) xb_add(&bar[XB_TOPGEN], 1u);
            else XB_SPIN(xb_ld(&bar[XB_TOPGEN]) == tg, bar);
            __builtin_amdgcn_fence(__ATOMIC_ACQUIRE, "agent");
            xb_add(&bar[XB_XGEN(b.x)], 1u);
            asm volatile("s_waitcnt vmcnt(0)" ::: "memory");
        } else {
            XB_SPIN(xb_ld(&bar[XB_XGEN(b.x)]) == gen, bar);
            __builtin_amdgcn_fence(__ATOMIC_ACQUIRE, "agent");
            asm volatile("s_waitcnt vmcnt(0)" ::: "memory");
        }
    }
    __syncthreads();
}

constexpr size_t WS_RSSP = WS_RSS;
constexpr size_t WS_KMEAN2 = 230 * MiB;
constexpr size_t WS_DL = 230 * MiB + 256 * 1024;
constexpr size_t WS_YC = WS_MQ;
constexpr size_t WS_YA = WS_SR;
constexpr size_t WS_S2 = 232 * MiB;
constexpr size_t WS_END2 = 248 * MiB;


namespace mix {
typedef unsigned u32x4 __attribute__((ext_vector_type(4)));
typedef unsigned u32x2 __attribute__((ext_vector_type(2)));
#define MIX_LAS __attribute__((address_space(3)))
using pg8::pack8; using pg8::unpack8; using pg8::cvt_pk_bf16;
#define MIX_BAR() do { asm volatile("s_waitcnt vmcnt(0) lgkmcnt(0)" ::: "memory"); __builtin_amdgcn_s_barrier(); asm volatile("" ::: "memory"); } while (0)

__device__ __forceinline__ void prepass_item(unsigned char* ws, const float* qw, const float* kw, int b, int blk, int h, MIX_LAS float* part, int tid, int lane, int wave) {
    const int sub = lane >> 4, c8 = (lane & 15) * 8;
    f32x4 qw0 = *(const f32x4*)(qw + c8) * QSCALE, qw1 = *(const f32x4*)(qw + c8 + 4) * QSCALE; const f32x4 kw0 = *(const f32x4*)(kw + c8), kw1 = *(const f32x4*)(kw + c8 + 4);
    f32x4 cs0 = {0.f, 0.f, 0.f, 0.f}, cs1 = cs0;
    bf16_t* MQ = (bf16_t*)(ws + WS_MQ); bf16_t* MK = (bf16_t*)(ws + WS_MK);
#pragma unroll 4
    for (int it = 0; it < 8; ++it) {
        const size_t off = ((size_t)b * SEQ + blk * 256 + wave * 32 + it * 4 + sub) * 512 + h * 128 + c8;
        { f32x4 a, c; unpack8(*(const u32x4*)(MQ + off), a, c); float ss = ((a[0] * a[0] + a[1] * a[1]) + (a[2] * a[2] + a[3] * a[3])) + ((c[0] * c[0] + c[1] * c[1]) + (c[2] * c[2] + c[3] * c[3]));
          ss += swz_xor<1>(ss); ss += swz_xor<2>(ss); ss += swz_xor<4>(ss); ss += swz_xor<8>(ss); const float rs = rsqrtf(ss * (1.f / 128.f) + EPS);
          *(u32x4*)(MQ + off) = pack8(a * rs * qw0, c * rs * qw1); }
        { f32x4 a, c; unpack8(*(const u32x4*)(MK + off), a, c); float ss = ((a[0] * a[0] + a[1] * a[1]) + (a[2] * a[2] + a[3] * a[3])) + ((c[0] * c[0] + c[1] * c[1]) + (c[2] * c[2] + c[3] * c[3]));
          ss += swz_xor<1>(ss); ss += swz_xor<2>(ss); ss += swz_xor<4>(ss); ss += swz_xor<8>(ss); const float rs = rsqrtf(ss * (1.f / 128.f) + EPS);
          a = a * rs * kw0; c = c * rs * kw1; cs0 += a; cs1 += c; *(u32x4*)(MK + off) = pack8(a, c); }
    }
#pragma unroll
    for (int j = 0; j < 4; ++j) { cs0[j] += swz_xor<16>(cs0[j]); cs0[j] = half_sum(cs0[j]); cs1[j] += swz_xor<16>(cs1[j]); cs1[j] = half_sum(cs1[j]); }
    if (sub == 0) { *(MIX_LAS f32x4*)(part + wave * 128 + c8) = cs0; *(MIX_LAS f32x4*)(part + wave * 128 + c8 + 4) = cs1; }
    MIX_BAR();
    if (tid < 128) { float s = 0.f;
#pragma unroll
        for (int w = 0; w < 8; ++w) s += part[w * 128 + tid];
        ((float*)(ws + WS_KMEAN))[(((size_t)b * 4 + h) * 8 + blk) * 128 + tid] = s * (1.f / 256.f); }
    MIX_BAR();
}

constexpr int PSTR = 272;
__device__ __forceinline__ void pool_item(unsigned char* ws, const float* pscale, int pm, int g, MIX_LAS unsigned char* lds, int tid, int lane, int wave) {
    MIX_LAS unsigned char* P = lds; MIX_LAS unsigned char* W = lds + 256 * PSTR;
    const bf16_t* PW = (const bf16_t*)(ws + WS_W + W_PW) + g * 128 * 128;
#pragma unroll
    for (int j = 0; j < 4; ++j) { const int id = tid + 512 * j, e = id >> 4, cc = id & 15; *(MIX_LAS u32x4*)(W + e * PSTR + cc * 16) = *(const u32x4*)(PW + e * 128 + cc * 8); }
    {
        const int cp = tid & 63, seg = tid >> 6, w = 2 << g; const int row0 = pm * 256 + seg * 32, t0 = row0 & (SEQ - 1);
        const unsigned* PU = (const unsigned*)(ws + WS_PU) + g * 64 + cp;
        float s0 = 0.f, s1 = 0.f;
        for (int j = 1; j < w; ++j) if (t0 - j >= 0) { const unsigned v = PU[(size_t)(row0 - j) * 256]; s0 += __uint_as_float(v << 16); s1 += __uint_as_float(v & 0xffff0000u); }
#pragma unroll 8
        for (int r = 0; r < 32; ++r) {
            const int t = t0 + r; const unsigned v = PU[(size_t)(row0 + r) * 256]; const float u0 = __uint_as_float(v << 16), u1 = __uint_as_float(v & 0xffff0000u);
            s0 += u0; s1 += u1; const float ic = 1.f / (float)min(t + 1, w);
            *(MIX_LAS unsigned*)(P + (seg * 32 + r) * PSTR + cp * 4) = cvt_pk_bf16(s0 * ic - u0, s1 * ic - u1);
            if (t - w + 1 >= 0) { const unsigned o = PU[(size_t)(row0 + r - w + 1) * 256]; s0 -= __uint_as_float(o << 16); s1 -= __uint_as_float(o & 0xffff0000u); }
        }
    }
    MIX_BAR();
    f32x4 acc[8][2];
#pragma unroll
    for (int n = 0; n < 8; ++n) { acc[n][0] = (f32x4){0.f, 0.f, 0.f, 0.f}; acc[n][1] = acc[n][0]; }
    const int r = lane & 15, q = lane >> 4;
#pragma unroll
    for (int kk = 0; kk < 4; ++kk) {
        bf16x8 pf[2];
#pragma unroll
        for (int m = 0; m < 2; ++m) pf[m] = *(const MIX_LAS bf16x8*)(P + (wave * 32 + m * 16 + r) * PSTR + (kk * 32 + 8 * q) * 2);
#pragma unroll
        for (int n = 0; n < 8; ++n) { const bf16x8 wf = *(const MIX_LAS bf16x8*)(W + (n * 16 + r) * PSTR + (kk * 32 + 8 * q) * 2);
#pragma unroll
            for (int m = 0; m < 2; ++m) acc[n][m] = __builtin_amdgcn_mfma_f32_16x16x32_bf16(wf, pf[m], acc[n][m], 0, 0, 0); }
    }
    bf16_t* YB = (bf16_t*)(ws + WS_YB);
#pragma unroll
    for (int n = 0; n < 8; ++n) { const f32x4 sc = *(const f32x4*)(pscale + g * 128 + n * 16 + 4 * q);
#pragma unroll
        for (int m = 0; m < 2; ++m) { const f32x4 y = acc[n][m] * sc; u32x2 o; o.x = cvt_pk_bf16(y[0], y[1]); o.y = cvt_pk_bf16(y[2], y[3]);
            *(u32x2*)(YB + (size_t)(pm * 256 + wave * 32 + m * 16 + r) * 512 + g * 128 + n * 16 + 4 * q) = o; } }
    MIX_BAR();
}

constexpr int GSTR = 144;
constexpr int GL_SEG = 0, GL_QE = 1024, GL_KE = GL_QE + 64 * GSTR, GL_VT = GL_KE + 64 * GSTR, GL_P = GL_VT + 128 * GSTR, GL_HALF = 49152;
__device__ __forceinline__ void gla_cumsum(const float* GG, size_t row0, int h, MIX_LAS unsigned char* lds, int d, int seg, float (&bc)[16], float& bL) {
    const float* g = GG + (row0 + seg * 16) * 256 + h * 64 + d; float c = 0.f;
#pragma unroll
    for (int j = 0; j < 16; ++j) { c += g[j * 256]; bc[j] = c; }
    MIX_LAS float* SEG = (MIX_LAS float*)(lds + GL_SEG); SEG[seg * 64 + d] = c;
    MIX_BAR();
    float off = 0.f, tot = 0.f;
#pragma unroll
    for (int s = 0; s < 4; ++s) { const float v = SEG[s * 64 + d]; tot += v; off += (s < seg) ? v : 0.f; }
#pragma unroll
    for (int j = 0; j < 16; ++j) bc[j] += off;
    bL = tot;
}
__device__ __forceinline__ void gla_vt(const bf16_t* GV, size_t row0, int h, MIX_LAS unsigned char* lds, int t8) {
    const int e = t8 & 127, tq = t8 >> 7; const bf16_t* v = GV + (row0 + tq * 32) * 512 + h * 128 + e; unsigned w[16];
#pragma unroll
    for (int j = 0; j < 16; ++j) w[j] = (unsigned)v[(2 * j) * 512] | ((unsigned)v[(2 * j + 1) * 512] << 16);
    MIX_LAS u32x4* p = (MIX_LAS u32x4*)(lds + GL_VT + e * GSTR + tq * 64);
#pragma unroll
    for (int j = 0; j < 4; ++j) p[j] = (u32x4){w[4 * j], w[4 * j + 1], w[4 * j + 2], w[4 * j + 3]};
}
__device__ __forceinline__ void gla_passA_pair(unsigned char* ws, int pair, MIX_LAS unsigned char* lds0, int tid, int lane, int wave) {
    const int hb = tid >> 8, t8 = tid & 255, w4 = wave & 3, cid = 2 * pair + hb; MIX_LAS unsigned char* lds = lds0 + hb * GL_HALF;
    const int d = t8 & 63, seg = t8 >> 6, bh = cid >> 5, n = cid & 31, b = bh >> 2, h = bh & 3; const size_t row0 = (size_t)b * SEQ + n * 64;
    float bc[16], bL;
    const bf16_t* gk = (const bf16_t*)(ws + WS_GK) + (row0 + seg * 16) * 256 + h * 64 + d; float kv[16];
#pragma unroll
    for (int j = 0; j < 16; ++j) kv[j] = bf2f(gk[j * 256]);
    gla_vt((const bf16_t*)(ws + WS_GV), row0, h, lds, t8);
    gla_cumsum((const float*)(ws + WS_GG), row0, h, lds, d, seg, bc, bL);
#pragma unroll
    for (int j8 = 0; j8 < 2; ++j8) { f32x4 a, c;
#pragma unroll
      for (int j = 0; j < 4; ++j) { a[j] = kv[8 * j8 + j] * __expf(bL - bc[8 * j8 + j]); c[j] = kv[8 * j8 + 4 + j] * __expf(bL - bc[8 * j8 + 4 + j]); }
      *(MIX_LAS u32x4*)(lds + GL_KE + d * GSTR + seg * 32 + j8 * 16) = pack8(a, c); }
    if (seg == 0) ((float*)(ws + WS_DL))[(size_t)cid * 64 + d] = __expf(bL);
    MIX_BAR();
    const int r = lane & 15, q = lane >> 4; f32x4 acc[2][4];
#pragma unroll
    for (int ee = 0; ee < 2; ++ee)
#pragma unroll
        for (int dt = 0; dt < 4; ++dt) acc[ee][dt] = (f32x4){0.f, 0.f, 0.f, 0.f};
#pragma unroll
    for (int kk = 0; kk < 2; ++kk) { bf16x8 kf[4];
#pragma unroll
        for (int dt = 0; dt < 4; ++dt) kf[dt] = *(const MIX_LAS bf16x8*)(lds + GL_KE + (dt * 16 + r) * GSTR + (kk * 32 + 8 * q) * 2);
#pragma unroll
        for (int ee = 0; ee < 2; ++ee) { const bf16x8 vf = *(const MIX_LAS bf16x8*)(lds + GL_VT + ((2 * w4 + ee) * 16 + r) * GSTR + (kk * 32 + 8 * q) * 2);
#pragma unroll
            for (int dt = 0; dt < 4; ++dt) acc[ee][dt] = __builtin_amdgcn_mfma_f32_16x16x32_bf16(kf[dt], vf, acc[ee][dt], 0, 0, 0); } }
#pragma unroll
    for (int ee = 0; ee < 2; ++ee) { bf16_t* US = (bf16_t*)(ws + WS_US) + ((size_t)cid * 128 + (2 * w4 + ee) * 16 + r) * 64;
#pragma unroll
        for (int dt = 0; dt < 4; ++dt) { u32x2 o; o.x = cvt_pk_bf16(acc[ee][dt][0], acc[ee][dt][1]); o.y = cvt_pk_bf16(acc[ee][dt][2], acc[ee][dt][3]); *(u32x2*)(US + dt * 16 + 4 * q) = o; } }
    MIX_BAR();
}
__device__ __forceinline__ void gla_scan(unsigned char* ws, int gtid) {
    const int bh = gtid >> 12, e = (gtid >> 5) & 127, dp = gtid & 31;
    const size_t uoff = (((size_t)bh * 32) * 128 + e) * 32 + dp; const unsigned* US = (const unsigned*)(ws + WS_US) + uoff; unsigned* S2 = (unsigned*)(ws + WS_S2) + uoff; const float* DLp = (const float*)(ws + WS_DL) + (size_t)bh * 32 * 64 + 2 * dp;
    float s0 = 0.f, s1 = 0.f;
#pragma unroll 8
    for (int n = 0; n < 32; ++n) { const unsigned u = US[(size_t)n * 128 * 32]; const float d0 = DLp[n * 64], d1 = DLp[n * 64 + 1];
        S2[(size_t)n * 128 * 32] = cvt_pk_bf16(s0, s1);
        s0 = d0 * s0 + __uint_as_float(u << 16); s1 = d1 * s1 + __uint_as_float(u & 0xffff0000u); }
}
__device__ __forceinline__ void gla_passC_pair(unsigned char* ws, const float* nw, int pair, MIX_LAS unsigned char* lds0, int tid, int lane, int wave, size_t ya_off) {
    const int hb = tid >> 8, t8 = tid & 255, w4 = wave & 3, cid = 2 * pair + hb; MIX_LAS unsigned char* lds = lds0 + hb * GL_HALF;
    const int d = t8 & 63, seg = t8 >> 6, bh = cid >> 5, n = cid & 31, b = bh >> 2, h = bh & 3; const size_t row0 = (size_t)b * SEQ + n * 64;
    const int r = lane & 15, q = lane >> 4, it = w4;
    const size_t yoff = (row0 + it * 16 + r) * 512 + h * 128 + 4 * q; u32x2 srv[8];
#pragma unroll
    for (int et = 0; et < 8; ++et) srv[et] = *(const u32x2*)((const bf16_t*)(ws + WS_SR) + yoff + et * 16);
    bf16x8 sfr[8][2]; { const bf16_t* ST = (const bf16_t*)(ws + WS_S2) + (size_t)cid * 128 * 64;
#pragma unroll
        for (int et = 0; et < 8; ++et)
#pragma unroll
            for (int kk = 0; kk < 2; ++kk) sfr[et][kk] = *(const bf16x8*)(ST + (et * 16 + r) * 64 + kk * 32 + 8 * q); }
    float bc[16], bL;
    {
        const bf16_t* gk = (const bf16_t*)(ws + WS_GK) + (row0 + seg * 16) * 256 + h * 64 + d; const bf16_t* gq = (const bf16_t*)(ws + WS_GQ) + (row0 + seg * 16) * 256 + h * 64 + d; float kv[16], qv[16];
#pragma unroll
        for (int j = 0; j < 16; ++j) { kv[j] = bf2f(gk[j * 256]); qv[j] = bf2f(gq[j * 256]); }
        gla_vt((const bf16_t*)(ws + WS_GV), row0, h, lds, t8);
        gla_cumsum((const float*)(ws + WS_GG), row0, h, lds, d, seg, bc, bL);
#pragma unroll
        for (int j = 0; j < 16; ++j) { const float ex = __expf(bc[j]);
            *(MIX_LAS bf16_t*)(lds + GL_QE + (seg * 16 + j) * GSTR + 2 * d) = f2bf(qv[j] * ex);
            *(MIX_LAS bf16_t*)(lds + GL_KE + (seg * 16 + j) * GSTR + 2 * d) = f2bf(kv[j] * __expf(-bc[j])); }
    }
    MIX_BAR();
    bf16x8 qf[2];
#pragma unroll
    for (int kk = 0; kk < 2; ++kk) qf[kk] = *(const MIX_LAS bf16x8*)(lds + GL_QE + (it * 16 + r) * GSTR + (kk * 32 + 8 * q) * 2);
#pragma unroll
    for (int jt = 0; jt < 4; ++jt) { f32x4 acc = {0.f, 0.f, 0.f, 0.f};
        if (jt <= it) {
#pragma unroll
            for (int kk = 0; kk < 2; ++kk) { const bf16x8 kf = *(const MIX_LAS bf16x8*)(lds + GL_KE + (jt * 16 + r) * GSTR + (kk * 32 + 8 * q) * 2);
                acc = __builtin_amdgcn_mfma_f32_16x16x32_bf16(qf[kk], kf, acc, 0, 0, 0); }
            if (jt == it) {
#pragma unroll
                for (int x = 0; x < 4; ++x) if (r > 4 * q + x) acc[x] = 0.f; } }
#pragma unroll
        for (int x = 0; x < 4; ++x) *(MIX_LAS bf16_t*)(lds + GL_P + (it * 16 + 4 * q + x) * GSTR + (jt * 16 + r) * 2) = f2bf(acc[x]); }
    asm volatile("s_waitcnt lgkmcnt(0)" ::: "memory");
    bf16x8 pf[2];
#pragma unroll
    for (int kk = 0; kk < 2; ++kk) pf[kk] = *(const MIX_LAS bf16x8*)(lds + GL_P + (it * 16 + r) * GSTR + (kk * 32 + 8 * q) * 2);
    f32x4 acc[8]; float ss = 0.f;
#pragma unroll
    for (int et = 0; et < 8; ++et) { acc[et] = (f32x4){0.f, 0.f, 0.f, 0.f};
#pragma unroll
        for (int kk = 0; kk < 2; ++kk) { const bf16x8 vf = *(const MIX_LAS bf16x8*)(lds + GL_VT + (et * 16 + r) * GSTR + (kk * 32 + 8 * q) * 2);
            const bf16x8 sf = sfr[et][kk];
            acc[et] = __builtin_amdgcn_mfma_f32_16x16x32_bf16(vf, pf[kk], acc[et], 0, 0, 0);
            acc[et] = __builtin_amdgcn_mfma_f32_16x16x32_bf16(sf, qf[kk], acc[et], 0, 0, 0); } }
#pragma unroll
    for (int et = 0; et < 8; ++et) ss += (acc[et][0] * acc[et][0] + acc[et][1] * acc[et][1]) + (acc[et][2] * acc[et][2] + acc[et][3] * acc[et][3]);
    ss += swz_xor<16>(ss); ss = half_sum(ss);
    const float rstd = rsqrtf(ss * (1.f / 128.f) + EPS);
    bf16_t* YA = (bf16_t*)(ws + ya_off) + yoff;
#pragma unroll
    for (int et = 0; et < 8; ++et) { const u32x2 sr = srv[et]; const f32x4 w4v = *(const f32x4*)(nw + et * 16 + 4 * q);
        const float y0 = acc[et][0] * rstd * w4v[0] * __uint_as_float(sr.x << 16), y1 = acc[et][1] * rstd * w4v[1] * __uint_as_float(sr.x & 0xffff0000u);
        const float y2 = acc[et][2] * rstd * w4v[2] * __uint_as_float(sr.y << 16), y3 = acc[et][3] * rstd * w4v[3] * __uint_as_float(sr.y & 0xffff0000u);
        u32x2 o; o.x = cvt_pk_bf16(y0, y1); o.y = cvt_pk_bf16(y2, y3); *(u32x2*)(YA + et * 16) = o; }
    MIX_BAR();
}
}

namespace moba {
typedef short s16x4 __attribute__((ext_vector_type(4)));
typedef float f32x16 __attribute__((ext_vector_type(16)));
typedef unsigned u32x4 __attribute__((ext_vector_type(4)));
using pg8::cvt_pk_bf16;
constexpr int D = 128, LD = 512, NW = 8, QBLK = 32, KVBLK = 128, QB = 256;
constexpr int SHM_V = KVBLK * D * 2, SHM_K = KVBLK * D * 2;
constexpr int LDS_WS = 131072 + 1024, LDS_TAB = LDS_WS + NW * 64 * 4, LDS_BYTES = LDS_TAB + 512;
constexpr float THR2 = 11.5f;
#define KSWZ(row, colB) ((row) * 256 + ((colB) ^ (((row) & 7) << 4)))
#define SBAR() __builtin_amdgcn_sched_barrier(0)
__device__ __forceinline__ int v_st(int k, int c) { const int kk = (k & ~0xC) | ((k & 4) << 1) | ((k & 8) >> 1); return ((kk >> 3) * 4 + (c >> 5)) * 512 + ((kk & 7) * 32 + (c & 31)) * 2; }
__device__ __forceinline__ int v_rd_base(int lane) { return ((lane & 3) << 3) | (((lane >> 2) & 3) << 6) | (((lane >> 4) & 1) << 5) | (((lane >> 5) & 1) << 8); }
constexpr int v_rd_off(int d0, int ks, int half) { return d0 * 512 + ks * 4096 + half * 2048; }
__device__ __forceinline__ int crow(int r, int hi) { return (r & 3) + 8 * (r >> 2) + 4 * hi; }
__device__ __forceinline__ bf16x8 load8(const bf16_t* p) { return *reinterpret_cast<const bf16x8*>(p); }

__device__ __forceinline__ void partialSM(f32x16& p0, f32x16& p1, float& m_reg, float& mn, float& alpha) {
    float pmax = p0[0];
#pragma unroll
    for (int r = 1; r < 16; ++r) pmax = fmaxf(pmax, p0[r]);
#pragma unroll
    for (int r = 0; r < 16; ++r) pmax = fmaxf(pmax, p1[r]);
    { auto rr = __builtin_amdgcn_permlane32_swap(__float_as_uint(pmax), __float_as_uint(pmax), false, false); pmax = fmaxf(__uint_as_float(rr[0]), __uint_as_float(rr[1])); }
    if (__builtin_expect(__all((pmax - m_reg) <= THR2), 1)) { mn = m_reg; alpha = 1.f; }
    else { mn = fmaxf(m_reg, pmax); alpha = __builtin_amdgcn_exp2f(m_reg - mn); m_reg = mn; }
#pragma unroll
    for (int r = 0; r < 16; ++r) p0[r] = p0[r] - mn;
#pragma unroll
    for (int r = 0; r < 16; ++r) p1[r] = p1[r] - mn;
#pragma unroll
    for (int r = 0; r < 16; ++r) p0[r] = __builtin_amdgcn_exp2f(p0[r]);
}
__device__ __forceinline__ void finishSM(f32x16& p0, f32x16& p1, float alpha, float& l_reg, bf16x8& pa0, bf16x8& pa1, bf16x8& pa2, bf16x8& pa3) {
#pragma unroll
    for (int r = 0; r < 16; ++r) p1[r] = __builtin_amdgcn_exp2f(p1[r]);
    float ps = 0;
#pragma unroll
    for (int r = 0; r < 16; ++r) ps += p0[r];
#pragma unroll
    for (int r = 0; r < 16; ++r) ps += p1[r];
    { auto rr = __builtin_amdgcn_permlane32_swap(__float_as_uint(ps), __float_as_uint(ps), false, false); ps = __uint_as_float(rr[0]) + __uint_as_float(rr[1]); }
    l_reg = l_reg * alpha + ps;
#define PK4(P, B_, OUT) do { unsigned a0 = cvt_pk_bf16(P[B_+0], P[B_+1]), a1 = cvt_pk_bf16(P[B_+2], P[B_+3]);                          \
        unsigned b0 = cvt_pk_bf16(P[B_+4], P[B_+5]), b1 = cvt_pk_bf16(P[B_+6], P[B_+7]);                                             \
        auto r0 = __builtin_amdgcn_permlane32_swap(a0, b0, false, false); auto r1 = __builtin_amdgcn_permlane32_swap(a1, b1, false, false); \
        u32x4 w = {r0[0], r1[0], r0[1], r1[1]}; OUT = *reinterpret_cast<bf16x8*>(&w); } while (0)
    PK4(p0, 0, pa0); PK4(p0, 8, pa1); PK4(p1, 0, pa2); PK4(p1, 8, pa3);
#undef PK4
}
template <int KB>
__device__ __forceinline__ void qkt(f32x16& p0, f32x16& p1, const char* K_lds, int krow, int hi, const bf16x8* qr, bool act) {
    if (!act) { const float NEG = -__builtin_inff();
#pragma unroll
        for (int r = 0; r < 16; ++r) { p0[r] = NEG; p1[r] = NEG; } return; }
    p0 = f32x16{}; p1 = f32x16{};
    const char* kb[4];
#pragma unroll
    for (int dd = 0; dd < 4; ++dd) kb[dd] = K_lds + KB * SHM_K + KSWZ(krow, (dd * 16 + hi * 8) * 2);
#pragma unroll
    for (int d0 = 0; d0 < 8; ++d0) { const char* a = kb[d0 & 3] + (d0 >> 2) * 128;
        bf16x8 b0 = *reinterpret_cast<const bf16x8*>(a);
        bf16x8 b1 = *reinterpret_cast<const bf16x8*>(a + 32 * 256);
        p0 = __builtin_amdgcn_mfma_f32_32x32x16_bf16(b0, qr[d0], p0, 0, 0, 0);
        p1 = __builtin_amdgcn_mfma_f32_32x32x16_bf16(b1, qr[d0], p1, 0, 0, 0); }
}
template <int VB>
__device__ __forceinline__ void pv_tile(f32x16* o, int vb0, bf16x8 pa0, bf16x8 pa1, bf16x8 pa2, bf16x8 pa3, bool act) {
    if (!act) return;
#define TRRD(dst, off) asm volatile("ds_read_b64_tr_b16 %0, %1 offset:%2" : "=&v"(dst) : "v"(vb0), "i"(off) : "memory")
#define PV_D0(d0) do { s16x4 l0, l1, l2, l3, h0, h1, h2, h3; constexpr int b_ = VB * SHM_V + v_rd_off(d0, 0, 0); \
        TRRD(l0, b_); TRRD(h0, b_ + 2048); TRRD(l1, b_ + 4096); TRRD(h1, b_ + 6144); TRRD(l2, b_ + 8192); TRRD(h2, b_ + 10240); TRRD(l3, b_ + 12288); TRRD(h3, b_ + 14336); \
        asm volatile("s_waitcnt lgkmcnt(0)" ::: "memory"); SBAR();   \
        o[d0] = __builtin_amdgcn_mfma_f32_32x32x16_bf16(pa0, (bf16x8){l0[0], l0[1], l0[2], l0[3], h0[0], h0[1], h0[2], h0[3]}, o[d0], 0, 0, 0);   \
        o[d0] = __builtin_amdgcn_mfma_f32_32x32x16_bf16(pa1, (bf16x8){l1[0], l1[1], l1[2], l1[3], h1[0], h1[1], h1[2], h1[3]}, o[d0], 0, 0, 0);   \
        o[d0] = __builtin_amdgcn_mfma_f32_32x32x16_bf16(pa2, (bf16x8){l2[0], l2[1], l2[2], l2[3], h2[0], h2[1], h2[2], h2[3]}, o[d0], 0, 0, 0);   \
        o[d0] = __builtin_amdgcn_mfma_f32_32x32x16_bf16(pa3, (bf16x8){l3[0], l3[1], l3[2], l3[3], h3[0], h3[1], h3[2], h3[3]}, o[d0], 0, 0, 0); } while (0)
    PV_D0(0); PV_D0(1); PV_D0(2); PV_D0(3);
#undef PV_D0
#undef TRRD
}
__device__ __forceinline__ void mask_bias_tile(f32x16& p0, f32x16& p1, int dq, const float* tab) {
    const float NEG = -__builtin_inff();
#pragma unroll
    for (int r = 0; r < 16; ++r) { const int c = (r & 3) + 8 * (r >> 2); const int d0 = dq - c, d1 = dq - c - 32;
        p0[r] = d0 < 0 ? NEG : p0[r] + tab[d0 > 113 ? 113 : d0];
        p1[r] = d1 < 0 ? NEG : p1[r] + tab[d1 > 113 ? 113 : d1]; }
}
__device__ __forceinline__ void bias_tile(f32x16& p0, f32x16& p1, int dq, const float* tab) {
#pragma unroll
    for (int r = 0; r < 16; ++r) { const int c = (r & 3) + 8 * (r >> 2); const int d0 = dq - c, d1 = dq - c - 32;
        p0[r] += tab[d0 > 113 ? 113 : d0]; p1[r] += tab[d1 > 113 ? 113 : d1]; }
}
__device__ __forceinline__ void kill_tile(f32x16& p0, f32x16& p1, bool ok) {
    const float NEG = -__builtin_inff();
#pragma unroll
    for (int r = 0; r < 16; ++r) { p0[r] = ok ? p0[r] : NEG; p1[r] = ok ? p1[r] : NEG; }
}

struct BlockRef { const bf16_t* Q; const bf16_t* K; const bf16_t* V; bf16_t* O; const float* km; int P0; };
struct Seam { bf16x8 qr[8]; bf16x8 st_v0, st_v1, st_v2, st_v3, st_k0, st_k1, st_k2, st_k3; };
#define ROW(p, k0, rr) ((p) + (size_t)((k0) + (rr)) * LD + sc)
#define VMW() asm volatile("s_waitcnt vmcnt(0)" ::: "memory")
#define SLOAD_H(Kp, Vp, k0) do { S.st_v0 = load8(ROW(Vp, k0, sr)); S.st_v1 = load8(ROW(Vp, k0, 32 + sr)); S.st_v2 = load8(ROW(Vp, k0, 64 + sr)); S.st_v3 = load8(ROW(Vp, k0, 96 + sr)); \
                                 S.st_k0 = load8(ROW(Kp, k0, sr)); S.st_k1 = load8(ROW(Kp, k0, 32 + sr)); S.st_k2 = load8(ROW(Kp, k0, 64 + sr)); S.st_k3 = load8(ROW(Kp, k0, 96 + sr)); } while (0)
#define SWRITE_HK(bf) do { *(bf16x8*)(K_lds + (bf) * SHM_K + kws) = S.st_k0; *(bf16x8*)(K_lds + (bf) * SHM_K + kws + 32 * 256) = S.st_k1; *(bf16x8*)(K_lds + (bf) * SHM_K + kws + 64 * 256) = S.st_k2; *(bf16x8*)(K_lds + (bf) * SHM_K + kws + 96 * 256) = S.st_k3; } while (0)
#define SWRITE_HV(bf) do { *(bf16x8*)(V_lds + (bf) * SHM_V + vst0) = S.st_v0; *(bf16x8*)(V_lds + (bf) * SHM_V + vst1) = S.st_v1; *(bf16x8*)(V_lds + (bf) * SHM_V + 16384 + vst0) = S.st_v2; *(bf16x8*)(V_lds + (bf) * SHM_V + 16384 + vst1) = S.st_v3; } while (0)
#define SWRITE_H(bf) do { SWRITE_HV(bf); SWRITE_HK(bf); } while (0)
__device__ __forceinline__ void prime(const BlockRef& cur, const float* rel_bias, int h, char* lds, Seam& S, int tid) {
    const int wid = __builtin_amdgcn_readfirstlane(tid >> 6), lane = tid & 63, r32 = lane & 31, hi = lane >> 5, rg = wid & 3;
    const int sr = tid >> 4, sc = (tid & 15) * 8, kws = KSWZ(sr, sc * 2); char* K_lds = lds + 2 * SHM_V;
    __syncthreads();
    if (tid < 128) { int bk = tid; if (tid >= 16) { bk = 16 + (int)(__logf((float)tid * (1.f / 16.f)) * (16.f / 2.0794415416798357f)); bk = bk > 31 ? 31 : bk; }
        ((float*)(lds + LDS_TAB))[tid] = tid >= 113 ? 0.f : (rel_bias[bk * 4 + h] - rel_bias[31 * 4 + h]) * LOG2E; }
#pragma unroll
    for (int d0 = 0; d0 < 8; ++d0) S.qr[d0] = load8(cur.Q + (size_t)(rg * QBLK + r32) * LD + d0 * 16 + hi * 8);
    SLOAD_H(cur.K, cur.V, 0); VMW(); SWRITE_HK(0);
    __syncthreads();
}
__device__ __forceinline__ void block(const BlockRef& cur, char* lds, Seam& S, int tid) {
    const int wid = __builtin_amdgcn_readfirstlane(tid >> 6), lane = tid & 63, r32 = lane & 31, hi = lane >> 5, rg = wid & 3, kh = wid >> 2;
    const int qblk = cur.P0 >> 8, NT = 2 * qblk + 2;
    const int qlo = cur.P0 + rg * QBLK, qm = qlo + r32 - 4 * hi - 64 * kh;
    char* V_lds = lds; char* K_lds = lds + 2 * SHM_V;
    float* ws = (float*)(lds + LDS_WS) + wid * 64; float* li_l = ws, * al_l = ws + 32; const float* tab = (const float*)(lds + LDS_TAB);
    float m_reg = -1e30f, l_reg = 0; f32x16 o[4] = {};
    const int sr = tid >> 4, sc = (tid & 15) * 8, vst0 = v_st(sr, sc), vst1 = v_st(32 + sr, sc), kws = KSWZ(sr, sc * 2);
    const int vb0 = (int)(uintptr_t)V_lds + v_rd_base(lane) + kh * 16384, krow = r32 + 64 * kh;
    const bf16_t* Kh = cur.K; const bf16_t* Vh = cur.V;
    unsigned sel = (1u << qblk) - 1u;
    if (qblk > 3) {
        float s[7];
#pragma unroll
        for (int n = 0; n < 7; ++n) { s[n] = -__builtin_inff();
            if (n < qblk) { float a = 0.f; const float* kmn = cur.km + n * 128 + hi * 8;
#pragma unroll
                for (int d0 = 0; d0 < 8; ++d0) { const f32x4 k0 = *(const f32x4*)(kmn + d0 * 16), k1 = *(const f32x4*)(kmn + d0 * 16 + 4); const bf16x8 qv = S.qr[d0];
#pragma unroll
                    for (int j = 0; j < 4; ++j) { a += __uint_as_float(((unsigned)(unsigned short)qv[j]) << 16) * k0[j]; a += __uint_as_float(((unsigned)(unsigned short)qv[4 + j]) << 16) * k1[j]; } }
                s[n] = half_sum(a); } }
        sel = 0u;
#pragma unroll
        for (int c = 0; c < 3; ++c) { float best = -__builtin_inff(); int bi = 0;
#pragma unroll
            for (int n = 0; n < 7; ++n) if (s[n] > best) { best = s[n]; bi = n; }
            sel |= 1u << bi;
#pragma unroll
            for (int n = 0; n < 7; ++n) s[n] = (n == bi) ? -__builtin_inff() : s[n]; }
    }
#define RESC(a) do { if (__any((a) < 1.f)) { if (hi == 0) al_l[r32] = (a); asm volatile("s_waitcnt lgkmcnt(0)" ::: "memory");              \
                     for (int d_ = 0; d_ < 4; ++d_) for (int r = 0; r < 16; ++r) o[d_][r] *= al_l[crow(r, hi)]; } } while (0)
#define KBASE(t) ((t) * KVBLK)
#define ACT(t) ((KBASE(t) >> 8) < qblk ? (__any((sel >> (KBASE(t) >> 8)) & 1u) != 0) : (KBASE(t) + 64 * kh <= qlo + QBLK - 1))
#define MASKT(P0_, P1_, t) do { const int kb_ = KBASE(t); if (ACT(t)) { if ((kb_ >> 8) < qblk) { if (kb_ + 64 * kh + 176 > qlo) bias_tile(P0_, P1_, qm - kb_, tab); kill_tile(P0_, P1_, ((sel >> (kb_ >> 8)) & 1u) != 0u); } \
                                     else mask_bias_tile(P0_, P1_, qm - kb_, tab); } } while (0)
    f32x16 pA0, pA1, pB0, pB1; float mnA, mnB, alA, alB; bf16x8 pa0, pa1, pa2, pa3;
    SWRITE_HV(0); SBAR();
    SLOAD_H(Kh, Vh, KBASE(1));
    SBAR(); qkt<0>(pA0, pA1, K_lds, krow, hi, S.qr, ACT(0));
    MASKT(pA0, pA1, 0); partialSM(pA0, pA1, m_reg, mnA, alA);
    VMW(); SWRITE_H(1); SBAR(); if (2 < NT) { SLOAD_H(Kh, Vh, KBASE(2)); } SBAR();
    __syncthreads();
#define HALF_STEP(PX0, PX1, mnX, alX, PY0, PY1, alY, t, KB, VB, SB) do {                                                      \
        SBAR(); qkt<KB>(PX0, PX1, K_lds, krow, hi, S.qr, ACT(t));                                                          \
        finishSM(PY0, PY1, alY, l_reg, pa0, pa1, pa2, pa3); SBAR();                                                           \
        pv_tile<VB>(o, vb0, pa0, pa1, pa2, pa3, ACT((t) - 1)); MASKT(PX0, PX1, (t)); partialSM(PX0, PX1, m_reg, mnX, alX);    \
        __syncthreads();                                                                                                      \
        if ((t) + 1 < NT) { VMW(); SWRITE_H(SB); SBAR(); if ((t) + 2 < NT) { SLOAD_H(Kh, Vh, KBASE((t) + 2)); } SBAR(); }          \
        RESC(alX); __syncthreads(); } while (0)
    for (int t = 1; t + 1 < NT; t += 2) {
        HALF_STEP(pB0, pB1, mnB, alB, pA0, pA1, alA, t, 1, 0, 0);
        HALF_STEP(pA0, pA1, mnA, alA, pB0, pB1, alB, t + 1, 0, 1, 1);
    }
    SBAR(); qkt<1>(pB0, pB1, K_lds, krow, hi, S.qr, ACT(NT - 1)); SBAR();
    finishSM(pA0, pA1, alA, l_reg, pa0, pa1, pa2, pa3); SBAR();
    pv_tile<0>(o, vb0, pa0, pa1, pa2, pa3, ACT(NT - 2));
    MASKT(pB0, pB1, NT - 1); partialSM(pB0, pB1, m_reg, mnB, alB); __syncthreads(); RESC(alB);
    finishSM(pB0, pB1, alB, l_reg, pa0, pa1, pa2, pa3); SBAR(); pv_tile<1>(o, vb0, pa0, pa1, pa2, pa3, ACT(NT - 1));
    __syncthreads();
    float* mls = (float*)(lds + LDS_WS) + (rg + 4) * 64;
    float* osh = (float*)lds + (size_t)rg * 64 * 64;
    if (kh == 1) { if (hi == 0) { mls[r32] = m_reg; mls[32 + r32] = l_reg; }
#pragma unroll
        for (int d0 = 0; d0 < 4; ++d0)
#pragma unroll
            for (int r = 0; r < 16; ++r) osh[(d0 * 16 + r) * 64 + lane] = o[d0][r]; }
    __syncthreads();
    if (kh == 0) {
        const float m1 = mls[r32], l1 = mls[32 + r32]; const float mm = fmaxf(m_reg, m1); const float a0 = __builtin_amdgcn_exp2f(m_reg - mm), a1 = __builtin_amdgcn_exp2f(m1 - mm);
        const float il = __builtin_amdgcn_rcpf(l_reg * a0 + l1 * a1);
        if (hi == 0) { li_l[r32] = a0 * il; al_l[r32] = a1 * il; } asm volatile("s_waitcnt lgkmcnt(0)" ::: "memory");
        bf16_t* Ow = cur.O + (size_t)(rg * QBLK) * LD;
#pragma unroll
        for (int r = 0; r < 16; ++r) { const int orow = crow(r, hi); const float f0 = li_l[orow], f1 = al_l[orow];
#pragma unroll
            for (int d0 = 0; d0 < 4; ++d0) { const float v = o[d0][r] * f0 + osh[(d0 * 16 + r) * 64 + lane] * f1; const float vn = swz_xor<1>(v);
                if ((r32 & 1) == 0) *(unsigned*)(Ow + (size_t)orow * LD + d0 * 32 + r32) = cvt_pk_bf16(v, vn); } }
    }
#undef RESC
#undef KBASE
#undef ACT
#undef MASKT
#undef HALF_STEP
}
#undef ROW
#undef VMW
#undef SLOAD_H
#undef SWRITE_HK
#undef SWRITE_HV
#undef SWRITE_H
#undef KSWZ
#undef SBAR
}

constexpr int PH_PREP = 0, PH_IN1 = 1, PH_MIX1 = 2, PH_MIX2 = 3, PH_MIX3 = 4, PH_GATES = 5, PH_UPM = 6, PH_OUT = 7, PH_FFN = 8, PH_DOWN = 9, PH_PER_LAYER = 10;
#ifndef PROBE_K
#define PROBE_K -1
#define PROBE_L 0
#define PROBE_N 1
#define PROBE_SUB 15
#endif
struct Args { Inputs in; float* out; unsigned char* ws; int ph_lo, ph_hi, li, mixmask; };

__device__ __forceinline__ void fill_rstd(LAS float* tab, const float* rssp, int bx, int tid) {
#pragma unroll
    for (int j = 0; j < 4; ++j) { const int r = tid + 512 * j; const f32x4* p = (const f32x4*)(rssp + ((size_t)(bx & 7) * 2048 + r) * 16);
        const f32x4 a = p[0], b = p[1], c = p[2], d = p[3]; const f32x4 s = (a + b) + (c + d);
        tab[r] = rsqrtf(((s[0] + s[1]) + (s[2] + s[3])) * (1.f / D) + EPS); }
    __syncthreads();
}
__device__ __forceinline__ int fresh_tid(int wave0) { int ln; asm volatile("v_mbcnt_lo_u32_b32 %0, -1, 0\n\tv_mbcnt_hi_u32_b32 %0, -1, %0" : "=v"(ln)); return wave0 * 64 + ln; }
__global__ void __launch_bounds__(NWAVES * 64, 2) mega_fwd(Args args) {
    extern __shared__ __attribute__((aligned(16))) unsigned char lds[];
    LAS unsigned char* ldsp = (LAS unsigned char*)lds;
    volatile LAS unsigned* MISC = (volatile LAS unsigned*)(ldsp + MISC_OFF);
    const int tid = threadIdx.x; const int wave0 = __builtin_amdgcn_readfirstlane(tid >> 6);
    const int G = gridDim.x; const int bx = blockIdx.x; const int vcu = (G % 8 == 0) ? (bx % 8) * (G / 8) + bx / 8 : bx;
    unsigned char* ws = args.ws;
    float* out = args.out;
    for (int u = tid; u < (LDS_BYTES - LDSCTL_OFF) / 4; u += NWAVES * 64) ((LAS unsigned*)(ldsp + LDSCTL_OFF))[u] = 0u;
    __syncthreads();
    XcdBarrier bar = xcd_barrier_post((unsigned*)(ws + WS_CTL) + CW_BAR + args.li * XCD_BAR_WORDS, MISC + 8); bar.w0 = wave0;
    const int NGW = G * NWAVES;

    unsigned char* const ws0 = ws; float* const out0 = out; const int bx0 = bx;
    for (int ph = args.ph_lo; ph < args.ph_hi; ++ph) {
        const int l = ph / PH_PER_LAYER, k = ph % PH_PER_LAYER;
        size_t zoff = 0; int bx = bx0; asm volatile("" : "+s"(zoff), "+s"(bx)); unsigned char* ws = ws0 + zoff; float* out = out0 + zoff;
#define KARG(i) (*(const float* const __attribute__((address_space(4)))*)((const __attribute__((address_space(4))) char*)__builtin_amdgcn_kernarg_segment_ptr() + 8 * (i) + zoff))
#define LOAD_INPUTS(v) const __attribute__((address_space(4))) Inputs* v = (const __attribute__((address_space(4))) Inputs*)((const __attribute__((address_space(4))) char*)__builtin_amdgcn_kernarg_segment_ptr() + zoff)
        float* rssp = (float*)(ws + WS_RSSP);
        const int nrep = (k == PROBE_K && l == PROBE_L) ? PROBE_N : 1;
        for (int rep = 0; rep < nrep; ++rep) {
        const int mmask = rep == 0 ? args.mixmask : (args.mixmask & PROBE_SUB); const bool stf = (rep + 1 == nrep);
        if (k == PH_PREP) {
            const int tidl = fresh_tid(wave0), lane = tidl & 63, wave = wave0, gw = vcu * NWAVES + wave;
            LOAD_INPUTS(in);
            float* scr = (float*)(lds + wave * 16384);
            for (int it = gw; it < PREP_ITEMS; it += NGW) prep_item(in, l, ws + WS_W, it, scr, lane);
            if (l == 0) {
                for (int row = gw; row < M; row += NGW) {
                    const f32x4* xr = (const f32x4*)(in->x + (size_t)row * D) + lane; float s = 0.f;
                    unsigned long long* o8 = (unsigned long long*)((bf16_t*)(ws + WS_XB) + (size_t)row * D) + lane;
#pragma unroll
                    for (int j = 0; j < 4; ++j) { const f32x4 v = xr[64 * j]; s += (v.x * v.x + v.y * v.y) + (v.z * v.z + v.w * v.w);
                        o8[64 * j] = (unsigned long long)pk2(v.x, v.y) | ((unsigned long long)pk2(v.z, v.w) << 32); }
                    s = wave_sum_s(s); if (lane < 16) rssp[(size_t)row * 16 + lane] = (lane == 0) ? s : 0.f;
                }
            }
        } else if (k == PH_IN1) {
            const int tidl = fresh_tid(wave0);
            pg8::Gemm g{(const bf16_t*)(ws + WS_XB), (const bf16_t*)(ws + WS_W + W_IN), M, NIN1, D}; pg8::StaticOrder S; S.init(M, NIN1, G, bx);
            fill_rstd((LAS float*)(ldsp + RSTD_OFF), rssp, bx, tidl);
            pg8::EpiIn1 E{ws, (const LAS float*)(ldsp + RSTD_OFF), KARG(4) + l * 256};
            pg8::gemm_phase<pg8::EpiIn1, pg8::StaticOrder, true, true>(ldsp, g, S, E, tidl);
        } else if (k == PH_MIX1) {
            const int tidl = fresh_tid(wave0), lane = tidl & 63, wave = wave0;
            if (mmask & 2) for (int it = vcu; it < 256; it += G) mix::prepass_item(ws, KARG(8) + l * 128, KARG(9) + l * 128, it >> 5, (it >> 2) & 7, it & 3, (LAS float*)ldsp, tidl, lane, wave);
            if (mmask & 1) for (int it = vcu; it < 256; it += G) mix::pool_item(ws, KARG(7) + l * 512, it >> 2, it & 3, ldsp, tidl, lane, wave);
            if (mmask & 4) for (int it = vcu; it < 512; it += G) mix::gla_passA_pair(ws, it, ldsp, tidl, lane, wave);
        } else if (k == PH_MIX2) {
            const int tidl = fresh_tid(wave0);
            if (mmask & 4) for (int g0 = vcu * 512 + tidl; g0 < 32 * 4096; g0 += G * 512) mix::gla_scan(ws, g0);
            if (mmask & 8) for (int pr = vcu; pr < 256; pr += G) {
                const int bh = pr >> 3, b = bh >> 2, h = bh & 3, rh = pr & 1, a = (pr >> 1) & 3; const size_t r0 = (size_t)b * SEQ * 512 + h * 128;
#pragma unroll 1
                for (int half = 0; half < 2; ++half) { const int qb = half == 0 ? 7 - a : a; const size_t qoff = r0 + (size_t)(qb * 256 + rh * 128) * 512;
                    moba::BlockRef cur; cur.Q = (const bf16_t*)(ws + WS_MQ) + qoff; cur.O = (bf16_t*)(ws + (stf ? WS_YC : WS_US)) + qoff;
                    cur.K = (const bf16_t*)(ws + WS_MK) + r0; cur.V = (const bf16_t*)(ws + WS_MV) + r0; cur.km = (const float*)(ws + WS_KMEAN) + (size_t)bh * 8 * 128; cur.P0 = qb * 256 + rh * 128;
                    const int tl = fresh_tid(wave0);
                    moba::Seam S; moba::prime(cur, KARG(10), h, (char*)lds, S, tl); moba::block(cur, (char*)lds, S, tl); }
            }
        } else if (k == PH_MIX3) {
            const int tidl = fresh_tid(wave0), lane = tidl & 63, wave = wave0;
            if (mmask & 4) for (int it = vcu; it < 512; it += G) mix::gla_passC_pair(ws, KARG(5) + l * 128, it, ldsp, tidl, lane, wave, stf ? WS_YA : WS_US);
        } else if (k == PH_GATES) {
            const int tidl = fresh_tid(wave0);
            pg8::Gemm g{(const bf16_t*)(ws + WS_XB), (const bf16_t*)(ws + WS_W + W_IN) + (size_t)NIN1 * D, M, NGATE, D}; pg8::StaticOrder S; S.init(M, NGATE, G, bx);
            fill_rstd((LAS float*)(ldsp + RSTD_OFF), rssp, bx, tidl);
            pg8::EpiGates E{ws, (const LAS float*)(ldsp + RSTD_OFF)};
            pg8::gemm_phase<pg8::EpiGates, pg8::StaticOrder, true, true>(ldsp, g, S, E, tidl);
        } else if (k == PH_UPM) {
            const int tidl = fresh_tid(wave0);
            pg8::Gemm g{nullptr, nullptr, M, D, 512}; pg8::UpmOrder S; S.so.init(M, D, G, bx);
            S.Y0 = (const bf16_t*)(ws + WS_YA); S.Y1 = (const bf16_t*)(ws + WS_YB); S.Y2 = (const bf16_t*)(ws + WS_YC);
            S.W0 = (const bf16_t*)(ws + WS_W + W_UP); S.W1 = (const bf16_t*)(ws + WS_W + W_UP + MiB); S.W2 = (const bf16_t*)(ws + WS_W + W_UP + 2 * MiB);
            pg8::EpiUpm E{ws};
            pg8::gemm_phase<pg8::EpiUpm, pg8::UpmOrder, true, true>(ldsp, g, S, E, tidl);
        } else if (k == PH_OUT) {
            const int tidl = fresh_tid(wave0);
            pg8::Gemm g{(const bf16_t*)(ws + WS_MERGED), (const bf16_t*)(ws + WS_W + W_OUT), M, D, D}; pg8::StaticOrder S; S.init(M, D, G, bx);
            pg8::EpiRes E{l == 0 ? KARG(0) : out, out, (bf16_t*)(ws + WS_X1B), rssp, stf};
            pg8::gemm_phase<pg8::EpiRes, pg8::StaticOrder, false, true>(ldsp, g, S, E, tidl);
        } else if (k == PH_FFN) {
            const int tidl = fresh_tid(wave0);
            pg8::Gemm g{(const bf16_t*)(ws + WS_X1B), (const bf16_t*)(ws + WS_W + W_GU), M, NGU, D}; pg8::StaticOrder S; S.init(M, NGU, G, bx);
            fill_rstd((LAS float*)(ldsp + RSTD_OFF), rssp, bx, tidl);
            pg8::EpiFfn E{(bf16_t*)(ws + WS_H), (const LAS float*)(ldsp + RSTD_OFF)};
            pg8::gemm_phase<pg8::EpiFfn, pg8::StaticOrder, true, true>(ldsp, g, S, E, tidl);
        } else if (k == PH_DOWN) {
            const int tidl = fresh_tid(wave0);
            pg8::Gemm g{(const bf16_t*)(ws + WS_H), (const bf16_t*)(ws + WS_W + W_DN), M, D, FF}; pg8::StaticOrder S; S.init(M, D, G, bx);
            pg8::EpiRes E{out, out, (l + 1 < DEPTH) ? (bf16_t*)(ws + WS_XB) : nullptr, (l + 1 < DEPTH) ? rssp : nullptr, stf};
            pg8::gemm_phase<pg8::EpiRes, pg8::StaticOrder, false, true>(ldsp, g, S, E, tidl);
        }
        if (rep + 1 < nrep) xcd_barrier(bar);
        }
        if (ph + 1 < args.ph_hi) xcd_barrier(bar);
    }
}

#ifndef MIXMASK
#define MIXMASK 15
#endif
static void launch_mega(const Args& a0, int lo, int hi, int li, int grid, hipStream_t stream) {
    Args a = a0; a.ph_lo = lo; a.ph_hi = hi; a.li = li;
    hipLaunchKernelGGL(mega_fwd, dim3(grid), dim3(NWAVES * 64), LDS_BYTES, stream, a);
}
extern "C" void kernel_launch(void* const* d_in, const int* in_sizes, int n_in, void* d_out, int out_size, void* d_ws, size_t ws_size, hipStream_t stream) {
    static int grid = 0;
    if (grid == 0) {
        if (n_in != 19 || out_size != M * D || ws_size < WS_END2) { fprintf(stderr, "kernel_launch: unexpected shapes (n_in %d out %d ws %zu)\n", n_in, out_size, ws_size); grid = -1; return; }
        int dev = 0, cus = 0;
        if (hipGetDevice(&dev) != hipSuccess || hipDeviceGetAttribute(&cus, hipDeviceAttributeMultiprocessorCount, dev) != hipSuccess) { grid = -1; return; }
        if (hipFuncSetAttribute((const void*)mega_fwd, hipFuncAttributeMaxDynamicSharedMemorySize, LDS_BYTES) != hipSuccess) { fprintf(stderr, "kernel_launch: hipFuncSetAttribute failed\n"); grid = -1; return; }
        int per_cu = 0; (void)hipOccupancyMaxActiveBlocksPerMultiprocessor(&per_cu, (const void*)mega_fwd, NWAVES * 64, LDS_BYTES); (void)hipGetLastError();
        if (per_cu < 1) fprintf(stderr, "kernel_launch: occupancy query reports %d blocks per CU\n", per_cu);
        grid = cus;
    }
    if (grid < 0) return;
    (void)hipMemsetAsync((char*)d_ws + WS_CTL, 0, CTL_BYTES, stream);
    Args a{}; { const float** ap = (const float**)&a.in; for (int i = 0; i < 19; ++i) ap[i] = (const float*)d_in[i]; }
    a.out = (float*)d_out; a.ws = (unsigned char*)d_ws;
    a.mixmask = 15;
    launch_mega(a, 0, DEPTH * PH_PER_LAYER, 0, grid, stream);
}
```

```cpp
#include <hip/hip_runtime.h>
#include <cstdint>
#include <cstdio>

typedef unsigned short bf16_t;
typedef short bf16x8 __attribute__((ext_vector_type(8)));
typedef float f32x4 __attribute__((ext_vector_type(4)));

constexpr int BATCH = 8, SEQ = 2048, D = 1024, M = BATCH * SEQ, DEPTH = 2;
constexpr int IN_COLS = 6672, NIN1 = 3840, NGATE = 3072, NIN = NIN1 + NGATE;
constexpr int FF = 2816, NGU = 2 * FF;
constexpr int C_GLR = 1024;
constexpr float EPS = 1e-6f;
constexpr float LOG2E = 1.4426950408889634f;
constexpr float QSCALE = 0.08838834764831845f * LOG2E;

constexpr size_t MiB = 1u << 20;
constexpr size_t WS_CTL = 0, CTL_BYTES = 1 * MiB;
constexpr size_t WS_RSS = 1 * MiB;
constexpr size_t WS_KMEAN = 230 * MiB;
constexpr size_t WS_W = 2 * MiB;
constexpr size_t W_IN = 0, W_UP = 13 * MiB + 512 * 1024, W_OUT = W_UP + 3 * MiB, W_GU = W_OUT + 2 * MiB, W_DN = W_GU + 11 * MiB, W_PW = W_DN + 5 * MiB + 512 * 1024;
constexpr size_t WS_XB = 38 * MiB;
constexpr size_t WS_GQ = 70 * MiB, WS_GK = 78 * MiB, WS_GG = 86 * MiB;
constexpr size_t WS_GV = 102 * MiB, WS_PU = 118 * MiB;
constexpr size_t WS_MK = 134 * MiB, WS_MV = 150 * MiB;
constexpr size_t WS_SR = 166 * MiB, WS_MQ = 182 * MiB;
constexpr size_t WS_YB = 198 * MiB, WS_US = 214 * MiB;
constexpr size_t WS_SGA = 70 * MiB, WS_SGB = 102 * MiB, WS_SGC = 134 * MiB;
constexpr size_t WS_MERGED = WS_XB, WS_X1B = 70 * MiB, WS_H = 102 * MiB;
constexpr size_t WS_END = 231 * MiB;

__device__ __forceinline__ float bf2f(bf16_t h) { return __uint_as_float(((unsigned)h) << 16); }
__device__ __forceinline__ bf16_t f2bf(float f) { unsigned u = __float_as_uint(f); return (bf16_t)((u + 0x7fffu + ((u >> 16) & 1u)) >> 16); }
__device__ __forceinline__ unsigned pk2(float lo, float hi) { return (unsigned)f2bf(lo) | ((unsigned)f2bf(hi) << 16); }
__device__ __forceinline__ float wave_sum(float v) {
#pragma unroll
    for (int o = 1; o < 64; o <<= 1) v += __shfl_xor(v, o);
    return v;
}
__device__ __forceinline__ float wave_max(float v) {
#pragma unroll
    for (int o = 1; o < 64; o <<= 1) v = fmaxf(v, __shfl_xor(v, o));
    return v;
}
__device__ __forceinline__ float sigmoidf_(float x) { return 1.f / (1.f + __expf(-x)); }
__device__ __forceinline__ float siluf_(float x) { return x / (1.f + __expf(-x)); }
__device__ __forceinline__ float logsigmoidf_(float x) { return fminf(x, 0.f) - log1pf(__expf(-fabsf(x))); }

struct Inputs {
    const float *x, *norm1_w, *w_in, *wg2, *bg, *gla_nw, *pool_w, *pool_scale, *qn_w, *kn_w, *rel_bias, *w_up_a, *w_up_b, *w_up_c, *w_out, *norm2_w, *w_gate, *w_up, *w_down;
};

template <class F>
__device__ __forceinline__ void transpose_item(F src, int K, bf16_t* dst, int k0, int n0, float* scr, int lane) {
    float tv[32];
#pragma unroll
    for (int i = 0; i < 32; ++i) tv[i] = src(k0 + i, n0 + lane);
#pragma unroll
    for (int i = 0; i < 32; ++i) scr[i * 65 + lane] = tv[i];
    __builtin_amdgcn_s_waitcnt(0xc07f); asm volatile("" ::: "memory");
    const int c = lane & 3;
#pragma unroll
    for (int j = 0; j < 4; ++j) {
        const int n = (lane >> 2) + 16 * j; const float* s = scr + (8 * c) * 65 + n;
        uint4 o; o.x = pk2(s[0], s[65]); o.y = pk2(s[130], s[195]); o.z = pk2(s[260], s[325]); o.w = pk2(s[390], s[455]);
        *(uint4*)(dst + (size_t)(n0 + n) * K + k0 + 8 * c) = o;
    }
    __builtin_amdgcn_s_waitcnt(0xc07f); asm volatile("" ::: "memory");
}
constexpr int PI_IN = 32 * (NIN / 64), PI_UP = 16 * 16, PI_OUT = 32 * 16, PI_GU = 32 * (NGU / 64), PI_DN = 88 * 16, PI_PW = 4 * 2;
constexpr int PREP_ITEMS = PI_IN + 3 * PI_UP + PI_OUT + PI_GU + PI_DN + 4 * PI_PW;
template <class InP>
__device__ __forceinline__ void prep_item(InP inp, int l, unsigned char* wsw, int it, float* scr, int lane) {
    if (it < PI_IN) {
        const int nb = NIN / 64, kb = it / nb, n0 = 64 * (it % nb), k0 = 32 * kb;
        const float* w = inp->w_in + (size_t)l * D * IN_COLS; const float* nw = inp->norm1_w + l * D; bf16_t* dst = (bf16_t*)(wsw + W_IN);
        if (n0 >= 512 && n0 < 768) {
            const float* g2 = inp->wg2 + (size_t)l * 16 * 256 + (n0 - 512) + lane; float g2v[16];
#pragma unroll
            for (int r = 0; r < 16; ++r) g2v[r] = g2[r * 256];
            transpose_item([&](int k, int n) { const f32x4* wr = (const f32x4*)(w + (size_t)k * IN_COLS + C_GLR); float s = 0.f;
#pragma unroll
                for (int r4 = 0; r4 < 4; ++r4) { const f32x4 v = wr[r4]; s += v[0] * g2v[4 * r4] + v[1] * g2v[4 * r4 + 1] + v[2] * g2v[4 * r4 + 2] + v[3] * g2v[4 * r4 + 3]; }
                return s * nw[k]; }, D, dst, k0, n0, scr, lane);
        } else {
            const int off = n0 < 512 ? 0 : (n0 < 1280 ? -256 : -240);
            transpose_item([&](int k, int n) { return w[(size_t)k * IN_COLS + n + off] * nw[k]; }, D, dst, k0, n0, scr, lane);
        }
        return;
    }
    it -= PI_IN;
    if (it < 3 * PI_UP) {
        const int br = it / PI_UP; it %= PI_UP; const int kb = it / 16, n0 = 64 * (it % 16), k0 = 32 * kb;
        const float* w = (br == 0 ? inp->w_up_a : br == 1 ? inp->w_up_b : inp->w_up_c) + (size_t)l * 512 * D;
        transpose_item([&](int k, int n) { return w[(size_t)k * D + n]; }, 512, (bf16_t*)(wsw + W_UP + br * MiB), k0, n0, scr, lane);
        return;
    }
    it -= 3 * PI_UP;
    if (it < PI_OUT) {
        const int kb = it / 16, n0 = 64 * (it % 16), k0 = 32 * kb; const float* w = inp->w_out + (size_t)l * D * D;
        transpose_item([&](int k, int n) { return w[(size_t)k * D + n]; }, D, (bf16_t*)(wsw + W_OUT), k0, n0, scr, lane);
        return;
    }
    it -= PI_OUT;
    if (it < PI_GU) {
        const int nb = NGU / 64, kb = it / nb, n0 = 64 * (it % nb), k0 = 32 * kb;
        const int pn = n0 >> 8, i0 = n0 & 255; const float* w = ((i0 < 128) ? inp->w_gate : inp->w_up) + (size_t)l * D * FF; const float* nw = inp->norm2_w + l * D;
        const int coff = 128 * pn + (i0 & 127) - n0;
        transpose_item([&](int k, int n) { return w[(size_t)k * FF + n + coff] * nw[k]; }, D, (bf16_t*)(wsw + W_GU), k0, n0, scr, lane);
        return;
    }
    it -= PI_GU;
    if (it < PI_DN) {
        const int kb = it / 16, n0 = 64 * (it % 16), k0 = 32 * kb; const float* w = inp->w_down + (size_t)l * FF * D;
        transpose_item([&](int k, int n) { return w[(size_t)k * D + n]; }, FF, (bf16_t*)(wsw + W_DN), k0, n0, scr, lane);
        return;
    }
    it -= PI_DN;
    { const int g = it / PI_PW; it %= PI_PW; const int kb = it / 2, n0 = 64 * (it % 2), k0 = 32 * kb; const float* w = inp->pool_w + ((size_t)l * 4 + g) * 128 * 128;
      transpose_item([&](int k, int n) { return w[(size_t)k * 128 + n]; }, 128, (bf16_t*)(wsw + W_PW) + g * 128 * 128, k0, n0, scr, lane); }
}
__global__ void __launch_bounds__(256) k_prep(Inputs in, int l, unsigned char* ws) {
    __shared__ float scr[4][32 * 65];
    const int lane = threadIdx.x & 63, wave = threadIdx.x >> 6;
    for (int it = blockIdx.x * 4 + wave; it < PREP_ITEMS; it += gridDim.x * 4) prep_item(&in, l, ws + WS_W, it, scr[wave], lane);
}

__global__ void __launch_bounds__(256) k_rows(const float* src, bf16_t* dst, float* rss) {
    const int lane = threadIdx.x & 63, row = blockIdx.x * 4 + (threadIdx.x >> 6);
    const f32x4* xr = (const f32x4*)(src + (size_t)row * D) + lane; float s = 0.f;
    unsigned long long* o8 = (unsigned long long*)(dst + (size_t)row * D) + lane;
#pragma unroll
    for (int j = 0; j < 4; ++j) { const f32x4 v = xr[64 * j]; s += (v.x * v.x + v.y * v.y) + (v.z * v.z + v.w * v.w);
        o8[64 * j] = (unsigned long long)pk2(v.x, v.y) | ((unsigned long long)pk2(v.z, v.w) << 32); }
    s = wave_sum(s); if (lane == 0) rss[row] = s;
}

__device__ __forceinline__ void ngemm32(const bf16_t* A, int lda, const bf16_t* Bt, int ldb, int K, f32x4 (&acc)[2][2], int lane) {
    const int r = lane & 15, q = lane >> 4;
    for (int k0 = 0; k0 < K; k0 += 32) {
        bf16x8 a[2], b[2];
#pragma unroll
        for (int i = 0; i < 2; ++i) { a[i] = *(const bf16x8*)(A + (size_t)(i * 16 + r) * lda + k0 + 8 * q); b[i] = *(const bf16x8*)(Bt + (size_t)(i * 16 + r) * ldb + k0 + 8 * q); }
#pragma unroll
        for (int i = 0; i < 2; ++i)
#pragma unroll
            for (int j = 0; j < 2; ++j) acc[i][j] = __builtin_amdgcn_mfma_f32_16x16x32_bf16(a[i], b[j], acc[i][j], 0, 0, 0);
    }
}
#define NG_PRE const int lane = threadIdx.x & 63, wave = threadIdx.x >> 6; const int row0 = blockIdx.y * 64 + (wave >> 1) * 32, col0 = blockIdx.x * 64 + (wave & 1) * 32; \
    f32x4 acc[2][2]; for (int i = 0; i < 2; ++i) for (int j = 0; j < 2; ++j) acc[i][j] = (f32x4){0.f, 0.f, 0.f, 0.f};
#define NG_FOR for (int i = 0; i < 2; ++i) for (int j = 0; j < 2; ++j) for (int rg = 0; rg < 4; ++rg) { const int row = row0 + i * 16 + (lane >> 4) * 4 + rg, col = col0 + j * 16 + (lane & 15);

__global__ void __launch_bounds__(256) k_inproj1(unsigned char* ws, const float* bg) {
    NG_PRE
    ngemm32((const bf16_t*)(ws + WS_XB) + (size_t)row0 * D, D, (const bf16_t*)(ws + WS_W + W_IN) + (size_t)col0 * D, D, D, acc, lane);
    const float* rss = (const float*)(ws + WS_RSS);
    NG_FOR
        const float v = acc[i][j][rg] * rsqrtf(rss[row] * (1.f / D) + EPS);
        const int t = col >> 8, c = col & 255;
        if (t == 0) ((bf16_t*)(ws + WS_GQ))[(size_t)row * 256 + c] = f2bf(v * 0.125f);
        else if (t == 1) ((bf16_t*)(ws + WS_GK))[(size_t)row * 256 + c] = f2bf(v);
        else if (t == 2) ((float*)(ws + WS_GG))[(size_t)row * 256 + c] = logsigmoidf_(v + bg[c]) * (1.f / 16.f);
        else if (t < 5) ((bf16_t*)(ws + WS_GV))[(size_t)row * 512 + (col - 768)] = f2bf(v);
        else if (t < 7) ((bf16_t*)(ws + WS_SR))[(size_t)row * 512 + (col - 1280)] = f2bf(siluf_(v));
        else if (t < 9) ((bf16_t*)(ws + WS_PU))[(size_t)row * 512 + (col - 1792)] = f2bf(v);
        else if (t < 11) ((bf16_t*)(ws + WS_MQ))[(size_t)row * 512 + (col - 2304)] = f2bf(v);
        else if (t < 13) ((bf16_t*)(ws + WS_MK))[(size_t)row * 512 + (col - 2816)] = f2bf(v);
        else ((bf16_t*)(ws + WS_MV))[(size_t)row * 512 + (col - 3328)] = f2bf(v);
    }
}
__global__ void __launch_bounds__(256) k_gates(unsigned char* ws) {
    NG_PRE
    ngemm32((const bf16_t*)(ws + WS_XB) + (size_t)row0 * D, D, (const bf16_t*)(ws + WS_W + W_IN) + (size_t)(NIN1 + col0) * D, D, D, acc, lane);
    const float* rss = (const float*)(ws + WS_RSS);
    NG_FOR
        const float v = acc[i][j][rg] * rsqrtf(rss[row] * (1.f / D) + EPS);
        const int br = col >> 10, c = col & 1023;
        ((bf16_t*)(ws + (br == 0 ? WS_SGA : br == 1 ? WS_SGB : WS_SGC)))[(size_t)row * D + c] = f2bf(sigmoidf_(v));
    }
}
__global__ void __launch_bounds__(256) k_upmerge(unsigned char* ws) {
    NG_PRE
    f32x4 tot[2][2]; for (int i = 0; i < 2; ++i) for (int j = 0; j < 2; ++j) tot[i][j] = (f32x4){0.f, 0.f, 0.f, 0.f};
    for (int br = 0; br < 3; ++br) {
        const bf16_t* Y = (const bf16_t*)(ws + (br == 0 ? WS_SR : br == 1 ? WS_YB : WS_MQ)); const bf16_t* G = (const bf16_t*)(ws + (br == 0 ? WS_SGA : br == 1 ? WS_SGB : WS_SGC));
        for (int i = 0; i < 2; ++i) for (int j = 0; j < 2; ++j) acc[i][j] = (f32x4){0.f, 0.f, 0.f, 0.f};
        ngemm32(Y + (size_t)row0 * 512, 512, (const bf16_t*)(ws + WS_W + W_UP + br * MiB) + (size_t)col0 * 512, 512, 512, acc, lane);
        NG_FOR tot[i][j][rg] += bf2f(G[(size_t)row * D + col]) * acc[i][j][rg]; }
    }
    NG_FOR ((bf16_t*)(ws + WS_MERGED))[(size_t)row * D + col] = f2bf(tot[i][j][rg]); }
}
__global__ void __launch_bounds__(256) k_resgemm(const bf16_t* A, const bf16_t* Bt, int K, const float* resid, float* xout) {
    NG_PRE
    ngemm32(A + (size_t)row0 * K, K, Bt + (size_t)col0 * K, K, K, acc, lane);
    NG_FOR xout[(size_t)row * D + col] = resid[(size_t)row * D + col] + acc[i][j][rg]; }
}
__global__ void __launch_bounds__(256) k_ffn(unsigned char* ws) {
    const int lane = threadIdx.x & 63, wave = threadIdx.x >> 6; const int row0 = blockIdx.y * 64 + (wave >> 1) * 32, j0 = blockIdx.x * 64 + (wave & 1) * 32;
    f32x4 ag[2][2], au[2][2]; for (int i = 0; i < 2; ++i) for (int j = 0; j < 2; ++j) { ag[i][j] = (f32x4){0.f, 0.f, 0.f, 0.f}; au[i][j] = ag[i][j]; }
    const int ng = 256 * (j0 >> 7) + (j0 & 127);
    const bf16_t* A = (const bf16_t*)(ws + WS_X1B) + (size_t)row0 * D; const bf16_t* W = (const bf16_t*)(ws + WS_W + W_GU);
    ngemm32(A, D, W + (size_t)ng * D, D, D, ag, lane);
    ngemm32(A, D, W + (size_t)(ng + 128) * D, D, D, au, lane);
    const float* rss = (const float*)(ws + WS_RSS);
    for (int i = 0; i < 2; ++i) for (int j = 0; j < 2; ++j) for (int rg = 0; rg < 4; ++rg) { const int row = row0 + i * 16 + (lane >> 4) * 4 + rg, col = j0 + j * 16 + (lane & 15);
        const float rs = rsqrtf(rss[row] * (1.f / D) + EPS);
        ((bf16_t*)(ws + WS_H))[(size_t)row * FF + col] = f2bf(siluf_(ag[i][j][rg] * rs) * (au[i][j][rg] * rs)); }
}

__global__ void __launch_bounds__(128) k_gla(unsigned char* ws, const float* nw) {
    const int e = threadIdx.x, b = blockIdx.x >> 2, h = blockIdx.x & 3, lane = e & 63, wave = e >> 6;
    const bf16_t* GQ = (const bf16_t*)(ws + WS_GQ); const bf16_t* GK = (const bf16_t*)(ws + WS_GK); const float* GG = (const float*)(ws + WS_GG);
    const bf16_t* GV = (const bf16_t*)(ws + WS_GV); bf16_t* YA = (bf16_t*)(ws + WS_SR);
    __shared__ float red[2][16]; __shared__ float osh[16][128];
    float S[64];
#pragma unroll
    for (int d = 0; d < 64; ++d) S[d] = 0.f;
    const float nwe = nw[e];
    for (int t0 = 0; t0 < SEQ; t0 += 16) {
#pragma unroll 1
        for (int tt = 0; tt < 16; ++tt) {
            const size_t row = (size_t)b * SEQ + t0 + tt;
            const bf16_t* q = GQ + row * 256 + h * 64; const bf16_t* k = GK + row * 256 + h * 64; const float* g = GG + row * 256 + h * 64;
            const float v = bf2f(GV[row * 512 + h * 128 + e]); float a = 0.f;
#pragma unroll
            for (int d = 0; d < 64; ++d) { S[d] = __expf(g[d]) * S[d] + bf2f(k[d]) * v; a += bf2f(q[d]) * S[d]; }
            osh[tt][e] = a;
            const float s = wave_sum(a * a); if (lane == 0) red[wave][tt] = s;
        }
        __syncthreads();
#pragma unroll 1
        for (int tt = 0; tt < 16; ++tt) { const float rstd = rsqrtf((red[0][tt] + red[1][tt]) * (1.f / 128.f) + EPS);
            const size_t idx = ((size_t)b * SEQ + t0 + tt) * 512 + h * 128 + e; YA[idx] = f2bf(osh[tt][e] * rstd * nwe * bf2f(YA[idx])); }
        __syncthreads();
    }
}

__global__ void __launch_bounds__(256) k_pool(unsigned char* ws, const float* pw, const float* pscale) {
    __shared__ float u[31][128]; __shared__ float p[16][128];
    const int g = blockIdx.x & 3, r0 = (blockIdx.x >> 2) * 16, t0 = r0 & (SEQ - 1), tid = threadIdx.x;
    const bf16_t* PU = (const bf16_t*)(ws + WS_PU);
    for (int x = tid; x < 31 * 128; x += 256) { const int i = x >> 7, c = x & 127, t = t0 - 15 + i; u[i][c] = t >= 0 ? bf2f(PU[(size_t)(r0 - 15 + i) * 512 + g * 128 + c]) : 0.f; }
    __syncthreads();
    const int w = 2 << g;
    for (int x = tid; x < 16 * 128; x += 256) { const int i = x >> 7, c = x & 127, t = t0 + i, cnt = min(t + 1, w); float s = 0.f;
        for (int j = 0; j < cnt; ++j) s += u[15 + i - j][c];
        p[i][c] = s / (float)cnt - u[15 + i][c]; }
    __syncthreads();
    for (int x = tid; x < 16 * 128; x += 256) { const int i = x >> 7, e = x & 127; float y = 0.f;
        for (int c = 0; c < 128; ++c) y += p[i][c] * pw[((size_t)g * 128 + c) * 128 + e];
        ((bf16_t*)(ws + WS_YB))[(size_t)(r0 + i) * 512 + g * 128 + e] = f2bf(y * pscale[g * 128 + e]); }
}

__global__ void __launch_bounds__(256) k_prepass(unsigned char* ws, const float* qw, const float* kw) {
    __shared__ float part[4][128];
    const int lane = threadIdx.x & 63, wave = threadIdx.x >> 6; const int h = blockIdx.x & 3, blk = (blockIdx.x >> 2) & 7, b = blockIdx.x >> 5;
    unsigned* MQ = (unsigned*)(ws + WS_MQ); unsigned* MK = (unsigned*)(ws + WS_MK);
    const float qw0 = qw[2 * lane] * QSCALE, qw1 = qw[2 * lane + 1] * QSCALE, kw0 = kw[2 * lane], kw1 = kw[2 * lane + 1];
    float c0 = 0.f, c1 = 0.f;
    for (int r = 0; r < 64; ++r) {
        const size_t idx = ((size_t)b * SEQ + blk * 256 + wave * 64 + r) * 256 + h * 64 + lane;
        { const unsigned v = MQ[idx]; const float a = __uint_as_float(v << 16), c = __uint_as_float(v & 0xffff0000u); const float rs = rsqrtf(wave_sum(a * a + c * c) * (1.f / 128.f) + EPS); MQ[idx] = pk2(a * rs * qw0, c * rs * qw1); }
        { const unsigned v = MK[idx]; const float a = __uint_as_float(v << 16), c = __uint_as_float(v & 0xffff0000u); const float rs = rsqrtf(wave_sum(a * a + c * c) * (1.f / 128.f) + EPS);
          const float k0 = a * rs * kw0, k1 = c * rs * kw1; c0 += k0; c1 += k1; MK[idx] = pk2(k0, k1); }
    }
    part[wave][2 * lane] = c0; part[wave][2 * lane + 1] = c1;
    __syncthreads();
    if (threadIdx.x < 128) ((float*)(ws + WS_KMEAN))[(((size_t)b * 4 + h) * 8 + blk) * 128 + threadIdx.x] = ((part[0][threadIdx.x] + part[1][threadIdx.x]) + (part[2][threadIdx.x] + part[3][threadIdx.x])) * (1.f / 256.f);
}

__global__ void __launch_bounds__(256) k_moba(unsigned char* ws, const float* rel_bias) {
    __shared__ float tab[4][132]; __shared__ float qs[4][128]; __shared__ float ps[4][1024];
    const int lane = threadIdx.x & 63, wave = threadIdx.x >> 6;
    const int gw = blockIdx.x * 4 + wave; const int t = gw & (SEQ - 1), h = (gw >> 11) & 3, b = gw >> 13;
    for (int x = threadIdx.x; x < 129; x += 256) { int bk = x; if (x >= 16) { bk = 16 + (int)(logf((float)x / 16.f) / 2.0794415416798357f * 16.f); if (bk > 31) bk = 31; } tab[0][x] = rel_bias[bk * 4 + h] * LOG2E; }
    __syncthreads();
    const size_t row = (size_t)b * SEQ + t; const int qblk = t >> 8;
    unsigned* QN = (unsigned*)(ws + WS_MQ); const bf16_t* KN = (const bf16_t*)(ws + WS_MK); const unsigned* MV = (const unsigned*)(ws + WS_MV);
    const unsigned qv = QN[row * 256 + h * 64 + lane]; const float q0 = __uint_as_float(qv << 16), q1 = __uint_as_float(qv & 0xffff0000u);
    qs[wave][2 * lane] = q0; qs[wave][2 * lane + 1] = q1;
    const float* km = (const float*)(ws + WS_KMEAN) + ((size_t)b * 4 + h) * 8 * 128;
    float sc[8];
#pragma unroll
    for (int n = 0; n < 8; ++n) sc[n] = (n < qblk) ? wave_sum(q0 * km[n * 128 + 2 * lane] + q1 * km[n * 128 + 2 * lane + 1]) : -INFINITY;
    int blks[4]; int nvalid = 0;
#pragma unroll
    for (int s = 0; s < 3; ++s) { float best = -INFINITY; int bi = -1;
#pragma unroll
        for (int n = 0; n < 8; ++n) if (sc[n] > best) { best = sc[n]; bi = n; }
        blks[s] = bi;
#pragma unroll
        for (int n = 0; n < 8; ++n) if (n == bi) sc[n] = -INFINITY; }
    blks[3] = qblk;
    __builtin_amdgcn_s_waitcnt(0xc07f);
    float lg[4][4]; float mx = -INFINITY;
#pragma unroll
    for (int s = 0; s < 4; ++s) {
        const int blk = blks[s];
#pragma unroll
        for (int i = 0; i < 4; ++i) {
            lg[s][i] = -INFINITY;
            if (blk >= 0) { const int j = lane + 64 * i, tk = blk * 256 + j, dist = t - tk;
                if (dist >= 0) { const bf16_t* kr = KN + ((size_t)b * SEQ + tk) * 512 + h * 128; float dsum = 0.f;
                    for (int c = 0; c < 16; ++c) { const bf16x8 kk = *(const bf16x8*)(kr + c * 8);
#pragma unroll
                        for (int x = 0; x < 8; ++x) dsum += bf2f((bf16_t)kk[x]) * qs[wave][c * 8 + x]; }
                    lg[s][i] = dsum + tab[0][dist > 128 ? 128 : dist]; mx = fmaxf(mx, lg[s][i]); } }
        }
    }
    mx = wave_max(mx); float sum = 0.f;
#pragma unroll
    for (int s = 0; s < 4; ++s)
#pragma unroll
        for (int i = 0; i < 4; ++i) { const float pp = exp2f(lg[s][i] - mx); sum += pp; ps[wave][s * 256 + lane + 64 * i] = pp; }
    sum = wave_sum(sum);
    __builtin_amdgcn_s_waitcnt(0xc07f);
    float o0 = 0.f, o1 = 0.f;
#pragma unroll
    for (int s = 0; s < 4; ++s) { const int blk = blks[s]; if (blk < 0) continue; const int jn = (s == 3) ? (t & 255) + 1 : 256;
        const unsigned* vr = MV + ((size_t)b * SEQ + blk * 256) * 256 + h * 64 + lane;
        for (int j = 0; j < jn; ++j) { const float pp = ps[wave][s * 256 + j]; const unsigned v = vr[(size_t)j * 256]; o0 += pp * __uint_as_float(v << 16); o1 += pp * __uint_as_float(v & 0xffff0000u); } }
    const float inv = 1.f / sum;
    QN[row * 256 + h * 64 + lane] = pk2(o0 * inv, o1 * inv);
}


template <int K> __device__ __forceinline__ float swz_xor(float v) { return __int_as_float(__builtin_amdgcn_ds_swizzle(__float_as_int(v), (K << 10) | 0x1f)); }
__device__ __forceinline__ float half_sum(float v) { auto rr = __builtin_amdgcn_permlane32_swap(__float_as_uint(v), __float_as_uint(v), false, false); return __uint_as_float(rr[0]) + __uint_as_float(rr[1]); }
__device__ __forceinline__ float wave_sum_s(float v) { v += swz_xor<1>(v); v += swz_xor<2>(v); v += swz_xor<4>(v); v += swz_xor<8>(v); v += swz_xor<16>(v); return half_sum(v); }
namespace pg8 {
#define PG8_LAS __attribute__((address_space(3)))
typedef unsigned u32x4 __attribute__((ext_vector_type(4)));
constexpr int BM = 256, BK = 64, HALF = 128, HTB = HALF * BK * 2, STAGE_BYTES = 8 * HTB, NXCD = 8, WGM = 8;
__host__ __device__ __forceinline__ int lds_byte(int r, int c) { const int st = (r >> 4) * 2 + (c >> 5), rr = r & 15, cc = c & 31, ob = rr * 64 + cc * 2; return st * 1024 + (ob ^ (((ob >> 9) & 1) << 5)); }
__host__ __device__ __forceinline__ void stage_rc(int b, int& R, int& C) { const int st = b / 1024, sb = b % 1024, swz = sb ^ (((sb >> 9) & 1) << 5); R = (st >> 1) * 16 + swz / 64; C = (st & 1) * 32 + (swz % 64) / 2; }
__host__ __device__ __forceinline__ int perm32(int rho) { const int n = rho >> 4, i = rho & 15; return 8 * (i >> 2) + 4 * n + (i & 3); }
struct Unit { int pm, pn, br; };
struct Gemm { const bf16_t* A; const bf16_t* Bt; int M, N, K; };
struct StaticOrder {
    int nM, nN, nwg, G, c;
    __device__ void init(int M_, int N_, int G_, int c_) { nM = M_ / BM; nN = N_ / BM; nwg = nM * nN; G = G_; c = c_; }
    __device__ bool next(int i, Unit& u) const {
        const long L = (long)i * G + c; if (L >= nwg) return false;
        int wgid = (int)L; { const int q = nwg / NXCD, r = nwg % NXCD, xcd = wgid % NXCD, off = wgid / NXCD; wgid = (xcd < r ? xcd * (q + 1) : r * (q + 1) + (xcd - r) * q) + off; }
        const int nig = WGM * nN, gid = wgid / nig, fm = gid * WGM, gsz = (nM - fm) < WGM ? (nM - fm) : WGM;
        u.pm = fm + ((wgid % nig) % gsz); u.pn = (wgid % nig) / gsz; u.br = 0; return true;
    }
    __device__ __forceinline__ const char* pa(const Unit& u, const Gemm& g) const { return (const char*)g.A + (size_t)u.pm * (size_t)(BM * 2) * g.K; }
    __device__ __forceinline__ const char* pb(const Unit& u, const Gemm& g) const { return (const char*)g.Bt + (size_t)u.pn * (size_t)(BM * 2) * g.K; }
    __device__ __forceinline__ void a_ready(const Unit&) const {}
    __device__ __forceinline__ void done(const Unit&) const {}
};
struct UpmOrder {
    StaticOrder so; const bf16_t *Y0, *Y1, *Y2, *W0, *W1, *W2;
    __device__ bool next(int i, Unit& u) const { if (i >= 3) return false; if (!so.next(0, u)) return false; u.br = i; return true; }
    __device__ __forceinline__ const char* pa(const Unit& u, const Gemm& g) const { const bf16_t* y = u.br == 0 ? Y0 : (u.br == 1 ? Y1 : Y2); return (const char*)y + (size_t)u.pm * (size_t)(BM * 2) * g.K; }
    __device__ __forceinline__ const char* pb(const Unit& u, const Gemm& g) const { const bf16_t* w = u.br == 0 ? W0 : (u.br == 1 ? W1 : W2); return (const char*)w + (size_t)u.pn * (size_t)(BM * 2) * g.K; }
    __device__ __forceinline__ void a_ready(const Unit&) const {}
    __device__ __forceinline__ void done(const Unit&) const {}
};
typedef float f32x2_t __attribute__((ext_vector_type(2))); typedef __bf16 bf16x2_t __attribute__((ext_vector_type(2)));
__device__ __forceinline__ unsigned cvt_pk_bf16(float lo, float hi) { const f32x2_t v = {lo, hi}; const bf16x2_t b = __builtin_convertvector(v, bf16x2_t); return __builtin_bit_cast(unsigned, b); }
__device__ __forceinline__ u32x4 pack8(const f32x4& a, const f32x4& b) { u32x4 w; w.x = cvt_pk_bf16(a[0], a[1]); w.y = cvt_pk_bf16(a[2], a[3]); w.z = cvt_pk_bf16(b[0], b[1]); w.w = cvt_pk_bf16(b[2], b[3]); return w; }
__device__ __forceinline__ void unpack8(const u32x4& w, f32x4& a, f32x4& b) {
    a[0] = __uint_as_float(w.x << 16); a[1] = __uint_as_float(w.x & 0xffff0000u); a[2] = __uint_as_float(w.y << 16); a[3] = __uint_as_float(w.y & 0xffff0000u);
    b[0] = __uint_as_float(w.z << 16); b[1] = __uint_as_float(w.z & 0xffff0000u); b[2] = __uint_as_float(w.w << 16); b[3] = __uint_as_float(w.w & 0xffff0000u);
}
__device__ __forceinline__ void row_rstd(const PG8_LAS float* tab, const Unit& u, int wr, int fr, float (&rs)[2][4]) {
#pragma unroll
    for (int ai = 0; ai < 2; ++ai)
#pragma unroll
        for (int m = 0; m < 4; ++m) rs[ai][m] = tab[(u.pm & 7) * BM + ai * HALF + wr * 64 + m * 16 + fr];
}
struct EpiIn1 {
    static constexpr bool PERM = true, AFTER_DRAIN = false;
    unsigned char* ws; const PG8_LAS float* rstab; const float* bg;
    __device__ __forceinline__ void operator()(const f32x4 (&acc)[2][2][4][2], const Unit& u, int wr, int wc, int fr, int fq) const {
        asm volatile("" : "+v"(fr), "+v"(fq));
        const int row0 = u.pm * BM + wr * 64 + fr, cw = wc * 32 + 8 * fq; const int pn = u.pn;
        float rs[2][4]; row_rstd(rstab, u, wr, fr, rs);
        if (pn == 2) {
            float* G = (float*)(ws + WS_GG); size_t zb = 0; asm volatile("" : "+s"(zb)); const float* bgl = bg + zb;
#pragma unroll
            for (int bj = 0; bj < 2; ++bj) { const int c = bj * HALF + cw; const f32x4 b0 = *(const f32x4*)(bgl + c), b1 = *(const f32x4*)(bgl + c + 4);
#pragma unroll
                for (int ai = 0; ai < 2; ++ai)
#pragma unroll
                    for (int m = 0; m < 4; ++m) { const float r = rs[ai][m]; f32x4 v0 = acc[ai][bj][m][0] * r + b0, v1 = acc[ai][bj][m][1] * r + b1;
#pragma unroll
                        for (int x = 0; x < 4; ++x) { v0[x] = (fminf(v0[x], 0.f) - __logf(1.f + __expf(-fabsf(v0[x])))) * 0.0625f; v1[x] = (fminf(v1[x], 0.f) - __logf(1.f + __expf(-fabsf(v1[x])))) * 0.0625f; }
                        float* p = G + (size_t)(row0 + ai * HALF + m * 16) * 256 + c; *(f32x4*)p = v0; *(f32x4*)(p + 4) = v1; asm volatile("" ::: "memory"); } }
            return;
        }
        bf16_t* base; int ldc, coff; float sc = 1.f; bool silu = false;
        if (pn == 0) { base = (bf16_t*)(ws + WS_GQ); ldc = 256; coff = 0; sc = 0.125f; }
        else if (pn == 1) { base = (bf16_t*)(ws + WS_GK); ldc = 256; coff = 0; }
        else { ldc = 512; const int k = (pn - 3) >> 1; coff = ((pn - 3) & 1) * 256; silu = (k == 1);
            base = (bf16_t*)(ws + (k == 0 ? WS_GV : k == 1 ? WS_SR : k == 2 ? WS_PU : k == 3 ? WS_MQ : k == 4 ? WS_MK : WS_MV)); }
#pragma unroll
        for (int ai = 0; ai < 2; ++ai)
#pragma unroll
            for (int m = 0; m < 4; ++m) { const float r = rs[ai][m] * sc; bf16_t* rowp = base + (size_t)(row0 + ai * HALF + m * 16) * ldc + coff + cw;
#pragma unroll
                for (int bj = 0; bj < 2; ++bj) { f32x4 v0 = acc[ai][bj][m][0] * r, v1 = acc[ai][bj][m][1] * r;
                    if (silu) {
#pragma unroll
                        for (int x = 0; x < 4; ++x) { v0[x] = siluf_(v0[x]); v1[x] = siluf_(v1[x]); } }
                    *(u32x4*)(rowp + bj * HALF) = pack8(v0, v1); } asm volatile("" ::: "memory"); }
    }
};
struct EpiGates {
    static constexpr bool PERM = true, AFTER_DRAIN = false;
    unsigned char* ws; const PG8_LAS float* rstab;
    __device__ __forceinline__ void operator()(const f32x4 (&acc)[2][2][4][2], const Unit& u, int wr, int wc, int fr, int fq) const {
        asm volatile("" : "+v"(fr), "+v"(fq));
        const int row0 = u.pm * BM + wr * 64 + fr, cw = wc * 32 + 8 * fq; const int br = u.pn >> 2;
        float rs[2][4]; row_rstd(rstab, u, wr, fr, rs);
        bf16_t* base = (bf16_t*)(ws + (br == 0 ? WS_SGA : br == 1 ? WS_SGB : WS_SGC)) + (u.pn & 3) * 256 + cw;
#pragma unroll
        for (int ai = 0; ai < 2; ++ai)
#pragma unroll
            for (int m = 0; m < 4; ++m) { const float r = rs[ai][m]; bf16_t* rowp = base + (size_t)(row0 + ai * HALF + m * 16) * D;
#pragma unroll
                for (int bj = 0; bj < 2; ++bj) { f32x4 v0 = acc[ai][bj][m][0] * r, v1 = acc[ai][bj][m][1] * r;
#pragma unroll
                    for (int x = 0; x < 4; ++x) { v0[x] = sigmoidf_(v0[x]); v1[x] = sigmoidf_(v1[x]); }
                    *(u32x4*)(rowp + bj * HALF) = pack8(v0, v1); } asm volatile("" ::: "memory"); }
    }
};
struct EpiUpm {
    static constexpr bool PERM = true, AFTER_DRAIN = false;
    unsigned char* ws;
    __device__ __forceinline__ void operator()(const f32x4 (&acc)[2][2][4][2], const Unit& u, int wr, int wc, int fr, int fq) const {
        asm volatile("" : "+v"(fr), "+v"(fq));
        const int row0 = u.pm * BM + wr * 64 + fr, col0 = u.pn * BM + wc * 32 + 8 * fq; const int br = u.br;
        const bf16_t* G = (const bf16_t*)(ws + (br == 0 ? WS_SGA : br == 1 ? WS_SGB : WS_SGC)); bf16_t* O = (bf16_t*)(ws + WS_MERGED);
#pragma unroll
        for (int ai = 0; ai < 2; ++ai)
#pragma unroll
            for (int m = 0; m < 4; ++m) { const size_t off = (size_t)(row0 + ai * HALF + m * 16) * D + col0;
#pragma unroll
                for (int bj = 0; bj < 2; ++bj) { f32x4 g0, g1; unpack8(*(const u32x4*)(G + off + bj * HALF), g0, g1);
                    f32x4 v0 = acc[ai][bj][m][0] * g0, v1 = acc[ai][bj][m][1] * g1;
                    if (br != 0) { f32x4 p0, p1; unpack8(*(const u32x4*)(O + off + bj * HALF), p0, p1); v0 += p0; v1 += p1; }
                    *(u32x4*)(O + off + bj * HALF) = pack8(v0, v1); } }
    }
};
template <int MODE> struct EpiRes {
    static constexpr bool PERM = true, AFTER_DRAIN = false;
    const float* resid; const bf16_t* resid_b; float* xout; bf16_t* xb; float* rssp; bool st;
    __device__ __forceinline__ void operator()(const f32x4 (&acc)[2][2][4][2], const Unit& u, int wr, int wc, int fr, int fq) const {
        asm volatile("" : "+v"(fr), "+v"(fq));
        const int row0 = u.pm * BM + wr * 64 + fr, col0 = u.pn * BM + wc * 32 + 8 * fq;
#pragma unroll
        for (int ai = 0; ai < 2; ++ai)
#pragma unroll
            for (int m = 0; m < 4; ++m) { const int row = row0 + ai * HALF + m * 16; const size_t off = (size_t)row * D + col0; float s = 0.f;
#pragma unroll
                for (int bj = 0; bj < 2; ++bj) { f32x4 r0, r1;
                    if (MODE == 0) { r0 = *(const f32x4*)(resid + off + bj * HALF); r1 = *(const f32x4*)(resid + off + bj * HALF + 4); }
                    else unpack8(*(const u32x4*)(resid_b + off + bj * HALF), r0, r1);
                    const f32x4 v0 = acc[ai][bj][m][0] + r0, v1 = acc[ai][bj][m][1] + r1;
                    if (MODE == 1 && st) { *(f32x4*)(xout + off + bj * HALF) = v0; *(f32x4*)(xout + off + bj * HALF + 4) = v1; }
                    if (xb && st) *(u32x4*)(xb + off + bj * HALF) = pack8(v0, v1);
                    s += ((v0[0] * v0[0] + v0[1] * v0[1]) + (v0[2] * v0[2] + v0[3] * v0[3])) + ((v1[0] * v1[0] + v1[1] * v1[1]) + (v1[2] * v1[2] + v1[3] * v1[3])); }
                s += swz_xor<16>(s); s = half_sum(s);
                if (fq == 0 && rssp && st) rssp[(size_t)row * 16 + u.pn * 4 + wc] = s; }
    }
};
struct EpiFfn {
    static constexpr bool PERM = true, AFTER_DRAIN = false;
    bf16_t* H; const PG8_LAS float* rstab;
    __device__ __forceinline__ void operator()(const f32x4 (&acc)[2][2][4][2], const Unit& u, int wr, int wc, int fr, int fq) const {
        asm volatile("" : "+v"(fr), "+v"(fq));
        const int row0 = u.pm * BM + wr * 64 + fr, col0 = u.pn * HALF + wc * 32 + 8 * fq;
        float rs[2][4]; row_rstd(rstab, u, wr, fr, rs);
#pragma unroll
        for (int ai = 0; ai < 2; ++ai)
#pragma unroll
            for (int m = 0; m < 4; ++m) { const float r = rs[ai][m]; f32x4 g0 = acc[ai][0][m][0] * r, g1 = acc[ai][0][m][1] * r; const f32x4 u0 = acc[ai][1][m][0] * r, u1 = acc[ai][1][m][1] * r;
#pragma unroll
                for (int x = 0; x < 4; ++x) { g0[x] = siluf_(g0[x]) * u0[x]; g1[x] = siluf_(g1[x]) * u1[x]; }
                *(u32x4*)(H + (size_t)(row0 + ai * HALF + m * 16) * FF + col0) = pack8(g0, g1); asm volatile("" ::: "memory"); }
    }
};
template <class Epi, class Sched, bool ALIGN_EPI = false, bool SP2 = false>
__device__ __forceinline__ void gemm_phase(PG8_LAS unsigned char* lds, const Gemm g, const Sched& S, const Epi& E, const int tid) {
    const int wid = __builtin_amdgcn_readfirstlane(tid >> 6), lane = tid & 63, wr = wid >> 2, wc = wid & 3, fr = lane & 15, fq = lane >> 4;
    const int K = g.K, nt = K / BK;
    unsigned voffA[2], voffB[2];
#pragma unroll
    for (int i = 0; i < 2; ++i) { int R, C; stage_rc(tid * 16 + i * 8192, R, C); const int Rb = Epi::PERM ? ((R & ~31) + perm32(R & 31)) : R;
        voffA[i] = (unsigned)(R * K + C) * 2u; voffB[i] = (unsigned)(Rb * K + C) * 2u; }
    const size_t kstep = (size_t)(BK * 2);
    const size_t hstep = (size_t)HALF * K * 2;
    const unsigned ldsw = (unsigned)wid * 1024u;
    const int aoff = lds_byte(wr * 64 + fr, fq * 8), boff = lds_byte(wc * 32 + fr, fq * 8);
#define PG8_SA(b, h) (((b) * 2 + (h)) * HTB)
#define PG8_SB(b, h) ((4 + (b) * 2 + (h)) * HTB)
#define PG8_STAGE(bufoff, gbase, voff) do { _Pragma("unroll") for (int _i = 0; _i < 2; ++_i) \
        __builtin_amdgcn_global_load_lds((const unsigned*)((const char*)(gbase) + (voff)[_i]), (PG8_LAS unsigned*)(lds + (bufoff) + ldsw + _i * 8192), 16, 0, 0); } while (0)
#define PG8_LDA(dst, b, h) do { _Pragma("unroll") for (int m = 0; m < 4; ++m) _Pragma("unroll") for (int k = 0; k < 2; ++k) dst[m][k] = *(const PG8_LAS bf16x8*)(lds + PG8_SA(b, h) + aoff + m * 2048 + k * 1024); } while (0)
#define PG8_LDB(dst, b, h) do { _Pragma("unroll") for (int n = 0; n < 2; ++n) _Pragma("unroll") for (int k = 0; k < 2; ++k) dst[n][k] = *(const PG8_LAS bf16x8*)(lds + PG8_SB(b, h) + boff + n * 2048 + k * 1024); } while (0)
#define PG8_MMA(ai, bj, At, Bt) do { __builtin_amdgcn_s_setprio(1); _Pragma("unroll") for (int m = 0; m < 4; ++m) _Pragma("unroll") for (int n = 0; n < 2; ++n) _Pragma("unroll") for (int k = 0; k < 2; ++k) \
        acc[ai][bj][m][n] = __builtin_amdgcn_mfma_f32_16x16x32_bf16(Bt[n][k], At[m][k], acc[ai][bj][m][n], 0, 0, 0); __builtin_amdgcn_s_setprio(0); } while (0)
#define PG8_WAIT_V(n) asm volatile("s_waitcnt vmcnt(" #n ")" ::: "memory")
#define PG8_WAIT_L(n) asm volatile("s_waitcnt lgkmcnt(" #n ")" ::: "memory")
#define PG8_BAR __builtin_amdgcn_s_barrier()
#define PG8_SCHED __builtin_amdgcn_sched_barrier(0)
    Unit cur, nxt; int ui = 0;
    if (!S.next(0, cur)) return;
    f32x4 acc[2][2][4][2];
#pragma unroll
    for (int a = 0; a < 2; ++a)
#pragma unroll
        for (int b = 0; b < 2; ++b)
#pragma unroll
            for (int m = 0; m < 4; ++m)
#pragma unroll
                for (int n = 0; n < 2; ++n) acc[a][b][m][n] = (f32x4){0.f, 0.f, 0.f, 0.f};
    bf16x8 At[4][2], B0[2][2], B1[2][2];
    const char* cA = S.pa(cur, g); const char* cB = S.pb(cur, g);
    S.a_ready(cur);
    if constexpr (SP2) {
        PG8_STAGE(PG8_SB(0, 0), cB, voffB); PG8_STAGE(PG8_SB(0, 1), cB + hstep, voffB); PG8_STAGE(PG8_SA(0, 0), cA, voffA); PG8_STAGE(PG8_SA(0, 1), cA + hstep, voffA);
        if (wr == 1) PG8_BAR;
        PG8_WAIT_V(2); PG8_BAR;
        PG8_STAGE(PG8_SB(1, 0), cB + kstep, voffB); PG8_STAGE(PG8_SA(1, 0), cA + kstep, voffA); PG8_STAGE(PG8_SB(1, 1), cB + hstep + kstep, voffB);
        PG8_WAIT_V(6); PG8_BAR;
    } else {
        PG8_STAGE(PG8_SB(0, 0), cB, voffB); PG8_STAGE(PG8_SA(0, 0), cA, voffA); PG8_STAGE(PG8_SB(0, 1), cB + hstep, voffB); PG8_STAGE(PG8_SA(0, 1), cA + hstep, voffA);
        if (wr == 1) PG8_BAR;
        PG8_WAIT_V(4); PG8_BAR;
        PG8_STAGE(PG8_SB(1, 0), cB + kstep, voffB); PG8_STAGE(PG8_SA(1, 0), cA + kstep, voffA); PG8_STAGE(PG8_SB(1, 1), cB + hstep + kstep, voffB);
        PG8_WAIT_V(6); PG8_BAR;
    }
    for (;;) {
        const bool has_next = S.next(ui + 1, nxt);
        const char* nA = has_next ? S.pa(nxt, g) : cA; const char* nB = has_next ? S.pb(nxt, g) : cB;
        for (int t = 0; t < nt; t += 2) {
            const bool last = (t == nt - 2);
            const char* a1 = cA + (size_t)(t + 1) * kstep;
            const char* a2 = last ? nA : cA + (size_t)(t + 2) * kstep; const char* b2 = last ? nB : cB + (size_t)(t + 2) * kstep;
            const char* a3 = a2 + kstep; const char* b3 = b2 + kstep;
            if (last && has_next) S.a_ready(nxt);
            if constexpr (SP2) {
            PG8_LDB(B0, 0, 0); PG8_LDB(B1, 0, 1); PG8_SCHED; PG8_LDA(At, 0, 0); PG8_STAGE(PG8_SA(1, 1), a1 + hstep, voffA);
            PG8_WAIT_V(8); PG8_WAIT_L(0); PG8_BAR; PG8_MMA(0, 0, At, B0); PG8_MMA(0, 1, At, B1); PG8_BAR; PG8_SCHED;
            PG8_LDA(At, 0, 1); PG8_STAGE(PG8_SB(0, 0), b2, voffB); PG8_STAGE(PG8_SB(0, 1), b2 + hstep, voffB); PG8_STAGE(PG8_SA(0, 0), a2, voffA);
            PG8_WAIT_V(8); PG8_WAIT_L(0); PG8_BAR; PG8_MMA(1, 0, At, B0); PG8_MMA(1, 1, At, B1); PG8_BAR; PG8_SCHED;
            PG8_LDB(B0, 1, 0); PG8_LDB(B1, 1, 1); PG8_SCHED; PG8_LDA(At, 1, 0); PG8_STAGE(PG8_SA(0, 1), a2 + hstep, voffA);
            PG8_WAIT_V(8); PG8_WAIT_L(0); PG8_BAR; PG8_MMA(0, 0, At, B0); PG8_MMA(0, 1, At, B1); PG8_BAR; PG8_SCHED;
            PG8_LDA(At, 1, 1); PG8_STAGE(PG8_SB(1, 0), b3, voffB); PG8_STAGE(PG8_SB(1, 1), b3 + hstep, voffB); PG8_STAGE(PG8_SA(1, 0), a3, voffA);
            PG8_WAIT_V(8); PG8_WAIT_L(0); PG8_BAR; PG8_MMA(1, 0, At, B0); PG8_MMA(1, 1, At, B1); PG8_BAR; PG8_SCHED;
            } else {
            PG8_LDB(B0, 0, 0); PG8_SCHED; PG8_LDA(At, 0, 0); PG8_STAGE(PG8_SA(1, 1), a1 + hstep, voffA);
            PG8_WAIT_L(8); PG8_BAR; PG8_WAIT_L(0); PG8_MMA(0, 0, At, B0); PG8_BAR; PG8_SCHED;
            PG8_LDB(B1, 0, 1); PG8_STAGE(PG8_SB(0, 0), b2, voffB);
            PG8_BAR; PG8_WAIT_L(0); PG8_MMA(0, 1, At, B1); PG8_BAR;
            PG8_LDA(At, 0, 1); PG8_STAGE(PG8_SA(0, 0), a2, voffA);
            PG8_BAR; PG8_WAIT_L(0); PG8_MMA(1, 0, At, B0); PG8_BAR; PG8_SCHED;
            PG8_STAGE(PG8_SB(0, 1), b2 + hstep, voffB);
            PG8_WAIT_V(6); PG8_BAR; PG8_MMA(1, 1, At, B1); PG8_BAR;
            PG8_LDB(B0, 1, 0); PG8_SCHED; PG8_LDA(At, 1, 0); PG8_STAGE(PG8_SA(0, 1), a2 + hstep, voffA);
            PG8_WAIT_L(8); PG8_BAR; PG8_WAIT_L(0); PG8_MMA(0, 0, At, B0); PG8_BAR; PG8_SCHED;
            PG8_LDB(B1, 1, 1); PG8_STAGE(PG8_SB(1, 0), b3, voffB);
            PG8_BAR; PG8_WAIT_L(0); PG8_MMA(0, 1, At, B1); PG8_BAR;
            PG8_LDA(At, 1, 1); PG8_STAGE(PG8_SA(1, 0), a3, voffA);
            PG8_BAR; PG8_WAIT_L(0); PG8_MMA(1, 0, At, B0); PG8_BAR; PG8_SCHED;
            PG8_STAGE(PG8_SB(1, 1), b3 + hstep, voffB);
            PG8_WAIT_V(6); PG8_BAR; PG8_MMA(1, 1, At, B1); PG8_BAR;
            }
        }
        if constexpr (ALIGN_EPI) { if (wr == 0) PG8_BAR; }
        if constexpr (!Epi::AFTER_DRAIN) { E(acc, cur, wr, wc, fr, fq); S.done(cur); }
        if (!has_next) break;
#pragma unroll
        for (int a = 0; a < 2; ++a)
#pragma unroll
            for (int b = 0; b < 2; ++b)
#pragma unroll
                for (int m = 0; m < 4; ++m)
#pragma unroll
                    for (int n = 0; n < 2; ++n) acc[a][b][m][n] = (f32x4){0.f, 0.f, 0.f, 0.f};
        cur = nxt; cA = nA; cB = nB; ++ui;
        if constexpr (ALIGN_EPI) { if (wr == 1) PG8_BAR; }
    }
    PG8_WAIT_V(0);
    if constexpr (!ALIGN_EPI) { if (wr == 0) PG8_BAR; }
    PG8_BAR;
    if constexpr (Epi::AFTER_DRAIN) { E.fused(acc, cur, wr, wc, fr, fq, lds, wid, lane); S.done(cur); }
#undef PG8_SA
#undef PG8_SB
#undef PG8_STAGE
#undef PG8_LDA
#undef PG8_LDB
#undef PG8_MMA
#undef PG8_WAIT_V
#undef PG8_WAIT_L
#undef PG8_BAR
#undef PG8_SCHED
}
}

constexpr int NWAVES = 8;
constexpr int RING_BYTES = 131072, LDSCTL_OFF = RING_BYTES, MISC_OFF = LDSCTL_OFF + 320, RSTD_OFF = RING_BYTES + 1024, LDS_BYTES = 147456;
constexpr int CW_BAR = 4096;
#define GAS __attribute__((address_space(1)))
#define LAS __attribute__((address_space(3)))
typedef GAS unsigned gu32;
#define RLX_AGENT __ATOMIC_RELAXED, __HIP_MEMORY_SCOPE_AGENT
#define XB_TMO      128
#define XB_XCNT(j)  (256  + 64 * (j))
#define XB_XSUB(j)  (1280 + 64 * (j))
#define XB_XGEN(j)  (2304 + 64 * (j))
#define XB_TOP      3328
#define XB_TOPGEN   3392
#define XCD_BAR_WORDS 3456
#define XB_SPIN_CAP (1u << 18)

__device__ __forceinline__ unsigned xb_ld(unsigned* p)              { return __hip_atomic_load(p, __ATOMIC_RELAXED, __HIP_MEMORY_SCOPE_AGENT); }
__device__ __forceinline__ unsigned xb_add(unsigned* p, unsigned v) { return __hip_atomic_fetch_add(p, v, __ATOMIC_RELAXED, __HIP_MEMORY_SCOPE_AGENT); }
__device__ __forceinline__ unsigned xb_xcc_id() { return (unsigned)__builtin_amdgcn_s_getreg((3 << 11) | 20) & 0xFu; }
#define XB_SPIN(cond, bar) do { unsigned _sp = 0; while (cond) { __builtin_amdgcn_s_sleep(1); \
    if ((++_sp & 255u) == 0u) { if (xb_ld(&(bar)[XB_TMO])) break; if (_sp > XB_SPIN_CAP) { atomicAdd(&(bar)[XB_TMO], 1u); break; } } } } while (0)

struct XcdBarrier {
    unsigned* bar; unsigned x; int w0;
    volatile LAS unsigned* st;
};

__device__ __forceinline__ XcdBarrier xcd_barrier_post(unsigned* bar, volatile LAS unsigned* st) {
    XcdBarrier b; b.bar = bar; b.x = xb_xcc_id(); b.st = st;
    if (threadIdx.x == 0) (void)xb_add(&bar[XB_XCNT(b.x)], 1u);
    return b;
}
__device__ __forceinline__ void xcd_barrier_complete(unsigned* bar, unsigned x, unsigned& nloc, unsigned& nx) {
    const unsigned G = gridDim.x * gridDim.y * gridDim.z;
    unsigned sum, cnt, mine, sp = 0u;
    for (;;) {
        sum = 0u; cnt = 0u; mine = 0u;
#pragma unroll
        for (unsigned j = 0; j < 16; ++j) { const unsigned c = xb_ld(&bar[XB_XCNT(j)]); sum += c; cnt += (c > 0u) ? 1u : 0u; mine = (j == x) ? c : mine; }
        if (sum == G) break;
        __builtin_amdgcn_s_sleep(1);
        if ((++sp & 255u) == 0u) { if (xb_ld(&bar[XB_TMO])) break; if (sp > XB_SPIN_CAP) { atomicAdd(&bar[XB_TMO], 1u); break; } }
    }
    nloc = mine > 0u ? mine : 1u; nx = cnt > 0u ? cnt : 1u;
}

__device__ __forceinline__ void xcd_barrier(const XcdBarrier& b) {
    asm volatile("s_waitcnt vmcnt(0)" ::: "memory");
    __syncthreads();
    int ln_; asm volatile("v_mbcnt_lo_u32_b32 %0, -1, 0\n\tv_mbcnt_hi_u32_b32 %0, -1, %0" : "=v"(ln_));
    if (b.w0 == 0 && ln_ == 0) {
        unsigned* bar = b.bar;
        __builtin_amdgcn_s_waitcnt(0);
        unsigned nloc = b.st[0], nx = b.st[1];
        if (nloc == 0u) { xcd_barrier_complete(bar, b.x, nloc, nx); b.st[0] = nloc; b.st[1] = nx; }
        const unsigned old = xb_add(&bar[XB_XSUB(b.x)], 1u);
        const unsigned gen = old / nloc;
        if (old + 1u == (gen + 1u) * nloc) {
            __builtin_amdgcn_fence(__ATOMIC_RELEASE, "agent");
            asm volatile("s_waitcnt vmcnt(0)" ::: "memory");
            const unsigned og = xb_add(&bar[XB_TOP], 1u);
            const unsigned tg = og / nx;
            if (og + 1u == (tg + 1u) * nx) xb_add(&bar[XB_TOPGEN], 1u);
            else XB_SPIN(xb_ld(&bar[XB_TOPGEN]) == tg, bar);
            __builtin_amdgcn_fence(__ATOMIC_ACQUIRE, "agent");
            xb_add(&bar[XB_XGEN(b.x)], 1u);
            asm volatile("s_waitcnt vmcnt(0)" ::: "memory");
        } else {
            XB_SPIN(xb_ld(&bar[XB_XGEN(b.x)]) == gen, bar);
            __builtin_amdgcn_fence(__ATOMIC_ACQUIRE, "agent");
            asm volatile("s_waitcnt vmcnt(0)" ::: "memory");
        }
    }
    __syncthreads();
}

constexpr size_t WS_RSSP = WS_RSS;
constexpr size_t WS_KMEAN2 = 230 * MiB;
constexpr size_t WS_DL = 230 * MiB + 256 * 1024;
constexpr size_t WS_YC = WS_MQ;
constexpr size_t WS_YA = WS_SR;
constexpr size_t WS_S2 = 232 * MiB;
constexpr size_t WS_END2 = 248 * MiB;


namespace mix {
typedef unsigned u32x4 __attribute__((ext_vector_type(4)));
typedef unsigned u32x2 __attribute__((ext_vector_type(2)));
#define MIX_LAS __attribute__((address_space(3)))
using pg8::pack8; using pg8::unpack8; using pg8::cvt_pk_bf16;
#define MIX_BAR() do { asm volatile("s_waitcnt vmcnt(0) lgkmcnt(0)" ::: "memory"); __builtin_amdgcn_s_barrier(); asm volatile("" ::: "memory"); } while (0)

__device__ __forceinline__ void prepass_item(unsigned char* ws, const float* qw, const float* kw, int b, int blk, int h, MIX_LAS float* part, int tid, int lane, int wave) {
    const int sub = lane >> 4, c8 = (lane & 15) * 8;
    f32x4 qw0 = *(const f32x4*)(qw + c8) * QSCALE, qw1 = *(const f32x4*)(qw + c8 + 4) * QSCALE; const f32x4 kw0 = *(const f32x4*)(kw + c8), kw1 = *(const f32x4*)(kw + c8 + 4);
    f32x4 cs0 = {0.f, 0.f, 0.f, 0.f}, cs1 = cs0;
    bf16_t* MQ = (bf16_t*)(ws + WS_MQ); bf16_t* MK = (bf16_t*)(ws + WS_MK);
#pragma unroll 4
    for (int it = 0; it < 8; ++it) {
        const size_t off = ((size_t)b * SEQ + blk * 256 + wave * 32 + it * 4 + sub) * 512 + h * 128 + c8;
        { f32x4 a, c; unpack8(*(const u32x4*)(MQ + off), a, c); float ss = ((a[0] * a[0] + a[1] * a[1]) + (a[2] * a[2] + a[3] * a[3])) + ((c[0] * c[0] + c[1] * c[1]) + (c[2] * c[2] + c[3] * c[3]));
          ss += swz_xor<1>(ss); ss += swz_xor<2>(ss); ss += swz_xor<4>(ss); ss += swz_xor<8>(ss); const float rs = rsqrtf(ss * (1.f / 128.f) + EPS);
          *(u32x4*)(MQ + off) = pack8(a * rs * qw0, c * rs * qw1); }
        { f32x4 a, c; unpack8(*(const u32x4*)(MK + off), a, c); float ss = ((a[0] * a[0] + a[1] * a[1]) + (a[2] * a[2] + a[3] * a[3])) + ((c[0] * c[0] + c[1] * c[1]) + (c[2] * c[2] + c[3] * c[3]));
          ss += swz_xor<1>(ss); ss += swz_xor<2>(ss); ss += swz_xor<4>(ss); ss += swz_xor<8>(ss); const float rs = rsqrtf(ss * (1.f / 128.f) + EPS);
          a = a * rs * kw0; c = c * rs * kw1; cs0 += a; cs1 += c; *(u32x4*)(MK + off) = pack8(a, c); }
    }
#pragma unroll
    for (int j = 0; j < 4; ++j) { cs0[j] += swz_xor<16>(cs0[j]); cs0[j] = half_sum(cs0[j]); cs1[j] += swz_xor<16>(cs1[j]); cs1[j] = half_sum(cs1[j]); }
    if (sub == 0) { *(MIX_LAS f32x4*)(part + wave * 128 + c8) = cs0; *(MIX_LAS f32x4*)(part + wave * 128 + c8 + 4) = cs1; }
    MIX_BAR();
    if (tid < 128) { float s = 0.f;
#pragma unroll
        for (int w = 0; w < 8; ++w) s += part[w * 128 + tid];
        ((float*)(ws + WS_KMEAN))[(((size_t)b * 4 + h) * 8 + blk) * 128 + tid] = s * (1.f / 256.f); }
    MIX_BAR();
}

constexpr int PSTR = 272;
__device__ __forceinline__ void pool_item(unsigned char* ws, const float* pscale, int pm, int g, MIX_LAS unsigned char* lds, int tid, int lane, int wave) {
    MIX_LAS unsigned char* P = lds; MIX_LAS unsigned char* W = lds + 256 * PSTR;
    const bf16_t* PW = (const bf16_t*)(ws + WS_W + W_PW) + g * 128 * 128;
#pragma unroll
    for (int j = 0; j < 4; ++j) { const int id = tid + 512 * j, e = id >> 4, cc = id & 15; *(MIX_LAS u32x4*)(W + e * PSTR + cc * 16) = *(const u32x4*)(PW + e * 128 + cc * 8); }
    {
        const int cp = tid & 63, seg = tid >> 6, w = 2 << g; const int row0 = pm * 256 + seg * 32, t0 = row0 & (SEQ - 1);
        const unsigned* PU = (const unsigned*)(ws + WS_PU) + g * 64 + cp;
        float s0 = 0.f, s1 = 0.f;
        for (int j = 1; j < w; ++j) if (t0 - j >= 0) { const unsigned v = PU[(size_t)(row0 - j) * 256]; s0 += __uint_as_float(v << 16); s1 += __uint_as_float(v & 0xffff0000u); }
#pragma unroll 8
        for (int r = 0; r < 32; ++r) {
            const int t = t0 + r; const unsigned v = PU[(size_t)(row0 + r) * 256]; const float u0 = __uint_as_float(v << 16), u1 = __uint_as_float(v & 0xffff0000u);
            s0 += u0; s1 += u1; const float ic = 1.f / (float)min(t + 1, w);
            *(MIX_LAS unsigned*)(P + (seg * 32 + r) * PSTR + cp * 4) = cvt_pk_bf16(s0 * ic - u0, s1 * ic - u1);
            if (t - w + 1 >= 0) { const unsigned o = PU[(size_t)(row0 + r - w + 1) * 256]; s0 -= __uint_as_float(o << 16); s1 -= __uint_as_float(o & 0xffff0000u); }
        }
    }
    MIX_BAR();
    f32x4 acc[8][2];
#pragma unroll
    for (int n = 0; n < 8; ++n) { acc[n][0] = (f32x4){0.f, 0.f, 0.f, 0.f}; acc[n][1] = acc[n][0]; }
    const int r = lane & 15, q = lane >> 4;
#pragma unroll
    for (int kk = 0; kk < 4; ++kk) {
        bf16x8 pf[2];
#pragma unroll
        for (int m = 0; m < 2; ++m) pf[m] = *(const MIX_LAS bf16x8*)(P + (wave * 32 + m * 16 + r) * PSTR + (kk * 32 + 8 * q) * 2);
#pragma unroll
        for (int n = 0; n < 8; ++n) { const bf16x8 wf = *(const MIX_LAS bf16x8*)(W + (n * 16 + r) * PSTR + (kk * 32 + 8 * q) * 2);
#pragma unroll
            for (int m = 0; m < 2; ++m) acc[n][m] = __builtin_amdgcn_mfma_f32_16x16x32_bf16(wf, pf[m], acc[n][m], 0, 0, 0); }
    }
    bf16_t* YB = (bf16_t*)(ws + WS_YB);
#pragma unroll
    for (int n = 0; n < 8; ++n) { const f32x4 sc = *(const f32x4*)(pscale + g * 128 + n * 16 + 4 * q);
#pragma unroll
        for (int m = 0; m < 2; ++m) { const f32x4 y = acc[n][m] * sc; u32x2 o; o.x = cvt_pk_bf16(y[0], y[1]); o.y = cvt_pk_bf16(y[2], y[3]);
            *(u32x2*)(YB + (size_t)(pm * 256 + wave * 32 + m * 16 + r) * 512 + g * 128 + n * 16 + 4 * q) = o; } }
    MIX_BAR();
}

constexpr int GSTR = 144;
constexpr int GL_SEG = 0, GL_QE = 1024, GL_KE = GL_QE + 64 * GSTR, GL_VT = GL_KE + 64 * GSTR, GL_P = GL_VT + 128 * GSTR, GL_HALF = 49152;
__device__ __forceinline__ void gla_cumsum(const float* GG, size_t row0, int h, MIX_LAS unsigned char* lds, int d, int seg, float (&bc)[16], float& bL) {
    const float* g = GG + (row0 + seg * 16) * 256 + h * 64 + d; float c = 0.f;
#pragma unroll
    for (int j = 0; j < 16; ++j) { c += g[j * 256]; bc[j] = c; }
    MIX_LAS float* SEG = (MIX_LAS float*)(lds + GL_SEG); SEG[seg * 64 + d] = c;
    MIX_BAR();
    float off = 0.f, tot = 0.f;
#pragma unroll
    for (int s = 0; s < 4; ++s) { const float v = SEG[s * 64 + d]; tot += v; off += (s < seg) ? v : 0.f; }
#pragma unroll
    for (int j = 0; j < 16; ++j) bc[j] += off;
    bL = tot;
}
__device__ __forceinline__ void gla_vt(const bf16_t* GV, size_t row0, int h, MIX_LAS unsigned char* lds, int t8) {
    const int e = t8 & 127, tq = t8 >> 7; const bf16_t* v = GV + (row0 + tq * 32) * 512 + h * 128 + e; unsigned w[16];
#pragma unroll
    for (int j = 0; j < 16; ++j) w[j] = (unsigned)v[(2 * j) * 512] | ((unsigned)v[(2 * j + 1) * 512] << 16);
    MIX_LAS u32x4* p = (MIX_LAS u32x4*)(lds + GL_VT + e * GSTR + tq * 64);
#pragma unroll
    for (int j = 0; j < 4; ++j) p[j] = (u32x4){w[4 * j], w[4 * j + 1], w[4 * j + 2], w[4 * j + 3]};
}
__device__ __forceinline__ void gla_passA_pair(unsigned char* ws, int pair, MIX_LAS unsigned char* lds0, int tid, int lane, int wave) {
    const int hb = tid >> 8, t8 = tid & 255, w4 = wave & 3, cid = 2 * pair + hb; MIX_LAS unsigned char* lds = lds0 + hb * GL_HALF;
    const int d = t8 & 63, seg = t8 >> 6, bh = cid >> 5, n = cid & 31, b = bh >> 2, h = bh & 3; const size_t row0 = (size_t)b * SEQ + n * 64;
    float bc[16], bL;
    const bf16_t* gk = (const bf16_t*)(ws + WS_GK) + (row0 + seg * 16) * 256 + h * 64 + d; float kv[16];
#pragma unroll
    for (int j = 0; j < 16; ++j) kv[j] = bf2f(gk[j * 256]);
    gla_vt((const bf16_t*)(ws + WS_GV), row0, h, lds, t8);
    gla_cumsum((const float*)(ws + WS_GG), row0, h, lds, d, seg, bc, bL);
#pragma unroll
    for (int j8 = 0; j8 < 2; ++j8) { f32x4 a, c;
#pragma unroll
      for (int j = 0; j < 4; ++j) { a[j] = kv[8 * j8 + j] * __expf(bL - bc[8 * j8 + j]); c[j] = kv[8 * j8 + 4 + j] * __expf(bL - bc[8 * j8 + 4 + j]); }
      *(MIX_LAS u32x4*)(lds + GL_KE + d * GSTR + seg * 32 + j8 * 16) = pack8(a, c); }
    if (seg == 0) ((float*)(ws + WS_DL))[(size_t)cid * 64 + d] = __expf(bL);
    MIX_BAR();
    const int r = lane & 15, q = lane >> 4; f32x4 acc[2][4];
#pragma unroll
    for (int ee = 0; ee < 2; ++ee)
#pragma unroll
        for (int dt = 0; dt < 4; ++dt) acc[ee][dt] = (f32x4){0.f, 0.f, 0.f, 0.f};
#pragma unroll
    for (int kk = 0; kk < 2; ++kk) { bf16x8 kf[4];
#pragma unroll
        for (int dt = 0; dt < 4; ++dt) kf[dt] = *(const MIX_LAS bf16x8*)(lds + GL_KE + (dt * 16 + r) * GSTR + (kk * 32 + 8 * q) * 2);
#pragma unroll
        for (int ee = 0; ee < 2; ++ee) { const bf16x8 vf = *(const MIX_LAS bf16x8*)(lds + GL_VT + ((2 * w4 + ee) * 16 + r) * GSTR + (kk * 32 + 8 * q) * 2);
#pragma unroll
            for (int dt = 0; dt < 4; ++dt) acc[ee][dt] = __builtin_amdgcn_mfma_f32_16x16x32_bf16(kf[dt], vf, acc[ee][dt], 0, 0, 0); } }
#pragma unroll
    for (int ee = 0; ee < 2; ++ee) { bf16_t* US = (bf16_t*)(ws + WS_US) + ((size_t)cid * 128 + (2 * w4 + ee) * 16 + r) * 64;
#pragma unroll
        for (int dt = 0; dt < 4; ++dt) { u32x2 o; o.x = cvt_pk_bf16(acc[ee][dt][0], acc[ee][dt][1]); o.y = cvt_pk_bf16(acc[ee][dt][2], acc[ee][dt][3]); *(u32x2*)(US + dt * 16 + 4 * q) = o; } }
    MIX_BAR();
}
__device__ __forceinline__ void gla_scan(unsigned char* ws, int gtid) {
    const int bh = gtid >> 12, e = (gtid >> 5) & 127, dp = gtid & 31;
    const size_t uoff = (((size_t)bh * 32) * 128 + e) * 32 + dp; const unsigned* US = (const unsigned*)(ws + WS_US) + uoff; unsigned* S2 = (unsigned*)(ws + WS_S2) + uoff; const float* DLp = (const float*)(ws + WS_DL) + (size_t)bh * 32 * 64 + 2 * dp;
    float s0 = 0.f, s1 = 0.f;
#pragma unroll 8
    for (int n = 0; n < 32; ++n) { const unsigned u = US[(size_t)n * 128 * 32]; const float d0 = DLp[n * 64], d1 = DLp[n * 64 + 1];
        S2[(size_t)n * 128 * 32] = cvt_pk_bf16(s0, s1);
        s0 = d0 * s0 + __uint_as_float(u << 16); s1 = d1 * s1 + __uint_as_float(u & 0xffff0000u); }
}
__device__ __forceinline__ void gla_passC_pair(unsigned char* ws, const float* nw, int pair, MIX_LAS unsigned char* lds0, int tid, int lane, int wave, size_t ya_off) {
    const int hb = tid >> 8, t8 = tid & 255, w4 = wave & 3, cid = 2 * pair + hb; MIX_LAS unsigned char* lds = lds0 + hb * GL_HALF;
    const int d = t8 & 63, seg = t8 >> 6, bh = cid >> 5, n = cid & 31, b = bh >> 2, h = bh & 3; const size_t row0 = (size_t)b * SEQ + n * 64;
    const int r = lane & 15, q = lane >> 4, it = w4;
    const size_t yoff = (row0 + it * 16 + r) * 512 + h * 128 + 4 * q; u32x2 srv[8];
#pragma unroll
    for (int et = 0; et < 8; ++et) srv[et] = *(const u32x2*)((const bf16_t*)(ws + WS_SR) + yoff + et * 16);
    bf16x8 sfr[8][2]; { const bf16_t* ST = (const bf16_t*)(ws + WS_S2) + (size_t)cid * 128 * 64;
#pragma unroll
        for (int et = 0; et < 8; ++et)
#pragma unroll
            for (int kk = 0; kk < 2; ++kk) sfr[et][kk] = *(const bf16x8*)(ST + (et * 16 + r) * 64 + kk * 32 + 8 * q); }
    float bc[16], bL;
    {
        const bf16_t* gk = (const bf16_t*)(ws + WS_GK) + (row0 + seg * 16) * 256 + h * 64 + d; const bf16_t* gq = (const bf16_t*)(ws + WS_GQ) + (row0 + seg * 16) * 256 + h * 64 + d; float kv[16], qv[16];
#pragma unroll
        for (int j = 0; j < 16; ++j) { kv[j] = bf2f(gk[j * 256]); qv[j] = bf2f(gq[j * 256]); }
        gla_vt((const bf16_t*)(ws + WS_GV), row0, h, lds, t8);
        gla_cumsum((const float*)(ws + WS_GG), row0, h, lds, d, seg, bc, bL);
#pragma unroll
        for (int j = 0; j < 16; ++j) { const float ex = __expf(bc[j]);
            *(MIX_LAS bf16_t*)(lds + GL_QE + (seg * 16 + j) * GSTR + 2 * d) = f2bf(qv[j] * ex);
            *(MIX_LAS bf16_t*)(lds + GL_KE + (seg * 16 + j) * GSTR + 2 * d) = f2bf(kv[j] * __expf(-bc[j])); }
    }
    MIX_BAR();
    bf16x8 qf[2];
#pragma unroll
    for (int kk = 0; kk < 2; ++kk) qf[kk] = *(const MIX_LAS bf16x8*)(lds + GL_QE + (it * 16 + r) * GSTR + (kk * 32 + 8 * q) * 2);
#pragma unroll
    for (int jt = 0; jt < 4; ++jt) { f32x4 acc = {0.f, 0.f, 0.f, 0.f};
        if (jt <= it) {
#pragma unroll
            for (int kk = 0; kk < 2; ++kk) { const bf16x8 kf = *(const MIX_LAS bf16x8*)(lds + GL_KE + (jt * 16 + r) * GSTR + (kk * 32 + 8 * q) * 2);
                acc = __builtin_amdgcn_mfma_f32_16x16x32_bf16(qf[kk], kf, acc, 0, 0, 0); }
            if (jt == it) {
#pragma unroll
                for (int x = 0; x < 4; ++x) if (r > 4 * q + x) acc[x] = 0.f; } }
#pragma unroll
        for (int x = 0; x < 4; ++x) *(MIX_LAS bf16_t*)(lds + GL_P + (it * 16 + 4 * q + x) * GSTR + (jt * 16 + r) * 2) = f2bf(acc[x]); }
    asm volatile("s_waitcnt lgkmcnt(0)" ::: "memory");
    bf16x8 pf[2];
#pragma unroll
    for (int kk = 0; kk < 2; ++kk) pf[kk] = *(const MIX_LAS bf16x8*)(lds + GL_P + (it * 16 + r) * GSTR + (kk * 32 + 8 * q) * 2);
    f32x4 acc[8]; float ss = 0.f;
#pragma unroll
    for (int et = 0; et < 8; ++et) { acc[et] = (f32x4){0.f, 0.f, 0.f, 0.f};
#pragma unroll
        for (int kk = 0; kk < 2; ++kk) { const bf16x8 vf = *(const MIX_LAS bf16x8*)(lds + GL_VT + (et * 16 + r) * GSTR + (kk * 32 + 8 * q) * 2);
            const bf16x8 sf = sfr[et][kk];
            acc[et] = __builtin_amdgcn_mfma_f32_16x16x32_bf16(vf, pf[kk], acc[et], 0, 0, 0);
            acc[et] = __builtin_amdgcn_mfma_f32_16x16x32_bf16(sf, qf[kk], acc[et], 0, 0, 0); } }
#pragma unroll
    for (int et = 0; et < 8; ++et) ss += (acc[et][0] * acc[et][0] + acc[et][1] * acc[et][1]) + (acc[et][2] * acc[et][2] + acc[et][3] * acc[et][3]);
    ss += swz_xor<16>(ss); ss = half_sum(ss);
    const float rstd = rsqrtf(ss * (1.f / 128.f) + EPS);
    bf16_t* YA = (bf16_t*)(ws + ya_off) + yoff;
#pragma unroll
    for (int et = 0; et < 8; ++et) { const u32x2 sr = srv[et]; const f32x4 w4v = *(const f32x4*)(nw + et * 16 + 4 * q);
        const float y0 = acc[et][0] * rstd * w4v[0] * __uint_as_float(sr.x << 16), y1 = acc[et][1] * rstd * w4v[1] * __uint_as_float(sr.x & 0xffff0000u);
        const float y2 = acc[et][2] * rstd * w4v[2] * __uint_as_float(sr.y << 16), y3 = acc[et][3] * rstd * w4v[3] * __uint_as_float(sr.y & 0xffff0000u);
        u32x2 o; o.x = cvt_pk_bf16(y0, y1); o.y = cvt_pk_bf16(y2, y3); *(u32x2*)(YA + et * 16) = o; }
    MIX_BAR();
}
}

namespace moba {
typedef short s16x4 __attribute__((ext_vector_type(4)));
typedef float f32x16 __attribute__((ext_vector_type(16)));
typedef unsigned u32x4 __attribute__((ext_vector_type(4)));
using pg8::cvt_pk_bf16;
constexpr int D = 128, LD = 512, NW = 8, QBLK = 32, KVBLK = 128, QB = 256;
constexpr int SHM_V = KVBLK * D * 2, SHM_K = KVBLK * D * 2;
constexpr int LDS_WS = 131072 + 1024, LDS_TAB = LDS_WS + NW * 64 * 4, LDS_BYTES = LDS_TAB + 512;
constexpr float THR2 = 11.5f;
#define KSWZ(row, colB) ((row) * 256 + ((colB) ^ (((row) & 7) << 4)))
#define SBAR() __builtin_amdgcn_sched_barrier(0)
__device__ __forceinline__ int v_st(int k, int c) { const int kk = (k & ~0xC) | ((k & 4) << 1) | ((k & 8) >> 1); return ((kk >> 3) * 4 + (c >> 5)) * 512 + ((kk & 7) * 32 + (c & 31)) * 2; }
__device__ __forceinline__ int v_rd_base(int lane) { return ((lane & 3) << 3) | (((lane >> 2) & 3) << 6) | (((lane >> 4) & 1) << 5) | (((lane >> 5) & 1) << 8); }
constexpr int v_rd_off(int d0, int ks, int half) { return d0 * 512 + ks * 4096 + half * 2048; }
__device__ __forceinline__ int crow(int r, int hi) { return (r & 3) + 8 * (r >> 2) + 4 * hi; }
__device__ __forceinline__ bf16x8 load8(const bf16_t* p) { return *reinterpret_cast<const bf16x8*>(p); }

__device__ __forceinline__ void partialSM(f32x16& p0, f32x16& p1, float& m_reg, float& mn, float& alpha) {
    float pmax = p0[0];
#pragma unroll
    for (int r = 1; r < 16; ++r) pmax = fmaxf(pmax, p0[r]);
#pragma unroll
    for (int r = 0; r < 16; ++r) pmax = fmaxf(pmax, p1[r]);
    { auto rr = __builtin_amdgcn_permlane32_swap(__float_as_uint(pmax), __float_as_uint(pmax), false, false); pmax = fmaxf(__uint_as_float(rr[0]), __uint_as_float(rr[1])); }
    if (__builtin_expect(__all((pmax - m_reg) <= THR2), 1)) { mn = m_reg; alpha = 1.f; }
    else { mn = fmaxf(m_reg, pmax); alpha = __builtin_amdgcn_exp2f(m_reg - mn); m_reg = mn; }
#pragma unroll
    for (int r = 0; r < 16; ++r) p0[r] = p0[r] - mn;
#pragma unroll
    for (int r = 0; r < 16; ++r) p1[r] = p1[r] - mn;
#pragma unroll
    for (int r = 0; r < 16; ++r) p0[r] = __builtin_amdgcn_exp2f(p0[r]);
}
__device__ __forceinline__ void finishSM(f32x16& p0, f32x16& p1, float alpha, float& l_reg, bf16x8& pa0, bf16x8& pa1, bf16x8& pa2, bf16x8& pa3) {
#pragma unroll
    for (int r = 0; r < 16; ++r) p1[r] = __builtin_amdgcn_exp2f(p1[r]);
    float ps = 0;
#pragma unroll
    for (int r = 0; r < 16; ++r) ps += p0[r];
#pragma unroll
    for (int r = 0; r < 16; ++r) ps += p1[r];
    { auto rr = __builtin_amdgcn_permlane32_swap(__float_as_uint(ps), __float_as_uint(ps), false, false); ps = __uint_as_float(rr[0]) + __uint_as_float(rr[1]); }
    l_reg = l_reg * alpha + ps;
#define PK4(P, B_, OUT) do { unsigned a0 = cvt_pk_bf16(P[B_+0], P[B_+1]), a1 = cvt_pk_bf16(P[B_+2], P[B_+3]);                          \
        unsigned b0 = cvt_pk_bf16(P[B_+4], P[B_+5]), b1 = cvt_pk_bf16(P[B_+6], P[B_+7]);                                             \
        auto r0 = __builtin_amdgcn_permlane32_swap(a0, b0, false, false); auto r1 = __builtin_amdgcn_permlane32_swap(a1, b1, false, false); \
        u32x4 w = {r0[0], r1[0], r0[1], r1[1]}; OUT = *reinterpret_cast<bf16x8*>(&w); } while (0)
    PK4(p0, 0, pa0); PK4(p0, 8, pa1); PK4(p1, 0, pa2); PK4(p1, 8, pa3);
#undef PK4
}
template <int KB>
__device__ __forceinline__ void qkt(f32x16& p0, f32x16& p1, const char* K_lds, int krow, int hi, const bf16x8* qr, bool act) {
    if (!act) { const float NEG = -__builtin_inff();
#pragma unroll
        for (int r = 0; r < 16; ++r) { p0[r] = NEG; p1[r] = NEG; } return; }
    p0 = f32x16{}; p1 = f32x16{};
    const char* kb[4];
#pragma unroll
    for (int dd = 0; dd < 4; ++dd) kb[dd] = K_lds + KB * SHM_K + KSWZ(krow, (dd * 16 + hi * 8) * 2);
#pragma unroll
    for (int d0 = 0; d0 < 8; ++d0) { const char* a = kb[d0 & 3] + (d0 >> 2) * 128;
        bf16x8 b0 = *reinterpret_cast<const bf16x8*>(a);
        bf16x8 b1 = *reinterpret_cast<const bf16x8*>(a + 32 * 256);
        p0 = __builtin_amdgcn_mfma_f32_32x32x16_bf16(b0, qr[d0], p0, 0, 0, 0);
        p1 = __builtin_amdgcn_mfma_f32_32x32x16_bf16(b1, qr[d0], p1, 0, 0, 0); }
}
template <int VB>
__device__ __forceinline__ void pv_tile(f32x16* o, int vb0, bf16x8 pa0, bf16x8 pa1, bf16x8 pa2, bf16x8 pa3, bool act) {
    if (!act) return;
#define TRRD(dst, off) asm volatile("ds_read_b64_tr_b16 %0, %1 offset:%2" : "=&v"(dst) : "v"(vb0), "i"(off) : "memory")
#define PV_D0(d0) do { s16x4 l0, l1, l2, l3, h0, h1, h2, h3; constexpr int b_ = VB * SHM_V + v_rd_off(d0, 0, 0); \
        TRRD(l0, b_); TRRD(h0, b_ + 2048); TRRD(l1, b_ + 4096); TRRD(h1, b_ + 6144); TRRD(l2, b_ + 8192); TRRD(h2, b_ + 10240); TRRD(l3, b_ + 12288); TRRD(h3, b_ + 14336); \
        asm volatile("s_waitcnt lgkmcnt(0)" ::: "memory"); SBAR();   \
        o[d0] = __builtin_amdgcn_mfma_f32_32x32x16_bf16(pa0, (bf16x8){l0[0], l0[1], l0[2], l0[3], h0[0], h0[1], h0[2], h0[3]}, o[d0], 0, 0, 0);   \
        o[d0] = __builtin_amdgcn_mfma_f32_32x32x16_bf16(pa1, (bf16x8){l1[0], l1[1], l1[2], l1[3], h1[0], h1[1], h1[2], h1[3]}, o[d0], 0, 0, 0);   \
        o[d0] = __builtin_amdgcn_mfma_f32_32x32x16_bf16(pa2, (bf16x8){l2[0], l2[1], l2[2], l2[3], h2[0], h2[1], h2[2], h2[3]}, o[d0], 0, 0, 0);   \
        o[d0] = __builtin_amdgcn_mfma_f32_32x32x16_bf16(pa3, (bf16x8){l3[0], l3[1], l3[2], l3[3], h3[0], h3[1], h3[2], h3[3]}, o[d0], 0, 0, 0); } while (0)
    PV_D0(0); PV_D0(1); PV_D0(2); PV_D0(3);
#undef PV_D0
#undef TRRD
}
__device__ __forceinline__ void mask_bias_tile(f32x16& p0, f32x16& p1, int dq, const float* tab) {
    const float NEG = -__builtin_inff();
#pragma unroll
    for (int r = 0; r < 16; ++r) { const int c = (r & 3) + 8 * (r >> 2); const int d0 = dq - c, d1 = dq - c - 32;
        p0[r] = d0 < 0 ? NEG : p0[r] + tab[d0 > 113 ? 113 : d0];
        p1[r] = d1 < 0 ? NEG : p1[r] + tab[d1 > 113 ? 113 : d1]; }
}
__device__ __forceinline__ void bias_tile(f32x16& p0, f32x16& p1, int dq, const float* tab) {
#pragma unroll
    for (int r = 0; r < 16; ++r) { const int c = (r & 3) + 8 * (r >> 2); const int d0 = dq - c, d1 = dq - c - 32;
        p0[r] += tab[d0 > 113 ? 113 : d0]; p1[r] += tab[d1 > 113 ? 113 : d1]; }
}
__device__ __forceinline__ void kill_tile(f32x16& p0, f32x16& p1, bool ok) {
    const float NEG = -__builtin_inff();
#pragma unroll
    for (int r = 0; r < 16; ++r) { p0[r] = ok ? p0[r] : NEG; p1[r] = ok ? p1[r] : NEG; }
}

struct BlockRef { const bf16_t* Q; const bf16_t* K; const bf16_t* V; bf16_t* O; const float* km; int P0; };
struct Seam { bf16x8 qr[8]; bf16x8 st_v0, st_v1, st_v2, st_v3, st_k0, st_k1, st_k2, st_k3; };
#define ROW(p, k0, rr) ((p) + (size_t)((k0) + (rr)) * LD + sc)
#define VMW() asm volatile("s_waitcnt vmcnt(0)" ::: "memory")
#define SLOAD_H(Kp, Vp, k0) do { S.st_v0 = load8(ROW(Vp, k0, sr)); S.st_v1 = load8(ROW(Vp, k0, 32 + sr)); S.st_v2 = load8(ROW(Vp, k0, 64 + sr)); S.st_v3 = load8(ROW(Vp, k0, 96 + sr)); \
                                 S.st_k0 = load8(ROW(Kp, k0, sr)); S.st_k1 = load8(ROW(Kp, k0, 32 + sr)); S.st_k2 = load8(ROW(Kp, k0, 64 + sr)); S.st_k3 = load8(ROW(Kp, k0, 96 + sr)); } while (0)
#define SWRITE_HK(bf) do { *(bf16x8*)(K_lds + (bf) * SHM_K + kws) = S.st_k0; *(bf16x8*)(K_lds + (bf) * SHM_K + kws + 32 * 256) = S.st_k1; *(bf16x8*)(K_lds + (bf) * SHM_K + kws + 64 * 256) = S.st_k2; *(bf16x8*)(K_lds + (bf) * SHM_K + kws + 96 * 256) = S.st_k3; } while (0)
#define SWRITE_HV(bf) do { *(bf16x8*)(V_lds + (bf) * SHM_V + vst0) = S.st_v0; *(bf16x8*)(V_lds + (bf) * SHM_V + vst1) = S.st_v1; *(bf16x8*)(V_lds + (bf) * SHM_V + 16384 + vst0) = S.st_v2; *(bf16x8*)(V_lds + (bf) * SHM_V + 16384 + vst1) = S.st_v3; } while (0)
#define SWRITE_H(bf) do { SWRITE_HV(bf); SWRITE_HK(bf); } while (0)
__device__ __forceinline__ void prime(const BlockRef& cur, const float* rel_bias, int h, char* lds, Seam& S, int tid) {
    const int wid = __builtin_amdgcn_readfirstlane(tid >> 6), lane = tid & 63, r32 = lane & 31, hi = lane >> 5, rg = wid & 3;
    const int sr = tid >> 4, sc = (tid & 15) * 8, kws = KSWZ(sr, sc * 2); char* K_lds = lds + 2 * SHM_V;
    __syncthreads();
    if (tid < 128) { int bk = tid; if (tid >= 16) { bk = 16 + (int)(__logf((float)tid * (1.f / 16.f)) * (16.f / 2.0794415416798357f)); bk = bk > 31 ? 31 : bk; }
        ((float*)(lds + LDS_TAB))[tid] = tid >= 113 ? 0.f : (rel_bias[bk * 4 + h] - rel_bias[31 * 4 + h]) * LOG2E; }
#pragma unroll
    for (int d0 = 0; d0 < 8; ++d0) S.qr[d0] = load8(cur.Q + (size_t)(rg * QBLK + r32) * LD + d0 * 16 + hi * 8);
    SLOAD_H(cur.K, cur.V, 0); VMW(); SWRITE_HK(0);
    __syncthreads();
}
__device__ __forceinline__ void block(const BlockRef& cur, char* lds, Seam& S, int tid) {
    const int wid = __builtin_amdgcn_readfirstlane(tid >> 6), lane = tid & 63, r32 = lane & 31, hi = lane >> 5, rg = wid & 3, kh = wid >> 2;
    const int qblk = cur.P0 >> 8, NT = 2 * qblk + 2;
    const int qlo = cur.P0 + rg * QBLK, qm = qlo + r32 - 4 * hi - 64 * kh;
    char* V_lds = lds; char* K_lds = lds + 2 * SHM_V;
    float* ws = (float*)(lds + LDS_WS) + wid * 64; float* li_l = ws, * al_l = ws + 32; const float* tab = (const float*)(lds + LDS_TAB);
    float m_reg = -1e30f, l_reg = 0; f32x16 o[4] = {};
    const int sr = tid >> 4, sc = (tid & 15) * 8, vst0 = v_st(sr, sc), vst1 = v_st(32 + sr, sc), kws = KSWZ(sr, sc * 2);
    const int vb0 = (int)(uintptr_t)V_lds + v_rd_base(lane) + kh * 16384, krow = r32 + 64 * kh;
    const bf16_t* Kh = cur.K; const bf16_t* Vh = cur.V;
    unsigned sel = (1u << qblk) - 1u;
    if (qblk > 3) {
        float s[7];
#pragma unroll
        for (int n = 0; n < 7; ++n) { s[n] = -__builtin_inff();
            if (n < qblk) { float a = 0.f; const float* kmn = cur.km + n * 128 + hi * 8;
#pragma unroll
                for (int d0 = 0; d0 < 8; ++d0) { const f32x4 k0 = *(const f32x4*)(kmn + d0 * 16), k1 = *(const f32x4*)(kmn + d0 * 16 + 4); const bf16x8 qv = S.qr[d0];
#pragma unroll
                    for (int j = 0; j < 4; ++j) { a += __uint_as_float(((unsigned)(unsigned short)qv[j]) << 16) * k0[j]; a += __uint_as_float(((unsigned)(unsigned short)qv[4 + j]) << 16) * k1[j]; } }
                s[n] = half_sum(a); } }
        sel = 0u;
#pragma unroll
        for (int c = 0; c < 3; ++c) { float best = -__builtin_inff(); int bi = 0;
#pragma unroll
            for (int n = 0; n < 7; ++n) if (s[n] > best) { best = s[n]; bi = n; }
            sel |= 1u << bi;
#pragma unroll
            for (int n = 0; n < 7; ++n) s[n] = (n == bi) ? -__builtin_inff() : s[n]; }
    }
#define RESC(a) do { if (__any((a) < 1.f)) { if (hi == 0) al_l[r32] = (a); asm volatile("s_waitcnt lgkmcnt(0)" ::: "memory");              \
                     for (int d_ = 0; d_ < 4; ++d_) for (int r = 0; r < 16; ++r) o[d_][r] *= al_l[crow(r, hi)]; } } while (0)
#define KBASE(t) ((t) * KVBLK)
#define ACT(t) ((KBASE(t) >> 8) < qblk ? (__any((sel >> (KBASE(t) >> 8)) & 1u) != 0) : (KBASE(t) + 64 * kh <= qlo + QBLK - 1))
#define MASKT(P0_, P1_, t) do { const int kb_ = KBASE(t); if (ACT(t)) { if ((kb_ >> 8) < qblk) { if (kb_ + 64 * kh + 176 > qlo) bias_tile(P0_, P1_, qm - kb_, tab); kill_tile(P0_, P1_, ((sel >> (kb_ >> 8)) & 1u) != 0u); } \
                                     else mask_bias_tile(P0_, P1_, qm - kb_, tab); } } while (0)
    f32x16 pA0, pA1, pB0, pB1; float mnA, mnB, alA, alB; bf16x8 pa0, pa1, pa2, pa3;
    SWRITE_HV(0); SBAR();
    SLOAD_H(Kh, Vh, KBASE(1));
    SBAR(); qkt<0>(pA0, pA1, K_lds, krow, hi, S.qr, ACT(0));
    MASKT(pA0, pA1, 0); partialSM(pA0, pA1, m_reg, mnA, alA);
    VMW(); SWRITE_H(1); SBAR(); if (2 < NT) { SLOAD_H(Kh, Vh, KBASE(2)); } SBAR();
    __syncthreads();
#define HALF_STEP(PX0, PX1, mnX, alX, PY0, PY1, alY, t, KB, VB, SB) do {                                                      \
        SBAR(); qkt<KB>(PX0, PX1, K_lds, krow, hi, S.qr, ACT(t));                                                          \
        finishSM(PY0, PY1, alY, l_reg, pa0, pa1, pa2, pa3); SBAR();                                                           \
        pv_tile<VB>(o, vb0, pa0, pa1, pa2, pa3, ACT((t) - 1)); MASKT(PX0, PX1, (t)); partialSM(PX0, PX1, m_reg, mnX, alX);    \
        __syncthreads();                                                                                                      \
        if ((t) + 1 < NT) { VMW(); SWRITE_H(SB); SBAR(); if ((t) + 2 < NT) { SLOAD_H(Kh, Vh, KBASE((t) + 2)); } SBAR(); }          \
        RESC(alX); __syncthreads(); } while (0)
    for (int t = 1; t + 1 < NT; t += 2) {
        HALF_STEP(pB0, pB1, mnB, alB, pA0, pA1, alA, t, 1, 0, 0);
        HALF_STEP(pA0, pA1, mnA, alA, pB0, pB1, alB, t + 1, 0, 1, 1);
    }
    SBAR(); qkt<1>(pB0, pB1, K_lds, krow, hi, S.qr, ACT(NT - 1)); SBAR();
    finishSM(pA0, pA1, alA, l_reg, pa0, pa1, pa2, pa3); SBAR();
    pv_tile<0>(o, vb0, pa0, pa1, pa2, pa3, ACT(NT - 2));
    MASKT(pB0, pB1, NT - 1); partialSM(pB0, pB1, m_reg, mnB, alB); __syncthreads(); RESC(alB);
    finishSM(pB0, pB1, alB, l_reg, pa0, pa1, pa2, pa3); SBAR(); pv_tile<1>(o, vb0, pa0, pa1, pa2, pa3, ACT(NT - 1));
    __syncthreads();
    float* mls = (float*)(lds + LDS_WS) + (rg + 4) * 64;
    float* osh = (float*)lds + (size_t)rg * 64 * 64;
    if (kh == 1) { if (hi == 0) { mls[r32] = m_reg; mls[32 + r32] = l_reg; }
#pragma unroll
        for (int d0 = 0; d0 < 4; ++d0)
#pragma unroll
            for (int r = 0; r < 16; ++r) osh[(d0 * 16 + r) * 64 + lane] = o[d0][r]; }
    __syncthreads();
    if (kh == 0) {
        const float m1 = mls[r32], l1 = mls[32 + r32]; const float mm = fmaxf(m_reg, m1); const float a0 = __builtin_amdgcn_exp2f(m_reg - mm), a1 = __builtin_amdgcn_exp2f(m1 - mm);
        const float il = __builtin_amdgcn_rcpf(l_reg * a0 + l1 * a1);
        if (hi == 0) { li_l[r32] = a0 * il; al_l[r32] = a1 * il; } asm volatile("s_waitcnt lgkmcnt(0)" ::: "memory");
        bf16_t* Ow = cur.O + (size_t)(rg * QBLK) * LD;
#pragma unroll
        for (int r = 0; r < 16; ++r) { const int orow = crow(r, hi); const float f0 = li_l[orow], f1 = al_l[orow];
#pragma unroll
            for (int d0 = 0; d0 < 4; ++d0) { const float v = o[d0][r] * f0 + osh[(d0 * 16 + r) * 64 + lane] * f1; const float vn = swz_xor<1>(v);
                if ((r32 & 1) == 0) *(unsigned*)(Ow + (size_t)orow * LD + d0 * 32 + r32) = cvt_pk_bf16(v, vn); } }
    }
#undef RESC
#undef KBASE
#undef ACT
#undef MASKT
#undef HALF_STEP
}
#undef ROW
#undef VMW
#undef SLOAD_H
#undef SWRITE_HK
#undef SWRITE_HV
#undef SWRITE_H
#undef KSWZ
#undef SBAR
}

constexpr int PH_PREP = 0, PH_IN1 = 1, PH_MIX1 = 2, PH_MIX2 = 3, PH_MIX3 = 4, PH_GATES = 5, PH_UPM = 6, PH_OUT = 7, PH_FFN = 8, PH_DOWN = 9, PH_PER_LAYER = 10;
#ifndef PROBE_K
#define PROBE_K -1
#define PROBE_L 0
#define PROBE_N 1
#define PROBE_SUB 15
#endif
struct Args { Inputs in; float* out; unsigned char* ws; int ph_lo, ph_hi, li, mixmask; };

__device__ __forceinline__ void fill_rstd(LAS float* tab, const float* rssp, int bx, int tid) {
#pragma unroll
    for (int j = 0; j < 4; ++j) { const int r = tid + 512 * j; const f32x4* p = (const f32x4*)(rssp + ((size_t)(bx & 7) * 2048 + r) * 16);
        const f32x4 a = p[0], b = p[1], c = p[2], d = p[3]; const f32x4 s = (a + b) + (c + d);
        tab[r] = rsqrtf(((s[0] + s[1]) + (s[2] + s[3])) * (1.f / D) + EPS); }
    __syncthreads();
}
__device__ __forceinline__ int fresh_tid(int wave0) { int ln; asm volatile("v_mbcnt_lo_u32_b32 %0, -1, 0\n\tv_mbcnt_hi_u32_b32 %0, -1, %0" : "=v"(ln)); return wave0 * 64 + ln; }
__global__ void __launch_bounds__(NWAVES * 64, 2) mega_fwd(Args args) {
    extern __shared__ __attribute__((aligned(16))) unsigned char lds[];
    LAS unsigned char* ldsp = (LAS unsigned char*)lds;
    volatile LAS unsigned* MISC = (volatile LAS unsigned*)(ldsp + MISC_OFF);
    const int tid = threadIdx.x; const int wave0 = __builtin_amdgcn_readfirstlane(tid >> 6);
    const int G = gridDim.x; const int bx = blockIdx.x; const int vcu = (G % 8 == 0) ? (bx % 8) * (G / 8) + bx / 8 : bx;
    unsigned char* ws = args.ws;
    float* out = args.out;
    for (int u = tid; u < (LDS_BYTES - LDSCTL_OFF) / 4; u += NWAVES * 64) ((LAS unsigned*)(ldsp + LDSCTL_OFF))[u] = 0u;
    __syncthreads();
    XcdBarrier bar = xcd_barrier_post((unsigned*)(ws + WS_CTL) + CW_BAR + args.li * XCD_BAR_WORDS, MISC + 8); bar.w0 = wave0;
    const int NGW = G * NWAVES;

    unsigned char* const ws0 = ws; float* const out0 = out; const int bx0 = bx;
    for (int ph = args.ph_lo; ph < args.ph_hi; ++ph) {
        const int l = ph / PH_PER_LAYER, k = ph % PH_PER_LAYER;
        size_t zoff = 0; int bx = bx0; asm volatile("" : "+s"(zoff), "+s"(bx)); unsigned char* ws = ws0 + zoff; float* out = out0 + zoff;
#define KARG(i) (*(const float* const __attribute__((address_space(4)))*)((const __attribute__((address_space(4))) char*)__builtin_amdgcn_kernarg_segment_ptr() + 8 * (i) + zoff))
#define LOAD_INPUTS(v) const __attribute__((address_space(4))) Inputs* v = (const __attribute__((address_space(4))) Inputs*)((const __attribute__((address_space(4))) char*)__builtin_amdgcn_kernarg_segment_ptr() + zoff)
        float* rssp = (float*)(ws + WS_RSSP);
        const int nrep = (k == PROBE_K && l == PROBE_L) ? PROBE_N : 1;
        for (int rep = 0; rep < nrep; ++rep) {
        const int mmask = rep == 0 ? args.mixmask : (args.mixmask & PROBE_SUB); const bool stf = (rep + 1 == nrep);
        if (k == PH_PREP) {
            const int tidl = fresh_tid(wave0), lane = tidl & 63, wave = wave0, gw = vcu * NWAVES + wave;
            LOAD_INPUTS(in);
            float* scr = (float*)(lds + wave * 16384);
            for (int it = gw; it < PREP_ITEMS; it += NGW) prep_item(in, l, ws + WS_W, it, scr, lane);
            if (l == 0) {
                for (int row = gw; row < M; row += NGW) {
                    const f32x4* xr = (const f32x4*)(in->x + (size_t)row * D) + lane; float s = 0.f;
                    unsigned long long* o8 = (unsigned long long*)((bf16_t*)(ws + WS_XB) + (size_t)row * D) + lane;
#pragma unroll
                    for (int j = 0; j < 4; ++j) { const f32x4 v = xr[64 * j]; s += (v.x * v.x + v.y * v.y) + (v.z * v.z + v.w * v.w);
                        o8[64 * j] = (unsigned long long)pk2(v.x, v.y) | ((unsigned long long)pk2(v.z, v.w) << 32); }
                    s = wave_sum_s(s); if (lane < 16) rssp[(size_t)row * 16 + lane] = (lane == 0) ? s : 0.f;
                }
            }
        } else if (k == PH_IN1) {
            const int tidl = fresh_tid(wave0);
            pg8::Gemm g{(const bf16_t*)(ws + WS_XB), (const bf16_t*)(ws + WS_W + W_IN), M, NIN1, D}; pg8::StaticOrder S; S.init(M, NIN1, G, bx);
            fill_rstd((LAS float*)(ldsp + RSTD_OFF), rssp, bx, tidl);
            pg8::EpiIn1 E{ws, (const LAS float*)(ldsp + RSTD_OFF), KARG(4) + l * 256};
            pg8::gemm_phase<pg8::EpiIn1, pg8::StaticOrder, true, true>(ldsp, g, S, E, tidl);
        } else if (k == PH_MIX1) {
            const int tidl = fresh_tid(wave0), lane = tidl & 63, wave = wave0;
            if (mmask & 2) for (int it = vcu; it < 256; it += G) mix::prepass_item(ws, KARG(8) + l * 128, KARG(9) + l * 128, it >> 5, (it >> 2) & 7, it & 3, (LAS float*)ldsp, tidl, lane, wave);
            if (mmask & 1) for (int it = vcu; it < 256; it += G) mix::pool_item(ws, KARG(7) + l * 512, it >> 2, it & 3, ldsp, tidl, lane, wave);
            if (mmask & 4) for (int it = vcu; it < 512; it += G) mix::gla_passA_pair(ws, it, ldsp, tidl, lane, wave);
        } else if (k == PH_MIX2) {
            const int tidl = fresh_tid(wave0);
            if (mmask & 4) for (int g0 = vcu * 512 + tidl; g0 < 32 * 4096; g0 += G * 512) mix::gla_scan(ws, g0);
            if (mmask & 8) for (int pr = vcu; pr < 256; pr += G) {
                const int bh = pr >> 3, b = bh >> 2, h = bh & 3, rh = pr & 1, a = (pr >> 1) & 3; const size_t r0 = (size_t)b * SEQ * 512 + h * 128;
#pragma unroll 1
                for (int half = 0; half < 2; ++half) { const int qb = half == 0 ? 7 - a : a; const size_t qoff = r0 + (size_t)(qb * 256 + rh * 128) * 512;
                    moba::BlockRef cur; cur.Q = (const bf16_t*)(ws + WS_MQ) + qoff; cur.O = (bf16_t*)(ws + (stf ? WS_YC : WS_US)) + qoff;
                    cur.K = (const bf16_t*)(ws + WS_MK) + r0; cur.V = (const bf16_t*)(ws + WS_MV) + r0; cur.km = (const float*)(ws + WS_KMEAN) + (size_t)bh * 8 * 128; cur.P0 = qb * 256 + rh * 128;
                    const int tl = fresh_tid(wave0);
                    moba::Seam S; moba::prime(cur, KARG(10), h, (char*)lds, S, tl); moba::block(cur, (char*)lds, S, tl); }
            }
        } else if (k == PH_MIX3) {
            const int tidl = fresh_tid(wave0), lane = tidl & 63, wave = wave0;
            if (mmask & 4) for (int it = vcu; it < 512; it += G) mix::gla_passC_pair(ws, KARG(5) + l * 128, it, ldsp, tidl, lane, wave, stf ? WS_YA : WS_US);
        } else if (k == PH_GATES) {
            const int tidl = fresh_tid(wave0);
            pg8::Gemm g{(const bf16_t*)(ws + WS_XB), (const bf16_t*)(ws + WS_W + W_IN) + (size_t)NIN1 * D, M, NGATE, D}; pg8::StaticOrder S; S.init(M, NGATE, G, bx);
            fill_rstd((LAS float*)(ldsp + RSTD_OFF), rssp, bx, tidl);
            pg8::EpiGates E{ws, (const LAS float*)(ldsp + RSTD_OFF)};
            pg8::gemm_phase<pg8::EpiGates, pg8::StaticOrder, true, true>(ldsp, g, S, E, tidl);
        } else if (k == PH_UPM) {
            const int tidl = fresh_tid(wave0);
            pg8::Gemm g{nullptr, nullptr, M, D, 512}; pg8::UpmOrder S; S.so.init(M, D, G, bx);
            S.Y0 = (const bf16_t*)(ws + WS_YA); S.Y1 = (const bf16_t*)(ws + WS_YB); S.Y2 = (const bf16_t*)(ws + WS_YC);
            S.W0 = (const bf16_t*)(ws + WS_W + W_UP); S.W1 = (const bf16_t*)(ws + WS_W + W_UP + MiB); S.W2 = (const bf16_t*)(ws + WS_W + W_UP + 2 * MiB);
            pg8::EpiUpm E{ws};
            pg8::gemm_phase<pg8::EpiUpm, pg8::UpmOrder, true, true>(ldsp, g, S, E, tidl);
        } else if (k == PH_OUT) {
            const int tidl = fresh_tid(wave0);
            pg8::Gemm g{(const bf16_t*)(ws + WS_MERGED), (const bf16_t*)(ws + WS_W + W_OUT), M, D, D}; pg8::StaticOrder S; S.init(M, D, G, bx);
            pg8::EpiRes<0> E{l == 0 ? KARG(0) : out, nullptr, nullptr, (bf16_t*)(ws + WS_X1B), rssp, stf};
            pg8::gemm_phase<pg8::EpiRes<0>, pg8::StaticOrder, false, true>(ldsp, g, S, E, tidl);
        } else if (k == PH_FFN) {
            const int tidl = fresh_tid(wave0);
            pg8::Gemm g{(const bf16_t*)(ws + WS_X1B), (const bf16_t*)(ws + WS_W + W_GU), M, NGU, D}; pg8::StaticOrder S; S.init(M, NGU, G, bx);
            fill_rstd((LAS float*)(ldsp + RSTD_OFF), rssp, bx, tidl);
            pg8::EpiFfn E{(bf16_t*)(ws + WS_H), (const LAS float*)(ldsp + RSTD_OFF)};
            pg8::gemm_phase<pg8::EpiFfn, pg8::StaticOrder, true, true>(ldsp, g, S, E, tidl);
        } else if (k == PH_DOWN) {
            const int tidl = fresh_tid(wave0);
            pg8::Gemm g{(const bf16_t*)(ws + WS_H), (const bf16_t*)(ws + WS_W + W_DN), M, D, FF}; pg8::StaticOrder S; S.init(M, D, G, bx);
            pg8::EpiRes<1> E{nullptr, (const bf16_t*)(ws + WS_X1B), out, (l + 1 < DEPTH) ? (bf16_t*)(ws + WS_XB) : nullptr, (l + 1 < DEPTH) ? rssp : nullptr, stf};
            pg8::gemm_phase<pg8::EpiRes<1>, pg8::StaticOrder, false, true>(ldsp, g, S, E, tidl);
        }
        if (rep + 1 < nrep) xcd_barrier(bar);
        }
        if (ph + 1 < args.ph_hi) xcd_barrier(bar);
    }
}

#ifndef MIXMASK
#define MIXMASK 15
#endif
static void launch_mega(const Args& a0, int lo, int hi, int li, int grid, hipStream_t stream) {
    Args a = a0; a.ph_lo = lo; a.ph_hi = hi; a.li = li;
    hipLaunchKernelGGL(mega_fwd, dim3(grid), dim3(NWAVES * 64), LDS_BYTES, stream, a);
}
extern "C" void kernel_launch(void* const* d_in, const int* in_sizes, int n_in, void* d_out, int out_size, void* d_ws, size_t ws_size, hipStream_t stream) {
    static int grid = 0;
    if (grid == 0) {
        if (n_in != 19 || out_size != M * D || ws_size < WS_END2) { fprintf(stderr, "kernel_launch: unexpected shapes (n_in %d out %d ws %zu)\n", n_in, out_size, ws_size); grid = -1; return; }
        int dev = 0, cus = 0;
        if (hipGetDevice(&dev) != hipSuccess || hipDeviceGetAttribute(&cus, hipDeviceAttributeMultiprocessorCount, dev) != hipSuccess) { grid = -1; return; }
        if (hipFuncSetAttribute((const void*)mega_fwd, hipFuncAttributeMaxDynamicSharedMemorySize, LDS_BYTES) != hipSuccess) { fprintf(stderr, "kernel_launch: hipFuncSetAttribute failed\n"); grid = -1; return; }
        int per_cu = 0; (void)hipOccupancyMaxActiveBlocksPerMultiprocessor(&per_cu, (const void*)mega_fwd, NWAVES * 64, LDS_BYTES); (void)hipGetLastError();
        if (per_cu < 1) fprintf(stderr, "kernel_launch: occupancy query reports %d blocks per CU\n", per_cu);
        grid = cus;
    }
    if (grid < 0) return;
    (void)hipMemsetAsync((char*)d_ws + WS_CTL, 0, CTL_BYTES, stream);
    Args a{}; { const float** ap = (const float**)&a.in; for (int i = 0; i < 19; ++i) ap[i] = (const float*)d_in[i]; }
    a.out = (float*)d_out; a.ws = (unsigned char*)d_ws;
    a.mixmask = 15;
    launch_mega(a, 0, DEPTH * PH_PER_LAYER, 0, grid, stream);
}
```

```cpp
#include <hip/hip_runtime.h>
#include <cstdint>
#include <cstdio>

typedef unsigned short bf16_t;
typedef short bf16x8 __attribute__((ext_vector_type(8)));
typedef float f32x4 __attribute__((ext_vector_type(4)));

constexpr int BATCH = 8, SEQ = 2048, D = 1024, M = BATCH * SEQ, DEPTH = 2;
constexpr int IN_COLS = 6672, NIN1 = 3840, NGATE = 3072, NIN = NIN1 + NGATE;
constexpr int FF = 2816, NGU = 2 * FF;
constexpr int C_GLR = 1024;
constexpr float EPS = 1e-6f;
constexpr float LOG2E = 1.4426950408889634f;
constexpr float QSCALE = 0.08838834764831845f * LOG2E;

constexpr size_t MiB = 1u << 20;
constexpr size_t WS_CTL = 0, CTL_BYTES = 1 * MiB;
constexpr size_t WS_RSS = 1 * MiB;
constexpr size_t WS_KMEAN = 248 * MiB;
constexpr size_t WS_W = 2 * MiB;
constexpr size_t W_IN = 0, W_UP = 13 * MiB + 512 * 1024, W_OUT = W_UP + 3 * MiB, W_GU = W_OUT + 2 * MiB, W_DN = W_GU + 11 * MiB, W_PW = W_DN + 5 * MiB + 512 * 1024;
constexpr size_t WS_XB = 38 * MiB;
constexpr size_t WS_GQ = 70 * MiB, WS_GK = 78 * MiB, WS_GG = 86 * MiB;
constexpr size_t WS_GV = 102 * MiB, WS_PU = 118 * MiB;
constexpr size_t WS_MK = 134 * MiB, WS_MV = 150 * MiB;
constexpr size_t WS_SR = 166 * MiB, WS_MQ = 182 * MiB;
constexpr size_t WS_YB = 198 * MiB, WS_US = 214 * MiB;
constexpr size_t WS_SGA = 70 * MiB, WS_SGB = 102 * MiB, WS_SGC = 134 * MiB;
constexpr size_t WS_MERGED = WS_XB, WS_X1B = 70 * MiB, WS_H = 102 * MiB;
constexpr size_t WS_END = 231 * MiB;

__device__ __forceinline__ float bf2f(bf16_t h) { return __uint_as_float(((unsigned)h) << 16); }
__device__ __forceinline__ bf16_t f2bf(float f) { unsigned u = __float_as_uint(f); return (bf16_t)((u + 0x7fffu + ((u >> 16) & 1u)) >> 16); }
__device__ __forceinline__ unsigned pk2(float lo, float hi) { return (unsigned)f2bf(lo) | ((unsigned)f2bf(hi) << 16); }
__device__ __forceinline__ float wave_sum(float v) {
#pragma unroll
    for (int o = 1; o < 64; o <<= 1) v += __shfl_xor(v, o);
    return v;
}
__device__ __forceinline__ float wave_max(float v) {
#pragma unroll
    for (int o = 1; o < 64; o <<= 1) v = fmaxf(v, __shfl_xor(v, o));
    return v;
}
__device__ __forceinline__ float sigmoidf_(float x) { return 1.f / (1.f + __expf(-x)); }
__device__ __forceinline__ float siluf_(float x) { return x / (1.f + __expf(-x)); }
__device__ __forceinline__ float logsigmoidf_(float x) { return fminf(x, 0.f) - log1pf(__expf(-fabsf(x))); }

struct Inputs {
    const float *x, *norm1_w, *w_in, *wg2, *bg, *gla_nw, *pool_w, *pool_scale, *qn_w, *kn_w, *rel_bias, *w_up_a, *w_up_b, *w_up_c, *w_out, *norm2_w, *w_gate, *w_up, *w_down;
};

template <class F>
__device__ __forceinline__ void transpose_item(F src, int K, bf16_t* dst, int k0, int n0, float* scr, int lane) {
    float tv[32];
#pragma unroll
    for (int i = 0; i < 32; ++i) tv[i] = src(k0 + i, n0 + lane);
#pragma unroll
    for (int i = 0; i < 32; ++i) scr[i * 65 + lane] = tv[i];
    __builtin_amdgcn_s_waitcnt(0xc07f); asm volatile("" ::: "memory");
    const int c = lane & 3;
#pragma unroll
    for (int j = 0; j < 4; ++j) {
        const int n = (lane >> 2) + 16 * j; const float* s = scr + (8 * c) * 65 + n;
        uint4 o; o.x = pk2(s[0], s[65]); o.y = pk2(s[130], s[195]); o.z = pk2(s[260], s[325]); o.w = pk2(s[390], s[455]);
        *(uint4*)(dst + (size_t)(n0 + n) * K + k0 + 8 * c) = o;
    }
    __builtin_amdgcn_s_waitcnt(0xc07f); asm volatile("" ::: "memory");
}
constexpr int PI_IN = 32 * (NIN / 64), PI_UP = 16 * 16, PI_OUT = 32 * 16, PI_GU = 32 * (NGU / 64), PI_DN = 88 * 16, PI_PW = 4 * 2;
constexpr int PREP_ITEMS = PI_IN + 3 * PI_UP + PI_OUT + PI_GU + PI_DN + 4 * PI_PW;
template <class InP>
__device__ __forceinline__ void prep_item(InP inp, int l, unsigned char* wsw, int it, float* scr, int lane) {
    if (it < PI_IN) {
        const int nb = NIN / 64, kb = it / nb, n0 = 64 * (it % nb), k0 = 32 * kb;
        const float* w = inp->w_in + (size_t)l * D * IN_COLS; const float* nw = inp->norm1_w + l * D; bf16_t* dst = (bf16_t*)(wsw + W_IN);
        if (n0 >= 512 && n0 < 768) {
            const float* g2 = inp->wg2 + (size_t)l * 16 * 256 + (n0 - 512) + lane; float g2v[16];
#pragma unroll
            for (int r = 0; r < 16; ++r) g2v[r] = g2[r * 256];
            transpose_item([&](int k, int n) { const f32x4* wr = (const f32x4*)(w + (size_t)k * IN_COLS + C_GLR); float s = 0.f;
#pragma unroll
                for (int r4 = 0; r4 < 4; ++r4) { const f32x4 v = wr[r4]; s += v[0] * g2v[4 * r4] + v[1] * g2v[4 * r4 + 1] + v[2] * g2v[4 * r4 + 2] + v[3] * g2v[4 * r4 + 3]; }
                return s * nw[k]; }, D, dst, k0, n0, scr, lane);
        } else {
            const int off = n0 < 512 ? 0 : (n0 < 1280 ? -256 : -240);
            transpose_item([&](int k, int n) { return w[(size_t)k * IN_COLS + n + off] * nw[k]; }, D, dst, k0, n0, scr, lane);
        }
        return;
    }
    it -= PI_IN;
    if (it < 3 * PI_UP) {
        const int br = it / PI_UP; it %= PI_UP; const int kb = it / 16, n0 = 64 * (it % 16), k0 = 32 * kb;
        const float* w = (br == 0 ? inp->w_up_a : br == 1 ? inp->w_up_b : inp->w_up_c) + (size_t)l * 512 * D;
        transpose_item([&](int k, int n) { return w[(size_t)k * D + n]; }, 512, (bf16_t*)(wsw + W_UP + br * MiB), k0, n0, scr, lane);
        return;
    }
    it -= 3 * PI_UP;
    if (it < PI_OUT) {
        const int kb = it / 16, n0 = 64 * (it % 16), k0 = 32 * kb; const float* w = inp->w_out + (size_t)l * D * D;
        transpose_item([&](int k, int n) { return w[(size_t)k * D + n]; }, D, (bf16_t*)(wsw + W_OUT), k0, n0, scr, lane);
        return;
    }
    it -= PI_OUT;
    if (it < PI_GU) {
        const int nb = NGU / 64, kb = it / nb, n0 = 64 * (it % nb), k0 = 32 * kb;
        const int pn = n0 >> 8, i0 = n0 & 255; const float* w = ((i0 < 128) ? inp->w_gate : inp->w_up) + (size_t)l * D * FF; const float* nw = inp->norm2_w + l * D;
        const int coff = 128 * pn + (i0 & 127) - n0;
        transpose_item([&](int k, int n) { return w[(size_t)k * FF + n + coff] * nw[k]; }, D, (bf16_t*)(wsw + W_GU), k0, n0, scr, lane);
        return;
    }
    it -= PI_GU;
    if (it < PI_DN) {
        const int kb = it / 16, n0 = 64 * (it % 16), k0 = 32 * kb; const float* w = inp->w_down + (size_t)l * FF * D;
        transpose_item([&](int k, int n) { return w[(size_t)k * D + n]; }, FF, (bf16_t*)(wsw + W_DN), k0, n0, scr, lane);
        return;
    }
    it -= PI_DN;
    { const int g = it / PI_PW; it %= PI_PW; const int kb = it / 2, n0 = 64 * (it % 2), k0 = 32 * kb; const float* w = inp->pool_w + ((size_t)l * 4 + g) * 128 * 128;
      transpose_item([&](int k, int n) { return w[(size_t)k * 128 + n]; }, 128, (bf16_t*)(wsw + W_PW) + g * 128 * 128, k0, n0, scr, lane); }
}
__global__ void __launch_bounds__(256) k_prep(Inputs in, int l, unsigned char* ws) {
    __shared__ float scr[4][32 * 65];
    const int lane = threadIdx.x & 63, wave = threadIdx.x >> 6;
    for (int it = blockIdx.x * 4 + wave; it < PREP_ITEMS; it += gridDim.x * 4) prep_item(&in, l, ws + WS_W, it, scr[wave], lane);
}

__global__ void __launch_bounds__(256) k_rows(const float* src, bf16_t* dst, float* rss) {
    const int lane = threadIdx.x & 63, row = blockIdx.x * 4 + (threadIdx.x >> 6);
    const f32x4* xr = (const f32x4*)(src + (size_t)row * D) + lane; float s = 0.f;
    unsigned long long* o8 = (unsigned long long*)(dst + (size_t)row * D) + lane;
#pragma unroll
    for (int j = 0; j < 4; ++j) { const f32x4 v = xr[64 * j]; s += (v.x * v.x + v.y * v.y) + (v.z * v.z + v.w * v.w);
        o8[64 * j] = (unsigned long long)pk2(v.x, v.y) | ((unsigned long long)pk2(v.z, v.w) << 32); }
    s = wave_sum(s); if (lane == 0) rss[row] = s;
}

__device__ __forceinline__ void ngemm32(const bf16_t* A, int lda, const bf16_t* Bt, int ldb, int K, f32x4 (&acc)[2][2], int lane) {
    const int r = lane & 15, q = lane >> 4;
    for (int k0 = 0; k0 < K; k0 += 32) {
        bf16x8 a[2], b[2];
#pragma unroll
        for (int i = 0; i < 2; ++i) { a[i] = *(const bf16x8*)(A + (size_t)(i * 16 + r) * lda + k0 + 8 * q); b[i] = *(const bf16x8*)(Bt + (size_t)(i * 16 + r) * ldb + k0 + 8 * q); }
#pragma unroll
        for (int i = 0; i < 2; ++i)
#pragma unroll
            for (int j = 0; j < 2; ++j) acc[i][j] = __builtin_amdgcn_mfma_f32_16x16x32_bf16(a[i], b[j], acc[i][j], 0, 0, 0);
    }
}
#define NG_PRE const int lane = threadIdx.x & 63, wave = threadIdx.x >> 6; const int row0 = blockIdx.y * 64 + (wave >> 1) * 32, col0 = blockIdx.x * 64 + (wave & 1) * 32; \
    f32x4 acc[2][2]; for (int i = 0; i < 2; ++i) for (int j = 0; j < 2; ++j) acc[i][j] = (f32x4){0.f, 0.f, 0.f, 0.f};
#define NG_FOR for (int i = 0; i < 2; ++i) for (int j = 0; j < 2; ++j) for (int rg = 0; rg < 4; ++rg) { const int row = row0 + i * 16 + (lane >> 4) * 4 + rg, col = col0 + j * 16 + (lane & 15);

__global__ void __launch_bounds__(256) k_inproj1(unsigned char* ws, const float* bg) {
    NG_PRE
    ngemm32((const bf16_t*)(ws + WS_XB) + (size_t)row0 * D, D, (const bf16_t*)(ws + WS_W + W_IN) + (size_t)col0 * D, D, D, acc, lane);
    const float* rss = (const float*)(ws + WS_RSS);
    NG_FOR
        const float v = acc[i][j][rg] * rsqrtf(rss[row] * (1.f / D) + EPS);
        const int t = col >> 8, c = col & 255;
        if (t == 0) ((bf16_t*)(ws + WS_GQ))[(size_t)row * 256 + c] = f2bf(v * 0.125f);
        else if (t == 1) ((bf16_t*)(ws + WS_GK))[(size_t)row * 256 + c] = f2bf(v);
        else if (t == 2) ((float*)(ws + WS_GG))[(size_t)row * 256 + c] = logsigmoidf_(v + bg[c]) * (1.f / 16.f);
        else if (t < 5) ((bf16_t*)(ws + WS_GV))[(size_t)row * 512 + (col - 768)] = f2bf(v);
        else if (t < 7) ((bf16_t*)(ws + WS_SR))[(size_t)row * 512 + (col - 1280)] = f2bf(siluf_(v));
        else if (t < 9) ((bf16_t*)(ws + WS_PU))[(size_t)row * 512 + (col - 1792)] = f2bf(v);
        else if (t < 11) ((bf16_t*)(ws + WS_MQ))[(size_t)row * 512 + (col - 2304)] = f2bf(v);
        else if (t < 13) ((bf16_t*)(ws + WS_MK))[(size_t)row * 512 + (col - 2816)] = f2bf(v);
        else ((bf16_t*)(ws + WS_MV))[(size_t)row * 512 + (col - 3328)] = f2bf(v);
    }
}
__global__ void __launch_bounds__(256) k_gates(unsigned char* ws) {
    NG_PRE
    ngemm32((const bf16_t*)(ws + WS_XB) + (size_t)row0 * D, D, (const bf16_t*)(ws + WS_W + W_IN) + (size_t)(NIN1 + col0) * D, D, D, acc, lane);
    const float* rss = (const float*)(ws + WS_RSS);
    NG_FOR
        const float v = acc[i][j][rg] * rsqrtf(rss[row] * (1.f / D) + EPS);
        const int br = col >> 10, c = col & 1023;
        ((bf16_t*)(ws + (br == 0 ? WS_SGA : br == 1 ? WS_SGB : WS_SGC)))[(size_t)row * D + c] = f2bf(sigmoidf_(v));
    }
}
__global__ void __launch_bounds__(256) k_upmerge(unsigned char* ws) {
    NG_PRE
    f32x4 tot[2][2]; for (int i = 0; i < 2; ++i) for (int j = 0; j < 2; ++j) tot[i][j] = (f32x4){0.f, 0.f, 0.f, 0.f};
    for (int br = 0; br < 3; ++br) {
        const bf16_t* Y = (const bf16_t*)(ws + (br == 0 ? WS_SR : br == 1 ? WS_YB : WS_MQ)); const bf16_t* G = (const bf16_t*)(ws + (br == 0 ? WS_SGA : br == 1 ? WS_SGB : WS_SGC));
        for (int i = 0; i < 2; ++i) for (int j = 0; j < 2; ++j) acc[i][j] = (f32x4){0.f, 0.f, 0.f, 0.f};
        ngemm32(Y + (size_t)row0 * 512, 512, (const bf16_t*)(ws + WS_W + W_UP + br * MiB) + (size_t)col0 * 512, 512, 512, acc, lane);
        NG_FOR tot[i][j][rg] += bf2f(G[(size_t)row * D + col]) * acc[i][j][rg]; }
    }
    NG_FOR ((bf16_t*)(ws + WS_MERGED))[(size_t)row * D + col] = f2bf(tot[i][j][rg]); }
}
__global__ void __launch_bounds__(256) k_resgemm(const bf16_t* A, const bf16_t* Bt, int K, const float* resid, float* xout) {
    NG_PRE
    ngemm32(A + (size_t)row0 * K, K, Bt + (size_t)col0 * K, K, K, acc, lane);
    NG_FOR xout[(size_t)row * D + col] = resid[(size_t)row * D + col] + acc[i][j][rg]; }
}
__global__ void __launch_bounds__(256) k_ffn(unsigned char* ws) {
    const int lane = threadIdx.x & 63, wave = threadIdx.x >> 6; const int row0 = blockIdx.y * 64 + (wave >> 1) * 32, j0 = blockIdx.x * 64 + (wave & 1) * 32;
    f32x4 ag[2][2], au[2][2]; for (int i = 0; i < 2; ++i) for (int j = 0; j < 2; ++j) { ag[i][j] = (f32x4){0.f, 0.f, 0.f, 0.f}; au[i][j] = ag[i][j]; }
    const int ng = 256 * (j0 >> 7) + (j0 & 127);
    const bf16_t* A = (const bf16_t*)(ws + WS_X1B) + (size_t)row0 * D; const bf16_t* W = (const bf16_t*)(ws + WS_W + W_GU);
    ngemm32(A, D, W + (size_t)ng * D, D, D, ag, lane);
    ngemm32(A, D, W + (size_t)(ng + 128) * D, D, D, au, lane);
    const float* rss = (const float*)(ws + WS_RSS);
    for (int i = 0; i < 2; ++i) for (int j = 0; j < 2; ++j) for (int rg = 0; rg < 4; ++rg) { const int row = row0 + i * 16 + (lane >> 4) * 4 + rg, col = j0 + j * 16 + (lane & 15);
        const float rs = rsqrtf(rss[row] * (1.f / D) + EPS);
        ((bf16_t*)(ws + WS_H))[(size_t)row * FF + col] = f2bf(siluf_(ag[i][j][rg] * rs) * (au[i][j][rg] * rs)); }
}

__global__ void __launch_bounds__(128) k_gla(unsigned char* ws, const float* nw) {
    const int e = threadIdx.x, b = blockIdx.x >> 2, h = blockIdx.x & 3, lane = e & 63, wave = e >> 6;
    const bf16_t* GQ = (const bf16_t*)(ws + WS_GQ); const bf16_t* GK = (const bf16_t*)(ws + WS_GK); const float* GG = (const float*)(ws + WS_GG);
    const bf16_t* GV = (const bf16_t*)(ws + WS_GV); bf16_t* YA = (bf16_t*)(ws + WS_SR);
    __shared__ float red[2][16]; __shared__ float osh[16][128];
    float S[64];
#pragma unroll
    for (int d = 0; d < 64; ++d) S[d] = 0.f;
    const float nwe = nw[e];
    for (int t0 = 0; t0 < SEQ; t0 += 16) {
#pragma unroll 1
        for (int tt = 0; tt < 16; ++tt) {
            const size_t row = (size_t)b * SEQ + t0 + tt;
            const bf16_t* q = GQ + row * 256 + h * 64; const bf16_t* k = GK + row * 256 + h * 64; const float* g = GG + row * 256 + h * 64;
            const float v = bf2f(GV[row * 512 + h * 128 + e]); float a = 0.f;
#pragma unroll
            for (int d = 0; d < 64; ++d) { S[d] = __expf(g[d]) * S[d] + bf2f(k[d]) * v; a += bf2f(q[d]) * S[d]; }
            osh[tt][e] = a;
            const float s = wave_sum(a * a); if (lane == 0) red[wave][tt] = s;
        }
        __syncthreads();
#pragma unroll 1
        for (int tt = 0; tt < 16; ++tt) { const float rstd = rsqrtf((red[0][tt] + red[1][tt]) * (1.f / 128.f) + EPS);
            const size_t idx = ((size_t)b * SEQ + t0 + tt) * 512 + h * 128 + e; YA[idx] = f2bf(osh[tt][e] * rstd * nwe * bf2f(YA[idx])); }
        __syncthreads();
    }
}

__global__ void __launch_bounds__(256) k_pool(unsigned char* ws, const float* pw, const float* pscale) {
    __shared__ float u[31][128]; __shared__ float p[16][128];
    const int g = blockIdx.x & 3, r0 = (blockIdx.x >> 2) * 16, t0 = r0 & (SEQ - 1), tid = threadIdx.x;
    const bf16_t* PU = (const bf16_t*)(ws + WS_PU);
    for (int x = tid; x < 31 * 128; x += 256) { const int i = x >> 7, c = x & 127, t = t0 - 15 + i; u[i][c] = t >= 0 ? bf2f(PU[(size_t)(r0 - 15 + i) * 512 + g * 128 + c]) : 0.f; }
    __syncthreads();
    const int w = 2 << g;
    for (int x = tid; x < 16 * 128; x += 256) { const int i = x >> 7, c = x & 127, t = t0 + i, cnt = min(t + 1, w); float s = 0.f;
        for (int j = 0; j < cnt; ++j) s += u[15 + i - j][c];
        p[i][c] = s / (float)cnt - u[15 + i][c]; }
    __syncthreads();
    for (int x = tid; x < 16 * 128; x += 256) { const int i = x >> 7, e = x & 127; float y = 0.f;
        for (int c = 0; c < 128; ++c) y += p[i][c] * pw[((size_t)g * 128 + c) * 128 + e];
        ((bf16_t*)(ws + WS_YB))[(size_t)(r0 + i) * 512 + g * 128 + e] = f2bf(y * pscale[g * 128 + e]); }
}

__global__ void __launch_bounds__(256) k_prepass(unsigned char* ws, const float* qw, const float* kw) {
    __shared__ float part[4][128];
    const int lane = threadIdx.x & 63, wave = threadIdx.x >> 6; const int h = blockIdx.x & 3, blk = (blockIdx.x >> 2) & 7, b = blockIdx.x >> 5;
    unsigned* MQ = (unsigned*)(ws + WS_MQ); unsigned* MK = (unsigned*)(ws + WS_MK);
    const float qw0 = qw[2 * lane] * QSCALE, qw1 = qw[2 * lane + 1] * QSCALE, kw0 = kw[2 * lane], kw1 = kw[2 * lane + 1];
    float c0 = 0.f, c1 = 0.f;
    for (int r = 0; r < 64; ++r) {
        const size_t idx = ((size_t)b * SEQ + blk * 256 + wave * 64 + r) * 256 + h * 64 + lane;
        { const unsigned v = MQ[idx]; const float a = __uint_as_float(v << 16), c = __uint_as_float(v & 0xffff0000u); const float rs = rsqrtf(wave_sum(a * a + c * c) * (1.f / 128.f) + EPS); MQ[idx] = pk2(a * rs * qw0, c * rs * qw1); }
        { const unsigned v = MK[idx]; const float a = __uint_as_float(v << 16), c = __uint_as_float(v & 0xffff0000u); const float rs = rsqrtf(wave_sum(a * a + c * c) * (1.f / 128.f) + EPS);
          const float k0 = a * rs * kw0, k1 = c * rs * kw1; c0 += k0; c1 += k1; MK[idx] = pk2(k0, k1); }
    }
    part[wave][2 * lane] = c0; part[wave][2 * lane + 1] = c1;
    __syncthreads();
    if (threadIdx.x < 128) ((float*)(ws + WS_KMEAN))[(((size_t)b * 4 + h) * 8 + blk) * 128 + threadIdx.x] = ((part[0][threadIdx.x] + part[1][threadIdx.x]) + (part[2][threadIdx.x] + part[3][threadIdx.x])) * (1.f / 256.f);
}

__global__ void __launch_bounds__(256) k_moba(unsigned char* ws, const float* rel_bias) {
    __shared__ float tab[4][132]; __shared__ float qs[4][128]; __shared__ float ps[4][1024];
    const int lane = threadIdx.x & 63, wave = threadIdx.x >> 6;
    const int gw = blockIdx.x * 4 + wave; const int t = gw & (SEQ - 1), h = (gw >> 11) & 3, b = gw >> 13;
    for (int x = threadIdx.x; x < 129; x += 256) { int bk = x; if (x >= 16) { bk = 16 + (int)(logf((float)x / 16.f) / 2.0794415416798357f * 16.f); if (bk > 31) bk = 31; } tab[0][x] = rel_bias[bk * 4 + h] * LOG2E; }
    __syncthreads();
    const size_t row = (size_t)b * SEQ + t; const int qblk = t >> 8;
    unsigned* QN = (unsigned*)(ws + WS_MQ); const bf16_t* KN = (const bf16_t*)(ws + WS_MK); const unsigned* MV = (const unsigned*)(ws + WS_MV);
    const unsigned qv = QN[row * 256 + h * 64 + lane]; const float q0 = __uint_as_float(qv << 16), q1 = __uint_as_float(qv & 0xffff0000u);
    qs[wave][2 * lane] = q0; qs[wave][2 * lane + 1] = q1;
    const float* km = (const float*)(ws + WS_KMEAN) + ((size_t)b * 4 + h) * 8 * 128;
    float sc[8];
#pragma unroll
    for (int n = 0; n < 8; ++n) sc[n] = (n < qblk) ? wave_sum(q0 * km[n * 128 + 2 * lane] + q1 * km[n * 128 + 2 * lane + 1]) : -INFINITY;
    int blks[4]; int nvalid = 0;
#pragma unroll
    for (int s = 0; s < 3; ++s) { float best = -INFINITY; int bi = -1;
#pragma unroll
        for (int n = 0; n < 8; ++n) if (sc[n] > best) { best = sc[n]; bi = n; }
        blks[s] = bi;
#pragma unroll
        for (int n = 0; n < 8; ++n) if (n == bi) sc[n] = -INFINITY; }
    blks[3] = qblk;
    __builtin_amdgcn_s_waitcnt(0xc07f);
    float lg[4][4]; float mx = -INFINITY;
#pragma unroll
    for (int s = 0; s < 4; ++s) {
        const int blk = blks[s];
#pragma unroll
        for (int i = 0; i < 4; ++i) {
            lg[s][i] = -INFINITY;
            if (blk >= 0) { const int j = lane + 64 * i, tk = blk * 256 + j, dist = t - tk;
                if (dist >= 0) { const bf16_t* kr = KN + ((size_t)b * SEQ + tk) * 512 + h * 128; float dsum = 0.f;
                    for (int c = 0; c < 16; ++c) { const bf16x8 kk = *(const bf16x8*)(kr + c * 8);
#pragma unroll
                        for (int x = 0; x < 8; ++x) dsum += bf2f((bf16_t)kk[x]) * qs[wave][c * 8 + x]; }
                    lg[s][i] = dsum + tab[0][dist > 128 ? 128 : dist]; mx = fmaxf(mx, lg[s][i]); } }
        }
    }
    mx = wave_max(mx); float sum = 0.f;
#pragma unroll
    for (int s = 0; s < 4; ++s)
#pragma unroll
        for (int i = 0; i < 4; ++i) { const float pp = exp2f(lg[s][i] - mx); sum += pp; ps[wave][s * 256 + lane + 64 * i] = pp; }
    sum = wave_sum(sum);
    __builtin_amdgcn_s_waitcnt(0xc07f);
    float o0 = 0.f, o1 = 0.f;
#pragma unroll
    for (int s = 0; s < 4; ++s) { const int blk = blks[s]; if (blk < 0) continue; const int jn = (s == 3) ? (t & 255) + 1 : 256;
        const unsigned* vr = MV + ((size_t)b * SEQ + blk * 256) * 256 + h * 64 + lane;
        for (int j = 0; j < jn; ++j) { const float pp = ps[wave][s * 256 + j]; const unsigned v = vr[(size_t)j * 256]; o0 += pp * __uint_as_float(v << 16); o1 += pp * __uint_as_float(v & 0xffff0000u); } }
    const float inv = 1.f / sum;
    QN[row * 256 + h * 64 + lane] = pk2(o0 * inv, o1 * inv);
}


template <int K> __device__ __forceinline__ float swz_xor(float v) { return __int_as_float(__builtin_amdgcn_ds_swizzle(__float_as_int(v), (K << 10) | 0x1f)); }
__device__ __forceinline__ float half_sum(float v) { auto rr = __builtin_amdgcn_permlane32_swap(__float_as_uint(v), __float_as_uint(v), false, false); return __uint_as_float(rr[0]) + __uint_as_float(rr[1]); }
__device__ __forceinline__ float wave_sum_s(float v) { v += swz_xor<1>(v); v += swz_xor<2>(v); v += swz_xor<4>(v); v += swz_xor<8>(v); v += swz_xor<16>(v); return half_sum(v); }
namespace pg8 {
#define PG8_LAS __attribute__((address_space(3)))
typedef unsigned u32x4 __attribute__((ext_vector_type(4)));
constexpr int BM = 256, BK = 64, HALF = 128, HTB = HALF * BK * 2, STAGE_BYTES = 8 * HTB, NXCD = 8, WGM = 8;
__host__ __device__ __forceinline__ int lds_byte(int r, int c) { const int st = (r >> 4) * 2 + (c >> 5), rr = r & 15, cc = c & 31, ob = rr * 64 + cc * 2; return st * 1024 + (ob ^ (((ob >> 9) & 1) << 5)); }
__host__ __device__ __forceinline__ void stage_rc(int b, int& R, int& C) { const int st = b / 1024, sb = b % 1024, swz = sb ^ (((sb >> 9) & 1) << 5); R = (st >> 1) * 16 + swz / 64; C = (st & 1) * 32 + (swz % 64) / 2; }
__host__ __device__ __forceinline__ int perm32(int rho) { const int n = rho >> 4, i = rho & 15; return 8 * (i >> 2) + 4 * n + (i & 3); }
struct Unit { int pm, pn, br; };
struct Gemm { const bf16_t* A; const bf16_t* Bt; int M, N, K; };
struct StaticOrder {
    int nM, nN, nwg, G, c;
    __device__ void init(int M_, int N_, int G_, int c_) { nM = M_ / BM; nN = N_ / BM; nwg = nM * nN; G = G_; c = c_; }
    __device__ bool next(int i, Unit& u) const {
        const long L = (long)i * G + c; if (L >= nwg) return false;
        int wgid = (int)L; { const int q = nwg / NXCD, r = nwg % NXCD, xcd = wgid % NXCD, off = wgid / NXCD; wgid = (xcd < r ? xcd * (q + 1) : r * (q + 1) + (xcd - r) * q) + off; }
        const int nig = WGM * nN, gid = wgid / nig, fm = gid * WGM, gsz = (nM - fm) < WGM ? (nM - fm) : WGM;
        u.pm = fm + ((wgid % nig) % gsz); u.pn = (wgid % nig) / gsz; u.br = 0; return true;
    }
    __device__ __forceinline__ const char* pa(const Unit& u, const Gemm& g) const { return (const char*)g.A + (size_t)u.pm * (size_t)(BM * 2) * g.K; }
    __device__ __forceinline__ const char* pb(const Unit& u, const Gemm& g) const { return (const char*)g.Bt + (size_t)u.pn * (size_t)(BM * 2) * g.K; }
    __device__ __forceinline__ void a_ready(const Unit&) const {}
    __device__ __forceinline__ void done(const Unit&) const {}
};
struct UpmOrder {
    StaticOrder so; const bf16_t *Y0, *Y1, *Y2, *W0, *W1, *W2;
    __device__ bool next(int i, Unit& u) const { if (i >= 3) return false; if (!so.next(0, u)) return false; u.br = i; return true; }
    __device__ __forceinline__ const char* pa(const Unit& u, const Gemm& g) const { const bf16_t* y = u.br == 0 ? Y0 : (u.br == 1 ? Y1 : Y2); return (const char*)y + (size_t)u.pm * (size_t)(BM * 2) * g.K; }
    __device__ __forceinline__ const char* pb(const Unit& u, const Gemm& g) const { const bf16_t* w = u.br == 0 ? W0 : (u.br == 1 ? W1 : W2); return (const char*)w + (size_t)u.pn * (size_t)(BM * 2) * g.K; }
    __device__ __forceinline__ void a_ready(const Unit&) const {}
    __device__ __forceinline__ void done(const Unit&) const {}
};
typedef float f32x2_t __attribute__((ext_vector_type(2))); typedef __bf16 bf16x2_t __attribute__((ext_vector_type(2)));
__device__ __forceinline__ unsigned cvt_pk_bf16(float lo, float hi) { const f32x2_t v = {lo, hi}; const bf16x2_t b = __builtin_convertvector(v, bf16x2_t); return __builtin_bit_cast(unsigned, b); }
__device__ __forceinline__ u32x4 pack8(const f32x4& a, const f32x4& b) { u32x4 w; w.x = cvt_pk_bf16(a[0], a[1]); w.y = cvt_pk_bf16(a[2], a[3]); w.z = cvt_pk_bf16(b[0], b[1]); w.w = cvt_pk_bf16(b[2], b[3]); return w; }
__device__ __forceinline__ void unpack8(const u32x4& w, f32x4& a, f32x4& b) {
    a[0] = __uint_as_float(w.x << 16); a[1] = __uint_as_float(w.x & 0xffff0000u); a[2] = __uint_as_float(w.y << 16); a[3] = __uint_as_float(w.y & 0xffff0000u);
    b[0] = __uint_as_float(w.z << 16); b[1] = __uint_as_float(w.z & 0xffff0000u); b[2] = __uint_as_float(w.w << 16); b[3] = __uint_as_float(w.w & 0xffff0000u);
}
__device__ __forceinline__ void row_rstd(const PG8_LAS float* tab, const Unit& u, int wr, int fr, float (&rs)[2][4]) {
#pragma unroll
    for (int ai = 0; ai < 2; ++ai)
#pragma unroll
        for (int m = 0; m < 4; ++m) rs[ai][m] = tab[(u.pm & 7) * BM + ai * HALF + wr * 64 + m * 16 + fr];
}
struct EpiIn1 {
    static constexpr bool PERM = true, AFTER_DRAIN = false;
    unsigned char* ws; const PG8_LAS float* rstab; const float* bg;
    __device__ __forceinline__ void operator()(const f32x4 (&acc)[2][2][4][2], const Unit& u, int wr, int wc, int fr, int fq) const {
        asm volatile("" : "+v"(fr), "+v"(fq));
        const int row0 = u.pm * BM + wr * 64 + fr, cw = wc * 32 + 8 * fq; const int pn = u.pn;
        float rs[2][4]; row_rstd(rstab, u, wr, fr, rs);
        if (pn == 2) {
            float* G = (float*)(ws + WS_GG); size_t zb = 0; asm volatile("" : "+s"(zb)); const float* bgl = bg + zb;
#pragma unroll
            for (int bj = 0; bj < 2; ++bj) { const int c = bj * HALF + cw; const f32x4 b0 = *(const f32x4*)(bgl + c), b1 = *(const f32x4*)(bgl + c + 4);
#pragma unroll
                for (int ai = 0; ai < 2; ++ai)
#pragma unroll
                    for (int m = 0; m < 4; ++m) { const float r = rs[ai][m]; f32x4 v0 = acc[ai][bj][m][0] * r + b0, v1 = acc[ai][bj][m][1] * r + b1;
#pragma unroll
                        for (int x = 0; x < 4; ++x) { v0[x] = (fminf(v0[x], 0.f) - __logf(1.f + __expf(-fabsf(v0[x])))) * 0.0625f; v1[x] = (fminf(v1[x], 0.f) - __logf(1.f + __expf(-fabsf(v1[x])))) * 0.0625f; }
                        float* p = G + (size_t)(row0 + ai * HALF + m * 16) * 256 + c; *(f32x4*)p = v0; *(f32x4*)(p + 4) = v1; asm volatile("" ::: "memory"); } }
            return;
        }
        bf16_t* base; int ldc, coff; float sc = 1.f; bool silu = false;
        if (pn == 0) { base = (bf16_t*)(ws + WS_GQ); ldc = 256; coff = 0; sc = 0.125f; }
        else if (pn == 1) { base = (bf16_t*)(ws + WS_GK); ldc = 256; coff = 0; }
        else { ldc = 512; const int k = (pn - 3) >> 1; coff = ((pn - 3) & 1) * 256; silu = (k == 1);
            base = (bf16_t*)(ws + (k == 0 ? WS_GV : k == 1 ? WS_SR : k == 2 ? WS_PU : k == 3 ? WS_MQ : k == 4 ? WS_MK : WS_MV)); }
#pragma unroll
        for (int ai = 0; ai < 2; ++ai)
#pragma unroll
            for (int m = 0; m < 4; ++m) { const float r = rs[ai][m] * sc; bf16_t* rowp = base + (size_t)(row0 + ai * HALF + m * 16) * ldc + coff + cw;
#pragma unroll
                for (int bj = 0; bj < 2; ++bj) { f32x4 v0 = acc[ai][bj][m][0] * r, v1 = acc[ai][bj][m][1] * r;
                    if (silu) {
#pragma unroll
                        for (int x = 0; x < 4; ++x) { v0[x] = siluf_(v0[x]); v1[x] = siluf_(v1[x]); } }
                    *(u32x4*)(rowp + bj * HALF) = pack8(v0, v1); } asm volatile("" ::: "memory"); }
    }
};
struct EpiGates {
    static constexpr bool PERM = true, AFTER_DRAIN = false;
    unsigned char* ws; const PG8_LAS float* rstab;
    __device__ __forceinline__ void operator()(const f32x4 (&acc)[2][2][4][2], const Unit& u, int wr, int wc, int fr, int fq) const {
        asm volatile("" : "+v"(fr), "+v"(fq));
        const int row0 = u.pm * BM + wr * 64 + fr, cw = wc * 32 + 8 * fq; const int br = u.pn >> 2;
        float rs[2][4]; row_rstd(rstab, u, wr, fr, rs);
        bf16_t* base = (bf16_t*)(ws + (br == 0 ? WS_SGA : br == 1 ? WS_SGB : WS_SGC)) + (u.pn & 3) * 256 + cw;
#pragma unroll
        for (int ai = 0; ai < 2; ++ai)
#pragma unroll
            for (int m = 0; m < 4; ++m) { const float r = rs[ai][m]; bf16_t* rowp = base + (size_t)(row0 + ai * HALF + m * 16) * D;
#pragma unroll
                for (int bj = 0; bj < 2; ++bj) { f32x4 v0 = acc[ai][bj][m][0] * r, v1 = acc[ai][bj][m][1] * r;
#pragma unroll
                    for (int x = 0; x < 4; ++x) { v0[x] = sigmoidf_(v0[x]); v1[x] = sigmoidf_(v1[x]); }
                    *(u32x4*)(rowp + bj * HALF) = pack8(v0, v1); } asm volatile("" ::: "memory"); }
    }
};
struct EpiUpm {
    static constexpr bool PERM = true, AFTER_DRAIN = false;
    unsigned char* ws;
    __device__ __forceinline__ void operator()(const f32x4 (&acc)[2][2][4][2], const Unit& u, int wr, int wc, int fr, int fq) const {
        asm volatile("" : "+v"(fr), "+v"(fq));
        const int row0 = u.pm * BM + wr * 64 + fr, col0 = u.pn * BM + wc * 32 + 8 * fq; const int br = u.br;
        const bf16_t* G = (const bf16_t*)(ws + (br == 0 ? WS_SGA : br == 1 ? WS_SGB : WS_SGC)); bf16_t* O = (bf16_t*)(ws + 214 * MiB);
#pragma unroll
        for (int ai = 0; ai < 2; ++ai)
#pragma unroll
            for (int m = 0; m < 4; ++m) { const size_t off = (size_t)(row0 + ai * HALF + m * 16) * D + col0;
#pragma unroll
                for (int bj = 0; bj < 2; ++bj) { f32x4 g0, g1; unpack8(*(const u32x4*)(G + off + bj * HALF), g0, g1);
                    f32x4 v0 = acc[ai][bj][m][0] * g0, v1 = acc[ai][bj][m][1] * g1;
                    if (br != 0) { f32x4 p0, p1; unpack8(*(const u32x4*)(O + off + bj * HALF), p0, p1); v0 += p0; v1 += p1; }
                    *(u32x4*)(O + off + bj * HALF) = pack8(v0, v1); } }
    }
};
struct EpiRes {
    static constexpr bool PERM = true, AFTER_DRAIN = false;
    const bf16_t* resid_b; float* xout; bf16_t* xb; float* rssp; bool st;
    __device__ __forceinline__ void operator()(const f32x4 (&acc)[2][2][4][2], const Unit& u, int wr, int wc, int fr, int fq) const {
        asm volatile("" : "+v"(fr), "+v"(fq));
        const int row0 = u.pm * BM + wr * 64 + fr, col0 = u.pn * BM + wc * 32 + 8 * fq;
#pragma unroll
        for (int ai = 0; ai < 2; ++ai)
#pragma unroll
            for (int m = 0; m < 4; ++m) { const int row = row0 + ai * HALF + m * 16; const size_t off = (size_t)row * D + col0; float s = 0.f;
#pragma unroll
                for (int bj = 0; bj < 2; ++bj) { f32x4 r0, r1; unpack8(*(const u32x4*)(resid_b + off + bj * HALF), r0, r1);
                    const f32x4 v0 = acc[ai][bj][m][0] + r0, v1 = acc[ai][bj][m][1] + r1;
                    if (xout && st) { *(f32x4*)(xout + off + bj * HALF) = v0; *(f32x4*)(xout + off + bj * HALF + 4) = v1; }
                    if (xb && st) *(u32x4*)(xb + off + bj * HALF) = pack8(v0, v1);
                    s += ((v0[0] * v0[0] + v0[1] * v0[1]) + (v0[2] * v0[2] + v0[3] * v0[3])) + ((v1[0] * v1[0] + v1[1] * v1[1]) + (v1[2] * v1[2] + v1[3] * v1[3])); }
                s += swz_xor<16>(s); s = half_sum(s);
                if (fq == 0 && rssp && st) rssp[(size_t)row * 16 + u.pn * 4 + wc] = s; }
    }
};
struct EpiFfn {
    static constexpr bool PERM = true, AFTER_DRAIN = false;
    bf16_t* H; const PG8_LAS float* rstab;
    __device__ __forceinline__ void operator()(const f32x4 (&acc)[2][2][4][2], const Unit& u, int wr, int wc, int fr, int fq) const {
        asm volatile("" : "+v"(fr), "+v"(fq));
        const int row0 = u.pm * BM + wr * 64 + fr, col0 = u.pn * HALF + wc * 32 + 8 * fq;
        float rs[2][4]; row_rstd(rstab, u, wr, fr, rs);
#pragma unroll
        for (int ai = 0; ai < 2; ++ai)
#pragma unroll
            for (int m = 0; m < 4; ++m) { const float r = rs[ai][m]; f32x4 g0 = acc[ai][0][m][0] * r, g1 = acc[ai][0][m][1] * r; const f32x4 u0 = acc[ai][1][m][0] * r, u1 = acc[ai][1][m][1] * r;
#pragma unroll
                for (int x = 0; x < 4; ++x) { g0[x] = siluf_(g0[x]) * u0[x]; g1[x] = siluf_(g1[x]) * u1[x]; }
                *(u32x4*)(H + (size_t)(row0 + ai * HALF + m * 16) * FF + col0) = pack8(g0, g1); asm volatile("" ::: "memory"); }
    }
};
template <class Epi, class Sched, bool ALIGN_EPI = false, bool SP2 = false>
__device__ __forceinline__ void gemm_phase(PG8_LAS unsigned char* lds, const Gemm g, const Sched& S, const Epi& E, const int tid) {
    const int wid = __builtin_amdgcn_readfirstlane(tid >> 6), lane = tid & 63, wr = wid >> 2, wc = wid & 3, fr = lane & 15, fq = lane >> 4;
    const int K = g.K, nt = K / BK;
    unsigned voffA[2], voffB[2];
#pragma unroll
    for (int i = 0; i < 2; ++i) { int R, C; stage_rc(tid * 16 + i * 8192, R, C); const int Rb = Epi::PERM ? ((R & ~31) + perm32(R & 31)) : R;
        voffA[i] = (unsigned)(R * K + C) * 2u; voffB[i] = (unsigned)(Rb * K + C) * 2u; }
    const size_t kstep = (size_t)(BK * 2);
    const size_t hstep = (size_t)HALF * K * 2;
    const unsigned ldsw = (unsigned)wid * 1024u;
    const int aoff = lds_byte(wr * 64 + fr, fq * 8), boff = lds_byte(wc * 32 + fr, fq * 8);
#define PG8_SA(b, h) (((b) * 2 + (h)) * HTB)
#define PG8_SB(b, h) ((4 + (b) * 2 + (h)) * HTB)
#define PG8_STAGE(bufoff, gbase, voff) do { _Pragma("unroll") for (int _i = 0; _i < 2; ++_i) \
        __builtin_amdgcn_global_load_lds((const unsigned*)((const char*)(gbase) + (voff)[_i]), (PG8_LAS unsigned*)(lds + (bufoff) + ldsw + _i * 8192), 16, 0, 0); } while (0)
#define PG8_LDA(dst, b, h) do { _Pragma("unroll") for (int m = 0; m < 4; ++m) _Pragma("unroll") for (int k = 0; k < 2; ++k) dst[m][k] = *(const PG8_LAS bf16x8*)(lds + PG8_SA(b, h) + aoff + m * 2048 + k * 1024); } while (0)
#define PG8_LDB(dst, b, h) do { _Pragma("unroll") for (int n = 0; n < 2; ++n) _Pragma("unroll") for (int k = 0; k < 2; ++k) dst[n][k] = *(const PG8_LAS bf16x8*)(lds + PG8_SB(b, h) + boff + n * 2048 + k * 1024); } while (0)
#define PG8_MMA(ai, bj, At, Bt) do { __builtin_amdgcn_s_setprio(1); _Pragma("unroll") for (int m = 0; m < 4; ++m) _Pragma("unroll") for (int n = 0; n < 2; ++n) _Pragma("unroll") for (int k = 0; k < 2; ++k) \
        acc[ai][bj][m][n] = __builtin_amdgcn_mfma_f32_16x16x32_bf16(Bt[n][k], At[m][k], acc[ai][bj][m][n], 0, 0, 0); __builtin_amdgcn_s_setprio(0); } while (0)
#define PG8_WAIT_V(n) asm volatile("s_waitcnt vmcnt(" #n ")" ::: "memory")
#define PG8_WAIT_L(n) asm volatile("s_waitcnt lgkmcnt(" #n ")" ::: "memory")
#define PG8_BAR __builtin_amdgcn_s_barrier()
#define PG8_SCHED __builtin_amdgcn_sched_barrier(0)
    Unit cur, nxt; int ui = 0;
    if (!S.next(0, cur)) return;
    f32x4 acc[2][2][4][2];
#pragma unroll
    for (int a = 0; a < 2; ++a)
#pragma unroll
        for (int b = 0; b < 2; ++b)
#pragma unroll
            for (int m = 0; m < 4; ++m)
#pragma unroll
                for (int n = 0; n < 2; ++n) acc[a][b][m][n] = (f32x4){0.f, 0.f, 0.f, 0.f};
    bf16x8 At[4][2], B0[2][2], B1[2][2];
    const char* cA = S.pa(cur, g); const char* cB = S.pb(cur, g);
    S.a_ready(cur);
    if constexpr (SP2) {
        PG8_STAGE(PG8_SB(0, 0), cB, voffB); PG8_STAGE(PG8_SB(0, 1), cB + hstep, voffB); PG8_STAGE(PG8_SA(0, 0), cA, voffA); PG8_STAGE(PG8_SA(0, 1), cA + hstep, voffA);
        if (wr == 1) PG8_BAR;
        PG8_WAIT_V(2); PG8_BAR;
        PG8_STAGE(PG8_SB(1, 0), cB + kstep, voffB); PG8_STAGE(PG8_SA(1, 0), cA + kstep, voffA); PG8_STAGE(PG8_SB(1, 1), cB + hstep + kstep, voffB);
        PG8_WAIT_V(6); PG8_BAR;
    } else {
        PG8_STAGE(PG8_SB(0, 0), cB, voffB); PG8_STAGE(PG8_SA(0, 0), cA, voffA); PG8_STAGE(PG8_SB(0, 1), cB + hstep, voffB); PG8_STAGE(PG8_SA(0, 1), cA + hstep, voffA);
        if (wr == 1) PG8_BAR;
        PG8_WAIT_V(4); PG8_BAR;
        PG8_STAGE(PG8_SB(1, 0), cB + kstep, voffB); PG8_STAGE(PG8_SA(1, 0), cA + kstep, voffA); PG8_STAGE(PG8_SB(1, 1), cB + hstep + kstep, voffB);
        PG8_WAIT_V(6); PG8_BAR;
    }
    for (;;) {
        const bool has_next = S.next(ui + 1, nxt);
        const char* nA = has_next ? S.pa(nxt, g) : cA; const char* nB = has_next ? S.pb(nxt, g) : cB;
        for (int t = 0; t < nt; t += 2) {
            const bool last = (t == nt - 2);
            const char* a1 = cA + (size_t)(t + 1) * kstep;
            const char* a2 = last ? nA : cA + (size_t)(t + 2) * kstep; const char* b2 = last ? nB : cB + (size_t)(t + 2) * kstep;
            const char* a3 = a2 + kstep; const char* b3 = b2 + kstep;
            if (last && has_next) S.a_ready(nxt);
            if constexpr (SP2) {
            PG8_LDB(B0, 0, 0); PG8_LDB(B1, 0, 1); PG8_SCHED; PG8_LDA(At, 0, 0); PG8_STAGE(PG8_SA(1, 1), a1 + hstep, voffA);
            PG8_WAIT_V(8); PG8_WAIT_L(0); PG8_BAR; PG8_MMA(0, 0, At, B0); PG8_MMA(0, 1, At, B1); PG8_BAR; PG8_SCHED;
            PG8_LDA(At, 0, 1); PG8_STAGE(PG8_SB(0, 0), b2, voffB); PG8_STAGE(PG8_SB(0, 1), b2 + hstep, voffB); PG8_STAGE(PG8_SA(0, 0), a2, voffA);
            PG8_WAIT_V(8); PG8_WAIT_L(0); PG8_BAR; PG8_MMA(1, 0, At, B0); PG8_MMA(1, 1, At, B1); PG8_BAR; PG8_SCHED;
            PG8_LDB(B0, 1, 0); PG8_LDB(B1, 1, 1); PG8_SCHED; PG8_LDA(At, 1, 0); PG8_STAGE(PG8_SA(0, 1), a2 + hstep, voffA);
            PG8_WAIT_V(8); PG8_WAIT_L(0); PG8_BAR; PG8_MMA(0, 0, At, B0); PG8_MMA(0, 1, At, B1); PG8_BAR; PG8_SCHED;
            PG8_LDA(At, 1, 1); PG8_STAGE(PG8_SB(1, 0), b3, voffB); PG8_STAGE(PG8_SB(1, 1), b3 + hstep, voffB); PG8_STAGE(PG8_SA(1, 0), a3, voffA);
            PG8_WAIT_V(8); PG8_WAIT_L(0); PG8_BAR; PG8_MMA(1, 0, At, B0); PG8_MMA(1, 1, At, B1); PG8_BAR; PG8_SCHED;
            } else {
            PG8_LDB(B0, 0, 0); PG8_SCHED; PG8_LDA(At, 0, 0); PG8_STAGE(PG8_SA(1, 1), a1 + hstep, voffA);
            PG8_WAIT_L(8); PG8_BAR; PG8_WAIT_L(0); PG8_MMA(0, 0, At, B0); PG8_BAR; PG8_SCHED;
            PG8_LDB(B1, 0, 1); PG8_STAGE(PG8_SB(0, 0), b2, voffB);
            PG8_BAR; PG8_WAIT_L(0); PG8_MMA(0, 1, At, B1); PG8_BAR;
            PG8_LDA(At, 0, 1); PG8_STAGE(PG8_SA(0, 0), a2, voffA);
            PG8_BAR; PG8_WAIT_L(0); PG8_MMA(1, 0, At, B0); PG8_BAR; PG8_SCHED;
            PG8_STAGE(PG8_SB(0, 1), b2 + hstep, voffB);
            PG8_WAIT_V(6); PG8_BAR; PG8_MMA(1, 1, At, B1); PG8_BAR;
            PG8_LDB(B0, 1, 0); PG8_SCHED; PG8_LDA(At, 1, 0); PG8_STAGE(PG8_SA(0, 1), a2 + hstep, voffA);
            PG8_WAIT_L(8); PG8_BAR; PG8_WAIT_L(0); PG8_MMA(0, 0, At, B0); PG8_BAR; PG8_SCHED;
            PG8_LDB(B1, 1, 1); PG8_STAGE(PG8_SB(1, 0), b3, voffB);
            PG8_BAR; PG8_WAIT_L(0); PG8_MMA(0, 1, At, B1); PG8_BAR;
            PG8_LDA(At, 1, 1); PG8_STAGE(PG8_SA(1, 0), a3, voffA);
            PG8_BAR; PG8_WAIT_L(0); PG8_MMA(1, 0, At, B0); PG8_BAR; PG8_SCHED;
            PG8_STAGE(PG8_SB(1, 1), b3 + hstep, voffB);
            PG8_WAIT_V(6); PG8_BAR; PG8_MMA(1, 1, At, B1); PG8_BAR;
            }
        }
        if constexpr (ALIGN_EPI) { if (wr == 0) PG8_BAR; }
        if constexpr (!Epi::AFTER_DRAIN) { E(acc, cur, wr, wc, fr, fq); S.done(cur); }
        if (!has_next) break;
#pragma unroll
        for (int a = 0; a < 2; ++a)
#pragma unroll
            for (int b = 0; b < 2; ++b)
#pragma unroll
                for (int m = 0; m < 4; ++m)
#pragma unroll
                    for (int n = 0; n < 2; ++n) acc[a][b][m][n] = (f32x4){0.f, 0.f, 0.f, 0.f};
        cur = nxt; cA = nA; cB = nB; ++ui;
        if constexpr (ALIGN_EPI) { if (wr == 1) PG8_BAR; }
    }
    PG8_WAIT_V(0);
    if constexpr (!ALIGN_EPI) { if (wr == 0) PG8_BAR; }
    PG8_BAR;
    if constexpr (Epi::AFTER_DRAIN) { E.fused(acc, cur, wr, wc, fr, fq, lds, wid, lane); S.done(cur); }
#undef PG8_SA
#undef PG8_SB
#undef PG8_STAGE
#undef PG8_LDA
#undef PG8_LDB
#undef PG8_MMA
#undef PG8_WAIT_V
#undef PG8_WAIT_L
#undef PG8_BAR
#undef PG8_SCHED
}
}

constexpr int NWAVES = 8;
constexpr int RING_BYTES = 131072, LDSCTL_OFF = RING_BYTES, MISC_OFF = LDSCTL_OFF + 320, RSTD_OFF = RING_BYTES + 1024, LDS_BYTES = 147456;
constexpr int CW_BAR = 4096;
#define GAS __attribute__((address_space(1)))
#define LAS __attribute__((address_space(3)))
typedef GAS unsigned gu32;
#define RLX_AGENT __ATOMIC_RELAXED, __HIP_MEMORY_SCOPE_AGENT
#define XB_TMO      128
#define XB_XCNT(j)  (256  + 64 * (j))
#define XB_XSUB(j)  (1280 + 64 * (j))
#define XB_XGEN(j)  (2304 + 64 * (j))
#define XB_TOP      3328
#define XB_TOPGEN   3392
#define XCD_BAR_WORDS 3456
#define XB_SPIN_CAP (1u << 18)

__device__ __forceinline__ unsigned xb_ld(unsigned* p)              { return __hip_atomic_load(p, __ATOMIC_RELAXED, __HIP_MEMORY_SCOPE_AGENT); }
__device__ __forceinline__ unsigned xb_add(unsigned* p, unsigned v) { return __hip_atomic_fetch_add(p, v, __ATOMIC_RELAXED, __HIP_MEMORY_SCOPE_AGENT); }
__device__ __forceinline__ unsigned xb_xcc_id() { return (unsigned)__builtin_amdgcn_s_getreg((3 << 11) | 20) & 0xFu; }
#define XB_SPIN(cond, bar) do { unsigned _sp = 0; while (cond) { __builtin_amdgcn_s_sleep(1); \
    if ((++_sp & 255u) == 0u) { if (xb_ld(&(bar)[XB_TMO])) break; if (_sp > XB_SPIN_CAP) { atomicAdd(&(bar)[XB_TMO], 1u); break; } } } } while (0)

struct XcdBarrier {
    unsigned* bar; unsigned x; int w0;
    volatile LAS unsigned* st;
};

__device__ __forceinline__ XcdBarrier xcd_barrier_post(unsigned* bar, volatile LAS unsigned* st) {
    XcdBarrier b; b.bar = bar; b.x = xb_xcc_id(); b.st = st;
    if (threadIdx.x == 0) (void)xb_add(&bar[XB_XCNT(b.x)], 1u);
    return b;
}
__device__ __forceinline__ void xcd_barrier_complete(unsigned* bar, unsigned x, unsigned& nloc, unsigned& nx) {
    const unsigned G = gridDim.x * gridDim.y * gridDim.z;
    unsigned sum, cnt, mine, sp = 0u;
    for (;;) {
        sum = 0u; cnt = 0u; mine = 0u;
#pragma unroll
        for (unsigned j = 0; j < 16; ++j) { const unsigned c = xb_ld(&bar[XB_XCNT(j)]); sum += c; cnt += (c > 0u) ? 1u : 0u; mine = (j == x) ? c : mine; }
        if (sum == G) break;
        __builtin_amdgcn_s_sleep(1);
        if ((++sp & 255u) == 0u) { if (xb_ld(&bar[XB_TMO])) break; if (sp > XB_SPIN_CAP) { atomicAdd(&bar[XB_TMO], 1u); break; } }
    }
    nloc = mine > 0u ? mine : 1u; nx = cnt > 0u ? cnt : 1u;
}

__device__ __forceinline__ void xcd_barrier(const XcdBarrier& b) {
    asm volatile("s_waitcnt vmcnt(0)" ::: "memory");
    __syncthreads();
    int ln_; asm volatile("v_mbcnt_lo_u32_b32 %0, -1, 0\n\tv_mbcnt_hi_u32_b32 %0, -1, %0" : "=v"(ln_));
    if (b.w0 == 0 && ln_ == 0) {
        unsigned* bar = b.bar;
        __builtin_amdgcn_s_waitcnt(0);
        unsigned nloc = b.st[0], nx = b.st[1];
        if (nloc == 0u) { xcd_barrier_complete(bar, b.x, nloc, nx); b.st[0] = nloc; b.st[1] = nx; }
        const unsigned old = xb_add(&bar[XB_XSUB(b.x)], 1u);
        const unsigned gen = old / nloc;
        if (old + 1u == (gen + 1u) * nloc) {
            __builtin_amdgcn_fence(__ATOMIC_RELEASE, "agent");
            asm volatile("s_waitcnt vmcnt(0)" ::: "memory");
            const unsigned og = xb_add(&bar[XB_TOP], 1u);
            const unsigned tg = og / nx;
            if (og + 1u == (tg + 1u) * nx) xb_add(&bar[XB_TOPGEN], 1u);
            else XB_SPIN(xb_ld(&bar[XB_TOPGEN]) == tg, bar);
            __builtin_amdgcn_fence(__ATOMIC_ACQUIRE, "agent");
            xb_add(&bar[XB_XGEN(b.x)], 1u);
            asm volatile("s_waitcnt vmcnt(0)" ::: "memory");
        } else {
            XB_SPIN(xb_ld(&bar[XB_XGEN(b.x)]) == gen, bar);
            __builtin_amdgcn_fence(__ATOMIC_ACQUIRE, "agent");
            asm volatile("s_waitcnt vmcnt(0)" ::: "memory");
        }
    }
    __syncthreads();
}

constexpr size_t WS_RSSP = WS_RSS;
constexpr size_t WS_DL = 248 * MiB + 256 * 1024;
constexpr size_t WS_YC = WS_MQ;
constexpr size_t WS_YA = WS_SR;
constexpr size_t WS_MERGED2 = 214 * MiB;
constexpr size_t WS_S2 = 232 * MiB;
constexpr size_t WS_END2 = 249 * MiB;


namespace mix {
typedef unsigned u32x4 __attribute__((ext_vector_type(4)));
typedef unsigned u32x2 __attribute__((ext_vector_type(2)));
#define MIX_LAS __attribute__((address_space(3)))
using pg8::pack8; using pg8::unpack8; using pg8::cvt_pk_bf16;
#define MIX_BAR() do { asm volatile("s_waitcnt vmcnt(0) lgkmcnt(0)" ::: "memory"); __builtin_amdgcn_s_barrier(); asm volatile("" ::: "memory"); } while (0)

__device__ __forceinline__ void prepass_item(unsigned char* ws, const float* qw, const float* kw, int b, int blk, int h, MIX_LAS float* part, int tid, int lane, int wave) {
    const int sub = lane >> 4, c8 = (lane & 15) * 8;
    f32x4 qw0 = *(const f32x4*)(qw + c8) * QSCALE, qw1 = *(const f32x4*)(qw + c8 + 4) * QSCALE; const f32x4 kw0 = *(const f32x4*)(kw + c8), kw1 = *(const f32x4*)(kw + c8 + 4);
    f32x4 cs0 = {0.f, 0.f, 0.f, 0.f}, cs1 = cs0;
    bf16_t* MQ = (bf16_t*)(ws + WS_MQ); bf16_t* MK = (bf16_t*)(ws + WS_MK);
#pragma unroll 4
    for (int it = 0; it < 8; ++it) {
        const size_t off = ((size_t)b * SEQ + blk * 256 + wave * 32 + it * 4 + sub) * 512 + h * 128 + c8;
        { f32x4 a, c; unpack8(*(const u32x4*)(MQ + off), a, c); float ss = ((a[0] * a[0] + a[1] * a[1]) + (a[2] * a[2] + a[3] * a[3])) + ((c[0] * c[0] + c[1] * c[1]) + (c[2] * c[2] + c[3] * c[3]));
          ss += swz_xor<1>(ss); ss += swz_xor<2>(ss); ss += swz_xor<4>(ss); ss += swz_xor<8>(ss); const float rs = rsqrtf(ss * (1.f / 128.f) + EPS);
          *(u32x4*)(MQ + off) = pack8(a * rs * qw0, c * rs * qw1); }
        { f32x4 a, c; unpack8(*(const u32x4*)(MK + off), a, c); float ss = ((a[0] * a[0] + a[1] * a[1]) + (a[2] * a[2] + a[3] * a[3])) + ((c[0] * c[0] + c[1] * c[1]) + (c[2] * c[2] + c[3] * c[3]));
          ss += swz_xor<1>(ss); ss += swz_xor<2>(ss); ss += swz_xor<4>(ss); ss += swz_xor<8>(ss); const float rs = rsqrtf(ss * (1.f / 128.f) + EPS);
          a = a * rs * kw0; c = c * rs * kw1; cs0 += a; cs1 += c; *(u32x4*)(MK + off) = pack8(a, c); }
    }
#pragma unroll
    for (int j = 0; j < 4; ++j) { cs0[j] += swz_xor<16>(cs0[j]); cs0[j] = half_sum(cs0[j]); cs1[j] += swz_xor<16>(cs1[j]); cs1[j] = half_sum(cs1[j]); }
    if (sub == 0) { *(MIX_LAS f32x4*)(part + wave * 128 + c8) = cs0; *(MIX_LAS f32x4*)(part + wave * 128 + c8 + 4) = cs1; }
    MIX_BAR();
    if (tid < 128) { float s = 0.f;
#pragma unroll
        for (int w = 0; w < 8; ++w) s += part[w * 128 + tid];
        ((float*)(ws + WS_KMEAN))[(((size_t)b * 4 + h) * 8 + blk) * 128 + tid] = s * (1.f / 256.f); }
    MIX_BAR();
}

constexpr int PSTR = 272;
__device__ __forceinline__ void pool_item(unsigned char* ws, const float* pscale, int pm, int g, MIX_LAS unsigned char* lds, int tid, int lane, int wave) {
    MIX_LAS unsigned char* P = lds; MIX_LAS unsigned char* W = lds + 256 * PSTR;
    const bf16_t* PW = (const bf16_t*)(ws + WS_W + W_PW) + g * 128 * 128;
#pragma unroll
    for (int j = 0; j < 4; ++j) { const int id = tid + 512 * j, e = id >> 4, cc = id & 15; *(MIX_LAS u32x4*)(W + e * PSTR + cc * 16) = *(const u32x4*)(PW + e * 128 + cc * 8); }
    {
        const int cp = tid & 63, seg = tid >> 6, w = 2 << g; const int row0 = pm * 256 + seg * 32, t0 = row0 & (SEQ - 1);
        const unsigned* PU = (const unsigned*)(ws + WS_PU) + g * 64 + cp;
        float s0 = 0.f, s1 = 0.f;
        for (int j = 1; j < w; ++j) if (t0 - j >= 0) { const unsigned v = PU[(size_t)(row0 - j) * 256]; s0 += __uint_as_float(v << 16); s1 += __uint_as_float(v & 0xffff0000u); }
#pragma unroll 8
        for (int r = 0; r < 32; ++r) {
            const int t = t0 + r; const unsigned v = PU[(size_t)(row0 + r) * 256]; const float u0 = __uint_as_float(v << 16), u1 = __uint_as_float(v & 0xffff0000u);
            s0 += u0; s1 += u1; const float ic = 1.f / (float)min(t + 1, w);
            *(MIX_LAS unsigned*)(P + (seg * 32 + r) * PSTR + cp * 4) = cvt_pk_bf16(s0 * ic - u0, s1 * ic - u1);
            if (t - w + 1 >= 0) { const unsigned o = PU[(size_t)(row0 + r - w + 1) * 256]; s0 -= __uint_as_float(o << 16); s1 -= __uint_as_float(o & 0xffff0000u); }
        }
    }
    MIX_BAR();
    f32x4 acc[8][2];
#pragma unroll
    for (int n = 0; n < 8; ++n) { acc[n][0] = (f32x4){0.f, 0.f, 0.f, 0.f}; acc[n][1] = acc[n][0]; }
    const int r = lane & 15, q = lane >> 4;
#pragma unroll
    for (int kk = 0; kk < 4; ++kk) {
        bf16x8 pf[2];
#pragma unroll
        for (int m = 0; m < 2; ++m) pf[m] = *(const MIX_LAS bf16x8*)(P + (wave * 32 + m * 16 + r) * PSTR + (kk * 32 + 8 * q) * 2);
#pragma unroll
        for (int n = 0; n < 8; ++n) { const bf16x8 wf = *(const MIX_LAS bf16x8*)(W + (n * 16 + r) * PSTR + (kk * 32 + 8 * q) * 2);
#pragma unroll
            for (int m = 0; m < 2; ++m) acc[n][m] = __builtin_amdgcn_mfma_f32_16x16x32_bf16(wf, pf[m], acc[n][m], 0, 0, 0); }
    }
    bf16_t* YB = (bf16_t*)(ws + WS_YB);
#pragma unroll
    for (int n = 0; n < 8; ++n) { const f32x4 sc = *(const f32x4*)(pscale + g * 128 + n * 16 + 4 * q);
#pragma unroll
        for (int m = 0; m < 2; ++m) { const f32x4 y = acc[n][m] * sc; u32x2 o; o.x = cvt_pk_bf16(y[0], y[1]); o.y = cvt_pk_bf16(y[2], y[3]);
            *(u32x2*)(YB + (size_t)(pm * 256 + wave * 32 + m * 16 + r) * 512 + g * 128 + n * 16 + 4 * q) = o; } }
    MIX_BAR();
}

constexpr int GSTR = 144;
constexpr int GL_SEG = 0, GL_QE = 1024, GL_KE = GL_QE + 64 * GSTR, GL_VT = GL_KE + 64 * GSTR, GL_P = GL_VT + 128 * GSTR, GL_HALF = 49152;
__device__ __forceinline__ void gla_cumsum(const float* GG, size_t row0, int h, MIX_LAS unsigned char* lds, int d, int seg, float (&bc)[16], float& bL) {
    const float* g = GG + (row0 + seg * 16) * 256 + h * 64 + d; float c = 0.f;
#pragma unroll
    for (int j = 0; j < 16; ++j) { c += g[j * 256]; bc[j] = c; }
    MIX_LAS float* SEG = (MIX_LAS float*)(lds + GL_SEG); SEG[seg * 64 + d] = c;
    MIX_BAR();
    float off = 0.f, tot = 0.f;
#pragma unroll
    for (int s = 0; s < 4; ++s) { const float v = SEG[s * 64 + d]; tot += v; off += (s < seg) ? v : 0.f; }
#pragma unroll
    for (int j = 0; j < 16; ++j) bc[j] += off;
    bL = tot;
}
__device__ __forceinline__ void gla_vt(const bf16_t* GV, size_t row0, int h, MIX_LAS unsigned char* lds, int t8) {
    const int e = t8 & 127, tq = t8 >> 7; const bf16_t* v = GV + (row0 + tq * 32) * 512 + h * 128 + e; unsigned w[16];
#pragma unroll
    for (int j = 0; j < 16; ++j) w[j] = (unsigned)v[(2 * j) * 512] | ((unsigned)v[(2 * j + 1) * 512] << 16);
    MIX_LAS u32x4* p = (MIX_LAS u32x4*)(lds + GL_VT + e * GSTR + tq * 64);
#pragma unroll
    for (int j = 0; j < 4; ++j) p[j] = (u32x4){w[4 * j], w[4 * j + 1], w[4 * j + 2], w[4 * j + 3]};
}
__device__ __forceinline__ void gla_passA_pair(unsigned char* ws, int pair, MIX_LAS unsigned char* lds0, int tid, int lane, int wave) {
    const int hb = tid >> 8, t8 = tid & 255, w4 = wave & 3, cid = 2 * pair + hb; MIX_LAS unsigned char* lds = lds0 + hb * GL_HALF;
    const int d = t8 & 63, seg = t8 >> 6, bh = cid >> 5, n = cid & 31, b = bh >> 2, h = bh & 3; const size_t row0 = (size_t)b * SEQ + n * 64;
    float bc[16], bL;
    const bf16_t* gk = (const bf16_t*)(ws + WS_GK) + (row0 + seg * 16) * 256 + h * 64 + d; float kv[16];
#pragma unroll
    for (int j = 0; j < 16; ++j) kv[j] = bf2f(gk[j * 256]);
    gla_vt((const bf16_t*)(ws + WS_GV), row0, h, lds, t8);
    gla_cumsum((const float*)(ws + WS_GG), row0, h, lds, d, seg, bc, bL);
#pragma unroll
    for (int j8 = 0; j8 < 2; ++j8) { f32x4 a, c;
#pragma unroll
      for (int j = 0; j < 4; ++j) { a[j] = kv[8 * j8 + j] * __expf(bL - bc[8 * j8 + j]); c[j] = kv[8 * j8 + 4 + j] * __expf(bL - bc[8 * j8 + 4 + j]); }
      *(MIX_LAS u32x4*)(lds + GL_KE + d * GSTR + seg * 32 + j8 * 16) = pack8(a, c); }
    if (seg == 0) ((float*)(ws + WS_DL))[(size_t)cid * 64 + d] = __expf(bL);
    MIX_BAR();
    const int r = lane & 15, q = lane >> 4; f32x4 acc[2][4];
#pragma unroll
    for (int ee = 0; ee < 2; ++ee)
#pragma unroll
        for (int dt = 0; dt < 4; ++dt) acc[ee][dt] = (f32x4){0.f, 0.f, 0.f, 0.f};
#pragma unroll
    for (int kk = 0; kk < 2; ++kk) { bf16x8 kf[4];
#pragma unroll
        for (int dt = 0; dt < 4; ++dt) kf[dt] = *(const MIX_LAS bf16x8*)(lds + GL_KE + (dt * 16 + r) * GSTR + (kk * 32 + 8 * q) * 2);
#pragma unroll
        for (int ee = 0; ee < 2; ++ee) { const bf16x8 vf = *(const MIX_LAS bf16x8*)(lds + GL_VT + ((2 * w4 + ee) * 16 + r) * GSTR + (kk * 32 + 8 * q) * 2);
#pragma unroll
            for (int dt = 0; dt < 4; ++dt) acc[ee][dt] = __builtin_amdgcn_mfma_f32_16x16x32_bf16(kf[dt], vf, acc[ee][dt], 0, 0, 0); } }
#pragma unroll
    for (int ee = 0; ee < 2; ++ee) { bf16_t* US = (bf16_t*)(ws + WS_US) + ((size_t)cid * 128 + (2 * w4 + ee) * 16 + r) * 64;
#pragma unroll
        for (int dt = 0; dt < 4; ++dt) { u32x2 o; o.x = cvt_pk_bf16(acc[ee][dt][0], acc[ee][dt][1]); o.y = cvt_pk_bf16(acc[ee][dt][2], acc[ee][dt][3]); *(u32x2*)(US + dt * 16 + 4 * q) = o; } }
    MIX_BAR();
}
__device__ __forceinline__ void gla_scan(unsigned char* ws, int gtid) {
    const int bh = gtid >> 12, e = (gtid >> 5) & 127, dp = gtid & 31;
    const size_t uoff = (((size_t)bh * 32) * 128 + e) * 32 + dp; const unsigned* US = (const unsigned*)(ws + WS_US) + uoff; unsigned* S2 = (unsigned*)(ws + WS_S2) + uoff; const float* DLp = (const float*)(ws + WS_DL) + (size_t)bh * 32 * 64 + 2 * dp;
    float s0 = 0.f, s1 = 0.f;
#pragma unroll 8
    for (int n = 0; n < 32; ++n) { const unsigned u = US[(size_t)n * 128 * 32]; const float d0 = DLp[n * 64], d1 = DLp[n * 64 + 1];
        S2[(size_t)n * 128 * 32] = cvt_pk_bf16(s0, s1);
        s0 = d0 * s0 + __uint_as_float(u << 16); s1 = d1 * s1 + __uint_as_float(u & 0xffff0000u); }
}
__device__ __forceinline__ void gla_passC_pair(unsigned char* ws, const float* nw, int pair, MIX_LAS unsigned char* lds0, int tid, int lane, int wave, size_t ya_off) {
    const int hb = tid >> 8, t8 = tid & 255, w4 = wave & 3, cid = 2 * pair + hb; MIX_LAS unsigned char* lds = lds0 + hb * GL_HALF;
    const int d = t8 & 63, seg = t8 >> 6, bh = cid >> 5, n = cid & 31, b = bh >> 2, h = bh & 3; const size_t row0 = (size_t)b * SEQ + n * 64;
    const int r = lane & 15, q = lane >> 4, it = w4;
    const size_t yoff = (row0 + it * 16 + r) * 512 + h * 128 + 4 * q; u32x2 srv[8];
#pragma unroll
    for (int et = 0; et < 8; ++et) srv[et] = *(const u32x2*)((const bf16_t*)(ws + WS_SR) + yoff + et * 16);
    bf16x8 sfr[8][2]; { const bf16_t* ST = (const bf16_t*)(ws + WS_S2) + (size_t)cid * 128 * 64;
#pragma unroll
        for (int et = 0; et < 8; ++et)
#pragma unroll
            for (int kk = 0; kk < 2; ++kk) sfr[et][kk] = *(const bf16x8*)(ST + (et * 16 + r) * 64 + kk * 32 + 8 * q); }
    float bc[16], bL;
    {
        const bf16_t* gk = (const bf16_t*)(ws + WS_GK) + (row0 + seg * 16) * 256 + h * 64 + d; const bf16_t* gq = (const bf16_t*)(ws + WS_GQ) + (row0 + seg * 16) * 256 + h * 64 + d; float kv[16], qv[16];
#pragma unroll
        for (int j = 0; j < 16; ++j) { kv[j] = bf2f(gk[j * 256]); qv[j] = bf2f(gq[j * 256]); }
        gla_vt((const bf16_t*)(ws + WS_GV), row0, h, lds, t8);
        gla_cumsum((const float*)(ws + WS_GG), row0, h, lds, d, seg, bc, bL);
#pragma unroll
        for (int j = 0; j < 16; ++j) { const float ex = __expf(bc[j]);
            *(MIX_LAS bf16_t*)(lds + GL_QE + (seg * 16 + j) * GSTR + 2 * d) = f2bf(qv[j] * ex);
            *(MIX_LAS bf16_t*)(lds + GL_KE + (seg * 16 + j) * GSTR + 2 * d) = f2bf(kv[j] * __expf(-bc[j])); }
    }
    MIX_BAR();
    bf16x8 qf[2];
#pragma unroll
    for (int kk = 0; kk < 2; ++kk) qf[kk] = *(const MIX_LAS bf16x8*)(lds + GL_QE + (it * 16 + r) * GSTR + (kk * 32 + 8 * q) * 2);
#pragma unroll
    for (int jt = 0; jt < 4; ++jt) { f32x4 acc = {0.f, 0.f, 0.f, 0.f};
        if (jt <= it) {
#pragma unroll
            for (int kk = 0; kk < 2; ++kk) { const bf16x8 kf = *(const MIX_LAS bf16x8*)(lds + GL_KE + (jt * 16 + r) * GSTR + (kk * 32 + 8 * q) * 2);
                acc = __builtin_amdgcn_mfma_f32_16x16x32_bf16(qf[kk], kf, acc, 0, 0, 0); }
            if (jt == it) {
#pragma unroll
                for (int x = 0; x < 4; ++x) if (r > 4 * q + x) acc[x] = 0.f; } }
#pragma unroll
        for (int x = 0; x < 4; ++x) *(MIX_LAS bf16_t*)(lds + GL_P + (it * 16 + 4 * q + x) * GSTR + (jt * 16 + r) * 2) = f2bf(acc[x]); }
    asm volatile("s_waitcnt lgkmcnt(0)" ::: "memory");
    bf16x8 pf[2];
#pragma unroll
    for (int kk = 0; kk < 2; ++kk) pf[kk] = *(const MIX_LAS bf16x8*)(lds + GL_P + (it * 16 + r) * GSTR + (kk * 32 + 8 * q) * 2);
    f32x4 acc[8]; float ss = 0.f;
#pragma unroll
    for (int et = 0; et < 8; ++et) { acc[et] = (f32x4){0.f, 0.f, 0.f, 0.f};
#pragma unroll
        for (int kk = 0; kk < 2; ++kk) { const bf16x8 vf = *(const MIX_LAS bf16x8*)(lds + GL_VT + (et * 16 + r) * GSTR + (kk * 32 + 8 * q) * 2);
            const bf16x8 sf = sfr[et][kk];
            acc[et] = __builtin_amdgcn_mfma_f32_16x16x32_bf16(vf, pf[kk], acc[et], 0, 0, 0);
            acc[et] = __builtin_amdgcn_mfma_f32_16x16x32_bf16(sf, qf[kk], acc[et], 0, 0, 0); } }
#pragma unroll
    for (int et = 0; et < 8; ++et) ss += (acc[et][0] * acc[et][0] + acc[et][1] * acc[et][1]) + (acc[et][2] * acc[et][2] + acc[et][3] * acc[et][3]);
    ss += swz_xor<16>(ss); ss = half_sum(ss);
    const float rstd = rsqrtf(ss * (1.f / 128.f) + EPS);
    bf16_t* YA = (bf16_t*)(ws + ya_off) + yoff;
#pragma unroll
    for (int et = 0; et < 8; ++et) { const u32x2 sr = srv[et]; const f32x4 w4v = *(const f32x4*)(nw + et * 16 + 4 * q);
        const float y0 = acc[et][0] * rstd * w4v[0] * __uint_as_float(sr.x << 16), y1 = acc[et][1] * rstd * w4v[1] * __uint_as_float(sr.x & 0xffff0000u);
        const float y2 = acc[et][2] * rstd * w4v[2] * __uint_as_float(sr.y << 16), y3 = acc[et][3] * rstd * w4v[3] * __uint_as_float(sr.y & 0xffff0000u);
        u32x2 o; o.x = cvt_pk_bf16(y0, y1); o.y = cvt_pk_bf16(y2, y3); *(u32x2*)(YA + et * 16) = o; }
    MIX_BAR();
}
}

namespace moba {
typedef short s16x4 __attribute__((ext_vector_type(4)));
typedef float f32x16 __attribute__((ext_vector_type(16)));
typedef unsigned u32x4 __attribute__((ext_vector_type(4)));
using pg8::cvt_pk_bf16;
constexpr int D = 128, LD = 512, NW = 8, QBLK = 32, KVBLK = 128, QB = 256;
constexpr int SHM_V = KVBLK * D * 2, SHM_K = KVBLK * D * 2;
constexpr int LDS_WS = 131072 + 1024, LDS_TAB = LDS_WS + NW * 64 * 4, LDS_BYTES = LDS_TAB + 512;
constexpr float THR2 = 11.5f;
#define KSWZ(row, colB) ((row) * 256 + ((colB) ^ (((row) & 7) << 4)))
#define SBAR() __builtin_amdgcn_sched_barrier(0)
__device__ __forceinline__ int v_st(int k, int c) { const int kk = (k & ~0xC) | ((k & 4) << 1) | ((k & 8) >> 1); return ((kk >> 3) * 4 + (c >> 5)) * 512 + ((kk & 7) * 32 + (c & 31)) * 2; }
__device__ __forceinline__ int v_rd_base(int lane) { return ((lane & 3) << 3) | (((lane >> 2) & 3) << 6) | (((lane >> 4) & 1) << 5) | (((lane >> 5) & 1) << 8); }
constexpr int v_rd_off(int d0, int ks, int half) { return d0 * 512 + ks * 4096 + half * 2048; }
__device__ __forceinline__ int crow(int r, int hi) { return (r & 3) + 8 * (r >> 2) + 4 * hi; }
__device__ __forceinline__ bf16x8 load8(const bf16_t* p) { return *reinterpret_cast<const bf16x8*>(p); }

__device__ __forceinline__ void partialSM(f32x16& p0, f32x16& p1, float& m_reg, float& mn, float& alpha) {
    float pmax = p0[0];
#pragma unroll
    for (int r = 1; r < 16; ++r) pmax = fmaxf(pmax, p0[r]);
#pragma unroll
    for (int r = 0; r < 16; ++r) pmax = fmaxf(pmax, p1[r]);
    { auto rr = __builtin_amdgcn_permlane32_swap(__float_as_uint(pmax), __float_as_uint(pmax), false, false); pmax = fmaxf(__uint_as_float(rr[0]), __uint_as_float(rr[1])); }
    if (__builtin_expect(__all((pmax - m_reg) <= THR2), 1)) { mn = m_reg; alpha = 1.f; }
    else { mn = fmaxf(m_reg, pmax); alpha = __builtin_amdgcn_exp2f(m_reg - mn); m_reg = mn; }
#pragma unroll
    for (int r = 0; r < 16; ++r) p0[r] = p0[r] - mn;
#pragma unroll
    for (int r = 0; r < 16; ++r) p1[r] = p1[r] - mn;
#pragma unroll
    for (int r = 0; r < 16; ++r) p0[r] = __builtin_amdgcn_exp2f(p0[r]);
}
__device__ __forceinline__ void finishSM(f32x16& p0, f32x16& p1, float alpha, float& l_reg, bf16x8& pa0, bf16x8& pa1, bf16x8& pa2, bf16x8& pa3) {
#pragma unroll
    for (int r = 0; r < 16; ++r) p1[r] = __builtin_amdgcn_exp2f(p1[r]);
    float ps = 0;
#pragma unroll
    for (int r = 0; r < 16; ++r) ps += p0[r];
#pragma unroll
    for (int r = 0; r < 16; ++r) ps += p1[r];
    { auto rr = __builtin_amdgcn_permlane32_swap(__float_as_uint(ps), __float_as_uint(ps), false, false); ps = __uint_as_float(rr[0]) + __uint_as_float(rr[1]); }
    l_reg = l_reg * alpha + ps;
#define PK4(P, B_, OUT) do { unsigned a0 = cvt_pk_bf16(P[B_+0], P[B_+1]), a1 = cvt_pk_bf16(P[B_+2], P[B_+3]);                          \
        unsigned b0 = cvt_pk_bf16(P[B_+4], P[B_+5]), b1 = cvt_pk_bf16(P[B_+6], P[B_+7]);                                             \
        auto r0 = __builtin_amdgcn_permlane32_swap(a0, b0, false, false); auto r1 = __builtin_amdgcn_permlane32_swap(a1, b1, false, false); \
        u32x4 w = {r0[0], r1[0], r0[1], r1[1]}; OUT = *reinterpret_cast<bf16x8*>(&w); } while (0)
    PK4(p0, 0, pa0); PK4(p0, 8, pa1); PK4(p1, 0, pa2); PK4(p1, 8, pa3);
#undef PK4
}
template <int KB>
__device__ __forceinline__ void qkt(f32x16& p0, f32x16& p1, const char* K_lds, int krow, int hi, const bf16x8* qr, bool act) {
    if (!act) { const float NEG = -__builtin_inff();
#pragma unroll
        for (int r = 0; r < 16; ++r) { p0[r] = NEG; p1[r] = NEG; } return; }
    p0 = f32x16{}; p1 = f32x16{};
    const char* kb[4];
#pragma unroll
    for (int dd = 0; dd < 4; ++dd) kb[dd] = K_lds + KB * SHM_K + KSWZ(krow, (dd * 16 + hi * 8) * 2);
#pragma unroll
    for (int d0 = 0; d0 < 8; ++d0) { const char* a = kb[d0 & 3] + (d0 >> 2) * 128;
        bf16x8 b0 = *reinterpret_cast<const bf16x8*>(a);
        bf16x8 b1 = *reinterpret_cast<const bf16x8*>(a + 32 * 256);
        p0 = __builtin_amdgcn_mfma_f32_32x32x16_bf16(b0, qr[d0], p0, 0, 0, 0);
        p1 = __builtin_amdgcn_mfma_f32_32x32x16_bf16(b1, qr[d0], p1, 0, 0, 0); }
}
template <int VB>
__device__ __forceinline__ void pv_tile(f32x16* o, int vb0, bf16x8 pa0, bf16x8 pa1, bf16x8 pa2, bf16x8 pa3, bool act) {
    if (!act) return;
#define TRRD(dst, off) asm volatile("ds_read_b64_tr_b16 %0, %1 offset:%2" : "=&v"(dst) : "v"(vb0), "i"(off) : "memory")
#define PV_D0(d0) do { s16x4 l0, l1, l2, l3, h0, h1, h2, h3; constexpr int b_ = VB * SHM_V + v_rd_off(d0, 0, 0); \
        TRRD(l0, b_); TRRD(h0, b_ + 2048); TRRD(l1, b_ + 4096); TRRD(h1, b_ + 6144); TRRD(l2, b_ + 8192); TRRD(h2, b_ + 10240); TRRD(l3, b_ + 12288); TRRD(h3, b_ + 14336); \
        asm volatile("s_waitcnt lgkmcnt(0)" ::: "memory"); SBAR();   \
        o[d0] = __builtin_amdgcn_mfma_f32_32x32x16_bf16(pa0, (bf16x8){l0[0], l0[1], l0[2], l0[3], h0[0], h0[1], h0[2], h0[3]}, o[d0], 0, 0, 0);   \
        o[d0] = __builtin_amdgcn_mfma_f32_32x32x16_bf16(pa1, (bf16x8){l1[0], l1[1], l1[2], l1[3], h1[0], h1[1], h1[2], h1[3]}, o[d0], 0, 0, 0);   \
        o[d0] = __builtin_amdgcn_mfma_f32_32x32x16_bf16(pa2, (bf16x8){l2[0], l2[1], l2[2], l2[3], h2[0], h2[1], h2[2], h2[3]}, o[d0], 0, 0, 0);   \
        o[d0] = __builtin_amdgcn_mfma_f32_32x32x16_bf16(pa3, (bf16x8){l3[0], l3[1], l3[2], l3[3], h3[0], h3[1], h3[2], h3[3]}, o[d0], 0, 0, 0); } while (0)
    PV_D0(0); PV_D0(1); PV_D0(2); PV_D0(3);
#undef PV_D0
#undef TRRD
}
__device__ __forceinline__ void mask_bias_tile(f32x16& p0, f32x16& p1, int dq, const float* tab) {
    const float NEG = -__builtin_inff();
#pragma unroll
    for (int r = 0; r < 16; ++r) { const int c = (r & 3) + 8 * (r >> 2); const int d0 = dq - c, d1 = dq - c - 32;
        p0[r] = d0 < 0 ? NEG : p0[r] + tab[d0 > 113 ? 113 : d0];
        p1[r] = d1 < 0 ? NEG : p1[r] + tab[d1 > 113 ? 113 : d1]; }
}
__device__ __forceinline__ void bias_tile(f32x16& p0, f32x16& p1, int dq, const float* tab) {
#pragma unroll
    for (int r = 0; r < 16; ++r) { const int c = (r & 3) + 8 * (r >> 2); const int d0 = dq - c, d1 = dq - c - 32;
        p0[r] += tab[d0 > 113 ? 113 : d0]; p1[r] += tab[d1 > 113 ? 113 : d1]; }
}
__device__ __forceinline__ void kill_tile(f32x16& p0, f32x16& p1, bool ok) {
    const float NEG = -__builtin_inff();
#pragma unroll
    for (int r = 0; r < 16; ++r) { p0[r] = ok ? p0[r] : NEG; p1[r] = ok ? p1[r] : NEG; }
}

struct BlockRef { const bf16_t* Q; const bf16_t* K; const bf16_t* V; bf16_t* O; const float* km; int P0; };
struct Seam { bf16x8 qr[8]; bf16x8 st_v0, st_v1, st_v2, st_v3, st_k0, st_k1, st_k2, st_k3; };
#define ROW(p, k0, rr) ((p) + (size_t)((k0) + (rr)) * LD + sc)
#define VMW() asm volatile("s_waitcnt vmcnt(0)" ::: "memory")
#define SLOAD_H(Kp, Vp, k0) do { S.st_v0 = load8(ROW(Vp, k0, sr)); S.st_v1 = load8(ROW(Vp, k0, 32 + sr)); S.st_v2 = load8(ROW(Vp, k0, 64 + sr)); S.st_v3 = load8(ROW(Vp, k0, 96 + sr)); \
                                 S.st_k0 = load8(ROW(Kp, k0, sr)); S.st_k1 = load8(ROW(Kp, k0, 32 + sr)); S.st_k2 = load8(ROW(Kp, k0, 64 + sr)); S.st_k3 = load8(ROW(Kp, k0, 96 + sr)); } while (0)
#define SWRITE_HK(bf) do { *(bf16x8*)(K_lds + (bf) * SHM_K + kws) = S.st_k0; *(bf16x8*)(K_lds + (bf) * SHM_K + kws + 32 * 256) = S.st_k1; *(bf16x8*)(K_lds + (bf) * SHM_K + kws + 64 * 256) = S.st_k2; *(bf16x8*)(K_lds + (bf) * SHM_K + kws + 96 * 256) = S.st_k3; } while (0)
#define SWRITE_HV(bf) do { *(bf16x8*)(V_lds + (bf) * SHM_V + vst0) = S.st_v0; *(bf16x8*)(V_lds + (bf) * SHM_V + vst1) = S.st_v1; *(bf16x8*)(V_lds + (bf) * SHM_V + 16384 + vst0) = S.st_v2; *(bf16x8*)(V_lds + (bf) * SHM_V + 16384 + vst1) = S.st_v3; } while (0)
#define SWRITE_H(bf) do { SWRITE_HV(bf); SWRITE_HK(bf); } while (0)
__device__ __forceinline__ void prime(const BlockRef& cur, const float* rel_bias, int h, char* lds, Seam& S, int tid) {
    const int wid = __builtin_amdgcn_readfirstlane(tid >> 6), lane = tid & 63, r32 = lane & 31, hi = lane >> 5, rg = wid & 3;
    const int sr = tid >> 4, sc = (tid & 15) * 8, kws = KSWZ(sr, sc * 2); char* K_lds = lds + 2 * SHM_V;
    __syncthreads();
    if (tid < 128) { int bk = tid; if (tid >= 16) { bk = 16 + (int)(__logf((float)tid * (1.f / 16.f)) * (16.f / 2.0794415416798357f)); bk = bk > 31 ? 31 : bk; }
        ((float*)(lds + LDS_TAB))[tid] = tid >= 113 ? 0.f : (rel_bias[bk * 4 + h] - rel_bias[31 * 4 + h]) * LOG2E; }
#pragma unroll
    for (int d0 = 0; d0 < 8; ++d0) S.qr[d0] = load8(cur.Q + (size_t)(rg * QBLK + r32) * LD + d0 * 16 + hi * 8);
    SLOAD_H(cur.K, cur.V, 0); VMW(); SWRITE_HK(0);
    __syncthreads();
}
__device__ __forceinline__ void block(const BlockRef& cur, char* lds, Seam& S, int tid) {
    const int wid = __builtin_amdgcn_readfirstlane(tid >> 6), lane = tid & 63, r32 = lane & 31, hi = lane >> 5, rg = wid & 3, kh = wid >> 2;
    const int qblk = cur.P0 >> 8, NT = 2 * qblk + 2;
    const int qlo = cur.P0 + rg * QBLK, qm = qlo + r32 - 4 * hi - 64 * kh;
    char* V_lds = lds; char* K_lds = lds + 2 * SHM_V;
    float* ws = (float*)(lds + LDS_WS) + wid * 64; float* li_l = ws, * al_l = ws + 32; const float* tab = (const float*)(lds + LDS_TAB);
    float m_reg = -1e30f, l_reg = 0; f32x16 o[4] = {};
    const int sr = tid >> 4, sc = (tid & 15) * 8, vst0 = v_st(sr, sc), vst1 = v_st(32 + sr, sc), kws = KSWZ(sr, sc * 2);
    const int vb0 = (int)(uintptr_t)V_lds + v_rd_base(lane) + kh * 16384, krow = r32 + 64 * kh;
    const bf16_t* Kh = cur.K; const bf16_t* Vh = cur.V;
    unsigned sel = (1u << qblk) - 1u;
    if (qblk > 3) {
        float s[7];
#pragma unroll
        for (int n = 0; n < 7; ++n) { s[n] = -__builtin_inff();
            if (n < qblk) { float a = 0.f; const float* kmn = cur.km + n * 128 + hi * 8;
#pragma unroll
                for (int d0 = 0; d0 < 8; ++d0) { const f32x4 k0 = *(const f32x4*)(kmn + d0 * 16), k1 = *(const f32x4*)(kmn + d0 * 16 + 4); const bf16x8 qv = S.qr[d0];
#pragma unroll
                    for (int j = 0; j < 4; ++j) { a += __uint_as_float(((unsigned)(unsigned short)qv[j]) << 16) * k0[j]; a += __uint_as_float(((unsigned)(unsigned short)qv[4 + j]) << 16) * k1[j]; } }
                s[n] = half_sum(a); } }
        sel = 0u;
#pragma unroll
        for (int c = 0; c < 3; ++c) { float best = -__builtin_inff(); int bi = 0;
#pragma unroll
            for (int n = 0; n < 7; ++n) if (s[n] > best) { best = s[n]; bi = n; }
            sel |= 1u << bi;
#pragma unroll
            for (int n = 0; n < 7; ++n) s[n] = (n == bi) ? -__builtin_inff() : s[n]; }
    }
#define RESC(a) do { if (__any((a) < 1.f)) { if (hi == 0) al_l[r32] = (a); asm volatile("s_waitcnt lgkmcnt(0)" ::: "memory");              \
                     for (int d_ = 0; d_ < 4; ++d_) for (int r = 0; r < 16; ++r) o[d_][r] *= al_l[crow(r, hi)]; } } while (0)
#define KBASE(t) ((t) * KVBLK)
#define ACT(t) ((KBASE(t) >> 8) < qblk ? (__any((sel >> (KBASE(t) >> 8)) & 1u) != 0) : (KBASE(t) + 64 * kh <= qlo + QBLK - 1))
#define MASKT(P0_, P1_, t) do { const int kb_ = KBASE(t); if (ACT(t)) { if ((kb_ >> 8) < qblk) { if (kb_ + 64 * kh + 176 > qlo) bias_tile(P0_, P1_, qm - kb_, tab); kill_tile(P0_, P1_, ((sel >> (kb_ >> 8)) & 1u) != 0u); } \
                                     else mask_bias_tile(P0_, P1_, qm - kb_, tab); } } while (0)
    f32x16 pA0, pA1, pB0, pB1; float mnA, mnB, alA, alB; bf16x8 pa0, pa1, pa2, pa3;
    SWRITE_HV(0); SBAR();
    SLOAD_H(Kh, Vh, KBASE(1));
    SBAR(); qkt<0>(pA0, pA1, K_lds, krow, hi, S.qr, ACT(0));
    MASKT(pA0, pA1, 0); partialSM(pA0, pA1, m_reg, mnA, alA);
    VMW(); SWRITE_H(1); SBAR(); if (2 < NT) { SLOAD_H(Kh, Vh, KBASE(2)); } SBAR();
    __syncthreads();
#define HALF_STEP(PX0, PX1, mnX, alX, PY0, PY1, alY, t, KB, VB, SB) do {                                                      \
        SBAR(); qkt<KB>(PX0, PX1, K_lds, krow, hi, S.qr, ACT(t));                                                          \
        finishSM(PY0, PY1, alY, l_reg, pa0, pa1, pa2, pa3); SBAR();                                                           \
        pv_tile<VB>(o, vb0, pa0, pa1, pa2, pa3, ACT((t) - 1)); MASKT(PX0, PX1, (t)); partialSM(PX0, PX1, m_reg, mnX, alX);    \
        __syncthreads();                                                                                                      \
        if ((t) + 1 < NT) { VMW(); SWRITE_H(SB); SBAR(); if ((t) + 2 < NT) { SLOAD_H(Kh, Vh, KBASE((t) + 2)); } SBAR(); }          \
        RESC(alX); __syncthreads(); } while (0)
    for (int t = 1; t + 1 < NT; t += 2) {
        HALF_STEP(pB0, pB1, mnB, alB, pA0, pA1, alA, t, 1, 0, 0);
        HALF_STEP(pA0, pA1, mnA, alA, pB0, pB1, alB, t + 1, 0, 1, 1);
    }
    SBAR(); qkt<1>(pB0, pB1, K_lds, krow, hi, S.qr, ACT(NT - 1)); SBAR();
    finishSM(pA0, pA1, alA, l_reg, pa0, pa1, pa2, pa3); SBAR();
    pv_tile<0>(o, vb0, pa0, pa1, pa2, pa3, ACT(NT - 2));
    MASKT(pB0, pB1, NT - 1); partialSM(pB0, pB1, m_reg, mnB, alB); __syncthreads(); RESC(alB);
    finishSM(pB0, pB1, alB, l_reg, pa0, pa1, pa2, pa3); SBAR(); pv_tile<1>(o, vb0, pa0, pa1, pa2, pa3, ACT(NT - 1));
    __syncthreads();
    float* mls = (float*)(lds + LDS_WS) + (rg + 4) * 64;
    float* osh = (float*)lds + (size_t)rg * 64 * 64;
    if (kh == 1) { if (hi == 0) { mls[r32] = m_reg; mls[32 + r32] = l_reg; }
#pragma unroll
        for (int d0 = 0; d0 < 4; ++d0)
#pragma unroll
            for (int r = 0; r < 16; ++r) osh[(d0 * 16 + r) * 64 + lane] = o[d0][r]; }
    __syncthreads();
    if (kh == 0) {
        const float m1 = mls[r32], l1 = mls[32 + r32]; const float mm = fmaxf(m_reg, m1); const float a0 = __builtin_amdgcn_exp2f(m_reg - mm), a1 = __builtin_amdgcn_exp2f(m1 - mm);
        const float il = __builtin_amdgcn_rcpf(l_reg * a0 + l1 * a1);
        if (hi == 0) { li_l[r32] = a0 * il; al_l[r32] = a1 * il; } asm volatile("s_waitcnt lgkmcnt(0)" ::: "memory");
        bf16_t* Ow = cur.O + (size_t)(rg * QBLK) * LD;
#pragma unroll
        for (int r = 0; r < 16; ++r) { const int orow = crow(r, hi); const float f0 = li_l[orow], f1 = al_l[orow];
#pragma unroll
            for (int d0 = 0; d0 < 4; ++d0) { const float v = o[d0][r] * f0 + osh[(d0 * 16 + r) * 64 + lane] * f1; const float vn = swz_xor<1>(v);
                if ((r32 & 1) == 0) *(unsigned*)(Ow + (size_t)orow * LD + d0 * 32 + r32) = cvt_pk_bf16(v, vn); } }
    }
#undef RESC
#undef KBASE
#undef ACT
#undef MASKT
#undef HALF_STEP
}
#undef ROW
#undef VMW
#undef SLOAD_H
#undef SWRITE_HK
#undef SWRITE_HV
#undef SWRITE_H
#undef KSWZ
#undef SBAR
}

constexpr int PH_PREP = 0, PH_IN1 = 1, PH_MIX1 = 2, PH_MIX2 = 3, PH_MIX3 = 4, PH_GATES = 5, PH_UPM = 6, PH_OUT = 7, PH_FFN = 8, PH_DOWN = 9, PH_PER_LAYER = 10;
#ifndef PROBE_K
#define PROBE_K -1
#define PROBE_L 0
#define PROBE_N 1
#define PROBE_SUB 15
#endif
struct Args { Inputs in; float* out; unsigned char* ws; int ph_lo, ph_hi, li, mixmask; };

__device__ __forceinline__ void fill_rstd(LAS float* tab, const float* rssp, int bx, int tid) {
#pragma unroll
    for (int j = 0; j < 4; ++j) { const int r = tid + 512 * j; const f32x4* p = (const f32x4*)(rssp + ((size_t)(bx & 7) * 2048 + r) * 16);
        const f32x4 a = p[0], b = p[1], c = p[2], d = p[3]; const f32x4 s = (a + b) + (c + d);
        tab[r] = rsqrtf(((s[0] + s[1]) + (s[2] + s[3])) * (1.f / D) + EPS); }
    __syncthreads();
}
__device__ __forceinline__ int fresh_tid(int wave0) { int ln; asm volatile("v_mbcnt_lo_u32_b32 %0, -1, 0\n\tv_mbcnt_hi_u32_b32 %0, -1, %0" : "=v"(ln)); return wave0 * 64 + ln; }
__global__ void __launch_bounds__(NWAVES * 64, 2) mega_fwd(Args args) {
    extern __shared__ __attribute__((aligned(16))) unsigned char lds[];
    LAS unsigned char* ldsp = (LAS unsigned char*)lds;
    volatile LAS unsigned* MISC = (volatile LAS unsigned*)(ldsp + MISC_OFF);
    const int tid = threadIdx.x; const int wave0 = __builtin_amdgcn_readfirstlane(tid >> 6);
    const int G = gridDim.x; const int bx = blockIdx.x; const int vcu = (G % 8 == 0) ? (bx % 8) * (G / 8) + bx / 8 : bx;
    unsigned char* ws = args.ws;
    float* out = args.out;
    for (int u = tid; u < (LDS_BYTES - LDSCTL_OFF) / 4; u += NWAVES * 64) ((LAS unsigned*)(ldsp + LDSCTL_OFF))[u] = 0u;
    __syncthreads();
    XcdBarrier bar = xcd_barrier_post((unsigned*)(ws + WS_CTL) + CW_BAR + args.li * XCD_BAR_WORDS, MISC + 8); bar.w0 = wave0;
    const int NGW = G * NWAVES;

    unsigned char* const ws0 = ws; float* const out0 = out; const int bx0 = bx;
    for (int ph = args.ph_lo; ph < args.ph_hi; ++ph) {
        const int l = ph / PH_PER_LAYER, k = ph % PH_PER_LAYER;
        size_t zoff = 0; int bx = bx0; asm volatile("" : "+s"(zoff), "+s"(bx)); unsigned char* ws = ws0 + zoff; float* out = out0 + zoff;
#define KARG(i) (*(const float* const __attribute__((address_space(4)))*)((const __attribute__((address_space(4))) char*)__builtin_amdgcn_kernarg_segment_ptr() + 8 * (i) + zoff))
#define LOAD_INPUTS(v) const __attribute__((address_space(4))) Inputs* v = (const __attribute__((address_space(4))) Inputs*)((const __attribute__((address_space(4))) char*)__builtin_amdgcn_kernarg_segment_ptr() + zoff)
        float* rssp = (float*)(ws + WS_RSSP);
        const int nrep = (k == PROBE_K && l == PROBE_L) ? PROBE_N : 1;
        for (int rep = 0; rep < nrep; ++rep) {
        const int mmask = rep == 0 ? args.mixmask : (args.mixmask & PROBE_SUB); const bool stf = (rep + 1 == nrep);
        if (k == PH_PREP) {
            const int tidl = fresh_tid(wave0), lane = tidl & 63, wave = wave0, gw = vcu * NWAVES + wave;
            LOAD_INPUTS(in);
            float* scr = (float*)(lds + wave * 16384);
            for (int it = gw; it < PREP_ITEMS; it += NGW) prep_item(in, l, ws + WS_W, it, scr, lane);
            if (l == 0) {
                for (int row = gw; row < M; row += NGW) {
                    const f32x4* xr = (const f32x4*)(in->x + (size_t)row * D) + lane; float s = 0.f;
                    unsigned long long* o8 = (unsigned long long*)((bf16_t*)(ws + WS_XB) + (size_t)row * D) + lane;
#pragma unroll
                    for (int j = 0; j < 4; ++j) { const f32x4 v = xr[64 * j]; s += (v.x * v.x + v.y * v.y) + (v.z * v.z + v.w * v.w);
                        o8[64 * j] = (unsigned long long)pk2(v.x, v.y) | ((unsigned long long)pk2(v.z, v.w) << 32); }
                    s = wave_sum_s(s); if (lane < 16) rssp[(size_t)row * 16 + lane] = (lane == 0) ? s : 0.f;
                }
            }
        } else if (k == PH_IN1) {
            const int tidl = fresh_tid(wave0);
            pg8::Gemm g{(const bf16_t*)(ws + WS_XB), (const bf16_t*)(ws + WS_W + W_IN), M, NIN1, D}; pg8::StaticOrder S; S.init(M, NIN1, G, bx);
            fill_rstd((LAS float*)(ldsp + RSTD_OFF), rssp, bx, tidl);
            pg8::EpiIn1 E{ws, (const LAS float*)(ldsp + RSTD_OFF), KARG(4) + l * 256};
            pg8::gemm_phase<pg8::EpiIn1, pg8::StaticOrder, true, true>(ldsp, g, S, E, tidl);
        } else if (k == PH_MIX1) {
            const int tidl = fresh_tid(wave0), lane = tidl & 63, wave = wave0;
            if (mmask & 2) for (int it = vcu; it < 256; it += G) mix::prepass_item(ws, KARG(8) + l * 128, KARG(9) + l * 128, it >> 5, (it >> 2) & 7, it & 3, (LAS float*)ldsp, tidl, lane, wave);
            if (mmask & 1) for (int it = vcu; it < 256; it += G) mix::pool_item(ws, KARG(7) + l * 512, it >> 2, it & 3, ldsp, tidl, lane, wave);
            if (mmask & 4) for (int it = vcu; it < 512; it += G) mix::gla_passA_pair(ws, it, ldsp, tidl, lane, wave);
        } else if (k == PH_MIX2) {
            const int tidl = fresh_tid(wave0);
            if (mmask & 4) for (int g0 = vcu * 512 + tidl; g0 < 32 * 4096; g0 += G * 512) mix::gla_scan(ws, g0);
            if (mmask & 8) for (int pr = vcu; pr < 256; pr += G) {
                const int bh = pr >> 3, b = bh >> 2, h = bh & 3, rh = pr & 1, a = (pr >> 1) & 3; const size_t r0 = (size_t)b * SEQ * 512 + h * 128;
#pragma unroll 1
                for (int half = 0; half < 2; ++half) { const int qb = half == 0 ? 7 - a : a; const size_t qoff = r0 + (size_t)(qb * 256 + rh * 128) * 512;
                    moba::BlockRef cur; cur.Q = (const bf16_t*)(ws + WS_MQ) + qoff; cur.O = (bf16_t*)(ws + (stf ? WS_YC : WS_US)) + qoff;
                    cur.K = (const bf16_t*)(ws + WS_MK) + r0; cur.V = (const bf16_t*)(ws + WS_MV) + r0; cur.km = (const float*)(ws + WS_KMEAN) + (size_t)bh * 8 * 128; cur.P0 = qb * 256 + rh * 128;
                    const int tl = fresh_tid(wave0);
                    moba::Seam S; moba::prime(cur, KARG(10), h, (char*)lds, S, tl); moba::block(cur, (char*)lds, S, tl); }
            }
        } else if (k == PH_MIX3) {
            const int tidl = fresh_tid(wave0), lane = tidl & 63, wave = wave0;
            if (mmask & 4) for (int it = vcu; it < 512; it += G) mix::gla_passC_pair(ws, KARG(5) + l * 128, it, ldsp, tidl, lane, wave, stf ? WS_YA : WS_US);
        } else if (k == PH_GATES) {
            const int tidl = fresh_tid(wave0);
            pg8::Gemm g{(const bf16_t*)(ws + WS_XB), (const bf16_t*)(ws + WS_W + W_IN) + (size_t)NIN1 * D, M, NGATE, D}; pg8::StaticOrder S; S.init(M, NGATE, G, bx);
            fill_rstd((LAS float*)(ldsp + RSTD_OFF), rssp, bx, tidl);
            pg8::EpiGates E{ws, (const LAS float*)(ldsp + RSTD_OFF)};
            pg8::gemm_phase<pg8::EpiGates, pg8::StaticOrder, true, true>(ldsp, g, S, E, tidl);
        } else if (k == PH_UPM) {
            const int tidl = fresh_tid(wave0);
            pg8::Gemm g{nullptr, nullptr, M, D, 512}; pg8::UpmOrder S; S.so.init(M, D, G, bx);
            S.Y0 = (const bf16_t*)(ws + WS_YA); S.Y1 = (const bf16_t*)(ws + WS_YB); S.Y2 = (const bf16_t*)(ws + WS_YC);
            S.W0 = (const bf16_t*)(ws + WS_W + W_UP); S.W1 = (const bf16_t*)(ws + WS_W + W_UP + MiB); S.W2 = (const bf16_t*)(ws + WS_W + W_UP + 2 * MiB);
            pg8::EpiUpm E{ws};
            pg8::gemm_phase<pg8::EpiUpm, pg8::UpmOrder, true, true>(ldsp, g, S, E, tidl);
        } else if (k == PH_OUT) {
            const int tidl = fresh_tid(wave0);
            pg8::Gemm g{(const bf16_t*)(ws + WS_MERGED2), (const bf16_t*)(ws + WS_W + W_OUT), M, D, D}; pg8::StaticOrder S; S.init(M, D, G, bx);
            pg8::EpiRes E{(const bf16_t*)(ws + WS_XB), nullptr, (bf16_t*)(ws + WS_X1B), rssp, stf};
            pg8::gemm_phase<pg8::EpiRes, pg8::StaticOrder, false, true>(ldsp, g, S, E, tidl);
        } else if (k == PH_FFN) {
            const int tidl = fresh_tid(wave0);
            pg8::Gemm g{(const bf16_t*)(ws + WS_X1B), (const bf16_t*)(ws + WS_W + W_GU), M, NGU, D}; pg8::StaticOrder S; S.init(M, NGU, G, bx);
            fill_rstd((LAS float*)(ldsp + RSTD_OFF), rssp, bx, tidl);
            pg8::EpiFfn E{(bf16_t*)(ws + WS_H), (const LAS float*)(ldsp + RSTD_OFF)};
            pg8::gemm_phase<pg8::EpiFfn, pg8::StaticOrder, true, true>(ldsp, g, S, E, tidl);
        } else if (k == PH_DOWN) {
            const int tidl = fresh_tid(wave0);
            pg8::Gemm g{(const bf16_t*)(ws + WS_H), (const bf16_t*)(ws + WS_W + W_DN), M, D, FF}; pg8::StaticOrder S; S.init(M, D, G, bx);
            pg8::EpiRes E{(const bf16_t*)(ws + WS_X1B), (l + 1 < DEPTH) ? nullptr : out, (l + 1 < DEPTH) ? (bf16_t*)(ws + WS_XB) : nullptr, (l + 1 < DEPTH) ? rssp : nullptr, stf};
            pg8::gemm_phase<pg8::EpiRes, pg8::StaticOrder, false, true>(ldsp, g, S, E, tidl);
        }
        if (rep + 1 < nrep) xcd_barrier(bar);
        }
        if (ph + 1 < args.ph_hi) xcd_barrier(bar);
    }
}

#ifndef MIXMASK
#define MIXMASK 15
#endif
static void launch_mega(const Args& a0, int lo, int hi, int li, int grid, hipStream_t stream) {
    Args a = a0; a.ph_lo = lo; a.ph_hi = hi; a.li = li;
    hipLaunchKernelGGL(mega_fwd, dim3(grid), dim3(NWAVES * 64), LDS_BYTES, stream, a);
}
extern "C" void kernel_launch(void* const* d_in, const int* in_sizes, int n_in, void* d_out, int out_size, void* d_ws, size_t ws_size, hipStream_t stream) {
    static int grid = 0;
    if (grid == 0) {
        if (n_in != 19 || out_size != M * D || ws_size < WS_END2) { fprintf(stderr, "kernel_launch: unexpected shapes (n_in %d out %d ws %zu)\n", n_in, out_size, ws_size); grid = -1; return; }
        int dev = 0, cus = 0;
        if (hipGetDevice(&dev) != hipSuccess || hipDeviceGetAttribute(&cus, hipDeviceAttributeMultiprocessorCount, dev) != hipSuccess) { grid = -1; return; }
        if (hipFuncSetAttribute((const void*)mega_fwd, hipFuncAttributeMaxDynamicSharedMemorySize, LDS_BYTES) != hipSuccess) { fprintf(stderr, "kernel_launch: hipFuncSetAttribute failed\n"); grid = -1; return; }
        int per_cu = 0; (void)hipOccupancyMaxActiveBlocksPerMultiprocessor(&per_cu, (const void*)mega_fwd, NWAVES * 64, LDS_BYTES); (void)hipGetLastError();
        if (per_cu < 1) fprintf(stderr, "kernel_launch: occupancy query reports %d blocks per CU\n", per_cu);
        grid = cus;
    }
    if (grid < 0) return;
    (void)hipMemsetAsync((char*)d_ws + WS_CTL, 0, CTL_BYTES, stream);
    Args a{}; { const float** ap = (const float**)&a.in; for (int i = 0; i < 19; ++i) ap[i] = (const float*)d_in[i]; }
    a.out = (float*)d_out; a.ws = (unsigned char*)d_ws;
    a.mixmask = 15;
    launch_mega(a, 0, DEPTH * PH_PER_LAYER, 0, grid, stream);
}
```

```cpp
#include <hip/hip_runtime.h>
#include <cstdint>
#include <cstdio>

typedef unsigned short bf16_t;
typedef short bf16x8 __attribute__((ext_vector_type(8)));
typedef float f32x4 __attribute__((ext_vector_type(4)));

constexpr int BATCH = 8, SEQ = 2048, D = 1024, M = BATCH * SEQ, DEPTH = 2;
constexpr int IN_COLS = 6672, NIN1 = 3840, NGATE = 3072, NIN = NIN1 + NGATE;
constexpr int FF = 2816, NGU = 2 * FF;
constexpr int C_GLR = 1024;
constexpr float EPS = 1e-6f;
constexpr float LOG2E = 1.4426950408889634f;
constexpr float QSCALE = 0.08838834764831845f * LOG2E;

constexpr size_t MiB = 1u << 20;
constexpr size_t WS_CTL = 0, CTL_BYTES = 1 * MiB;
constexpr size_t WS_RSS = 1 * MiB;
constexpr size_t WS_W = 2 * MiB;
constexpr size_t W_IN = 0, W_UP = 13 * MiB + 512 * 1024, W_OUT = W_UP + 3 * MiB, W_GU = W_OUT + 2 * MiB, W_DN = W_GU + 11 * MiB, W_PW = W_DN + 5 * MiB + 512 * 1024;
constexpr size_t WS_XB = 38 * MiB;
constexpr size_t WS_GQ = 70 * MiB, WS_GK = 78 * MiB, WS_GG = 86 * MiB;
constexpr size_t WS_GV = 102 * MiB, WS_PU = 118 * MiB;
constexpr size_t WS_MK = 134 * MiB, WS_MV = 150 * MiB;
constexpr size_t WS_SR = 166 * MiB, WS_MQ = 182 * MiB;
constexpr size_t WS_YB = 198 * MiB, WS_US = 214 * MiB;
constexpr size_t WS_SGA = 70 * MiB, WS_SGB = 102 * MiB, WS_SGC = 134 * MiB;
constexpr size_t WS_X1B = 70 * MiB, WS_H = 102 * MiB;
constexpr size_t WS_KMEAN = 248 * MiB;

__device__ __forceinline__ float bf2f(bf16_t h) { return __uint_as_float(((unsigned)h) << 16); }
__device__ __forceinline__ bf16_t f2bf(float f) { unsigned u = __float_as_uint(f); return (bf16_t)((u + 0x7fffu + ((u >> 16) & 1u)) >> 16); }
__device__ __forceinline__ unsigned pk2(float lo, float hi) { return (unsigned)f2bf(lo) | ((unsigned)f2bf(hi) << 16); }
__device__ __forceinline__ float sigmoidf_(float x) { return 1.f / (1.f + __expf(-x)); }
__device__ __forceinline__ float siluf_(float x) { return x / (1.f + __expf(-x)); }

struct Inputs {
    const float *x, *norm1_w, *w_in, *wg2, *bg, *gla_nw, *pool_w, *pool_scale, *qn_w, *kn_w, *rel_bias, *w_up_a, *w_up_b, *w_up_c, *w_out, *norm2_w, *w_gate, *w_up, *w_down;
};

template <class F>
__device__ __forceinline__ void transpose_item(F src, int K, bf16_t* dst, int k0, int n0, float* scr, int lane) {
    float tv[32];
#pragma unroll
    for (int i = 0; i < 32; ++i) tv[i] = src(k0 + i, n0 + lane);
#pragma unroll
    for (int i = 0; i < 32; ++i) scr[i * 65 + lane] = tv[i];
    __builtin_amdgcn_s_waitcnt(0xc07f); asm volatile("" ::: "memory");
    const int c = lane & 3;
#pragma unroll
    for (int j = 0; j < 4; ++j) {
        const int n = (lane >> 2) + 16 * j; const float* s = scr + (8 * c) * 65 + n;
        uint4 o; o.x = pk2(s[0], s[65]); o.y = pk2(s[130], s[195]); o.z = pk2(s[260], s[325]); o.w = pk2(s[390], s[455]);
        *(uint4*)(dst + (size_t)(n0 + n) * K + k0 + 8 * c) = o;
    }
    __builtin_amdgcn_s_waitcnt(0xc07f); asm volatile("" ::: "memory");
}
constexpr int PI_IN = 32 * (NIN / 64), PI_UP = 16 * 16, PI_OUT = 32 * 16, PI_GU = 32 * (NGU / 64), PI_DN = 88 * 16, PI_PW = 4 * 2;
constexpr int PREP_ITEMS = PI_IN + 3 * PI_UP + PI_OUT + PI_GU + PI_DN + 4 * PI_PW;
template <class InP>
__device__ __forceinline__ void prep_item(InP inp, int l, unsigned char* wsw, int it, float* scr, int lane) {
    if (it < PI_IN) {
        const int nb = NIN / 64, kb = it / nb, n0 = 64 * (it % nb), k0 = 32 * kb;
        const float* w = inp->w_in + (size_t)l * D * IN_COLS; const float* nw = inp->norm1_w + l * D; bf16_t* dst = (bf16_t*)(wsw + W_IN);
        if (n0 >= 512 && n0 < 768) {
            const float* g2 = inp->wg2 + (size_t)l * 16 * 256 + (n0 - 512) + lane; float g2v[16];
#pragma unroll
            for (int r = 0; r < 16; ++r) g2v[r] = g2[r * 256];
            transpose_item([&](int k, int n) { const f32x4* wr = (const f32x4*)(w + (size_t)k * IN_COLS + C_GLR); float s = 0.f;
#pragma unroll
                for (int r4 = 0; r4 < 4; ++r4) { const f32x4 v = wr[r4]; s += v[0] * g2v[4 * r4] + v[1] * g2v[4 * r4 + 1] + v[2] * g2v[4 * r4 + 2] + v[3] * g2v[4 * r4 + 3]; }
                return s * nw[k]; }, D, dst, k0, n0, scr, lane);
        } else {
            const int off = n0 < 512 ? 0 : (n0 < 1280 ? -256 : -240);
            transpose_item([&](int k, int n) { return w[(size_t)k * IN_COLS + n + off] * nw[k]; }, D, dst, k0, n0, scr, lane);
        }
        return;
    }
    it -= PI_IN;
    if (it < 3 * PI_UP) {
        const int br = it / PI_UP; it %= PI_UP; const int kb = it / 16, n0 = 64 * (it % 16), k0 = 32 * kb;
        const float* w = (br == 0 ? inp->w_up_a : br == 1 ? inp->w_up_b : inp->w_up_c) + (size_t)l * 512 * D;
        transpose_item([&](int k, int n) { return w[(size_t)k * D + n]; }, 512, (bf16_t*)(wsw + W_UP + br * MiB), k0, n0, scr, lane);
        return;
    }
    it -= 3 * PI_UP;
    if (it < PI_OUT) {
        const int kb = it / 16, n0 = 64 * (it % 16), k0 = 32 * kb; const float* w = inp->w_out + (size_t)l * D * D;
        transpose_item([&](int k, int n) { return w[(size_t)k * D + n]; }, D, (bf16_t*)(wsw + W_OUT), k0, n0, scr, lane);
        return;
    }
    it -= PI_OUT;
    if (it < PI_GU) {
        const int nb = NGU / 64, kb = it / nb, n0 = 64 * (it % nb), k0 = 32 * kb;
        const int pn = n0 >> 8, i0 = n0 & 255; const float* w = ((i0 < 128) ? inp->w_gate : inp->w_up) + (size_t)l * D * FF; const float* nw = inp->norm2_w + l * D;
        const int coff = 128 * pn + (i0 & 127) - n0;
        transpose_item([&](int k, int n) { return w[(size_t)k * FF + n + coff] * nw[k]; }, D, (bf16_t*)(wsw + W_GU), k0, n0, scr, lane);
        return;
    }
    it -= PI_GU;
    if (it < PI_DN) {
        const int kb = it / 16, n0 = 64 * (it % 16), k0 = 32 * kb; const float* w = inp->w_down + (size_t)l * FF * D;
        transpose_item([&](int k, int n) { return w[(size_t)k * D + n]; }, FF, (bf16_t*)(wsw + W_DN), k0, n0, scr, lane);
        return;
    }
    it -= PI_DN;
    { const int g = it / PI_PW; it %= PI_PW; const int kb = it / 2, n0 = 64 * (it % 2), k0 = 32 * kb; const float* w = inp->pool_w + ((size_t)l * 4 + g) * 128 * 128;
      transpose_item([&](int k, int n) { return w[(size_t)k * 128 + n]; }, 128, (bf16_t*)(wsw + W_PW) + g * 128 * 128, k0, n0, scr, lane); }
}


template <int K> __device__ __forceinline__ float swz_xor(float v) { return __int_as_float(__builtin_amdgcn_ds_swizzle(__float_as_int(v), (K << 10) | 0x1f)); }
__device__ __forceinline__ float half_sum(float v) { auto rr = __builtin_amdgcn_permlane32_swap(__float_as_uint(v), __float_as_uint(v), false, false); return __uint_as_float(rr[0]) + __uint_as_float(rr[1]); }
__device__ __forceinline__ float wave_sum_s(float v) { v += swz_xor<1>(v); v += swz_xor<2>(v); v += swz_xor<4>(v); v += swz_xor<8>(v); v += swz_xor<16>(v); return half_sum(v); }
namespace pg8 {
#define PG8_LAS __attribute__((address_space(3)))
typedef unsigned u32x4 __attribute__((ext_vector_type(4)));
constexpr int BM = 256, BK = 64, HALF = 128, HTB = HALF * BK * 2, STAGE_BYTES = 8 * HTB, NXCD = 8, WGM = 8;
__host__ __device__ __forceinline__ int lds_byte(int r, int c) { const int st = (r >> 4) * 2 + (c >> 5), rr = r & 15, cc = c & 31, ob = rr * 64 + cc * 2; return st * 1024 + (ob ^ (((ob >> 9) & 1) << 5)); }
__host__ __device__ __forceinline__ void stage_rc(int b, int& R, int& C) { const int st = b / 1024, sb = b % 1024, swz = sb ^ (((sb >> 9) & 1) << 5); R = (st >> 1) * 16 + swz / 64; C = (st & 1) * 32 + (swz % 64) / 2; }
__host__ __device__ __forceinline__ int perm32(int rho) { const int n = rho >> 4, i = rho & 15; return 8 * (i >> 2) + 4 * n + (i & 3); }
struct Unit { int pm, pn, br; };
struct Gemm { const bf16_t* A; const bf16_t* Bt; int M, N, K; };
struct StaticOrder {
    int nM, nN, nwg, G, c;
    __device__ void init(int M_, int N_, int G_, int c_) { nM = M_ / BM; nN = N_ / BM; nwg = nM * nN; G = G_; c = c_; }
    __device__ bool next(int i, Unit& u) const {
        const long L = (long)i * G + c; if (L >= nwg) return false;
        int wgid = (int)L; { const int q = nwg / NXCD, r = nwg % NXCD, xcd = wgid % NXCD, off = wgid / NXCD; wgid = (xcd < r ? xcd * (q + 1) : r * (q + 1) + (xcd - r) * q) + off; }
        const int nig = WGM * nN, gid = wgid / nig, fm = gid * WGM, gsz = (nM - fm) < WGM ? (nM - fm) : WGM;
        u.pm = fm + ((wgid % nig) % gsz); u.pn = (wgid % nig) / gsz; u.br = 0; return true;
    }
    __device__ __forceinline__ const char* pa(const Unit& u, const Gemm& g) const { return (const char*)g.A + (size_t)u.pm * (size_t)(BM * 2) * g.K; }
    __device__ __forceinline__ const char* pb(const Unit& u, const Gemm& g) const { return (const char*)g.Bt + (size_t)u.pn * (size_t)(BM * 2) * g.K; }
    __device__ __forceinline__ void a_ready(const Unit&) const {}
    __device__ __forceinline__ void done(const Unit&) const {}
};
struct UpmOrder {
    StaticOrder so; const bf16_t *Y0, *Y1, *Y2, *W0, *W1, *W2;
    __device__ bool next(int i, Unit& u) const { if (i >= 3) return false; if (!so.next(0, u)) return false; u.br = i; return true; }
    __device__ __forceinline__ const char* pa(const Unit& u, const Gemm& g) const { const bf16_t* y = u.br == 0 ? Y0 : (u.br == 1 ? Y1 : Y2); return (const char*)y + (size_t)u.pm * (size_t)(BM * 2) * g.K; }
    __device__ __forceinline__ const char* pb(const Unit& u, const Gemm& g) const { const bf16_t* w = u.br == 0 ? W0 : (u.br == 1 ? W1 : W2); return (const char*)w + (size_t)u.pn * (size_t)(BM * 2) * g.K; }
    __device__ __forceinline__ void a_ready(const Unit&) const {}
    __device__ __forceinline__ void done(const Unit&) const {}
};
typedef float f32x2_t __attribute__((ext_vector_type(2))); typedef __bf16 bf16x2_t __attribute__((ext_vector_type(2)));
__device__ __forceinline__ unsigned cvt_pk_bf16(float lo, float hi) { const f32x2_t v = {lo, hi}; const bf16x2_t b = __builtin_convertvector(v, bf16x2_t); return __builtin_bit_cast(unsigned, b); }
__device__ __forceinline__ u32x4 pack8(const f32x4& a, const f32x4& b) { u32x4 w; w.x = cvt_pk_bf16(a[0], a[1]); w.y = cvt_pk_bf16(a[2], a[3]); w.z = cvt_pk_bf16(b[0], b[1]); w.w = cvt_pk_bf16(b[2], b[3]); return w; }
__device__ __forceinline__ void unpack8(const u32x4& w, f32x4& a, f32x4& b) {
    a[0] = __uint_as_float(w.x << 16); a[1] = __uint_as_float(w.x & 0xffff0000u); a[2] = __uint_as_float(w.y << 16); a[3] = __uint_as_float(w.y & 0xffff0000u);
    b[0] = __uint_as_float(w.z << 16); b[1] = __uint_as_float(w.z & 0xffff0000u); b[2] = __uint_as_float(w.w << 16); b[3] = __uint_as_float(w.w & 0xffff0000u);
}
__device__ __forceinline__ void row_rstd(const PG8_LAS float* tab, const Unit& u, int wr, int fr, float (&rs)[2][4]) {
#pragma unroll
    for (int ai = 0; ai < 2; ++ai)
#pragma unroll
        for (int m = 0; m < 4; ++m) rs[ai][m] = tab[(u.pm & 7) * BM + ai * HALF + wr * 64 + m * 16 + fr];
}
struct EpiIn1 {
    static constexpr bool PERM = true, AFTER_DRAIN = false;
    unsigned char* ws; const PG8_LAS float* rstab; const float* bg;
    __device__ __forceinline__ void operator()(const f32x4 (&acc)[2][2][4][2], const Unit& u, int wr, int wc, int fr, int fq) const {
        asm volatile("" : "+v"(fr), "+v"(fq));
        const int row0 = u.pm * BM + wr * 64 + fr, cw = wc * 32 + 8 * fq; const int pn = u.pn;
        float rs[2][4]; row_rstd(rstab, u, wr, fr, rs);
        if (pn == 2) {
            float* G = (float*)(ws + WS_GG); size_t zb = 0; asm volatile("" : "+s"(zb)); const float* bgl = bg + zb;
#pragma unroll
            for (int bj = 0; bj < 2; ++bj) { const int c = bj * HALF + cw; const f32x4 b0 = *(const f32x4*)(bgl + c), b1 = *(const f32x4*)(bgl + c + 4);
#pragma unroll
                for (int ai = 0; ai < 2; ++ai)
#pragma unroll
                    for (int m = 0; m < 4; ++m) { const float r = rs[ai][m]; f32x4 v0 = acc[ai][bj][m][0] * r + b0, v1 = acc[ai][bj][m][1] * r + b1;
#pragma unroll
                        for (int x = 0; x < 4; ++x) { v0[x] = (fminf(v0[x], 0.f) - __logf(1.f + __expf(-fabsf(v0[x])))) * 0.0625f; v1[x] = (fminf(v1[x], 0.f) - __logf(1.f + __expf(-fabsf(v1[x])))) * 0.0625f; }
                        float* p = G + (size_t)(row0 + ai * HALF + m * 16) * 256 + c; *(f32x4*)p = v0; *(f32x4*)(p + 4) = v1; asm volatile("" ::: "memory"); } }
            return;
        }
        bf16_t* base; int ldc, coff; float sc = 1.f; bool silu = false;
        if (pn == 0) { base = (bf16_t*)(ws + WS_GQ); ldc = 256; coff = 0; sc = 0.125f; }
        else if (pn == 1) { base = (bf16_t*)(ws + WS_GK); ldc = 256; coff = 0; }
        else { ldc = 512; const int k = (pn - 3) >> 1; coff = ((pn - 3) & 1) * 256; silu = (k == 1);
            base = (bf16_t*)(ws + (k == 0 ? WS_GV : k == 1 ? WS_SR : k == 2 ? WS_PU : k == 3 ? WS_MQ : k == 4 ? WS_MK : WS_MV)); }
#pragma unroll
        for (int ai = 0; ai < 2; ++ai)
#pragma unroll
            for (int m = 0; m < 4; ++m) { const float r = rs[ai][m] * sc; bf16_t* rowp = base + (size_t)(row0 + ai * HALF + m * 16) * ldc + coff + cw;
#pragma unroll
                for (int bj = 0; bj < 2; ++bj) { f32x4 v0 = acc[ai][bj][m][0] * r, v1 = acc[ai][bj][m][1] * r;
                    if (silu) {
#pragma unroll
                        for (int x = 0; x < 4; ++x) { v0[x] = siluf_(v0[x]); v1[x] = siluf_(v1[x]); } }
                    *(u32x4*)(rowp + bj * HALF) = pack8(v0, v1); } asm volatile("" ::: "memory"); }
    }
};
struct EpiGates {
    static constexpr bool PERM = true, AFTER_DRAIN = false;
    unsigned char* ws; const PG8_LAS float* rstab;
    __device__ __forceinline__ void operator()(const f32x4 (&acc)[2][2][4][2], const Unit& u, int wr, int wc, int fr, int fq) const {
        asm volatile("" : "+v"(fr), "+v"(fq));
        const int row0 = u.pm * BM + wr * 64 + fr, cw = wc * 32 + 8 * fq; const int br = u.pn >> 2;
        float rs[2][4]; row_rstd(rstab, u, wr, fr, rs);
        bf16_t* base = (bf16_t*)(ws + (br == 0 ? WS_SGA : br == 1 ? WS_SGB : WS_SGC)) + (u.pn & 3) * 256 + cw;
#pragma unroll
        for (int ai = 0; ai < 2; ++ai)
#pragma unroll
            for (int m = 0; m < 4; ++m) { const float r = rs[ai][m]; bf16_t* rowp = base + (size_t)(row0 + ai * HALF + m * 16) * D;
#pragma unroll
                for (int bj = 0; bj < 2; ++bj) { f32x4 v0 = acc[ai][bj][m][0] * r, v1 = acc[ai][bj][m][1] * r;
#pragma unroll
                    for (int x = 0; x < 4; ++x) { v0[x] = sigmoidf_(v0[x]); v1[x] = sigmoidf_(v1[x]); }
                    *(u32x4*)(rowp + bj * HALF) = pack8(v0, v1); } asm volatile("" ::: "memory"); }
    }
};
struct EpiUpm {
    static constexpr bool PERM = true, AFTER_DRAIN = false;
    unsigned char* ws;
    __device__ __forceinline__ void operator()(const f32x4 (&acc)[2][2][4][2], const Unit& u, int wr, int wc, int fr, int fq) const {
        asm volatile("" : "+v"(fr), "+v"(fq));
        const int row0 = u.pm * BM + wr * 64 + fr, col0 = u.pn * BM + wc * 32 + 8 * fq; const int br = u.br;
        const bf16_t* G = (const bf16_t*)(ws + (br == 0 ? WS_SGA : br == 1 ? WS_SGB : WS_SGC)); bf16_t* O = (bf16_t*)(ws + 214 * MiB);
#pragma unroll
        for (int ai = 0; ai < 2; ++ai)
#pragma unroll
            for (int m = 0; m < 4; ++m) { const size_t off = (size_t)(row0 + ai * HALF + m * 16) * D + col0;
#pragma unroll
                for (int bj = 0; bj < 2; ++bj) { f32x4 g0, g1; unpack8(*(const u32x4*)(G + off + bj * HALF), g0, g1);
                    f32x4 v0 = acc[ai][bj][m][0] * g0, v1 = acc[ai][bj][m][1] * g1;
                    if (br != 0) { f32x4 p0, p1; unpack8(*(const u32x4*)(O + off + bj * HALF), p0, p1); v0 += p0; v1 += p1; }
                    *(u32x4*)(O + off + bj * HALF) = pack8(v0, v1); } }
    }
};
struct EpiRes {
    static constexpr bool PERM = true, AFTER_DRAIN = false;
    const bf16_t* resid_b; float* xout; bf16_t* xb; float* rssp; bool st;
    __device__ __forceinline__ void operator()(const f32x4 (&acc)[2][2][4][2], const Unit& u, int wr, int wc, int fr, int fq) const {
        asm volatile("" : "+v"(fr), "+v"(fq));
        const int row0 = u.pm * BM + wr * 64 + fr, col0 = u.pn * BM + wc * 32 + 8 * fq;
#pragma unroll
        for (int ai = 0; ai < 2; ++ai)
#pragma unroll
            for (int m = 0; m < 4; ++m) { const int row = row0 + ai * HALF + m * 16; const size_t off = (size_t)row * D + col0; float s = 0.f;
#pragma unroll
                for (int bj = 0; bj < 2; ++bj) { f32x4 r0, r1; unpack8(*(const u32x4*)(resid_b + off + bj * HALF), r0, r1);
                    const f32x4 v0 = acc[ai][bj][m][0] + r0, v1 = acc[ai][bj][m][1] + r1;
                    if (xout && st) { *(f32x4*)(xout + off + bj * HALF) = v0; *(f32x4*)(xout + off + bj * HALF + 4) = v1; }
                    if (xb && st) *(u32x4*)(xb + off + bj * HALF) = pack8(v0, v1);
                    s += ((v0[0] * v0[0] + v0[1] * v0[1]) + (v0[2] * v0[2] + v0[3] * v0[3])) + ((v1[0] * v1[0] + v1[1] * v1[1]) + (v1[2] * v1[2] + v1[3] * v1[3])); }
                s += swz_xor<16>(s); s = half_sum(s);
                if (fq == 0 && rssp && st) rssp[(size_t)row * 16 + u.pn * 4 + wc] = s; }
    }
};
struct EpiFfn {
    static constexpr bool PERM = true, AFTER_DRAIN = false;
    bf16_t* H; const PG8_LAS float* rstab;
    __device__ __forceinline__ void operator()(const f32x4 (&acc)[2][2][4][2], const Unit& u, int wr, int wc, int fr, int fq) const {
        asm volatile("" : "+v"(fr), "+v"(fq));
        const int row0 = u.pm * BM + wr * 64 + fr, col0 = u.pn * HALF + wc * 32 + 8 * fq;
        float rs[2][4]; row_rstd(rstab, u, wr, fr, rs);
#pragma unroll
        for (int ai = 0; ai < 2; ++ai)
#pragma unroll
            for (int m = 0; m < 4; ++m) { const float r = rs[ai][m]; f32x4 g0 = acc[ai][0][m][0] * r, g1 = acc[ai][0][m][1] * r; const f32x4 u0 = acc[ai][1][m][0] * r, u1 = acc[ai][1][m][1] * r;
#pragma unroll
                for (int x = 0; x < 4; ++x) { g0[x] = siluf_(g0[x]) * u0[x]; g1[x] = siluf_(g1[x]) * u1[x]; }
                *(u32x4*)(H + (size_t)(row0 + ai * HALF + m * 16) * FF + col0) = pack8(g0, g1); asm volatile("" ::: "memory"); }
    }
};
template <class Epi, class Sched, bool ALIGN_EPI = false, bool SP2 = false>
__device__ __forceinline__ void gemm_phase(PG8_LAS unsigned char* lds, const Gemm g, const Sched& S, const Epi& E, const int tid) {
    const int wid = __builtin_amdgcn_readfirstlane(tid >> 6), lane = tid & 63, wr = wid >> 2, wc = wid & 3, fr = lane & 15, fq = lane >> 4;
    const int K = g.K, nt = K / BK;
    unsigned voffA[2], voffB[2];
#pragma unroll
    for (int i = 0; i < 2; ++i) { int R, C; stage_rc(tid * 16 + i * 8192, R, C); const int Rb = Epi::PERM ? ((R & ~31) + perm32(R & 31)) : R;
        voffA[i] = (unsigned)(R * K + C) * 2u; voffB[i] = (unsigned)(Rb * K + C) * 2u; }
    const size_t kstep = (size_t)(BK * 2);
    const size_t hstep = (size_t)HALF * K * 2;
    const unsigned ldsw = (unsigned)wid * 1024u;
    const int aoff = lds_byte(wr * 64 + fr, fq * 8), boff = lds_byte(wc * 32 + fr, fq * 8);
#define PG8_SA(b, h) (((b) * 2 + (h)) * HTB)
#define PG8_SB(b, h) ((4 + (b) * 2 + (h)) * HTB)
#define PG8_STAGE(bufoff, gbase, voff) do { _Pragma("unroll") for (int _i = 0; _i < 2; ++_i) \
        __builtin_amdgcn_global_load_lds((const unsigned*)((const char*)(gbase) + (voff)[_i]), (PG8_LAS unsigned*)(lds + (bufoff) + ldsw + _i * 8192), 16, 0, 0); } while (0)
#define PG8_LDA(dst, b, h) do { _Pragma("unroll") for (int m = 0; m < 4; ++m) _Pragma("unroll") for (int k = 0; k < 2; ++k) dst[m][k] = *(const PG8_LAS bf16x8*)(lds + PG8_SA(b, h) + aoff + m * 2048 + k * 1024); } while (0)
#define PG8_LDB(dst, b, h) do { _Pragma("unroll") for (int n = 0; n < 2; ++n) _Pragma("unroll") for (int k = 0; k < 2; ++k) dst[n][k] = *(const PG8_LAS bf16x8*)(lds + PG8_SB(b, h) + boff + n * 2048 + k * 1024); } while (0)
#define PG8_MMA(ai, bj, At, Bt) do { __builtin_amdgcn_s_setprio(1); _Pragma("unroll") for (int m = 0; m < 4; ++m) _Pragma("unroll") for (int n = 0; n < 2; ++n) _Pragma("unroll") for (int k = 0; k < 2; ++k) \
        acc[ai][bj][m][n] = __builtin_amdgcn_mfma_f32_16x16x32_bf16(Bt[n][k], At[m][k], acc[ai][bj][m][n], 0, 0, 0); __builtin_amdgcn_s_setprio(0); } while (0)
#define PG8_WAIT_V(n) asm volatile("s_waitcnt vmcnt(" #n ")" ::: "memory")
#define PG8_WAIT_L(n) asm volatile("s_waitcnt lgkmcnt(" #n ")" ::: "memory")
#define PG8_BAR __builtin_amdgcn_s_barrier()
#define PG8_SCHED __builtin_amdgcn_sched_barrier(0)
    Unit cur, nxt; int ui = 0;
    if (!S.next(0, cur)) return;
    f32x4 acc[2][2][4][2];
#pragma unroll
    for (int a = 0; a < 2; ++a)
#pragma unroll
        for (int b = 0; b < 2; ++b)
#pragma unroll
            for (int m = 0; m < 4; ++m)
#pragma unroll
                for (int n = 0; n < 2; ++n) acc[a][b][m][n] = (f32x4){0.f, 0.f, 0.f, 0.f};
    bf16x8 At[4][2], B0[2][2], B1[2][2];
    const char* cA = S.pa(cur, g); const char* cB = S.pb(cur, g);
    S.a_ready(cur);
    if constexpr (SP2) {
        PG8_STAGE(PG8_SB(0, 0), cB, voffB); PG8_STAGE(PG8_SB(0, 1), cB + hstep, voffB); PG8_STAGE(PG8_SA(0, 0), cA, voffA); PG8_STAGE(PG8_SA(0, 1), cA + hstep, voffA);
        if (wr == 1) PG8_BAR;
        PG8_WAIT_V(2); PG8_BAR;
        PG8_STAGE(PG8_SB(1, 0), cB + kstep, voffB); PG8_STAGE(PG8_SA(1, 0), cA + kstep, voffA); PG8_STAGE(PG8_SB(1, 1), cB + hstep + kstep, voffB);
        PG8_WAIT_V(6); PG8_BAR;
    } else {
        PG8_STAGE(PG8_SB(0, 0), cB, voffB); PG8_STAGE(PG8_SA(0, 0), cA, voffA); PG8_STAGE(PG8_SB(0, 1), cB + hstep, voffB); PG8_STAGE(PG8_SA(0, 1), cA + hstep, voffA);
        if (wr == 1) PG8_BAR;
        PG8_WAIT_V(4); PG8_BAR;
        PG8_STAGE(PG8_SB(1, 0), cB + kstep, voffB); PG8_STAGE(PG8_SA(1, 0), cA + kstep, voffA); PG8_STAGE(PG8_SB(1, 1), cB + hstep + kstep, voffB);
        PG8_WAIT_V(6); PG8_BAR;
    }
    for (;;) {
        const bool has_next = S.next(ui + 1, nxt);
        const char* nA = has_next ? S.pa(nxt, g) : cA; const char* nB = has_next ? S.pb(nxt, g) : cB;
        for (int t = 0; t < nt; t += 2) {
            const bool last = (t == nt - 2);
            const char* a1 = cA + (size_t)(t + 1) * kstep;
            const char* a2 = last ? nA : cA + (size_t)(t + 2) * kstep; const char* b2 = last ? nB : cB + (size_t)(t + 2) * kstep;
            const char* a3 = a2 + kstep; const char* b3 = b2 + kstep;
            if (last && has_next) S.a_ready(nxt);
            if constexpr (SP2) {
            PG8_LDB(B0, 0, 0); PG8_LDB(B1, 0, 1); PG8_SCHED; PG8_LDA(At, 0, 0); PG8_STAGE(PG8_SA(1, 1), a1 + hstep, voffA);
            PG8_WAIT_V(8); PG8_WAIT_L(0); PG8_BAR; PG8_MMA(0, 0, At, B0); PG8_MMA(0, 1, At, B1); PG8_BAR; PG8_SCHED;
            PG8_LDA(At, 0, 1); PG8_STAGE(PG8_SB(0, 0), b2, voffB); PG8_STAGE(PG8_SB(0, 1), b2 + hstep, voffB); PG8_STAGE(PG8_SA(0, 0), a2, voffA);
            PG8_WAIT_V(8); PG8_WAIT_L(0); PG8_BAR; PG8_MMA(1, 0, At, B0); PG8_MMA(1, 1, At, B1); PG8_BAR; PG8_SCHED;
            PG8_LDB(B0, 1, 0); PG8_LDB(B1, 1, 1); PG8_SCHED; PG8_LDA(At, 1, 0); PG8_STAGE(PG8_SA(0, 1), a2 + hstep, voffA);
            PG8_WAIT_V(8); PG8_WAIT_L(0); PG8_BAR; PG8_MMA(0, 0, At, B0); PG8_MMA(0, 1, At, B1); PG8_BAR; PG8_SCHED;
            PG8_LDA(At, 1, 1); PG8_STAGE(PG8_SB(1, 0), b3, voffB); PG8_STAGE(PG8_SB(1, 1), b3 + hstep, voffB); PG8_STAGE(PG8_SA(1, 0), a3, voffA);
            PG8_WAIT_V(8); PG8_WAIT_L(0); PG8_BAR; PG8_MMA(1, 0, At, B0); PG8_MMA(1, 1, At, B1); PG8_BAR; PG8_SCHED;
            } else {
            PG8_LDB(B0, 0, 0); PG8_SCHED; PG8_LDA(At, 0, 0); PG8_STAGE(PG8_SA(1, 1), a1 + hstep, voffA);
            PG8_WAIT_L(8); PG8_BAR; PG8_WAIT_L(0); PG8_MMA(0, 0, At, B0); PG8_BAR; PG8_SCHED;
            PG8_LDB(B1, 0, 1); PG8_STAGE(PG8_SB(0, 0), b2, voffB);
            PG8_BAR; PG8_WAIT_L(0); PG8_MMA(0, 1, At, B1); PG8_BAR;
            PG8_LDA(At, 0, 1); PG8_STAGE(PG8_SA(0, 0), a2, voffA);
            PG8_BAR; PG8_WAIT_L(0); PG8_MMA(1, 0, At, B0); PG8_BAR; PG8_SCHED;
            PG8_STAGE(PG8_SB(0, 1), b2 + hstep, voffB);
            PG8_WAIT_V(6); PG8_BAR; PG8_MMA(1, 1, At, B1); PG8_BAR;
            PG8_LDB(B0, 1, 0); PG8_SCHED; PG8_LDA(At, 1, 0); PG8_STAGE(PG8_SA(0, 1), a2 + hstep, voffA);
            PG8_WAIT_L(8); PG8_BAR; PG8_WAIT_L(0); PG8_MMA(0, 0, At, B0); PG8_BAR; PG8_SCHED;
            PG8_LDB(B1, 1, 1); PG8_STAGE(PG8_SB(1, 0), b3, voffB);
            PG8_BAR; PG8_WAIT_L(0); PG8_MMA(0, 1, At, B1); PG8_BAR;
            PG8_LDA(At, 1, 1); PG8_STAGE(PG8_SA(1, 0), a3, voffA);
            PG8_BAR; PG8_WAIT_L(0); PG8_MMA(1, 0, At, B0); PG8_BAR; PG8_SCHED;
            PG8_STAGE(PG8_SB(1, 1), b3 + hstep, voffB);
            PG8_WAIT_V(6); PG8_BAR; PG8_MMA(1, 1, At, B1); PG8_BAR;
            }
        }
        if constexpr (ALIGN_EPI) { if (wr == 0) PG8_BAR; }
        if constexpr (!Epi::AFTER_DRAIN) { E(acc, cur, wr, wc, fr, fq); S.done(cur); }
        if (!has_next) break;
#pragma unroll
        for (int a = 0; a < 2; ++a)
#pragma unroll
            for (int b = 0; b < 2; ++b)
#pragma unroll
                for (int m = 0; m < 4; ++m)
#pragma unroll
                    for (int n = 0; n < 2; ++n) acc[a][b][m][n] = (f32x4){0.f, 0.f, 0.f, 0.f};
        cur = nxt; cA = nA; cB = nB; ++ui;
        if constexpr (ALIGN_EPI) { if (wr == 1) PG8_BAR; }
    }
    PG8_WAIT_V(0);
    if constexpr (!ALIGN_EPI) { if (wr == 0) PG8_BAR; }
    PG8_BAR;
    if constexpr (Epi::AFTER_DRAIN) { E.fused(acc, cur, wr, wc, fr, fq, lds, wid, lane); S.done(cur); }
#undef PG8_SA
#undef PG8_SB
#undef PG8_STAGE
#undef PG8_LDA
#undef PG8_LDB
#undef PG8_MMA
#undef PG8_WAIT_V
#undef PG8_WAIT_L
#undef PG8_BAR
#undef PG8_SCHED
}
}

constexpr int NWAVES = 8;
constexpr int RING_BYTES = 131072, LDSCTL_OFF = RING_BYTES, MISC_OFF = LDSCTL_OFF + 320, RSTD_OFF = RING_BYTES + 1024, LDS_BYTES = 147456;
constexpr int CW_BAR = 4096;
#define GAS __attribute__((address_space(1)))
#define LAS __attribute__((address_space(3)))
typedef GAS unsigned gu32;
#define RLX_AGENT __ATOMIC_RELAXED, __HIP_MEMORY_SCOPE_AGENT
#define XB_TMO      128
#define XB_XCNT(j)  (256  + 64 * (j))
#define XB_XSUB(j)  (1280 + 64 * (j))
#define XB_XGEN(j)  (2304 + 64 * (j))
#define XB_TOP      3328
#define XB_TOPGEN   3392
#define XCD_BAR_WORDS 3456
#define XB_SPIN_CAP (1u << 18)

__device__ __forceinline__ unsigned xb_ld(unsigned* p)              { return __hip_atomic_load(p, __ATOMIC_RELAXED, __HIP_MEMORY_SCOPE_AGENT); }
__device__ __forceinline__ unsigned xb_add(unsigned* p, unsigned v) { return __hip_atomic_fetch_add(p, v, __ATOMIC_RELAXED, __HIP_MEMORY_SCOPE_AGENT); }
__device__ __forceinline__ unsigned xb_xcc_id() { return (unsigned)__builtin_amdgcn_s_getreg((3 << 11) | 20) & 0xFu; }
#define XB_SPIN(cond, bar) do { unsigned _sp = 0; while (cond) { __builtin_amdgcn_s_sleep(1); \
    if ((++_sp & 255u) == 0u) { if (xb_ld(&(bar)[XB_TMO])) break; if (_sp > XB_SPIN_CAP) { atomicAdd(&(bar)[XB_TMO], 1u); break; } } } } while (0)

struct XcdBarrier {
    unsigned* bar; unsigned x; int w0;
    volatile LAS unsigned* st;
};

__device__ __forceinline__ XcdBarrier xcd_barrier_post(unsigned* bar, volatile LAS unsigned* st) {
    XcdBarrier b; b.bar = bar; b.x = xb_xcc_id(); b.st = st;
    if (threadIdx.x == 0) (void)xb_add(&bar[XB_XCNT(b.x)], 1u);
    return b;
}
__device__ __forceinline__ void xcd_barrier_complete(unsigned* bar, unsigned x, unsigned& nloc, unsigned& nx) {
    const unsigned G = gridDim.x * gridDim.y * gridDim.z;
    unsigned sum, cnt, mine, sp = 0u;
    for (;;) {
        sum = 0u; cnt = 0u; mine = 0u;
#pragma unroll
        for (unsigned j = 0; j < 16; ++j) { const unsigned c = xb_ld(&bar[XB_XCNT(j)]); sum += c; cnt += (c > 0u) ? 1u : 0u; mine = (j == x) ? c : mine; }
        if (sum == G) break;
        __builtin_amdgcn_s_sleep(1);
        if ((++sp & 255u) == 0u) { if (xb_ld(&bar[XB_TMO])) break; if (sp > XB_SPIN_CAP) { atomicAdd(&bar[XB_TMO], 1u); break; } }
    }
    nloc = mine > 0u ? mine : 1u; nx = cnt > 0u ? cnt : 1u;
}

__device__ __forceinline__ void xcd_barrier(const XcdBarrier& b) {
    asm volatile("s_waitcnt vmcnt(0)" ::: "memory");
    __syncthreads();
    int ln_; asm volatile("v_mbcnt_lo_u32_b32 %0, -1, 0\n\tv_mbcnt_hi_u32_b32 %0, -1, %0" : "=v"(ln_));
    if (b.w0 == 0 && ln_ == 0) {
        unsigned* bar = b.bar;
        __builtin_amdgcn_s_waitcnt(0);
        unsigned nloc = b.st[0], nx = b.st[1];
        if (nloc == 0u) { xcd_barrier_complete(bar, b.x, nloc, nx); b.st[0] = nloc; b.st[1] = nx; }
        const unsigned old = xb_add(&bar[XB_XSUB(b.x)], 1u);
        const unsigned gen = old / nloc;
        if (old + 1u == (gen + 1u) * nloc) {
            __builtin_amdgcn_fence(__ATOMIC_RELEASE, "agent");
            asm volatile("s_waitcnt vmcnt(0)" ::: "memory");
            const unsigned og = xb_add(&bar[XB_TOP], 1u);
            const unsigned tg = og / nx;
            if (og + 1u == (tg + 1u) * nx) xb_add(&bar[XB_TOPGEN], 1u);
            else XB_SPIN(xb_ld(&bar[XB_TOPGEN]) == tg, bar);
            __builtin_amdgcn_fence(__ATOMIC_ACQUIRE, "agent");
            xb_add(&bar[XB_XGEN(b.x)], 1u);
            asm volatile("s_waitcnt vmcnt(0)" ::: "memory");
        } else {
            XB_SPIN(xb_ld(&bar[XB_XGEN(b.x)]) == gen, bar);
            __builtin_amdgcn_fence(__ATOMIC_ACQUIRE, "agent");
            asm volatile("s_waitcnt vmcnt(0)" ::: "memory");
        }
    }
    __syncthreads();
}

constexpr size_t WS_RSSP = WS_RSS;
constexpr size_t WS_DL = 248 * MiB + 256 * 1024;
constexpr size_t WS_YC = WS_MQ;
constexpr size_t WS_YA = WS_SR;
constexpr size_t WS_MERGED2 = 214 * MiB;
constexpr size_t WS_S2 = 232 * MiB;
constexpr size_t WS_END2 = 249 * MiB;


namespace mix {
typedef unsigned u32x4 __attribute__((ext_vector_type(4)));
typedef unsigned u32x2 __attribute__((ext_vector_type(2)));
#define MIX_LAS __attribute__((address_space(3)))
using pg8::pack8; using pg8::unpack8; using pg8::cvt_pk_bf16;
#define MIX_BAR() do { asm volatile("s_waitcnt vmcnt(0) lgkmcnt(0)" ::: "memory"); __builtin_amdgcn_s_barrier(); asm volatile("" ::: "memory"); } while (0)

__device__ __forceinline__ void prepass_item(unsigned char* ws, const float* qw, const float* kw, int b, int blk, int h, MIX_LAS float* part, int tid, int lane, int wave) {
    const int sub = lane >> 4, c8 = (lane & 15) * 8;
    const f32x4 kw0 = *(const f32x4*)(kw + c8), kw1 = *(const f32x4*)(kw + c8 + 4);
    f32x4 cs0 = {0.f, 0.f, 0.f, 0.f}, cs1 = cs0;
    bf16_t* MK = (bf16_t*)(ws + WS_MK);
#pragma unroll 4
    for (int it = 0; it < 8; ++it) {
        const size_t off = ((size_t)b * SEQ + blk * 256 + wave * 32 + it * 4 + sub) * 512 + h * 128 + c8;
        { f32x4 a, c; unpack8(*(const u32x4*)(MK + off), a, c); float ss = ((a[0] * a[0] + a[1] * a[1]) + (a[2] * a[2] + a[3] * a[3])) + ((c[0] * c[0] + c[1] * c[1]) + (c[2] * c[2] + c[3] * c[3]));
          ss += swz_xor<1>(ss); ss += swz_xor<2>(ss); ss += swz_xor<4>(ss); ss += swz_xor<8>(ss); const float rs = rsqrtf(ss * (1.f / 128.f) + EPS);
          a = a * rs * kw0; c = c * rs * kw1; cs0 += a; cs1 += c; *(u32x4*)(MK + off) = pack8(a, c); }
    }
#pragma unroll
    for (int j = 0; j < 4; ++j) { cs0[j] += swz_xor<16>(cs0[j]); cs0[j] = half_sum(cs0[j]); cs1[j] += swz_xor<16>(cs1[j]); cs1[j] = half_sum(cs1[j]); }
    if (sub == 0) { *(MIX_LAS f32x4*)(part + wave * 128 + c8) = cs0; *(MIX_LAS f32x4*)(part + wave * 128 + c8 + 4) = cs1; }
    MIX_BAR();
    if (tid < 128) { float s = 0.f;
#pragma unroll
        for (int w = 0; w < 8; ++w) s += part[w * 128 + tid];
        ((float*)(ws + WS_KMEAN))[(((size_t)b * 4 + h) * 8 + blk) * 128 + tid] = s * (1.f / 256.f); }
    MIX_BAR();
}

constexpr int PSTR = 272;
__device__ __forceinline__ void pool_item(unsigned char* ws, const float* pscale, int pm, int g, MIX_LAS unsigned char* lds, int tid, int lane, int wave) {
    MIX_LAS unsigned char* P = lds; MIX_LAS unsigned char* W = lds + 256 * PSTR;
    const bf16_t* PW = (const bf16_t*)(ws + WS_W + W_PW) + g * 128 * 128;
#pragma unroll
    for (int j = 0; j < 4; ++j) { const int id = tid + 512 * j, e = id >> 4, cc = id & 15; *(MIX_LAS u32x4*)(W + e * PSTR + cc * 16) = *(const u32x4*)(PW + e * 128 + cc * 8); }
    {
        const int cp = tid & 63, seg = tid >> 6, w = 2 << g; const int row0 = pm * 256 + seg * 32, t0 = row0 & (SEQ - 1);
        const unsigned* PU = (const unsigned*)(ws + WS_PU) + g * 64 + cp;
        float s0 = 0.f, s1 = 0.f;
        for (int j = 1; j < w; ++j) if (t0 - j >= 0) { const unsigned v = PU[(size_t)(row0 - j) * 256]; s0 += __uint_as_float(v << 16); s1 += __uint_as_float(v & 0xffff0000u); }
#pragma unroll 8
        for (int r = 0; r < 32; ++r) {
            const int t = t0 + r; const unsigned v = PU[(size_t)(row0 + r) * 256]; const float u0 = __uint_as_float(v << 16), u1 = __uint_as_float(v & 0xffff0000u);
            s0 += u0; s1 += u1; const float ic = 1.f / (float)min(t + 1, w);
            *(MIX_LAS unsigned*)(P + (seg * 32 + r) * PSTR + cp * 4) = cvt_pk_bf16(s0 * ic - u0, s1 * ic - u1);
            if (t - w + 1 >= 0) { const unsigned o = PU[(size_t)(row0 + r - w + 1) * 256]; s0 -= __uint_as_float(o << 16); s1 -= __uint_as_float(o & 0xffff0000u); }
        }
    }
    MIX_BAR();
    f32x4 acc[8][2];
#pragma unroll
    for (int n = 0; n < 8; ++n) { acc[n][0] = (f32x4){0.f, 0.f, 0.f, 0.f}; acc[n][1] = acc[n][0]; }
    const int r = lane & 15, q = lane >> 4;
#pragma unroll
    for (int kk = 0; kk < 4; ++kk) {
        bf16x8 pf[2];
#pragma unroll
        for (int m = 0; m < 2; ++m) pf[m] = *(const MIX_LAS bf16x8*)(P + (wave * 32 + m * 16 + r) * PSTR + (kk * 32 + 8 * q) * 2);
#pragma unroll
        for (int n = 0; n < 8; ++n) { const bf16x8 wf = *(const MIX_LAS bf16x8*)(W + (n * 16 + r) * PSTR + (kk * 32 + 8 * q) * 2);
#pragma unroll
            for (int m = 0; m < 2; ++m) acc[n][m] = __builtin_amdgcn_mfma_f32_16x16x32_bf16(wf, pf[m], acc[n][m], 0, 0, 0); }
    }
    bf16_t* YB = (bf16_t*)(ws + WS_YB);
#pragma unroll
    for (int n = 0; n < 8; ++n) { const f32x4 sc = *(const f32x4*)(pscale + g * 128 + n * 16 + 4 * q);
#pragma unroll
        for (int m = 0; m < 2; ++m) { const f32x4 y = acc[n][m] * sc; u32x2 o; o.x = cvt_pk_bf16(y[0], y[1]); o.y = cvt_pk_bf16(y[2], y[3]);
            *(u32x2*)(YB + (size_t)(pm * 256 + wave * 32 + m * 16 + r) * 512 + g * 128 + n * 16 + 4 * q) = o; } }
    MIX_BAR();
}

constexpr int GSTR = 144;
constexpr int GL_SEG = 0, GL_QE = 1024, GL_KE = GL_QE + 64 * GSTR, GL_VT = GL_KE + 64 * GSTR, GL_P = GL_VT + 128 * GSTR, GL_HALF = 49152;
__device__ __forceinline__ void gla_cumsum(const float* GG, size_t row0, int h, MIX_LAS unsigned char* lds, int d, int seg, float (&bc)[16], float& bL) {
    const float* g = GG + (row0 + seg * 16) * 256 + h * 64 + d; float c = 0.f;
#pragma unroll
    for (int j = 0; j < 16; ++j) { c += g[j * 256]; bc[j] = c; }
    MIX_LAS float* SEG = (MIX_LAS float*)(lds + GL_SEG); SEG[seg * 64 + d] = c;
    MIX_BAR();
    float off = 0.f, tot = 0.f;
#pragma unroll
    for (int s = 0; s < 4; ++s) { const float v = SEG[s * 64 + d]; tot += v; off += (s < seg) ? v : 0.f; }
#pragma unroll
    for (int j = 0; j < 16; ++j) bc[j] += off;
    bL = tot;
}
__device__ __forceinline__ void gla_vt(const bf16_t* GV, size_t row0, int h, MIX_LAS unsigned char* lds, int t8) {
    const int e = t8 & 127, tq = t8 >> 7; const bf16_t* v = GV + (row0 + tq * 32) * 512 + h * 128 + e; unsigned w[16];
#pragma unroll
    for (int j = 0; j < 16; ++j) w[j] = (unsigned)v[(2 * j) * 512] | ((unsigned)v[(2 * j + 1) * 512] << 16);
    MIX_LAS u32x4* p = (MIX_LAS u32x4*)(lds + GL_VT + e * GSTR + tq * 64);
#pragma unroll
    for (int j = 0; j < 4; ++j) p[j] = (u32x4){w[4 * j], w[4 * j + 1], w[4 * j + 2], w[4 * j + 3]};
}
__device__ __forceinline__ void gla_passA_pair(unsigned char* ws, int pair, MIX_LAS unsigned char* lds0, int tid, int lane, int wave) {
    const int hb = tid >> 8, t8 = tid & 255, w4 = wave & 3, cid = 2 * pair + hb; MIX_LAS unsigned char* lds = lds0 + hb * GL_HALF;
    const int d = t8 & 63, seg = t8 >> 6, bh = cid >> 5, n = cid & 31, b = bh >> 2, h = bh & 3; const size_t row0 = (size_t)b * SEQ + n * 64;
    float bc[16], bL;
    const bf16_t* gk = (const bf16_t*)(ws + WS_GK) + (row0 + seg * 16) * 256 + h * 64 + d; float kv[16];
#pragma unroll
    for (int j = 0; j < 16; ++j) kv[j] = bf2f(gk[j * 256]);
    gla_vt((const bf16_t*)(ws + WS_GV), row0, h, lds, t8);
    gla_cumsum((const float*)(ws + WS_GG), row0, h, lds, d, seg, bc, bL);
#pragma unroll
    for (int j8 = 0; j8 < 2; ++j8) { f32x4 a, c;
#pragma unroll
      for (int j = 0; j < 4; ++j) { a[j] = kv[8 * j8 + j] * __expf(bL - bc[8 * j8 + j]); c[j] = kv[8 * j8 + 4 + j] * __expf(bL - bc[8 * j8 + 4 + j]); }
      *(MIX_LAS u32x4*)(lds + GL_KE + d * GSTR + seg * 32 + j8 * 16) = pack8(a, c); }
    if (seg == 0) ((float*)(ws + WS_DL))[(size_t)cid * 64 + d] = __expf(bL);
    MIX_BAR();
    const int r = lane & 15, q = lane >> 4; f32x4 acc[2][4];
#pragma unroll
    for (int ee = 0; ee < 2; ++ee)
#pragma unroll
        for (int dt = 0; dt < 4; ++dt) acc[ee][dt] = (f32x4){0.f, 0.f, 0.f, 0.f};
#pragma unroll
    for (int kk = 0; kk < 2; ++kk) { bf16x8 kf[4];
#pragma unroll
        for (int dt = 0; dt < 4; ++dt) kf[dt] = *(const MIX_LAS bf16x8*)(lds + GL_KE + (dt * 16 + r) * GSTR + (kk * 32 + 8 * q) * 2);
#pragma unroll
        for (int ee = 0; ee < 2; ++ee) { const bf16x8 vf = *(const MIX_LAS bf16x8*)(lds + GL_VT + ((2 * w4 + ee) * 16 + r) * GSTR + (kk * 32 + 8 * q) * 2);
#pragma unroll
            for (int dt = 0; dt < 4; ++dt) acc[ee][dt] = __builtin_amdgcn_mfma_f32_16x16x32_bf16(kf[dt], vf, acc[ee][dt], 0, 0, 0); } }
#pragma unroll
    for (int ee = 0; ee < 2; ++ee) { bf16_t* US = (bf16_t*)(ws + WS_US) + ((size_t)cid * 128 + (2 * w4 + ee) * 16 + r) * 64;
#pragma unroll
        for (int dt = 0; dt < 4; ++dt) { u32x2 o; o.x = cvt_pk_bf16(acc[ee][dt][0], acc[ee][dt][1]); o.y = cvt_pk_bf16(acc[ee][dt][2], acc[ee][dt][3]); *(u32x2*)(US + dt * 16 + 4 * q) = o; } }
    MIX_BAR();
}
__device__ __forceinline__ void gla_scan(unsigned char* ws, int gtid) {
    const int bh = gtid >> 12, e = (gtid >> 5) & 127, dp = gtid & 31;
    const size_t uoff = (((size_t)bh * 32) * 128 + e) * 32 + dp; const unsigned* US = (const unsigned*)(ws + WS_US) + uoff; unsigned* S2 = (unsigned*)(ws + WS_S2) + uoff; const float* DLp = (const float*)(ws + WS_DL) + (size_t)bh * 32 * 64 + 2 * dp;
    float s0 = 0.f, s1 = 0.f;
#pragma unroll 8
    for (int n = 0; n < 32; ++n) { const unsigned u = US[(size_t)n * 128 * 32]; const float d0 = DLp[n * 64], d1 = DLp[n * 64 + 1];
        S2[(size_t)n * 128 * 32] = cvt_pk_bf16(s0, s1);
        s0 = d0 * s0 + __uint_as_float(u << 16); s1 = d1 * s1 + __uint_as_float(u & 0xffff0000u); }
}
__device__ __forceinline__ void gla_passC_pair(unsigned char* ws, const float* nw, int pair, MIX_LAS unsigned char* lds0, int tid, int lane, int wave, size_t ya_off) {
    const int hb = tid >> 8, t8 = tid & 255, w4 = wave & 3, cid = 2 * pair + hb; MIX_LAS unsigned char* lds = lds0 + hb * GL_HALF;
    const int d = t8 & 63, seg = t8 >> 6, bh = cid >> 5, n = cid & 31, b = bh >> 2, h = bh & 3; const size_t row0 = (size_t)b * SEQ + n * 64;
    const int r = lane & 15, q = lane >> 4, it = w4;
    const size_t yoff = (row0 + it * 16 + r) * 512 + h * 128 + 4 * q; u32x2 srv[8];
#pragma unroll
    for (int et = 0; et < 8; ++et) srv[et] = *(const u32x2*)((const bf16_t*)(ws + WS_SR) + yoff + et * 16);
    bf16x8 sfr[8][2]; { const bf16_t* ST = (const bf16_t*)(ws + WS_S2) + (size_t)cid * 128 * 64;
#pragma unroll
        for (int et = 0; et < 8; ++et)
#pragma unroll
            for (int kk = 0; kk < 2; ++kk) sfr[et][kk] = *(const bf16x8*)(ST + (et * 16 + r) * 64 + kk * 32 + 8 * q); }
    float bc[16], bL;
    {
        const bf16_t* gk = (const bf16_t*)(ws + WS_GK) + (row0 + seg * 16) * 256 + h * 64 + d; const bf16_t* gq = (const bf16_t*)(ws + WS_GQ) + (row0 + seg * 16) * 256 + h * 64 + d; float kv[16], qv[16];
#pragma unroll
        for (int j = 0; j < 16; ++j) { kv[j] = bf2f(gk[j * 256]); qv[j] = bf2f(gq[j * 256]); }
        gla_vt((const bf16_t*)(ws + WS_GV), row0, h, lds, t8);
        gla_cumsum((const float*)(ws + WS_GG), row0, h, lds, d, seg, bc, bL);
#pragma unroll
        for (int j = 0; j < 16; ++j) { const float ex = __expf(bc[j]);
            *(MIX_LAS bf16_t*)(lds + GL_QE + (seg * 16 + j) * GSTR + 2 * d) = f2bf(qv[j] * ex);
            *(MIX_LAS bf16_t*)(lds + GL_KE + (seg * 16 + j) * GSTR + 2 * d) = f2bf(kv[j] * __expf(-bc[j])); }
    }
    MIX_BAR();
    bf16x8 qf[2];
#pragma unroll
    for (int kk = 0; kk < 2; ++kk) qf[kk] = *(const MIX_LAS bf16x8*)(lds + GL_QE + (it * 16 + r) * GSTR + (kk * 32 + 8 * q) * 2);
#pragma unroll
    for (int jt = 0; jt < 4; ++jt) { f32x4 acc = {0.f, 0.f, 0.f, 0.f};
        if (jt <= it) {
#pragma unroll
            for (int kk = 0; kk < 2; ++kk) { const bf16x8 kf = *(const MIX_LAS bf16x8*)(lds + GL_KE + (jt * 16 + r) * GSTR + (kk * 32 + 8 * q) * 2);
                acc = __builtin_amdgcn_mfma_f32_16x16x32_bf16(qf[kk], kf, acc, 0, 0, 0); }
            if (jt == it) {
#pragma unroll
                for (int x = 0; x < 4; ++x) if (r > 4 * q + x) acc[x] = 0.f; } }
#pragma unroll
        for (int x = 0; x < 4; ++x) *(MIX_LAS bf16_t*)(lds + GL_P + (it * 16 + 4 * q + x) * GSTR + (jt * 16 + r) * 2) = f2bf(acc[x]); }
    asm volatile("s_waitcnt lgkmcnt(0)" ::: "memory");
    bf16x8 pf[2];
#pragma unroll
    for (int kk = 0; kk < 2; ++kk) pf[kk] = *(const MIX_LAS bf16x8*)(lds + GL_P + (it * 16 + r) * GSTR + (kk * 32 + 8 * q) * 2);
    f32x4 acc[8]; float ss = 0.f;
#pragma unroll
    for (int et = 0; et < 8; ++et) { acc[et] = (f32x4){0.f, 0.f, 0.f, 0.f};
#pragma unroll
        for (int kk = 0; kk < 2; ++kk) { const bf16x8 vf = *(const MIX_LAS bf16x8*)(lds + GL_VT + (et * 16 + r) * GSTR + (kk * 32 + 8 * q) * 2);
            const bf16x8 sf = sfr[et][kk];
            acc[et] = __builtin_amdgcn_mfma_f32_16x16x32_bf16(vf, pf[kk], acc[et], 0, 0, 0);
            acc[et] = __builtin_amdgcn_mfma_f32_16x16x32_bf16(sf, qf[kk], acc[et], 0, 0, 0); } }
#pragma unroll
    for (int et = 0; et < 8; ++et) ss += (acc[et][0] * acc[et][0] + acc[et][1] * acc[et][1]) + (acc[et][2] * acc[et][2] + acc[et][3] * acc[et][3]);
    ss += swz_xor<16>(ss); ss = half_sum(ss);
    const float rstd = rsqrtf(ss * (1.f / 128.f) + EPS);
    bf16_t* YA = (bf16_t*)(ws + ya_off) + yoff;
#pragma unroll
    for (int et = 0; et < 8; ++et) { const u32x2 sr = srv[et]; const f32x4 w4v = *(const f32x4*)(nw + et * 16 + 4 * q);
        const float y0 = acc[et][0] * rstd * w4v[0] * __uint_as_float(sr.x << 16), y1 = acc[et][1] * rstd * w4v[1] * __uint_as_float(sr.x & 0xffff0000u);
        const float y2 = acc[et][2] * rstd * w4v[2] * __uint_as_float(sr.y << 16), y3 = acc[et][3] * rstd * w4v[3] * __uint_as_float(sr.y & 0xffff0000u);
        u32x2 o; o.x = cvt_pk_bf16(y0, y1); o.y = cvt_pk_bf16(y2, y3); *(u32x2*)(YA + et * 16) = o; }
    MIX_BAR();
}
}

namespace moba {
typedef short s16x4 __attribute__((ext_vector_type(4)));
typedef float f32x16 __attribute__((ext_vector_type(16)));
typedef unsigned u32x4 __attribute__((ext_vector_type(4)));
using pg8::cvt_pk_bf16;
constexpr int D = 128, LD = 512, NW = 8, QBLK = 32, KVBLK = 128, QB = 256;
constexpr int SHM_V = KVBLK * D * 2, SHM_K = KVBLK * D * 2;
constexpr int LDS_WS = 131072 + 1024, LDS_TAB = LDS_WS + NW * 64 * 4, LDS_BYTES = LDS_TAB + 512;
constexpr float THR2 = 11.5f;
#define KSWZ(row, colB) ((row) * 256 + ((colB) ^ (((row) & 7) << 4)))
#define SBAR() __builtin_amdgcn_sched_barrier(0)
__device__ __forceinline__ int v_st(int k, int c) { const int kk = (k & ~0xC) | ((k & 4) << 1) | ((k & 8) >> 1); return ((kk >> 3) * 4 + (c >> 5)) * 512 + ((kk & 7) * 32 + (c & 31)) * 2; }
__device__ __forceinline__ int v_rd_base(int lane) { return ((lane & 3) << 3) | (((lane >> 2) & 3) << 6) | (((lane >> 4) & 1) << 5) | (((lane >> 5) & 1) << 8); }
constexpr int v_rd_off(int d0, int ks, int half) { return d0 * 512 + ks * 4096 + half * 2048; }
__device__ __forceinline__ int crow(int r, int hi) { return (r & 3) + 8 * (r >> 2) + 4 * hi; }
__device__ __forceinline__ bf16x8 load8(const bf16_t* p) { return *reinterpret_cast<const bf16x8*>(p); }

__device__ __forceinline__ void partialSM(f32x16& p0, f32x16& p1, float& m_reg, float& mn, float& alpha) {
    float pmax = p0[0];
#pragma unroll
    for (int r = 1; r < 16; ++r) pmax = fmaxf(pmax, p0[r]);
#pragma unroll
    for (int r = 0; r < 16; ++r) pmax = fmaxf(pmax, p1[r]);
    { auto rr = __builtin_amdgcn_permlane32_swap(__float_as_uint(pmax), __float_as_uint(pmax), false, false); pmax = fmaxf(__uint_as_float(rr[0]), __uint_as_float(rr[1])); }
    if (__builtin_expect(__all((pmax - m_reg) <= THR2), 1)) { mn = m_reg; alpha = 1.f; }
    else { mn = fmaxf(m_reg, pmax); alpha = __builtin_amdgcn_exp2f(m_reg - mn); m_reg = mn; }
#pragma unroll
    for (int r = 0; r < 16; ++r) p0[r] = p0[r] - mn;
#pragma unroll
    for (int r = 0; r < 16; ++r) p1[r] = p1[r] - mn;
#pragma unroll
    for (int r = 0; r < 16; ++r) p0[r] = __builtin_amdgcn_exp2f(p0[r]);
}
__device__ __forceinline__ void finishSM(f32x16& p0, f32x16& p1, float alpha, float& l_reg, bf16x8& pa0, bf16x8& pa1, bf16x8& pa2, bf16x8& pa3) {
#pragma unroll
    for (int r = 0; r < 16; ++r) p1[r] = __builtin_amdgcn_exp2f(p1[r]);
    float ps = 0;
#pragma unroll
    for (int r = 0; r < 16; ++r) ps += p0[r];
#pragma unroll
    for (int r = 0; r < 16; ++r) ps += p1[r];
    { auto rr = __builtin_amdgcn_permlane32_swap(__float_as_uint(ps), __float_as_uint(ps), false, false); ps = __uint_as_float(rr[0]) + __uint_as_float(rr[1]); }
    l_reg = l_reg * alpha + ps;
#define PK4(P, B_, OUT) do { unsigned a0 = cvt_pk_bf16(P[B_+0], P[B_+1]), a1 = cvt_pk_bf16(P[B_+2], P[B_+3]);                          \
        unsigned b0 = cvt_pk_bf16(P[B_+4], P[B_+5]), b1 = cvt_pk_bf16(P[B_+6], P[B_+7]);                                             \
        auto r0 = __builtin_amdgcn_permlane32_swap(a0, b0, false, false); auto r1 = __builtin_amdgcn_permlane32_swap(a1, b1, false, false); \
        u32x4 w = {r0[0], r1[0], r0[1], r1[1]}; OUT = *reinterpret_cast<bf16x8*>(&w); } while (0)
    PK4(p0, 0, pa0); PK4(p0, 8, pa1); PK4(p1, 0, pa2); PK4(p1, 8, pa3);
#undef PK4
}
template <int KB>
__device__ __forceinline__ void qkt(f32x16& p0, f32x16& p1, const char* K_lds, int krow, int hi, const bf16x8* qr, bool act) {
    if (!act) { const float NEG = -__builtin_inff();
#pragma unroll
        for (int r = 0; r < 16; ++r) { p0[r] = NEG; p1[r] = NEG; } return; }
    p0 = f32x16{}; p1 = f32x16{};
    const char* kb[4];
#pragma unroll
    for (int dd = 0; dd < 4; ++dd) kb[dd] = K_lds + KB * SHM_K + KSWZ(krow, (dd * 16 + hi * 8) * 2);
#pragma unroll
    for (int d0 = 0; d0 < 8; ++d0) { const char* a = kb[d0 & 3] + (d0 >> 2) * 128;
        bf16x8 b0 = *reinterpret_cast<const bf16x8*>(a);
        bf16x8 b1 = *reinterpret_cast<const bf16x8*>(a + 32 * 256);
        p0 = __builtin_amdgcn_mfma_f32_32x32x16_bf16(b0, qr[d0], p0, 0, 0, 0);
        p1 = __builtin_amdgcn_mfma_f32_32x32x16_bf16(b1, qr[d0], p1, 0, 0, 0); }
}
template <int VB>
__device__ __forceinline__ void pv_tile(f32x16* o, int vb0, bf16x8 pa0, bf16x8 pa1, bf16x8 pa2, bf16x8 pa3, bool act) {
    if (!act) return;
#define TRRD(dst, off) asm volatile("ds_read_b64_tr_b16 %0, %1 offset:%2" : "=&v"(dst) : "v"(vb0), "i"(off) : "memory")
#define PV_D0(d0) do { s16x4 l0, l1, l2, l3, h0, h1, h2, h3; constexpr int b_ = VB * SHM_V + v_rd_off(d0, 0, 0); \
        TRRD(l0, b_); TRRD(h0, b_ + 2048); TRRD(l1, b_ + 4096); TRRD(h1, b_ + 6144); TRRD(l2, b_ + 8192); TRRD(h2, b_ + 10240); TRRD(l3, b_ + 12288); TRRD(h3, b_ + 14336); \
        asm volatile("s_waitcnt lgkmcnt(0)" ::: "memory"); SBAR();   \
        o[d0] = __builtin_amdgcn_mfma_f32_32x32x16_bf16(pa0, (bf16x8){l0[0], l0[1], l0[2], l0[3], h0[0], h0[1], h0[2], h0[3]}, o[d0], 0, 0, 0);   \
        o[d0] = __builtin_amdgcn_mfma_f32_32x32x16_bf16(pa1, (bf16x8){l1[0], l1[1], l1[2], l1[3], h1[0], h1[1], h1[2], h1[3]}, o[d0], 0, 0, 0);   \
        o[d0] = __builtin_amdgcn_mfma_f32_32x32x16_bf16(pa2, (bf16x8){l2[0], l2[1], l2[2], l2[3], h2[0], h2[1], h2[2], h2[3]}, o[d0], 0, 0, 0);   \
        o[d0] = __builtin_amdgcn_mfma_f32_32x32x16_bf16(pa3, (bf16x8){l3[0], l3[1], l3[2], l3[3], h3[0], h3[1], h3[2], h3[3]}, o[d0], 0, 0, 0); } while (0)
    PV_D0(0); PV_D0(1); PV_D0(2); PV_D0(3);
#undef PV_D0
#undef TRRD
}
__device__ __forceinline__ void mask_bias_tile(f32x16& p0, f32x16& p1, int dq, const float* tab) {
    const float NEG = -__builtin_inff();
#pragma unroll
    for (int r = 0; r < 16; ++r) { const int c = (r & 3) + 8 * (r >> 2); const int d0 = dq - c, d1 = dq - c - 32;
        p0[r] = d0 < 0 ? NEG : p0[r] + tab[d0 > 113 ? 113 : d0];
        p1[r] = d1 < 0 ? NEG : p1[r] + tab[d1 > 113 ? 113 : d1]; }
}
__device__ __forceinline__ void bias_tile(f32x16& p0, f32x16& p1, int dq, const float* tab) {
#pragma unroll
    for (int r = 0; r < 16; ++r) { const int c = (r & 3) + 8 * (r >> 2); const int d0 = dq - c, d1 = dq - c - 32;
        p0[r] += tab[d0 > 113 ? 113 : d0]; p1[r] += tab[d1 > 113 ? 113 : d1]; }
}
__device__ __forceinline__ void kill_tile(f32x16& p0, f32x16& p1, bool ok) {
    const float NEG = -__builtin_inff();
#pragma unroll
    for (int r = 0; r < 16; ++r) { p0[r] = ok ? p0[r] : NEG; p1[r] = ok ? p1[r] : NEG; }
}

struct BlockRef { const bf16_t* Q; const bf16_t* K; const bf16_t* V; bf16_t* O; const float* km; int P0; };
struct Seam { bf16x8 qr[8]; bf16x8 st_v0, st_v1, st_v2, st_v3, st_k0, st_k1, st_k2, st_k3; };
#define ROW(p, k0, rr) ((p) + (size_t)((k0) + (rr)) * LD + sc)
#define VMW() asm volatile("s_waitcnt vmcnt(0)" ::: "memory")
#define SLOAD_H(Kp, Vp, k0) do { S.st_v0 = load8(ROW(Vp, k0, sr)); S.st_v1 = load8(ROW(Vp, k0, 32 + sr)); S.st_v2 = load8(ROW(Vp, k0, 64 + sr)); S.st_v3 = load8(ROW(Vp, k0, 96 + sr)); \
                                 S.st_k0 = load8(ROW(Kp, k0, sr)); S.st_k1 = load8(ROW(Kp, k0, 32 + sr)); S.st_k2 = load8(ROW(Kp, k0, 64 + sr)); S.st_k3 = load8(ROW(Kp, k0, 96 + sr)); } while (0)
#define SWRITE_HK(bf) do { *(bf16x8*)(K_lds + (bf) * SHM_K + kws) = S.st_k0; *(bf16x8*)(K_lds + (bf) * SHM_K + kws + 32 * 256) = S.st_k1; *(bf16x8*)(K_lds + (bf) * SHM_K + kws + 64 * 256) = S.st_k2; *(bf16x8*)(K_lds + (bf) * SHM_K + kws + 96 * 256) = S.st_k3; } while (0)
#define SWRITE_HV(bf) do { *(bf16x8*)(V_lds + (bf) * SHM_V + vst0) = S.st_v0; *(bf16x8*)(V_lds + (bf) * SHM_V + vst1) = S.st_v1; *(bf16x8*)(V_lds + (bf) * SHM_V + 16384 + vst0) = S.st_v2; *(bf16x8*)(V_lds + (bf) * SHM_V + 16384 + vst1) = S.st_v3; } while (0)
#define SWRITE_H(bf) do { SWRITE_HV(bf); SWRITE_HK(bf); } while (0)
__device__ __forceinline__ void prime(const BlockRef& cur, const float* rel_bias, const float* qw, int h, char* lds, Seam& S, int tid) {
    const int wid = __builtin_amdgcn_readfirstlane(tid >> 6), lane = tid & 63, r32 = lane & 31, hi = lane >> 5, rg = wid & 3;
    const int sr = tid >> 4, sc = (tid & 15) * 8, kws = KSWZ(sr, sc * 2); char* K_lds = lds + 2 * SHM_V;
    __syncthreads();
    if (tid < 128) { int bk = tid; if (tid >= 16) { bk = 16 + (int)(__logf((float)tid * (1.f / 16.f)) * (16.f / 2.0794415416798357f)); bk = bk > 31 ? 31 : bk; }
        ((float*)(lds + LDS_TAB))[tid] = tid >= 113 ? 0.f : (rel_bias[bk * 4 + h] - rel_bias[31 * 4 + h]) * LOG2E; }
#pragma unroll
    for (int d0 = 0; d0 < 8; ++d0) S.qr[d0] = load8(cur.Q + (size_t)(rg * QBLK + r32) * LD + d0 * 16 + hi * 8);
    SLOAD_H(cur.K, cur.V, 0);
    {
        float qf[8][8]; float ss = 0.f;
#pragma unroll
        for (int d0 = 0; d0 < 8; ++d0)
#pragma unroll
            for (int j = 0; j < 8; ++j) { qf[d0][j] = __uint_as_float(((unsigned)(unsigned short)S.qr[d0][j]) << 16); ss += qf[d0][j] * qf[d0][j]; }
        ss = half_sum(ss); const float rs = rsqrtf(ss * (1.f / 128.f) + EPS) * QSCALE;
#pragma unroll
        for (int d0 = 0; d0 < 8; ++d0) { const f32x4 w0 = *(const f32x4*)(qw + d0 * 16 + hi * 8), w1 = *(const f32x4*)(qw + d0 * 16 + hi * 8 + 4);
            u32x4 pk; pk.x = cvt_pk_bf16(qf[d0][0] * rs * w0[0], qf[d0][1] * rs * w0[1]); pk.y = cvt_pk_bf16(qf[d0][2] * rs * w0[2], qf[d0][3] * rs * w0[3]);
            pk.z = cvt_pk_bf16(qf[d0][4] * rs * w1[0], qf[d0][5] * rs * w1[1]); pk.w = cvt_pk_bf16(qf[d0][6] * rs * w1[2], qf[d0][7] * rs * w1[3]);
            S.qr[d0] = *reinterpret_cast<bf16x8*>(&pk); }
    }
    VMW(); SWRITE_HK(0);
    __syncthreads();
}
__device__ __forceinline__ void block(const BlockRef& cur, char* lds, Seam& S, int tid) {
    const int wid = __builtin_amdgcn_readfirstlane(tid >> 6), lane = tid & 63, r32 = lane & 31, hi = lane >> 5, rg = wid & 3, kh = wid >> 2;
    const int qblk = cur.P0 >> 8, NT = 2 * qblk + 2;
    const int qlo = cur.P0 + rg * QBLK, qm = qlo + r32 - 4 * hi - 64 * kh;
    char* V_lds = lds; char* K_lds = lds + 2 * SHM_V;
    float* ws = (float*)(lds + LDS_WS) + wid * 64; float* li_l = ws, * al_l = ws + 32; const float* tab = (const float*)(lds + LDS_TAB);
    float m_reg = -1e30f, l_reg = 0; f32x16 o[4] = {};
    const int sr = tid >> 4, sc = (tid & 15) * 8, vst0 = v_st(sr, sc), vst1 = v_st(32 + sr, sc), kws = KSWZ(sr, sc * 2);
    const int vb0 = (int)(uintptr_t)V_lds + v_rd_base(lane) + kh * 16384, krow = r32 + 64 * kh;
    const bf16_t* Kh = cur.K; const bf16_t* Vh = cur.V;
    unsigned sel = (1u << qblk) - 1u;
    if (qblk > 3) {
        float s[7];
#pragma unroll
        for (int n = 0; n < 7; ++n) { s[n] = -__builtin_inff();
            if (n < qblk) { float a = 0.f; const float* kmn = cur.km + n * 128 + hi * 8;
#pragma unroll
                for (int d0 = 0; d0 < 8; ++d0) { const f32x4 k0 = *(const f32x4*)(kmn + d0 * 16), k1 = *(const f32x4*)(kmn + d0 * 16 + 4); const bf16x8 qv = S.qr[d0];
#pragma unroll
                    for (int j = 0; j < 4; ++j) { a += __uint_as_float(((unsigned)(unsigned short)qv[j]) << 16) * k0[j]; a += __uint_as_float(((unsigned)(unsigned short)qv[4 + j]) << 16) * k1[j]; } }
                s[n] = half_sum(a); } }
        sel = 0u;
#pragma unroll
        for (int c = 0; c < 3; ++c) { float best = -__builtin_inff(); int bi = 0;
#pragma unroll
            for (int n = 0; n < 7; ++n) if (s[n] > best) { best = s[n]; bi = n; }
            sel |= 1u << bi;
#pragma unroll
            for (int n = 0; n < 7; ++n) s[n] = (n == bi) ? -__builtin_inff() : s[n]; }
    }
#define RESC(a) do { if (__any((a) < 1.f)) { if (hi == 0) al_l[r32] = (a); asm volatile("s_waitcnt lgkmcnt(0)" ::: "memory");              \
                     for (int d_ = 0; d_ < 4; ++d_) for (int r = 0; r < 16; ++r) o[d_][r] *= al_l[crow(r, hi)]; } } while (0)
#define KBASE(t) ((t) * KVBLK)
#define ACT(t) ((KBASE(t) >> 8) < qblk ? (__any((sel >> (KBASE(t) >> 8)) & 1u) != 0) : (KBASE(t) + 64 * kh <= qlo + QBLK - 1))
#define MASKT(P0_, P1_, t) do { const int kb_ = KBASE(t); if (ACT(t)) { if ((kb_ >> 8) < qblk) { if (kb_ + 64 * kh + 176 > qlo) bias_tile(P0_, P1_, qm - kb_, tab); kill_tile(P0_, P1_, ((sel >> (kb_ >> 8)) & 1u) != 0u); } \
                                     else mask_bias_tile(P0_, P1_, qm - kb_, tab); } } while (0)
    f32x16 pA0, pA1, pB0, pB1; float mnA, mnB, alA, alB; bf16x8 pa0, pa1, pa2, pa3;
    SWRITE_HV(0); SBAR();
    SLOAD_H(Kh, Vh, KBASE(1));
    SBAR(); qkt<0>(pA0, pA1, K_lds, krow, hi, S.qr, ACT(0));
    MASKT(pA0, pA1, 0); partialSM(pA0, pA1, m_reg, mnA, alA);
    VMW(); SWRITE_H(1); SBAR(); if (2 < NT) { SLOAD_H(Kh, Vh, KBASE(2)); } SBAR();
    __syncthreads();
#define HALF_STEP(PX0, PX1, mnX, alX, PY0, PY1, alY, t, KB, VB, SB) do {                                                      \
        SBAR(); qkt<KB>(PX0, PX1, K_lds, krow, hi, S.qr, ACT(t));                                                          \
        finishSM(PY0, PY1, alY, l_reg, pa0, pa1, pa2, pa3); SBAR();                                                           \
        pv_tile<VB>(o, vb0, pa0, pa1, pa2, pa3, ACT((t) - 1)); MASKT(PX0, PX1, (t)); partialSM(PX0, PX1, m_reg, mnX, alX);    \
        __syncthreads();                                                                                                      \
        if ((t) + 1 < NT) { VMW(); SWRITE_H(SB); SBAR(); if ((t) + 2 < NT) { SLOAD_H(Kh, Vh, KBASE((t) + 2)); } SBAR(); }          \
        RESC(alX); __syncthreads(); } while (0)
    for (int t = 1; t + 1 < NT; t += 2) {
        HALF_STEP(pB0, pB1, mnB, alB, pA0, pA1, alA, t, 1, 0, 0);
        HALF_STEP(pA0, pA1, mnA, alA, pB0, pB1, alB, t + 1, 0, 1, 1);
    }
    SBAR(); qkt<1>(pB0, pB1, K_lds, krow, hi, S.qr, ACT(NT - 1)); SBAR();
    finishSM(pA0, pA1, alA, l_reg, pa0, pa1, pa2, pa3); SBAR();
    pv_tile<0>(o, vb0, pa0, pa1, pa2, pa3, ACT(NT - 2));
    MASKT(pB0, pB1, NT - 1); partialSM(pB0, pB1, m_reg, mnB, alB); __syncthreads(); RESC(alB);
    finishSM(pB0, pB1, alB, l_reg, pa0, pa1, pa2, pa3); SBAR(); pv_tile<1>(o, vb0, pa0, pa1, pa2, pa3, ACT(NT - 1));
    __syncthreads();
    float* mls = (float*)(lds + LDS_WS) + (rg + 4) * 64;
    float* osh = (float*)lds + (size_t)rg * 64 * 64;
    if (kh == 1) { if (hi == 0) { mls[r32] = m_reg; mls[32 + r32] = l_reg; }
#pragma unroll
        for (int d0 = 0; d0 < 4; ++d0)
#pragma unroll
            for (int r = 0; r < 16; ++r) osh[(d0 * 16 + r) * 64 + lane] = o[d0][r]; }
    __syncthreads();
    if (kh == 0) {
        const float m1 = mls[r32], l1 = mls[32 + r32]; const float mm = fmaxf(m_reg, m1); const float a0 = __builtin_amdgcn_exp2f(m_reg - mm), a1 = __builtin_amdgcn_exp2f(m1 - mm);
        const float il = __builtin_amdgcn_rcpf(l_reg * a0 + l1 * a1);
        if (hi == 0) { li_l[r32] = a0 * il; al_l[r32] = a1 * il; } asm volatile("s_waitcnt lgkmcnt(0)" ::: "memory");
        bf16_t* Ow = cur.O + (size_t)(rg * QBLK) * LD;
#pragma unroll
        for (int r = 0; r < 16; ++r) { const int orow = crow(r, hi); const float f0 = li_l[orow], f1 = al_l[orow];
#pragma unroll
            for (int d0 = 0; d0 < 4; ++d0) { const float v = o[d0][r] * f0 + osh[(d0 * 16 + r) * 64 + lane] * f1; const float vn = swz_xor<1>(v);
                if ((r32 & 1) == 0) *(unsigned*)(Ow + (size_t)orow * LD + d0 * 32 + r32) = cvt_pk_bf16(v, vn); } }
    }
#undef RESC
#undef KBASE
#undef ACT
#undef MASKT
#undef HALF_STEP
}
#undef ROW
#undef VMW
#undef SLOAD_H
#undef SWRITE_HK
#undef SWRITE_HV
#undef SWRITE_H
#undef KSWZ
#undef SBAR
}

constexpr int PH_PREP = 0, PH_IN1 = 1, PH_MIX1 = 2, PH_MIX2 = 3, PH_MIX3 = 4, PH_GATES = 5, PH_UPM = 6, PH_OUT = 7, PH_FFN = 8, PH_DOWN = 9, PH_PER_LAYER = 10;
#ifndef PROBE_K
#define PROBE_K -1
#define PROBE_L 0
#define PROBE_N 1
#define PROBE_SUB 15
#endif
struct Args { Inputs in; float* out; unsigned char* ws; int ph_lo, ph_hi, li, mixmask; };

__device__ __forceinline__ void fill_rstd(LAS float* tab, const float* rssp, int bx, int tid) {
#pragma unroll
    for (int j = 0; j < 4; ++j) { const int r = tid + 512 * j; const f32x4* p = (const f32x4*)(rssp + ((size_t)(bx & 7) * 2048 + r) * 16);
        const f32x4 a = p[0], b = p[1], c = p[2], d = p[3]; const f32x4 s = (a + b) + (c + d);
        tab[r] = rsqrtf(((s[0] + s[1]) + (s[2] + s[3])) * (1.f / D) + EPS); }
    __syncthreads();
}
__device__ __forceinline__ int fresh_tid(int wave0) { int ln; asm volatile("v_mbcnt_lo_u32_b32 %0, -1, 0\n\tv_mbcnt_hi_u32_b32 %0, -1, %0" : "=v"(ln)); return wave0 * 64 + ln; }
__global__ void __launch_bounds__(NWAVES * 64, 2) mega_fwd(Args args) {
    extern __shared__ __attribute__((aligned(16))) unsigned char lds[];
    LAS unsigned char* ldsp = (LAS unsigned char*)lds;
    volatile LAS unsigned* MISC = (volatile LAS unsigned*)(ldsp + MISC_OFF);
    const int tid = threadIdx.x; const int wave0 = __builtin_amdgcn_readfirstlane(tid >> 6);
    const int G = gridDim.x; const int bx = blockIdx.x; const int vcu = (G % 8 == 0) ? (bx % 8) * (G / 8) + bx / 8 : bx;
    unsigned char* ws = args.ws;
    float* out = args.out;
    for (int u = tid; u < (LDS_BYTES - LDSCTL_OFF) / 4; u += NWAVES * 64) ((LAS unsigned*)(ldsp + LDSCTL_OFF))[u] = 0u;
    __syncthreads();
    XcdBarrier bar = xcd_barrier_post((unsigned*)(ws + WS_CTL) + CW_BAR + args.li * XCD_BAR_WORDS, MISC + 8); bar.w0 = wave0;
    const int NGW = G * NWAVES;

    unsigned char* const ws0 = ws; float* const out0 = out; const int bx0 = bx;
    for (int ph = args.ph_lo; ph < args.ph_hi; ++ph) {
        const int l = ph / PH_PER_LAYER, k = ph % PH_PER_LAYER;
        size_t zoff = 0; int bx = bx0; asm volatile("" : "+s"(zoff), "+s"(bx)); unsigned char* ws = ws0 + zoff; float* out = out0 + zoff;
#define KARG(i) (*(const float* const __attribute__((address_space(4)))*)((const __attribute__((address_space(4))) char*)__builtin_amdgcn_kernarg_segment_ptr() + 8 * (i) + zoff))
#define LOAD_INPUTS(v) const __attribute__((address_space(4))) Inputs* v = (const __attribute__((address_space(4))) Inputs*)((const __attribute__((address_space(4))) char*)__builtin_amdgcn_kernarg_segment_ptr() + zoff)
        float* rssp = (float*)(ws + WS_RSSP);
        const int nrep = (k == PROBE_K && l == PROBE_L) ? PROBE_N : 1;
        for (int rep = 0; rep < nrep; ++rep) {
        const int mmask = rep == 0 ? args.mixmask : (args.mixmask & PROBE_SUB); const bool stf = (rep + 1 == nrep);
        if (k == PH_PREP) {
            const int tidl = fresh_tid(wave0), lane = tidl & 63, wave = wave0, gw = vcu * NWAVES + wave;
            LOAD_INPUTS(in);
            float* scr = (float*)(lds + wave * 16384);
            for (int it = gw; it < PREP_ITEMS; it += NGW) prep_item(in, l, ws + WS_W, it, scr, lane);
            if (l == 0) {
                for (int row = gw; row < M; row += NGW) {
                    const f32x4* xr = (const f32x4*)(in->x + (size_t)row * D) + lane; float s = 0.f;
                    unsigned long long* o8 = (unsigned long long*)((bf16_t*)(ws + WS_XB) + (size_t)row * D) + lane;
#pragma unroll
                    for (int j = 0; j < 4; ++j) { const f32x4 v = xr[64 * j]; s += (v.x * v.x + v.y * v.y) + (v.z * v.z + v.w * v.w);
                        o8[64 * j] = (unsigned long long)pk2(v.x, v.y) | ((unsigned long long)pk2(v.z, v.w) << 32); }
                    s = wave_sum_s(s); if (lane < 16) rssp[(size_t)row * 16 + lane] = (lane == 0) ? s : 0.f;
                }
            }
        } else if (k == PH_IN1) {
            const int tidl = fresh_tid(wave0);
            pg8::Gemm g{(const bf16_t*)(ws + WS_XB), (const bf16_t*)(ws + WS_W + W_IN), M, NIN1, D}; pg8::StaticOrder S; S.init(M, NIN1, G, bx);
            fill_rstd((LAS float*)(ldsp + RSTD_OFF), rssp, bx, tidl);
            pg8::EpiIn1 E{ws, (const LAS float*)(ldsp + RSTD_OFF), KARG(4) + l * 256};
            pg8::gemm_phase<pg8::EpiIn1, pg8::StaticOrder, true, true>(ldsp, g, S, E, tidl);
        } else if (k == PH_MIX1) {
            const int tidl = fresh_tid(wave0), lane = tidl & 63, wave = wave0;
            if (mmask & 2) for (int it = vcu; it < 256; it += G) mix::prepass_item(ws, KARG(8) + l * 128, KARG(9) + l * 128, it >> 5, (it >> 2) & 7, it & 3, (LAS float*)ldsp, tidl, lane, wave);
            if (mmask & 1) for (int it = vcu; it < 256; it += G) mix::pool_item(ws, KARG(7) + l * 512, it >> 2, it & 3, ldsp, tidl, lane, wave);
            if (mmask & 4) for (int it = vcu; it < 512; it += G) mix::gla_passA_pair(ws, it, ldsp, tidl, lane, wave);
        } else if (k == PH_MIX2) {
            const int tidl = fresh_tid(wave0);
            if (mmask & 4) for (int g0 = vcu * 512 + tidl; g0 < 32 * 4096; g0 += G * 512) mix::gla_scan(ws, g0);
            if (mmask & 8) for (int pr = vcu; pr < 256; pr += G) {
                const int bh = pr >> 3, b = bh >> 2, h = bh & 3, rh = pr & 1, a = (pr >> 1) & 3; const size_t r0 = (size_t)b * SEQ * 512 + h * 128;
#pragma unroll 1
                for (int half = 0; half < 2; ++half) { const int qb = half == 0 ? 7 - a : a; const size_t qoff = r0 + (size_t)(qb * 256 + rh * 128) * 512;
                    moba::BlockRef cur; cur.Q = (const bf16_t*)(ws + WS_MQ) + qoff; cur.O = (bf16_t*)(ws + (stf ? WS_YC : WS_US)) + qoff;
                    cur.K = (const bf16_t*)(ws + WS_MK) + r0; cur.V = (const bf16_t*)(ws + WS_MV) + r0; cur.km = (const float*)(ws + WS_KMEAN) + (size_t)bh * 8 * 128; cur.P0 = qb * 256 + rh * 128;
                    const int tl = fresh_tid(wave0);
                    moba::Seam S; moba::prime(cur, KARG(10), KARG(8) + l * 128, h, (char*)lds, S, tl); moba::block(cur, (char*)lds, S, tl); }
            }
        } else if (k == PH_MIX3) {
            const int tidl = fresh_tid(wave0), lane = tidl & 63, wave = wave0;
            if (mmask & 4) for (int it = vcu; it < 512; it += G) mix::gla_passC_pair(ws, KARG(5) + l * 128, it, ldsp, tidl, lane, wave, stf ? WS_YA : WS_US);
        } else if (k == PH_GATES) {
            const int tidl = fresh_tid(wave0);
            pg8::Gemm g{(const bf16_t*)(ws + WS_XB), (const bf16_t*)(ws + WS_W + W_IN) + (size_t)NIN1 * D, M, NGATE, D}; pg8::StaticOrder S; S.init(M, NGATE, G, bx);
            fill_rstd((LAS float*)(ldsp + RSTD_OFF), rssp, bx, tidl);
            pg8::EpiGates E{ws, (const LAS float*)(ldsp + RSTD_OFF)};
            pg8::gemm_phase<pg8::EpiGates, pg8::StaticOrder, true, true>(ldsp, g, S, E, tidl);
        } else if (k == PH_UPM) {
            const int tidl = fresh_tid(wave0);
            pg8::Gemm g{nullptr, nullptr, M, D, 512}; pg8::UpmOrder S; S.so.init(M, D, G, bx);
            S.Y0 = (const bf16_t*)(ws + WS_YA); S.Y1 = (const bf16_t*)(ws + WS_YB); S.Y2 = (const bf16_t*)(ws + WS_YC);
            S.W0 = (const bf16_t*)(ws + WS_W + W_UP); S.W1 = (const bf16_t*)(ws + WS_W + W_UP + MiB); S.W2 = (const bf16_t*)(ws + WS_W + W_UP + 2 * MiB);
            pg8::EpiUpm E{ws};
            pg8::gemm_phase<pg8::EpiUpm, pg8::UpmOrder, true, true>(ldsp, g, S, E, tidl);
        } else if (k == PH_OUT) {
            const int tidl = fresh_tid(wave0);
            pg8::Gemm g{(const bf16_t*)(ws + WS_MERGED2), (const bf16_t*)(ws + WS_W + W_OUT), M, D, D}; pg8::StaticOrder S; S.init(M, D, G, bx);
            pg8::EpiRes E{(const bf16_t*)(ws + WS_XB), nullptr, (bf16_t*)(ws + WS_X1B), rssp, stf};
            pg8::gemm_phase<pg8::EpiRes, pg8::StaticOrder, false, true>(ldsp, g, S, E, tidl);
        } else if (k == PH_FFN) {
            const int tidl = fresh_tid(wave0);
            pg8::Gemm g{(const bf16_t*)(ws + WS_X1B), (const bf16_t*)(ws + WS_W + W_GU), M, NGU, D}; pg8::StaticOrder S; S.init(M, NGU, G, bx);
            fill_rstd((LAS float*)(ldsp + RSTD_OFF), rssp, bx, tidl);
            pg8::EpiFfn E{(bf16_t*)(ws + WS_H), (const LAS float*)(ldsp + RSTD_OFF)};
            pg8::gemm_phase<pg8::EpiFfn, pg8::StaticOrder, true, true>(ldsp, g, S, E, tidl);
        } else if (k == PH_DOWN) {
            const int tidl = fresh_tid(wave0);
            pg8::Gemm g{(const bf16_t*)(ws + WS_H), (const bf16_t*)(ws + WS_W + W_DN), M, D, FF}; pg8::StaticOrder S; S.init(M, D, G, bx);
            pg8::EpiRes E{(const bf16_t*)(ws + WS_X1B), (l + 1 < DEPTH) ? nullptr : out, (l + 1 < DEPTH) ? (bf16_t*)(ws + WS_XB) : nullptr, (l + 1 < DEPTH) ? rssp : nullptr, stf};
            pg8::gemm_phase<pg8::EpiRes, pg8::StaticOrder, false, true>(ldsp, g, S, E, tidl);
        }
        if (rep + 1 < nrep) xcd_barrier(bar);
        }
        if (ph + 1 < args.ph_hi) xcd_barrier(bar);
    }
}

#ifndef MIXMASK
#define MIXMASK 15
#endif
static void launch_mega(const Args& a0, int lo, int hi, int li, int grid, hipStream_t stream) {
    Args a = a0; a.ph_lo = lo; a.ph_hi = hi; a.li = li;
    hipLaunchKernelGGL(mega_fwd, dim3(grid), dim3(NWAVES * 64), LDS_BYTES, stream, a);
}
extern "C" void kernel_launch(void* const* d_in, const int* in_sizes, int n_in, void* d_out, int out_size, void* d_ws, size_t ws_size, hipStream_t stream) {
    static int grid = 0;
    if (grid == 0) {
        if (n_in != 19 || out_size != M * D || ws_size < WS_END2) { fprintf(stderr, "kernel_launch: unexpected shapes (n_in %d out %d ws %zu)\n", n_in, out_size, ws_size); grid = -1; return; }
        int dev = 0, cus = 0;
        if (hipGetDevice(&dev) != hipSuccess || hipDeviceGetAttribute(&cus, hipDeviceAttributeMultiprocessorCount, dev) != hipSuccess) { grid = -1; return; }
        if (hipFuncSetAttribute((const void*)mega_fwd, hipFuncAttributeMaxDynamicSharedMemorySize, LDS_BYTES) != hipSuccess) { fprintf(stderr, "kernel_launch: hipFuncSetAttribute failed\n"); grid = -1; return; }
        int per_cu = 0; (void)hipOccupancyMaxActiveBlocksPerMultiprocessor(&per_cu, (const void*)mega_fwd, NWAVES * 64, LDS_BYTES); (void)hipGetLastError();
        if (per_cu < 1) fprintf(stderr, "kernel_launch: occupancy query reports %d blocks per CU\n", per_cu);
        grid = cus;
    }
    if (grid < 0) return;
    (void)hipMemsetAsync((char*)d_ws + WS_CTL, 0, CTL_BYTES, stream);
    Args a{}; { const float** ap = (const float**)&a.in; for (int i = 0; i < 19; ++i) ap[i] = (const float*)d_in[i]; }
    a.out = (float*)d_out; a.ws = (unsigned char*)d_ws;
    a.mixmask = 15;
    launch_mega(a, 0, DEPTH * PH_PER_LAYER, 0, grid, stream);
}
```
